# Optimizing an MI355X kernel written in HIP

```python
import math
import jax
import jax.numpy as jnp
from jax import lax
import numpy as np

D_MODEL = 1024
BATCH = 2
SEQ = 8192
DEPTH = 4
DEC_BATCH = 128
DEC_SEQ = 1
PAST_LEN = 8192
PAGE_SIZE = 128

D_MIX = D_MODEL
HEAD_DIM = 64
A_WIDTH = D_MIX // 4
A_HEADS = A_WIDTH // HEAD_DIM
A_DECAY_LORA = 64
A_AAA_LORA = 64
A_GATE_LORA = 128
A_PROJ = 3 * A_WIDTH + A_DECAY_LORA + A_AAA_LORA + A_GATE_LORA
B_WIDTH = D_MIX // 4
B_HEADS = B_WIDTH // HEAD_DIM
B_KV_HEADS = 2
B_GROUP = B_HEADS // B_KV_HEADS
B_PROJ = B_WIDTH + 2 * B_KV_HEADS * HEAD_DIM
WINDOW = 128
BLOCK = 128
C_WIDTH = D_MIX - A_WIDTH - B_WIDTH
C_HEADS = C_WIDTH // HEAD_DIM
C_GROUPS = 2
C_HPG = C_HEADS // C_GROUPS
D_STATE = 128
SSM_CONV = 4
CHUNK = 128
CONV_DIM = C_WIDTH + 2 * C_GROUPS * D_STATE
C_PROJ = C_WIDTH + CONV_DIM + C_HEADS
PROJ = A_PROJ + B_PROJ + C_PROJ
D_FF = ((8 * D_MODEL // 3 + 127) // 128) * 128
FFN_CONV = 3
NORM_EPS = 1e-6
GN_EPS = 64e-5

kernel_name = "hymba_rwkv7_swa_mamba2_convglu_step"

F32 = jnp.float32


def rms_norm(x, g):
    xf = x.astype(F32)
    y = xf * lax.rsqrt(jnp.mean(xf * xf, axis=-1, keepdims=True) + NORM_EPS)
    return (y * g.astype(F32)).astype(x.dtype)


def causal_dwconv(u, buf, w, b):
    k_w = w.shape[0]
    t = u.shape[1]
    full = jnp.concatenate([buf.astype(u.dtype), u], axis=1)
    y = b
    for j in range(k_w):
        y = y + full[:, j:j + t] * w[j]
    return y, full[:, t:]


def rwkv7_mixer(pa, shift_prev, wkv0, lp):
    n, t, _ = pa.shape
    prev = jnp.concatenate([shift_prev[:, None].astype(pa.dtype), pa[:, :-1]], axis=1)
    xs = pa + (prev - pa) * lp['rwkv_mu']
    cuts = [A_WIDTH, 2 * A_WIDTH, 3 * A_WIDTH, 3 * A_WIDTH + A_DECAY_LORA,
            3 * A_WIDTH + A_DECAY_LORA + A_AAA_LORA]
    r, k, v, lw, la, lg = jnp.split(xs, cuts, axis=-1)
    w_log = -jax.nn.softplus(-(lp['rwkv_w0'] + jnp.tanh(lw) @ lp['rwkv_w2'])) - 0.5
    a = jax.nn.sigmoid(lp['rwkv_a0'] + la @ lp['rwkv_a2'])
    g = jax.nn.sigmoid(lg) @ lp['rwkv_g2']

    def heads(z):
        return z.reshape(n, t, A_HEADS, HEAD_DIM).astype(F32)

    kk = heads(k * lp['rwkv_k_k'])
    kk = kk / jnp.maximum(jnp.sqrt(jnp.sum(kk * kk, axis=-1, keepdims=True)), 1e-12)
    k = k * (1 + (a - 1) * lp['rwkv_k_a'])
    rh, kh, vh, ah = heads(r), heads(k), heads(v), heads(a)
    decay = jnp.exp(-jnp.exp(heads(w_log)))

    def step(s, inp):
        r_t, k_t, v_t, d_t, a_t, b_t = inp
        sa = jnp.einsum('nhvk,nhk->nhv', s, a_t)
        s = s * d_t[:, :, None, :] + sa[..., None] * b_t[:, :, None, :] + v_t[..., None] * k_t[:, :, None, :]
        return s, jnp.einsum('nhvk,nhk->nhv', s, r_t)

    def tm(z):
        return jnp.moveaxis(z, 1, 0)

    s_fin, y = lax.scan(step, wkv0.astype(F32),
                        (tm(rh), tm(kh), tm(vh), tm(decay), tm(-kk), tm(kk * ah)))
    y = jnp.moveaxis(y, 0, 1)
    mean = jnp.mean(y, axis=-1, keepdims=True)
    var = jnp.mean(jnp.square(y - mean), axis=-1, keepdims=True)
    y = ((y - mean) * lax.rsqrt(var + GN_EPS)).reshape(n, t, A_WIDTH)
    y = y * lp['rwkv_ln_g'].astype(F32) + lp['rwkv_ln_b'].astype(F32)
    bonus = jnp.sum(rh * kh * lp['rwkv_r_k'].astype(F32), axis=-1, keepdims=True) * vh
    y = (y + bonus.reshape(n, t, A_WIDTH)) * g.astype(F32)
    return y.astype(pa.dtype), pa[:, -1], s_fin.astype(wkv0.dtype)


def sink_weights(s, mask, sinks):
    sink = sinks.astype(F32).reshape(B_KV_HEADS, B_GROUP, 1, 1)
    s = jnp.where(mask, s, -jnp.inf)
    m = jnp.maximum(jnp.max(s, axis=-1, keepdims=True), sink)
    p = jnp.exp(s - m)
    return p / (jnp.sum(p, axis=-1, keepdims=True) + jnp.exp(sink - m))


def swa_mixer(pb, cache_k, cache_v, lp, decode):
    n, t, _ = pb.shape
    q, k, v = jnp.split(pb, [B_WIDTH, B_WIDTH + B_KV_HEADS * HEAD_DIM], axis=-1)
    q = rms_norm(q.reshape(n, t, B_KV_HEADS, B_GROUP, HEAD_DIM), lp['attn_q_norm_g'])
    k = rms_norm(k.reshape(n, t, B_KV_HEADS, HEAD_DIM), lp['attn_k_norm_g'])
    v = v.reshape(n, t, B_KV_HEADS, HEAD_DIM)
    scale = HEAD_DIM ** -0.5
    if decode:
        kf = jnp.concatenate([cache_k.astype(k.dtype), k], axis=1)
        vf = jnp.concatenate([cache_v.astype(v.dtype), v], axis=1)
        s = jnp.einsum('ntkgd,nskd->nkgts', q, kf, preferred_element_type=F32) * scale
        rel = jnp.arange(t)[:, None] + WINDOW - jnp.arange(WINDOW + t)[None, :]
        p = sink_weights(s, (rel >= 0) & (rel <= WINDOW), lp['attn_sinks'])
        o = jnp.einsum('nkgts,nskd->ntkgd', p, vf.astype(F32))
        new_k, new_v = kf[:, t:], vf[:, t:]
    else:
        nb = t // BLOCK
        qb = q.reshape(n, nb, BLOCK, B_KV_HEADS, B_GROUP, HEAD_DIM)
        kb = k.reshape(n, nb, BLOCK, B_KV_HEADS, HEAD_DIM)
        vb = v.reshape(n, nb, BLOCK, B_KV_HEADS, HEAD_DIM)

        def with_prev(z):
            zp = jnp.pad(z, ((0, 0), (1, 0), (0, 0), (0, 0), (0, 0)))[:, :-1]
            return jnp.concatenate([zp, z], axis=2)

        kc, vc = with_prev(kb), with_prev(vb)
        s = jnp.einsum('nbqkgd,nbskd->nbkgqs', qb, kc, preferred_element_type=F32) * scale
        rel = jnp.arange(BLOCK)[:, None] + BLOCK - jnp.arange(2 * BLOCK)[None, :]
        band = (rel >= 0) & (rel <= WINDOW)
        has_prev = (jnp.arange(nb)[:, None, None] > 0) | (jnp.arange(2 * BLOCK) >= BLOCK)[None, None, :]
        mask = (band[None] & has_prev)[None, :, None, None]
        p = sink_weights(s, mask, lp['attn_sinks'])
        o = jnp.einsum('nbkgqs,nbskd->nbqkgd', p, vc.astype(F32))
        new_k, new_v = k[:, -WINDOW:], v[:, -WINDOW:]
    return o.reshape(n, t, B_WIDTH).astype(pb.dtype), new_k, new_v


def ssd_chunked(xdt, da, bm, cm, h0):
    n, t = xdt.shape[:2]
    nc = t // CHUNK
    x = xdt.reshape(n, nc, CHUNK, C_GROUPS, C_HPG, HEAD_DIM)
    acum = jnp.cumsum(da.reshape(n, nc, CHUNK, C_GROUPS, C_HPG), axis=2)
    b = bm.reshape(n, nc, CHUNK, C_GROUPS, D_STATE)
    c = cm.reshape(n, nc, CHUNK, C_GROUPS, D_STATE)
    causal = jnp.tril(jnp.ones((CHUNK, CHUNK), dtype=bool))[:, :, None, None]
    seg = acum[:, :, :, None] - acum[:, :, None, :]
    lmat = jnp.exp(jnp.where(causal, seg, -jnp.inf))
    cb = jnp.einsum('nclgd,ncmgd->nclmg', c, b)
    y_diag = jnp.einsum('nclmg,nclmge,ncmgep->nclgep', cb, lmat, x)
    decay_to_end = jnp.exp(acum[:, :, -1:] - acum)
    states = jnp.einsum('ncmgd,ncmge,ncmgep->ncgepd', b, decay_to_end, x)
    chunk_decay = jnp.exp(acum[:, :, -1])

    def step(h, inp):
        st, dec = inp
        return h * dec[..., None, None] + st, h

    h_init = h0.reshape(n, C_GROUPS, C_HPG, HEAD_DIM, D_STATE)
    h_fin, h_prev = lax.scan(step, h_init, (jnp.moveaxis(states, 1, 0), jnp.moveaxis(chunk_decay, 1, 0)))
    h_prev = jnp.moveaxis(h_prev, 0, 1)
    y_off = jnp.einsum('nclgd,ncgepd,nclge->nclgep', c, h_prev, jnp.exp(acum))
    y = (y_diag + y_off).reshape(n, t, C_HEADS, HEAD_DIM)
    return y, h_fin.reshape(n, C_HEADS, HEAD_DIM, D_STATE)


def ssd_recurrent(xdt, da, bm, cm, h0):
    bh = jnp.repeat(bm, C_HPG, axis=2)
    ch = jnp.repeat(cm, C_HPG, axis=2)

    def step(h, inp):
        x_t, a_t, b_t, c_t = inp
        h = h * jnp.exp(a_t)[..., None, None] + x_t[..., None] * b_t[:, :, None, :]
        return h, jnp.einsum('nhpd,nhd->nhp', h, c_t)

    h_fin, y = lax.scan(step, h0, (jnp.moveaxis(xdt, 1, 0), jnp.moveaxis(da, 1, 0),
                                   jnp.moveaxis(bh, 1, 0), jnp.moveaxis(ch, 1, 0)))
    return jnp.moveaxis(y, 0, 1), h_fin


def mamba2_mixer(pc, conv_buf, h0, lp, decode):
    n, t, _ = pc.shape
    z, xbc, dt = jnp.split(pc, [C_WIDTH, C_WIDTH + CONV_DIM], axis=-1)
    xbc, new_buf = causal_dwconv(xbc, conv_buf, lp['ssm_conv_w'], lp['ssm_conv_b'])
    xbc = jax.nn.silu(xbc)
    x, bm, cm = jnp.split(xbc, [C_WIDTH, C_WIDTH + C_GROUPS * D_STATE], axis=-1)
    x = x.reshape(n, t, C_HEADS, HEAD_DIM).astype(F32)
    bm = bm.reshape(n, t, C_GROUPS, D_STATE).astype(F32)
    cm = cm.reshape(n, t, C_GROUPS, D_STATE).astype(F32)
    dt = jax.nn.softplus(dt.astype(F32) + lp['ssm_dt_bias'].astype(F32))
    a = -jnp.exp(lp['ssm_a_log'].astype(F32))
    ssd = ssd_recurrent if decode else ssd_chunked
    y, h_fin = ssd(x * dt[..., None], dt * a, bm, cm, h0.astype(F32))
    y = (y + lp['ssm_d'].astype(F32)[:, None] * x).reshape(n, t, C_WIDTH)
    y = rms_norm(y * jax.nn.silu(z.astype(F32)), lp['ssm_norm_g'])
    return y.astype(pc.dtype), new_buf, h_fin.astype(h0.dtype)


def conv_glu(h, buf, lp):
    gate, val = jnp.split(h @ lp['ffn_w_up'], 2, axis=-1)
    gate, new_buf = causal_dwconv(gate, buf, lp['ffn_conv_w'], lp['ffn_conv_b'])
    return (jax.nn.silu(gate) * val) @ lp['ffn_w_down'], new_buf


def trunk_layer(x, c, shift_prev, wkv0, swa_k, swa_v, ssm_conv_buf, ssm_h0, ffn_buf, lp, decode):
    mod = jax.nn.silu(c) @ lp['ada_w'] + lp['ada_b']
    sh1, sc1, g1, sh2, sc2, g2 = jnp.split(mod[:, None, :], 6, axis=-1)
    h = rms_norm(x, lp['norm_mix_g']) * (1 + sc1) + sh1
    pa, pb, pc = jnp.split(h @ lp['w_in'], [A_PROJ, A_PROJ + B_PROJ], axis=-1)
    ya, new_shift, new_wkv = rwkv7_mixer(pa, shift_prev, wkv0, lp)
    yb, new_k, new_v = swa_mixer(pb, swa_k, swa_v, lp, decode)
    yc, new_conv, new_ssm = mamba2_mixer(pc, ssm_conv_buf, ssm_h0, lp, decode)
    x = x + g1 * (jnp.concatenate([ya, yb, yc], axis=-1) @ lp['w_out'])
    h = rms_norm(x, lp['norm_ffn_g']) * (1 + sc2) + sh2
    f, new_ffn = conv_glu(h, ffn_buf, lp)
    x = x + g2 * f
    return x, (new_shift, new_wkv, new_k, new_v, new_conv, new_ssm, new_ffn)


def setup_inputs(seed: int = 0) -> dict:
    key = jax.random.key(seed)
    ks = iter(jax.random.split(key, 64))

    def nrm(shape, s=1.0):
        return s * jax.random.normal(next(ks), shape, F32)

    def uni(shape, lo, hi):
        return jax.random.uniform(next(ks), shape, F32, lo, hi)

    L = DEPTH
    dt0 = jnp.exp(uni((L, C_HEADS), math.log(1e-3), math.log(1e-1)))
    return {
        'x_prompt': nrm((BATCH, SEQ, D_MODEL)),
        'x_sample': nrm((DEC_BATCH, DEC_SEQ, D_MODEL)),
        'c_prompt': nrm((BATCH, D_MODEL)),
        'c_sample': nrm((DEC_BATCH, D_MODEL)),
        'state_rwkv_shift': nrm((L, DEC_BATCH, A_PROJ)),
        'state_rwkv_wkv': nrm((L, DEC_BATCH, A_HEADS, HEAD_DIM, HEAD_DIM), 0.3),
        'cache_swa_k': nrm((L, DEC_BATCH, WINDOW, B_KV_HEADS, HEAD_DIM)),
        'cache_swa_v': nrm((L, DEC_BATCH, WINDOW, B_KV_HEADS, HEAD_DIM)),
        'state_ssm_conv': nrm((L, DEC_BATCH, SSM_CONV - 1, CONV_DIM)),
        'state_ssm': nrm((L, DEC_BATCH, C_HEADS, HEAD_DIM, D_STATE), 0.1),
        'state_ffn_conv': nrm((L, DEC_BATCH, FFN_CONV - 1, D_FF)),
        'ada_w': nrm((L, D_MODEL, 6 * D_MODEL), D_MODEL ** -0.5),
        'ada_b': nrm((L, 6 * D_MODEL), 0.02),
        'norm_mix_g': 1.0 + nrm((L, D_MODEL), 0.02),
        'norm_ffn_g': 1.0 + nrm((L, D_MODEL), 0.02),
        'w_in': nrm((L, D_MODEL, PROJ), D_MODEL ** -0.5),
        'w_out': nrm((L, D_MIX, D_MODEL), D_MIX ** -0.5),
        'rwkv_mu': uni((L, A_PROJ), 0.0, 1.0),
        'rwkv_w0': uni((L, A_WIDTH), -6.5, -1.5),
        'rwkv_w2': nrm((L, A_DECAY_LORA, A_WIDTH), 0.1 * A_DECAY_LORA ** -0.5),
        'rwkv_a0': nrm((L, A_WIDTH), 0.1),
        'rwkv_a2': nrm((L, A_AAA_LORA, A_WIDTH), 0.5 * A_AAA_LORA ** -0.5),
        'rwkv_g2': nrm((L, A_GATE_LORA, A_WIDTH), A_GATE_LORA ** -0.5),
        'rwkv_k_k': 0.85 + nrm((L, A_WIDTH), 0.05),
        'rwkv_k_a': 1.0 + nrm((L, A_WIDTH), 0.05),
        'rwkv_r_k': nrm((L, A_HEADS, HEAD_DIM), 0.1),
        'rwkv_ln_g': 1.0 + nrm((L, A_WIDTH), 0.02),
        'rwkv_ln_b': nrm((L, A_WIDTH), 0.02),
        'attn_q_norm_g': 1.0 + nrm((L, HEAD_DIM), 0.02),
        'attn_k_norm_g': 1.0 + nrm((L, HEAD_DIM), 0.02),
        'attn_sinks': nrm((L, B_HEADS), 0.5),
        'ssm_conv_w': nrm((L, SSM_CONV, CONV_DIM), SSM_CONV ** -0.5),
        'ssm_conv_b': nrm((L, CONV_DIM), 0.02),
        'ssm_dt_bias': dt0 + jnp.log(-jnp.expm1(-dt0)),
        'ssm_a_log': jnp.log(uni((L, C_HEADS), 1.0, 16.0)),
        'ssm_d': 1.0 + nrm((L, C_HEADS), 0.02),
        'ssm_norm_g': 1.0 + nrm((L, C_WIDTH), 0.02),
        'ffn_w_up': nrm((L, D_MODEL, 2 * D_FF), D_MODEL ** -0.5),
        'ffn_conv_w': nrm((L, FFN_CONV, D_FF), FFN_CONV ** -0.5),
        'ffn_conv_b': nrm((L, D_FF), 0.02),
        'ffn_w_down': nrm((L, D_FF, D_MODEL), D_FF ** -0.5),
    }


def reference(x_prompt, x_sample, c_prompt, c_sample,
              state_rwkv_shift, state_rwkv_wkv, cache_swa_k, cache_swa_v,
              state_ssm_conv, state_ssm, state_ffn_conv,
              ada_w, ada_b, norm_mix_g, norm_ffn_g, w_in, w_out,
              rwkv_mu, rwkv_w0, rwkv_w2, rwkv_a0, rwkv_a2, rwkv_g2,
              rwkv_k_k, rwkv_k_a, rwkv_r_k, rwkv_ln_g, rwkv_ln_b,
              attn_q_norm_g, attn_k_norm_g, attn_sinks,
              ssm_conv_w, ssm_conv_b, ssm_dt_bias, ssm_a_log, ssm_d, ssm_norm_g,
              ffn_w_up, ffn_conv_w, ffn_conv_b, ffn_w_down):
    nb = x_prompt.shape[0]
    fdt = x_prompt.dtype
    zp_shift = jnp.zeros((nb, A_PROJ), fdt)
    zp_wkv = jnp.zeros((nb, A_HEADS, HEAD_DIM, HEAD_DIM), F32)
    zp_sconv = jnp.zeros((nb, SSM_CONV - 1, CONV_DIM), fdt)
    zp_ssm = jnp.zeros((nb, C_HEADS, HEAD_DIM, D_STATE), F32)
    zp_ffn = jnp.zeros((nb, FFN_CONV - 1, D_FF), fdt)
    prompt_new = [[] for _ in range(7)]
    sample_new = [[] for _ in range(7)]
    yp, ys = x_prompt, x_sample
    for i in range(DEPTH):
        lp = {
            'ada_w': ada_w[i], 'ada_b': ada_b[i], 'norm_mix_g': norm_mix_g[i], 'norm_ffn_g': norm_ffn_g[i],
            'w_in': w_in[i], 'w_out': w_out[i],
            'rwkv_mu': rwkv_mu[i], 'rwkv_w0': rwkv_w0[i], 'rwkv_w2': rwkv_w2[i], 'rwkv_a0': rwkv_a0[i],
            'rwkv_a2': rwkv_a2[i], 'rwkv_g2': rwkv_g2[i], 'rwkv_k_k': rwkv_k_k[i], 'rwkv_k_a': rwkv_k_a[i],
            'rwkv_r_k': rwkv_r_k[i], 'rwkv_ln_g': rwkv_ln_g[i], 'rwkv_ln_b': rwkv_ln_b[i],
            'attn_q_norm_g': attn_q_norm_g[i], 'attn_k_norm_g': attn_k_norm_g[i], 'attn_sinks': attn_sinks[i],
            'ssm_conv_w': ssm_conv_w[i], 'ssm_conv_b': ssm_conv_b[i], 'ssm_dt_bias': ssm_dt_bias[i],
            'ssm_a_log': ssm_a_log[i], 'ssm_d': ssm_d[i], 'ssm_norm_g': ssm_norm_g[i],
            'ffn_w_up': ffn_w_up[i], 'ffn_conv_w': ffn_conv_w[i], 'ffn_conv_b': ffn_conv_b[i],
            'ffn_w_down': ffn_w_down[i],
        }
        yp, new_p = trunk_layer(yp, c_prompt, zp_shift, zp_wkv, None, None, zp_sconv, zp_ssm, zp_ffn,
                                lp, False)
        ys, new_s = trunk_layer(ys, c_sample, state_rwkv_shift[i], state_rwkv_wkv[i], cache_swa_k[i],
                                cache_swa_v[i], state_ssm_conv[i], state_ssm[i], state_ffn_conv[i], lp, True)
        for lst, arr in zip(prompt_new, new_p):
            lst.append(arr)
        for lst, arr in zip(sample_new, new_s):
            lst.append(arr)
    p_shift, p_wkv, p_k, p_v, p_conv, p_ssm, p_ffn = [jnp.stack(l) for l in prompt_new]
    s_shift, s_wkv, s_k, s_v, s_conv, s_ssm, s_ffn = [jnp.stack(l) for l in sample_new]
    return (yp, ys, p_shift, p_wkv, p_k, p_v, p_conv, p_ssm, p_ffn,
            s_shift, s_wkv, s_k, s_v, s_conv, s_ssm, s_ffn)
```

```cpp
#include <hip/hip_runtime.h>
#include <cstdint>
#include <cstdio>

typedef unsigned short bf16_t;
__device__ __forceinline__ float bf2f(bf16_t v) { return __uint_as_float(((unsigned)v) << 16); }
__device__ __forceinline__ bf16_t f2bf(float f) { unsigned u = __float_as_uint(f); return (bf16_t)((u + 0x7fffu + ((u >> 16) & 1u)) >> 16); }

constexpr int D = 1024, NP = 2, T = 8192, MP = NP * T, NS = 128, R = MP + NS, NSEQ = NP + NS, L = 4;
constexpr int PROJ = 3080, PCOLS = 3072, DFF = 2816;
constexpr int OFF_B = 1024, OFF_Z = 1536, OFF_XBC = 2048;
constexpr float NORM_EPS = 1e-6f, GN_EPS = 64e-5f;
constexpr int NTHREADS = 512, NWAVES = 8;

enum { I_XP = 0, I_XS, I_CP, I_CS, I_SHIFT, I_WKV, I_CK, I_CV, I_SCONV, I_SSM, I_FCONV, I_ADAW, I_ADAB, I_NMIXG, I_NFFNG, I_WIN, I_WOUT,
       I_MU, I_W0, I_W2, I_A0, I_A2, I_G2, I_KK, I_KA, I_RK, I_LNG, I_LNB, I_QNG, I_KNG, I_SINK, I_CONVW, I_CONVB, I_DTB, I_ALOG, I_SSMD, I_SSMNG,
       I_WUP, I_FCW, I_FCB, I_WDOWN, N_IN };

constexpr size_t O_YP = 0;
constexpr size_t O_YS = O_YP + (size_t)MP * D;
constexpr size_t O_PSHIFT = O_YS + (size_t)NS * D;
constexpr size_t O_PWKV = O_PSHIFT + (size_t)L * NP * 1024;
constexpr size_t O_PK = O_PWKV + (size_t)L * NP * 4 * 64 * 64;
constexpr size_t O_PV = O_PK + (size_t)L * NP * 128 * 128;
constexpr size_t O_PCONV = O_PV + (size_t)L * NP * 128 * 128;
constexpr size_t O_PSSM = O_PCONV + (size_t)L * NP * 3 * 1024;
constexpr size_t O_PFFN = O_PSSM + (size_t)L * NP * 8 * 64 * 128;
constexpr size_t O_SSHIFT = O_PFFN + (size_t)L * NP * 2 * DFF;
constexpr size_t O_SWKV = O_SSHIFT + (size_t)L * NS * 1024;
constexpr size_t O_SK = O_SWKV + (size_t)L * NS * 4 * 64 * 64;
constexpr size_t O_SV = O_SK + (size_t)L * NS * 128 * 128;
constexpr size_t O_SCONV = O_SV + (size_t)L * NS * 128 * 128;
constexpr size_t O_SSSM = O_SCONV + (size_t)L * NS * 3 * 1024;
constexpr size_t O_SFFN = O_SSSM + (size_t)L * NS * 8 * 64 * 128;
constexpr size_t O_END = O_SFFN + (size_t)L * NS * 2 * DFF;

constexpr size_t MiB = 1u << 20;
constexpr int MPAD = 16640;
constexpr size_t WS_X = 0;
constexpr size_t WS_H = 65 * MiB;
constexpr size_t WS_MOD = 98 * MiB;
constexpr size_t WS_P = 111 * MiB;
constexpr size_t WS_DT = 209 * MiB;
constexpr size_t WS_YCAT = 210 * MiB;
constexpr size_t WS_GV = 243 * MiB;
constexpr size_t WS_U = 422 * MiB;
constexpr size_t WS_END = 512 * MiB;
constexpr size_t WS_RW = WS_GV;
constexpr size_t WS_QN = WS_RW + 113 * MiB;
constexpr size_t WS_KN = WS_QN + 17 * MiB;
constexpr size_t WS_YTMP = WS_KN + 9 * MiB;
static_assert(WS_YTMP + (size_t)R * 512 * 4 <= WS_U, "mixer temporaries fit the GV region");
constexpr size_t WS_XBCC = WS_U;
static_assert(WS_XBCC + (size_t)R * 1024 * 4 <= WS_END, "xbc fits the U region");

struct Params {
    const float* in[N_IN];
    float* out;
    unsigned char* ws;
};

__device__ __forceinline__ int seq_of_row(int row) { return row < MP ? (row >> 13) : (NP + row - MP); }
__device__ __forceinline__ float wave_sum(float v) {
#pragma unroll
    for (int o = 1; o < 64; o <<= 1) v += __shfl_xor(v, o);
    return v;
}
__device__ __forceinline__ float wave_max(float v) {
#pragma unroll
    for (int o = 1; o < 64; o <<= 1) v = fmaxf(v, __shfl_xor(v, o));
    return v;
}
__device__ __forceinline__ float silu_f(float x) { return x / (1.f + __expf(-x)); }
__device__ __forceinline__ float sigmoid_f(float x) { return 1.f / (1.f + __expf(-x)); }
__device__ __forceinline__ float softplus_f(float x) { return fmaxf(x, 0.f) + log1pf(__expf(-fabsf(x))); }

__device__ __forceinline__ void stage_init(const Params& p) {
    const size_t gt = (size_t)blockIdx.x * NTHREADS + threadIdx.x, GT = (size_t)gridDim.x * NTHREADS;
    float* X = (float*)(p.ws + WS_X);
    for (size_t i = gt; i < (size_t)R * D; i += GT) X[i] = i < (size_t)MP * D ? p.in[I_XP][i] : p.in[I_XS][i - (size_t)MP * D];
    float* MOD = (float*)(p.ws + WS_MOD);
    for (size_t i = gt; i < (size_t)L * NSEQ * 6144; i += GT) {
        const int j = (int)(i % 6144), s = (int)((i / 6144) % NSEQ), l = (int)(i / ((size_t)6144 * NSEQ));
        const float* c = s < NP ? p.in[I_CP] + (size_t)s * D : p.in[I_CS] + (size_t)(s - NP) * D;
        const float* w = p.in[I_ADAW] + (size_t)l * D * 6144 + j;
        float acc = p.in[I_ADAB][(size_t)l * 6144 + j];
        for (int k = 0; k < D; ++k) acc += silu_f(c[k]) * w[(size_t)k * 6144];
        MOD[i] = acc;
    }
}

__device__ __forceinline__ void stage_norm(const Params& p, int l, int which) {
    const int lane = threadIdx.x & 63, gw = blockIdx.x * NWAVES + (threadIdx.x >> 6), GW = gridDim.x * NWAVES;
    const float* X = (const float*)(p.ws + WS_X);
    bf16_t* H = (bf16_t*)(p.ws + WS_H);
    const float* MOD = (const float*)(p.ws + WS_MOD);
    const float* g = p.in[which ? I_NFFNG : I_NMIXG] + (size_t)l * D;
    for (int row = gw; row < R; row += GW) {
        const float* x = X + (size_t)row * D;
        const float* md = MOD + ((size_t)l * NSEQ + seq_of_row(row)) * 6144 + which * 3072;
        float v[16]; float ss = 0.f;
#pragma unroll
        for (int j = 0; j < 16; ++j) { v[j] = x[lane + 64 * j]; ss += v[j] * v[j]; }
        ss = wave_sum(ss);
        const float rstd = rsqrtf(ss * (1.f / D) + NORM_EPS);
#pragma unroll
        for (int j = 0; j < 16; ++j) { const int c = lane + 64 * j; H[(size_t)row * D + c] = f2bf(v[j] * rstd * g[c] * (1.f + md[1024 + c]) + md[c]); }
    }
}

template <class Epi>
__device__ __forceinline__ void gemm_naive(const bf16_t* A, int lda, const float* W, int M, int N, int K, const Epi& epi, float* lds) {
    float* As = lds;
    float* Bs = lds + 16 * 132;
    const int tid = threadIdx.x, ty = tid >> 4, tx = tid & 15;
    const int ntm = M / 128, ntn = (N + 127) / 128;
    for (int tile = blockIdx.x; tile < ntm * ntn; tile += gridDim.x) {
        const int tm = tile % ntm, tn = tile / ntm, m0 = tm * 128, n0 = tn * 128;
        float acc[4][8];
#pragma unroll
        for (int i = 0; i < 4; ++i)
#pragma unroll
            for (int j = 0; j < 8; ++j) acc[i][j] = 0.f;
        for (int k0 = 0; k0 < K; k0 += 16) {
            __syncthreads();
            {
                const int r = tid >> 2, kq = (tid & 3) * 4;
                const bf16_t* a = A + (size_t)(m0 + r) * lda + k0 + kq;
#pragma unroll
                for (int i = 0; i < 4; ++i) As[(kq + i) * 132 + r] = bf2f(a[i]);
                const int kk = tid >> 5, nq = (tid & 31) * 4;
#pragma unroll
                for (int i = 0; i < 4; ++i) { const int n = n0 + nq + i; Bs[kk * 128 + nq + i] = n < N ? W[(size_t)(k0 + kk) * N + n] : 0.f; }
            }
            __syncthreads();
#pragma unroll
            for (int k = 0; k < 16; ++k) {
                float a[4], b[8];
#pragma unroll
                for (int i = 0; i < 4; ++i) a[i] = As[k * 132 + ty * 4 + i];
#pragma unroll
                for (int j = 0; j < 8; ++j) b[j] = Bs[k * 128 + tx * 8 + j];
#pragma unroll
                for (int i = 0; i < 4; ++i)
#pragma unroll
                    for (int j = 0; j < 8; ++j) acc[i][j] += a[i] * b[j];
            }
        }
#pragma unroll
        for (int i = 0; i < 4; ++i)
#pragma unroll
            for (int j = 0; j < 8; ++j) { const int row = m0 + ty * 4 + i, col = n0 + tx * 8 + j; if (col < N) epi(row, col, acc[i][j]); }
    }
}
struct EpiP { bf16_t* P; float* DT; __device__ void operator()(int row, int col, float v) const { if (col < PCOLS) P[(size_t)row * PCOLS + col] = f2bf(v); else DT[(size_t)row * 8 + col - PCOLS] = v; } };
struct EpiBf { bf16_t* O; int ldc; __device__ void operator()(int row, int col, float v) const { O[(size_t)row * ldc + col] = f2bf(v); } };
struct EpiRes { float* X; const float* gate;   __device__ void operator()(int row, int col, float v) const { X[(size_t)row * D + col] += gate[(size_t)seq_of_row(row) * 6144 + col] * v; } };

__device__ __forceinline__ void stage_rwprep(const Params& p, int l, float* lds) {
    const bf16_t* P = (const bf16_t*)(p.ws + WS_P);
    float* RW = (float*)(p.ws + WS_RW);
    float* xs = lds; float* kk = lds + 1024;
    const int tid = threadIdx.x;
    const float* mu = p.in[I_MU] + (size_t)l * 1024;
    for (int row = blockIdx.x; row < R; row += gridDim.x) {
        const bool samp = row >= MP; const int n = samp ? row - MP : row >> 13, t = samp ? 0 : (row & (T - 1));
        __syncthreads();
        for (int c = tid; c < 1024; c += NTHREADS) {
            const float pa = bf2f(P[(size_t)row * PCOLS + c]);
            float prev;
            if (t > 0) prev = bf2f(P[(size_t)(row - 1) * PCOLS + c]);
            else prev = samp ? p.in[I_SHIFT][((size_t)l * NS + n) * 1024 + c] : 0.f;
            float v = pa + (prev - pa) * mu[c];
            if (c >= 768 && c < 832) v = tanhf(v);
            if (c >= 896) v = sigmoid_f(v);
            xs[c] = v;
            if (samp) p.out[O_SSHIFT + ((size_t)l * NS + n) * 1024 + c] = pa;
            else if (t == T - 1) p.out[O_PSHIFT + ((size_t)l * NP + n) * 1024 + c] = pa;
        }
        __syncthreads();
        float av = 0.f, gv = 0.f, dec = 0.f, kraw = 0.f;
        if (tid < 256) {
            const int j = tid;
            float wl = p.in[I_W0][(size_t)l * 256 + j], al = p.in[I_A0][(size_t)l * 256 + j]; gv = 0.f;
            const float* w2 = p.in[I_W2] + (size_t)l * 64 * 256 + j; const float* a2 = p.in[I_A2] + (size_t)l * 64 * 256 + j; const float* g2 = p.in[I_G2] + (size_t)l * 128 * 256 + j;
#pragma unroll 4
            for (int i = 0; i < 64; ++i) { wl += xs[768 + i] * w2[i * 256]; al += xs[832 + i] * a2[i * 256]; }
#pragma unroll 4
            for (int i = 0; i < 128; ++i) gv += xs[896 + i] * g2[i * 256];
            const float w_log = -softplus_f(-wl) - 0.5f;
            dec = __expf(-__expf(w_log));
            av = sigmoid_f(al);
            kraw = xs[256 + j];
            kk[j] = kraw * p.in[I_KK][(size_t)l * 256 + j];
        }
        __syncthreads();
        if (tid < 256) {
            const int j = tid, h0 = j & ~63;
            float s = 0.f;
#pragma unroll 4
            for (int i = 0; i < 64; ++i) s += kk[h0 + i] * kk[h0 + i];
            const float kkn = kk[j] / fmaxf(sqrtf(s), 1e-12f);
            const float kmod = kraw * (1.f + (av - 1.f) * p.in[I_KA][(size_t)l * 256 + j]);
            float* rw = RW + (size_t)row * 7 * 256 + j;
            rw[0] = xs[j]; rw[256] = kmod; rw[512] = xs[512 + j]; rw[768] = dec; rw[1024] = -kkn; rw[1280] = kkn * av; rw[1536] = gv;
        }
    }
}

#define WAVE_LDS_SYNC() do { asm volatile("s_waitcnt lgkmcnt(0)" ::: "memory"); __builtin_amdgcn_wave_barrier(); } while (0)
__device__ __forceinline__ void stage_rwscan(const Params& p, int l, float* lds) {
    const int lane = threadIdx.x & 63, wave = threadIdx.x >> 6;
    const float* RW = (const float*)(p.ws + WS_RW);
    bf16_t* Y = (bf16_t*)(p.ws + WS_YCAT);
    float* wl = lds + wave * 512;
    for (int u = blockIdx.x + gridDim.x * wave; u < NSEQ * 4; u += gridDim.x * NWAVES) {
        const int s = u >> 2, h = u & 3; const bool samp = s >= NP; const int n = samp ? s - NP : s;
        const int row0 = samp ? MP + n : n * T, nt = samp ? 1 : T;
        float S[64];
        if (samp) { const float* st = p.in[I_WKV] + ((((size_t)l * NS + n) * 4 + h) * 64 + lane) * 64;
#pragma unroll
            for (int k = 0; k < 64; ++k) S[k] = st[k]; }
        else {
#pragma unroll
            for (int k = 0; k < 64; ++k) S[k] = 0.f; }
        const float lng = p.in[I_LNG][(size_t)l * 256 + h * 64 + lane], lnb = p.in[I_LNB][(size_t)l * 256 + h * 64 + lane];
        const float rkl = p.in[I_RK][(size_t)l * 256 + h * 64 + lane];
        for (int t = 0; t < nt; ++t) {
            const float* rw = RW + (size_t)(row0 + t) * 7 * 256 + h * 64 + lane;
            const float rl = rw[0], kl = rw[256], vl = rw[512], gl = rw[1536];
            WAVE_LDS_SYNC();
            wl[lane] = rl; wl[64 + lane] = kl; wl[128 + lane] = rw[768]; wl[192 + lane] = rw[1024]; wl[256 + lane] = rw[1280];
            WAVE_LDS_SYNC();
            const float bd = wave_sum(rl * kl * rkl);
            float sa = 0.f;
#pragma unroll
            for (int k = 0; k < 64; ++k) sa += S[k] * wl[192 + k];
            float y = 0.f;
#pragma unroll
            for (int k = 0; k < 64; ++k) {
                S[k] = S[k] * wl[128 + k] + sa * wl[256 + k] + vl * wl[64 + k];
                y += S[k] * wl[k];
            }
            const float mean = wave_sum(y) * (1.f / 64.f), dl = y - mean;
            const float var = wave_sum(dl * dl) * (1.f / 64.f);
            const float yn = dl * rsqrtf(var + GN_EPS) * lng + lnb;
            Y[(size_t)(row0 + t) * D + h * 64 + lane] = f2bf((yn + bd * vl) * gl);
        }
        float* so = p.out + (samp ? O_SWKV + ((((size_t)l * NS + n) * 4 + h) * 64 + lane) * 64 : O_PWKV + ((((size_t)l * NP + n) * 4 + h) * 64 + lane) * 64);
#pragma unroll
        for (int k = 0; k < 64; ++k) so[k] = S[k];
    }
}

__device__ __forceinline__ void stage_qkn(const Params& p, int l) {
    const int lane = threadIdx.x & 63, gw = blockIdx.x * NWAVES + (threadIdx.x >> 6), GW = gridDim.x * NWAVES;
    const bf16_t* P = (const bf16_t*)(p.ws + WS_P);
    float* QN = (float*)(p.ws + WS_QN); float* KN = (float*)(p.ws + WS_KN);
    for (int it = gw; it < R * 6; it += GW) {
        const int row = it / 6, unit = it % 6;
        const bool samp = row >= MP; const int n = samp ? row - MP : row >> 13, t = samp ? 0 : (row & (T - 1));
        const float x = bf2f(P[(size_t)row * PCOLS + OFF_B + unit * 64 + lane]);
        const float ss = wave_sum(x * x) * (1.f / 64.f);
        const float g = unit < 4 ? p.in[I_QNG][(size_t)l * 64 + lane] : p.in[I_KNG][(size_t)l * 64 + lane];
        const float y = x * rsqrtf(ss + NORM_EPS) * g;
        if (unit < 4) QN[(size_t)row * 256 + unit * 64 + lane] = y;
        else {
            const int kvh = unit - 4;
            KN[(size_t)row * 128 + kvh * 64 + lane] = y;
            const float v = bf2f(P[(size_t)row * PCOLS + OFF_B + 384 + kvh * 64 + lane]);
            if (samp) { const size_t o = (((size_t)l * NS + n) * 128 + 127) * 128 + kvh * 64 + lane; p.out[O_SK + o] = y; p.out[O_SV + o] = v; }
            else if (t >= T - 128) { const size_t o = (((size_t)l * NP + n) * 128 + (t - (T - 128))) * 128 + kvh * 64 + lane; p.out[O_PK + o] = y; p.out[O_PV + o] = v; }
        }
    }
    const size_t gt = (size_t)blockIdx.x * NTHREADS + threadIdx.x, GT = (size_t)gridDim.x * NTHREADS;
    for (size_t i = gt; i < (size_t)NS * 127 * 128; i += GT) {
        const int c = (int)(i % 128), r = (int)((i / 128) % 127), n = (int)(i / (128 * 127));
        const size_t src = (((size_t)l * NS + n) * 128 + r + 1) * 128 + c, dst = (((size_t)l * NS + n) * 128 + r) * 128 + c;
        p.out[O_SK + dst] = p.in[I_CK][src]; p.out[O_SV + dst] = p.in[I_CV][src];
    }
}

__device__ __forceinline__ void stage_att(const Params& p, int l) {
    const int lane = threadIdx.x & 63, gw = blockIdx.x * NWAVES + (threadIdx.x >> 6), GW = gridDim.x * NWAVES;
    const bf16_t* P = (const bf16_t*)(p.ws + WS_P);
    const float* QN = (const float*)(p.ws + WS_QN); const float* KN = (const float*)(p.ws + WS_KN);
    bf16_t* Y = (bf16_t*)(p.ws + WS_YCAT);
    for (int it = gw; it < R * 4; it += GW) {
        const int row = it >> 2, hq = it & 3, kvh = hq >> 1;
        const bool samp = row >= MP; const int n = samp ? row - MP : row >> 13, t = samp ? 0 : (row & (T - 1));
        const int rowbase = row - t;
        const float* q = QN + (size_t)row * 256 + hq * 64;
        const float sink = p.in[I_SINK][(size_t)l * 4 + hq];
        float sc[3]; float mx = -INFINITY;
#pragma unroll
        for (int j = 0; j < 3; ++j) {
            const int i = lane + 64 * j; sc[j] = -INFINITY;
            if (i <= 128) {
                const int pos = t - 128 + i;
                const float* kp = nullptr;
                if (pos >= 0) kp = KN + (size_t)(rowbase + pos) * 128 + kvh * 64;
                else if (samp) kp = p.in[I_CK] + (((size_t)l * NS + n) * 128 + i) * 128 + kvh * 64;
                if (kp) { float s = 0.f; for (int d = 0; d < 64; ++d) s += q[d] * kp[d]; sc[j] = s * 0.125f; }
            }
            mx = fmaxf(mx, sc[j]);
        }
        mx = fmaxf(wave_max(mx), sink);
        float pr[3]; float sum = 0.f;
#pragma unroll
        for (int j = 0; j < 3; ++j) { pr[j] = sc[j] == -INFINITY ? 0.f : __expf(sc[j] - mx); sum += pr[j]; }
        sum = wave_sum(sum) + __expf(sink - mx);
        float o = 0.f;
        for (int i = 0; i <= 128; ++i) {
            const float prs = i < 64 ? pr[0] : (i < 128 ? pr[1] : pr[2]);
            const float pi = __shfl(prs, i & 63);
            const int pos = t - 128 + i;
            float v = 0.f;
            if (pos >= 0) v = bf2f(P[(size_t)(rowbase + pos) * PCOLS + OFF_B + 384 + kvh * 64 + lane]);
            else if (samp) v = p.in[I_CV][(((size_t)l * NS + n) * 128 + i) * 128 + kvh * 64 + lane];
            o += pi * v;
        }
        Y[(size_t)row * D + 256 + hq * 64 + lane] = f2bf(o / sum);
    }
}

__device__ __forceinline__ void stage_mconv(const Params& p, int l) {
    const size_t gt = (size_t)blockIdx.x * NTHREADS + threadIdx.x, GT = (size_t)gridDim.x * NTHREADS;
    const bf16_t* P = (const bf16_t*)(p.ws + WS_P);
    float* XB = (float*)(p.ws + WS_XBCC); float* DT = (float*)(p.ws + WS_DT);
    const float* cw = p.in[I_CONVW] + (size_t)l * 4 * 1024; const float* cb = p.in[I_CONVB] + (size_t)l * 1024;
    for (size_t i = gt; i < (size_t)R * 1024; i += GT) {
        const int c = (int)(i & 1023), row = (int)(i >> 10);
        const bool samp = row >= MP; const int n = samp ? row - MP : row >> 13, t = samp ? 0 : (row & (T - 1));
        float acc = cb[c];
#pragma unroll
        for (int j = 0; j < 4; ++j) {
            const int tau = t - 3 + j; float u;
            if (tau >= 0) u = bf2f(P[(size_t)(row - 3 + j) * PCOLS + OFF_XBC + c]);
            else u = samp ? p.in[I_SCONV][(((size_t)l * NS + n) * 3 + (3 + tau)) * 1024 + c] : 0.f;
            acc += cw[j * 1024 + c] * u;
        }
        XB[i] = silu_f(acc);
        const float raw = bf2f(P[(size_t)row * PCOLS + OFF_XBC + c]);
        if (samp) {
            float* o = p.out + O_SCONV + ((size_t)l * NS + n) * 3 * 1024 + c;
            const float* st = p.in[I_SCONV] + ((size_t)l * NS + n) * 3 * 1024 + c;
            o[0] = st[1024]; o[1024] = st[2048]; o[2048] = raw;
        } else if (t >= T - 3) p.out[O_PCONV + (((size_t)l * NP + n) * 3 + (t - (T - 3))) * 1024 + c] = raw;
    }
    for (size_t i = gt; i < (size_t)R * 8; i += GT) DT[i] = softplus_f(DT[i] + p.in[I_DTB][(size_t)l * 8 + (i & 7)]);
}

__device__ __forceinline__ void stage_mscan(const Params& p, int l, float* lds) {
    const int lane = threadIdx.x & 63, wave = threadIdx.x >> 6;
    const float* XB = (const float*)(p.ws + WS_XBCC); const float* DT = (const float*)(p.ws + WS_DT);
    float* YT = (float*)(p.ws + WS_YTMP);
    float* wl = lds + wave * 512;
    for (int u = blockIdx.x + gridDim.x * wave; u < NSEQ * 8; u += gridDim.x * NWAVES) {
        const int s = u >> 3, h = u & 7, g = h >> 2; const bool samp = s >= NP; const int n = samp ? s - NP : s;
        const int row0 = samp ? MP + n : n * T, nt = samp ? 1 : T;
        float hs[128];
        if (samp) { const float* st = p.in[I_SSM] + ((((size_t)l * NS + n) * 8 + h) * 64 + lane) * 128;
#pragma unroll
            for (int d = 0; d < 128; ++d) hs[d] = st[d]; }
        else {
#pragma unroll
            for (int d = 0; d < 128; ++d) hs[d] = 0.f; }
        const float A = -__expf(p.in[I_ALOG][(size_t)l * 8 + h]), Dh = p.in[I_SSMD][(size_t)l * 8 + h];
        for (int t = 0; t < nt; ++t) {
            const size_t row = (size_t)row0 + t;
            const float dtv = DT[row * 8 + h], dA = __expf(dtv * A);
            const float x = XB[row * 1024 + h * 64 + lane], xdt = x * dtv;
            const float* b = XB + row * 1024 + 512 + g * 128; const float* c = XB + row * 1024 + 768 + g * 128;
            WAVE_LDS_SYNC();
            wl[lane] = b[lane]; wl[64 + lane] = b[64 + lane]; wl[128 + lane] = c[lane]; wl[192 + lane] = c[64 + lane];
            WAVE_LDS_SYNC();
            float y = 0.f;
#pragma unroll
            for (int d = 0; d < 128; ++d) { hs[d] = hs[d] * dA + xdt * wl[d]; y += hs[d] * wl[128 + d]; }
            YT[row * 512 + h * 64 + lane] = y + Dh * x;
        }
        float* so = p.out + (samp ? O_SSSM + ((((size_t)l * NS + n) * 8 + h) * 64 + lane) * 128 : O_PSSM + ((((size_t)l * NP + n) * 8 + h) * 64 + lane) * 128);
#pragma unroll
        for (int d = 0; d < 128; ++d) so[d] = hs[d];
    }
}

__device__ __forceinline__ void stage_mgate(const Params& p, int l) {
    const int lane = threadIdx.x & 63, gw = blockIdx.x * NWAVES + (threadIdx.x >> 6), GW = gridDim.x * NWAVES;
    const bf16_t* P = (const bf16_t*)(p.ws + WS_P); const float* YT = (const float*)(p.ws + WS_YTMP);
    bf16_t* Y = (bf16_t*)(p.ws + WS_YCAT);
    const float* g = p.in[I_SSMNG] + (size_t)l * 512;
    for (int row = gw; row < R; row += GW) {
        float v[8]; float ss = 0.f;
#pragma unroll
        for (int j = 0; j < 8; ++j) { const int c = lane + 64 * j; v[j] = YT[(size_t)row * 512 + c] * silu_f(bf2f(P[(size_t)row * PCOLS + OFF_Z + c])); ss += v[j] * v[j]; }
        const float rstd = rsqrtf(wave_sum(ss) * (1.f / 512.f) + NORM_EPS);
#pragma unroll
        for (int j = 0; j < 8; ++j) { const int c = lane + 64 * j; Y[(size_t)row * D + 512 + c] = f2bf(v[j] * rstd * g[c]); }
    }
}

__device__ __forceinline__ void stage_glu(const Params& p, int l) {
    const size_t gt = (size_t)blockIdx.x * NTHREADS + threadIdx.x, GT = (size_t)gridDim.x * NTHREADS;
    const bf16_t* GV = (const bf16_t*)(p.ws + WS_GV); bf16_t* U = (bf16_t*)(p.ws + WS_U);
    const float* cw = p.in[I_FCW] + (size_t)l * 3 * DFF; const float* cb = p.in[I_FCB] + (size_t)l * DFF;
    for (size_t i = gt; i < (size_t)R * DFF; i += GT) {
        const int c = (int)(i % DFF), row = (int)(i / DFF);
        const bool samp = row >= MP; const int n = samp ? row - MP : row >> 13, t = samp ? 0 : (row & (T - 1));
        float acc = cb[c];
#pragma unroll
        for (int j = 0; j < 3; ++j) {
            const int tau = t - 2 + j; float u;
            if (tau >= 0) u = bf2f(GV[(size_t)(row - 2 + j) * 5632 + c]);
            else u = samp ? p.in[I_FCONV][(((size_t)l * NS + n) * 2 + (2 + tau)) * DFF + c] : 0.f;
            acc += cw[j * DFF + c] * u;
        }
        U[i] = f2bf(silu_f(acc) * bf2f(GV[(size_t)row * 5632 + DFF + c]));
        const float raw = bf2f(GV[(size_t)row * 5632 + c]);
        if (samp) { float* o = p.out + O_SFFN + ((size_t)l * NS + n) * 2 * DFF + c; o[0] = p.in[I_FCONV][(((size_t)l * NS + n) * 2 + 1) * DFF + c]; o[DFF] = raw; }
        else if (t >= T - 2) p.out[O_PFFN + (((size_t)l * NP + n) * 2 + (t - (T - 2))) * DFF + c] = raw;
    }
}

__device__ __forceinline__ void stage_final(const Params& p) {
    const size_t gt = (size_t)blockIdx.x * NTHREADS + threadIdx.x, GT = (size_t)gridDim.x * NTHREADS;
    const float* X = (const float*)(p.ws + WS_X);
    for (size_t i = gt; i < (size_t)R * D; i += GT) p.out[i] = X[i];
}

constexpr int STAGES_PER_LAYER = 14, N_STAGES = 1 + L * STAGES_PER_LAYER + 1;

template <int K>
__global__ void __launch_bounds__(NTHREADS) fwd(Params p, int l) {
    __shared__ float lds[4352];
    const float* MODl = (const float*)(p.ws + WS_MOD) + (size_t)l * NSEQ * 6144;
    if constexpr (K == 100) stage_init(p);
    if constexpr (K == 101) stage_final(p);
    if constexpr (K == 0) stage_norm(p, l, 0);
    if constexpr (K == 1) gemm_naive((const bf16_t*)(p.ws + WS_H), D, p.in[I_WIN] + (size_t)l * D * PROJ, R, PROJ, D, EpiP{(bf16_t*)(p.ws + WS_P), (float*)(p.ws + WS_DT)}, lds);
    if constexpr (K == 2) stage_rwprep(p, l, lds);
    if constexpr (K == 3) stage_rwscan(p, l, lds);
    if constexpr (K == 4) stage_qkn(p, l);
    if constexpr (K == 5) stage_att(p, l);
    if constexpr (K == 6) stage_mconv(p, l);
    if constexpr (K == 7) stage_mscan(p, l, lds);
    if constexpr (K == 8) stage_mgate(p, l);
    if constexpr (K == 9) gemm_naive((const bf16_t*)(p.ws + WS_YCAT), D, p.in[I_WOUT] + (size_t)l * D * D, R, D, D, EpiRes{(float*)(p.ws + WS_X), MODl + 2048}, lds);
    if constexpr (K == 10) stage_norm(p, l, 1);
    if constexpr (K == 11) gemm_naive((const bf16_t*)(p.ws + WS_H), D, p.in[I_WUP] + (size_t)l * D * 5632, R, 5632, D, EpiBf{(bf16_t*)(p.ws + WS_GV), 5632}, lds);
    if constexpr (K == 12) stage_glu(p, l);
    if constexpr (K == 13) gemm_naive((const bf16_t*)(p.ws + WS_U), DFF, p.in[I_WDOWN] + (size_t)l * DFF * D, R, D, DFF, EpiRes{(float*)(p.ws + WS_X), MODl + 5120}, lds);
}

extern "C" void kernel_launch(void* const* d_in, const int* in_sizes, int n_in, void* d_out, int out_size, void* d_ws, size_t ws_size, hipStream_t stream) {
    if (n_in != N_IN || (size_t)out_size != O_END || ws_size < WS_END) { fprintf(stderr, "kernel_launch: unexpected sizes n_in %d out %d ws %zu\n", n_in, out_size, ws_size); return; }
    Params p{};
    for (int i = 0; i < N_IN; ++i) p.in[i] = (const float*)d_in[i];
    p.out = (float*)d_out; p.ws = (unsigned char*)d_ws;
#define LAUNCH(K, l) hipLaunchKernelGGL(fwd<K>, dim3(256), dim3(NTHREADS), 0, stream, p, l)
    LAUNCH(100, 0);
    for (int l = 0; l < L; ++l) {
        LAUNCH(0, l); LAUNCH(1, l); LAUNCH(2, l); LAUNCH(3, l); LAUNCH(4, l); LAUNCH(5, l); LAUNCH(6, l); LAUNCH(7, l); LAUNCH(8, l); LAUNCH(9, l); LAUNCH(10, l); LAUNCH(11, l); LAUNCH(12, l); LAUNCH(13, l);
    }
    LAUNCH(101, 0);
}
```

```cpp
#include <hip/hip_runtime.h>
#include <hip/hip_cooperative_groups.h>
#include <cstdint>
#include <cstdio>

typedef unsigned short bf16_t;
__device__ __forceinline__ float bf2f(bf16_t v) { return __uint_as_float(((unsigned)v) << 16); }
typedef float f32x2_t __attribute__((ext_vector_type(2)));
typedef __bf16 bf16x2_t __attribute__((ext_vector_type(2)));
__device__ __forceinline__ unsigned cvtpk(float lo, float hi) { const f32x2_t v = {lo, hi}; const bf16x2_t b = __builtin_convertvector(v, bf16x2_t); return __builtin_bit_cast(unsigned, b); }
__device__ __forceinline__ bf16_t f2bf(float f) { return (bf16_t)cvtpk(f, 0.f); }

constexpr int D = 1024, NP = 2, T = 8192, MP = NP * T, NS = 128, R = MP + NS, NSEQ = NP + NS, L = 4;
constexpr int PROJ = 3080, PCOLS = 3072, DFF = 2816;
constexpr int OFF_B = 1024, OFF_Z = 1536, OFF_XBC = 2048;
constexpr float NORM_EPS = 1e-6f, GN_EPS = 64e-5f;
constexpr int NTHREADS = 512, NWAVES = 8;
typedef short bf16x8 __attribute__((ext_vector_type(8)));
typedef short bf16x4 __attribute__((ext_vector_type(4)));
typedef float f32x4 __attribute__((ext_vector_type(4)));
__device__ __forceinline__ bf16x4 pack4(f32x4 v) { typedef unsigned u32x2_t __attribute__((ext_vector_type(2))); const u32x2_t w = {cvtpk(v[0], v[1]), cvtpk(v[2], v[3])}; return __builtin_bit_cast(bf16x4, w); }
constexpr int LD = 72, MSZ = 64 * LD;
constexpr int LD2 = 136;

enum { I_XP = 0, I_XS, I_CP, I_CS, I_SHIFT, I_WKV, I_CK, I_CV, I_SCONV, I_SSM, I_FCONV, I_ADAW, I_ADAB, I_NMIXG, I_NFFNG, I_WIN, I_WOUT,
       I_MU, I_W0, I_W2, I_A0, I_A2, I_G2, I_KK, I_KA, I_RK, I_LNG, I_LNB, I_QNG, I_KNG, I_SINK, I_CONVW, I_CONVB, I_DTB, I_ALOG, I_SSMD, I_SSMNG,
       I_WUP, I_FCW, I_FCB, I_WDOWN, N_IN };

constexpr size_t O_YP = 0;
constexpr size_t O_YS = O_YP + (size_t)MP * D;
constexpr size_t O_PSHIFT = O_YS + (size_t)NS * D;
constexpr size_t O_PWKV = O_PSHIFT + (size_t)L * NP * 1024;
constexpr size_t O_PK = O_PWKV + (size_t)L * NP * 4 * 64 * 64;
constexpr size_t O_PV = O_PK + (size_t)L * NP * 128 * 128;
constexpr size_t O_PCONV = O_PV + (size_t)L * NP * 128 * 128;
constexpr size_t O_PSSM = O_PCONV + (size_t)L * NP * 3 * 1024;
constexpr size_t O_PFFN = O_PSSM + (size_t)L * NP * 8 * 64 * 128;
constexpr size_t O_SSHIFT = O_PFFN + (size_t)L * NP * 2 * DFF;
constexpr size_t O_SWKV = O_SSHIFT + (size_t)L * NS * 1024;
constexpr size_t O_SK = O_SWKV + (size_t)L * NS * 4 * 64 * 64;
constexpr size_t O_SV = O_SK + (size_t)L * NS * 128 * 128;
constexpr size_t O_SCONV = O_SV + (size_t)L * NS * 128 * 128;
constexpr size_t O_SSSM = O_SCONV + (size_t)L * NS * 3 * 1024;
constexpr size_t O_SFFN = O_SSSM + (size_t)L * NS * 8 * 64 * 128;
constexpr size_t O_END = O_SFFN + (size_t)L * NS * 2 * DFF;

constexpr size_t MiB = 1u << 20;
constexpr int MPAD = 16640;
constexpr size_t WS_XB = 0;
constexpr size_t WS_X = 0;
constexpr size_t WS_H = 65 * MiB;
constexpr size_t WS_YCAT = WS_H;
constexpr size_t WS_MOD = 98 * MiB;
constexpr size_t WS_P = 111 * MiB;
constexpr size_t WS_DT = 209 * MiB;
constexpr size_t WS_GV = 210 * MiB;
constexpr size_t WS_U = 389 * MiB;
constexpr size_t WS_WIN = 479 * MiB;
constexpr size_t WS_WOUT = 503 * MiB;
constexpr size_t WS_WUP = 511 * MiB;
constexpr size_t WS_WDN = 555 * MiB;
constexpr size_t WS_RWC_Y0 = 578 * MiB;
constexpr size_t WS_CTL = 595 * MiB;
constexpr size_t WS_LORA = 596 * MiB;
constexpr size_t WS_WDTT = WS_LORA + 512 * 1024;
constexpr size_t WS_DT2 = 597 * MiB;
constexpr size_t WS_END = 598 * MiB;
constexpr size_t WS_RWC_RP = WS_U + 65 * MiB;
constexpr size_t WS_RWC_MC = WS_RWC_RP + 8 * MiB;
constexpr size_t WS_RWC_NCT = WS_RWC_MC + 8 * MiB;
static_assert(WS_RWC_NCT + 8 * MiB <= WS_WIN, "rwkv chunk buffers fit the U region tail");
constexpr size_t WS_RW = WS_GV;
constexpr size_t WS_RWD = WS_RW + 49 * MiB;
constexpr size_t WS_HPREV = WS_RW + 70 * MiB;
constexpr size_t WS_QN = WS_RW + 113 * MiB;
constexpr size_t WS_KN = WS_QN + 17 * MiB;
constexpr size_t WS_YTMP = WS_KN + 9 * MiB;
static_assert(WS_YTMP + (size_t)R * 512 * 4 <= WS_U, "mixer temporaries fit the GV region");
constexpr size_t WS_XBCC = WS_U;
constexpr size_t WS_SST = WS_U + 33 * MiB;
static_assert(WS_XBCC + (size_t)R * 1024 * 2 <= WS_SST && WS_SST + 32 * MiB <= WS_RWC_RP, "xbc / ssd states fit the U region");
constexpr size_t WS_SCD = WS_RWC_Y0 + 16 * MiB;

struct Params {
    const float* in[N_IN];
    float* out;
    unsigned char* ws;
    int wave, pad;
};

__device__ __forceinline__ int seq_of_row(int row) { return row < MP ? (row >> 13) : (NP + row - MP); }
__device__ __forceinline__ float wave_sum(float v) {
#pragma unroll
    for (int o = 1; o < 64; o <<= 1) v += __shfl_xor(v, o);
    return v;
}
__device__ __forceinline__ float wave_max(float v) {
#pragma unroll
    for (int o = 1; o < 64; o <<= 1) v = fmaxf(v, __shfl_xor(v, o));
    return v;
}
__device__ __forceinline__ float silu_f(float x) { return x * __builtin_amdgcn_rcpf(1.f + __expf(-x)); }
__device__ __forceinline__ float sigmoid_f(float x) { return __builtin_amdgcn_rcpf(1.f + __expf(-x)); }
__device__ __forceinline__ float tanh_fast(float x) { return 1.f - 2.f * __builtin_amdgcn_rcpf(1.f + __expf(2.f * x)); }
__device__ __forceinline__ float softplus_fast(float x) { return fmaxf(x, 0.f) + __logf(1.f + __expf(-fabsf(x))); }
__device__ __forceinline__ float softplus_f(float x) { return fmaxf(x, 0.f) + log1pf(__expf(-fabsf(x))); }

namespace pg8 {
#define PG8_LAS __attribute__((address_space(3)))
typedef unsigned short bf16_t;
typedef short bf16x8 __attribute__((ext_vector_type(8)));
typedef float f32x4 __attribute__((ext_vector_type(4)));
typedef unsigned u32x4 __attribute__((ext_vector_type(4)));
constexpr int BM = 256, BK = 64, HALF = 128, HTB = HALF * BK * 2  , STAGE_BYTES = 8 * HTB, NXCD = 8, WGM = 8;

__host__ __device__ __forceinline__ int lds_byte(int r, int c) { const int st = (r >> 4) * 2 + (c >> 5), rr = r & 15, cc = c & 31, ob = rr * 64 + cc * 2; return st * 1024 + (ob ^ (((ob >> 9) & 1) << 5)); }
__host__ __device__ __forceinline__ void stage_rc(int b, int& R, int& C) { const int st = b / 1024, sb = b % 1024, swz = sb ^ (((sb >> 9) & 1) << 5); R = (st >> 1) * 16 + swz / 64; C = (st & 1) * 32 + (swz % 64) / 2; }
__host__ __device__ __forceinline__ int perm32(int rho) { const int n = rho >> 4, i = rho & 15; return 8 * (i >> 2) + 4 * n + (i & 3); }

struct Unit { int pm, pn; };
struct Gemm { const bf16_t* A; const bf16_t* Bt; int M, N, K; };

struct StaticOrder {
    int nM, nN, nwg, G, c;
    __host__ __device__ void init(int M, int N, int G_, int c_) { nM = M / BM; nN = N / BM; nwg = nM * nN; G = G_; c = c_; }
    __host__ __device__ bool next(int i, Unit& u) const {
        const long L = (long)i * G + c; if (L >= nwg) return false;
        int wgid = (int)L; { const int q = nwg / NXCD, r = nwg % NXCD, xcd = wgid % NXCD, off = wgid / NXCD; wgid = (xcd < r ? xcd * (q + 1) : r * (q + 1) + (xcd - r) * q) + off; }
        const int nig = WGM * nN, gid = wgid / nig, fm = gid * WGM, gsz = (nM - fm) < WGM ? (nM - fm) : WGM;
        u.pm = fm + ((wgid % nig) % gsz); u.pn = (wgid % nig) / gsz; return true;
    }
    __device__ __forceinline__ void a_ready(const Unit&) const {}
    __device__ __forceinline__ void done(const Unit&) const {}
};

__device__ __forceinline__ unsigned cvt_pk_bf16(float lo, float hi) { unsigned r; asm volatile("v_cvt_pk_bf16_f32 %0, %1, %2" : "=v"(r) : "v"(lo), "v"(hi)); return r; }
typedef float f32x2 __attribute__((ext_vector_type(2)));
__device__ __forceinline__ f32x2 gelu_pk(f32x2 v) {
    const f32x2 av = __builtin_elementwise_abs(v), d = av * 0.2316418882f + 1.0f;
    f32x2 t; t.x = __builtin_amdgcn_rcpf(d.x); t.y = __builtin_amdgcn_rcpf(d.y);
    f32x2 q = t * 0.5307027145f + (-0.7265760135f); q = q * t + 0.7107068705f; q = q * t + (-0.142248368f); q = q * t + 0.127414796f; q = q * t;
    const f32x2 s = (v * v) * (-0.72134752044f);
    f32x2 e; e.x = __builtin_amdgcn_exp2f(s.x); e.y = __builtin_amdgcn_exp2f(s.y);
    const f32x2 m = v * (q * e), r = v - m;
    f32x2 o; o.x = v.x < 0.f ? m.x : r.x; o.y = v.y < 0.f ? m.y : r.y; return o;
}

template <int ACT  > struct EpiBf16 {
    static constexpr bool PERM = true, AFTER_DRAIN = false; static_assert(ACT == 0 || ACT == 1, "EpiBf16: ACT is 0 (none) or 1 (gelu_pk)");
    bf16_t* O; int ldc; const float* bias; int split_cols; size_t split_stride; float scale0;
    __device__ __forceinline__ void operator()(const f32x4 (&acc)[2][2][4][2], const Unit& u, int wr, int wc, int fr, int fq) const {
        const int row0 = u.pm * BM + wr * 64 + fr; int colt = u.pn * BM; bf16_t* base = O;
        float sc = 1.f; if (split_cols) { const int t = colt / split_cols; base += (size_t)t * split_stride; colt -= t * split_cols; if (t == 0) sc = scale0; }
        const int col0 = colt + wc * 32 + 8 * fq, bcol0 = u.pn * BM + wc * 32 + 8 * fq;
        f32x4 bv[2][2];
#pragma unroll
        for (int bj = 0; bj < 2; ++bj)
#pragma unroll
            for (int n = 0; n < 2; ++n) bv[bj][n] = bias ? *(const f32x4*)(bias + bcol0 + bj * HALF + 4 * n) : (f32x4){0.f, 0.f, 0.f, 0.f};
#pragma unroll
        for (int ai = 0; ai < 2; ++ai)
#pragma unroll
            for (int m = 0; m < 4; ++m) { bf16_t* rowp = base + (size_t)(row0 + ai * HALF + m * 16) * ldc + col0;
#pragma unroll
                for (int bj = 0; bj < 2; ++bj) { f32x4 v0 = acc[ai][bj][m][0] + bv[bj][0], v1 = acc[ai][bj][m][1] + bv[bj][1];
                    if (ACT == 1) { f32x2 a = gelu_pk((f32x2){v0[0], v0[1]}), b = gelu_pk((f32x2){v0[2], v0[3]}), c = gelu_pk((f32x2){v1[0], v1[1]}), d = gelu_pk((f32x2){v1[2], v1[3]});
                        v0 = (f32x4){a.x, a.y, b.x, b.y}; v1 = (f32x4){c.x, c.y, d.x, d.y}; }
                    v0 = v0 * sc; v1 = v1 * sc; u32x4 w; w.x = cvt_pk_bf16(v0[0], v0[1]); w.y = cvt_pk_bf16(v0[2], v0[3]); w.z = cvt_pk_bf16(v1[0], v1[1]); w.w = cvt_pk_bf16(v1[2], v1[3]);
                    *(u32x4*)(rowp + bj * HALF) = w; } }
    }
};

__device__ __forceinline__ float dpp_shr(float cur, float prevblk, int n  ) {
    const int c = __builtin_bit_cast(int, cur), pb = __builtin_bit_cast(int, prevblk);
    int t;
    if (n == 1) { t = __builtin_amdgcn_update_dpp(0, pb, 0x121, 0xf, 0xf, false); t = __builtin_amdgcn_update_dpp(t, c, 0x111, 0xf, 0xf, false); }
    else        { t = __builtin_amdgcn_update_dpp(0, pb, 0x122, 0xf, 0xf, false); t = __builtin_amdgcn_update_dpp(t, c, 0x112, 0xf, 0xf, false); }
    return __builtin_bit_cast(float, t);
}
struct EpiGlu {
    static constexpr bool PERM = true, AFTER_DRAIN = false;
    bf16_t* GV; bf16_t* U; const float* cw; const float* cb;
    __device__ __forceinline__ void operator()(const f32x4 (&acc)[2][2][4][2], const Unit& u, int wr, int wc, int fr, int fq) const {
        const int row0 = u.pm * BM + wr * 64 + fr, x0 = wc * 32 + 8 * fq, ch0 = u.pn * HALF + x0;
        f32x4 w0[2], w1[2], w2[2], bb[2];
#pragma unroll
        for (int n = 0; n < 2; ++n) { w0[n] = *(const f32x4*)(cw + ch0 + 4 * n); w1[n] = *(const f32x4*)(cw + 2816 + ch0 + 4 * n); w2[n] = *(const f32x4*)(cw + 5632 + ch0 + 4 * n); bb[n] = *(const f32x4*)(cb + ch0 + 4 * n); }
#pragma unroll
        for (int ai = 0; ai < 2; ++ai)
#pragma unroll
            for (int m = 0; m < 4; ++m) {
                const int row = row0 + ai * HALF + m * 16;
                bf16_t* gp = GV + (size_t)row * 5632 + u.pn * BM + x0;
                u32x4 wu;
#pragma unroll
                for (int n = 0; n < 2; ++n) {
                    const f32x4 g = acc[ai][0][m][n], v = acc[ai][1][m][n], pv = acc[ai][0][m > 0 ? m - 1 : 0][n];
                    float o[4];
#pragma unroll
                    for (int e = 0; e < 4; ++e) {
                        const float g1 = dpp_shr(g[e], pv[e], 1), g2 = dpp_shr(g[e], pv[e], 2);
                        const float a = bb[n][e] + w0[n][e] * g2 + w1[n][e] * g1 + w2[n][e] * g[e];
                        o[e] = a * __builtin_amdgcn_rcpf(1.f + __expf(-a)) * v[e];
                    }
                    if (n == 0) { wu.x = cvt_pk_bf16(o[0], o[1]); wu.y = cvt_pk_bf16(o[2], o[3]); } else { wu.z = cvt_pk_bf16(o[0], o[1]); wu.w = cvt_pk_bf16(o[2], o[3]); }
                }
                if (m > 0 || fr >= 2) *(u32x4*)(U + (size_t)row * 2816 + ch0) = wu;
                u32x4 wg, wv;
                wg.x = cvt_pk_bf16(acc[ai][0][m][0][0], acc[ai][0][m][0][1]); wg.y = cvt_pk_bf16(acc[ai][0][m][0][2], acc[ai][0][m][0][3]); wg.z = cvt_pk_bf16(acc[ai][0][m][1][0], acc[ai][0][m][1][1]); wg.w = cvt_pk_bf16(acc[ai][0][m][1][2], acc[ai][0][m][1][3]);
                wv.x = cvt_pk_bf16(acc[ai][1][m][0][0], acc[ai][1][m][0][1]); wv.y = cvt_pk_bf16(acc[ai][1][m][0][2], acc[ai][1][m][0][3]); wv.z = cvt_pk_bf16(acc[ai][1][m][1][0], acc[ai][1][m][1][1]); wv.w = cvt_pk_bf16(acc[ai][1][m][1][2], acc[ai][1][m][1][3]);
                if ((m == 0 && fr < 2) || (m == 3 && fr >= 14)) { *(u32x4*)gp = wg; *(u32x4*)(gp + HALF) = wv; }
            }
    }
};

struct EpiResGate {
    static constexpr bool PERM = true, AFTER_DRAIN = false;
    float* Xf; const float* Xinf; bf16_t* Xb; const float* gate; int src_f32, dst_f32, seq_shift, gate_ld;
    __device__ __forceinline__ void operator()(const f32x4 (&acc)[2][2][4][2], const Unit& u, int wr, int wc, int fr, int fq) const {
        const int col0 = u.pn * BM + wc * 32 + 8 * fq;
#pragma unroll
        for (int ai = 0; ai < 2; ++ai)
#pragma unroll
            for (int m = 0; m < 4; ++m) {
                const int row = u.pm * BM + ai * HALF + wr * 64 + m * 16 + fr;
                const float* gp = gate + (size_t)(row >> seq_shift) * gate_ld + col0; const size_t off = (size_t)row * 1024 + col0;
#pragma unroll
                for (int bj = 0; bj < 2; ++bj) {
                    const f32x4 g0 = *(const f32x4*)(gp + bj * HALF), g1 = *(const f32x4*)(gp + bj * HALF + 4);
                    f32x4 x0, x1;
                    if (src_f32) { x0 = *(const f32x4*)(Xinf + off + bj * HALF); x1 = *(const f32x4*)(Xinf + off + bj * HALF + 4); }
                    else { const u32x4 w = *(const u32x4*)(Xb + off + bj * HALF);
                        x0 = (f32x4){__builtin_bit_cast(float, w.x << 16), __builtin_bit_cast(float, w.x & 0xffff0000u), __builtin_bit_cast(float, w.y << 16), __builtin_bit_cast(float, w.y & 0xffff0000u)};
                        x1 = (f32x4){__builtin_bit_cast(float, w.z << 16), __builtin_bit_cast(float, w.z & 0xffff0000u), __builtin_bit_cast(float, w.w << 16), __builtin_bit_cast(float, w.w & 0xffff0000u)}; }
                    x0 = x0 + g0 * acc[ai][bj][m][0]; x1 = x1 + g1 * acc[ai][bj][m][1];
                    if (dst_f32) { *(f32x4*)(Xf + off + bj * HALF) = x0; *(f32x4*)(Xf + off + bj * HALF + 4) = x1; }
                    else { u32x4 w; w.x = cvt_pk_bf16(x0[0], x0[1]); w.y = cvt_pk_bf16(x0[2], x0[3]); w.z = cvt_pk_bf16(x1[0], x1[1]); w.w = cvt_pk_bf16(x1[2], x1[3]); *(u32x4*)(Xb + off + bj * HALF) = w; }
                }
            }
    }
};
template <class Epi, class Sched, bool ALIGN_EPI = false, bool SP2 = false>
__device__ __forceinline__ void gemm_phase(PG8_LAS unsigned char* lds, const Gemm g, const Sched& S, const Epi& E, int tid_in) {
    int tid_ = tid_in; asm volatile("" : "+v"(tid_));
    const int tid = tid_, wid = __builtin_amdgcn_readfirstlane(tid >> 6), lane = tid & 63, wr = wid >> 2, wc = wid & 3, fr = lane & 15, fq = lane >> 4;
    const int K = g.K, nt = K / BK;
    unsigned voffA[2], voffB[2];
#pragma unroll
    for (int i = 0; i < 2; ++i) { int R, C; stage_rc(tid * 16 + i * 8192, R, C); const int Rb = Epi::PERM ? ((R & ~31) + perm32(R & 31)) : R;
        voffA[i] = (unsigned)(R * K + C) * 2u; voffB[i] = (unsigned)(Rb * K + C) * 2u; }
    const size_t kstep = (size_t)(BK * 2);
    const size_t hstep = (size_t)HALF * K * 2;
    const size_t tstep = 2 * hstep;
    const unsigned ldsw = (unsigned)wid * 1024u;
    const int aoff = lds_byte(wr * 64 + fr, fq * 8), boff = lds_byte(wc * 32 + fr, fq * 8);
#define PG8_SA(b, h) (((b) * 2 + (h)) * HTB)
#define PG8_SB(b, h) ((4 + (b) * 2 + (h)) * HTB)
#define PG8_STAGE(bufoff, gbase, voff) do { _Pragma("unroll") for (int _i = 0; _i < 2; ++_i) \
        __builtin_amdgcn_global_load_lds((const unsigned*)((const char*)(gbase) + (voff)[_i]), (PG8_LAS unsigned*)(lds + (bufoff) + ldsw + _i * 8192), 16, 0, 0); } while (0)
#define PG8_LDA(dst, b, h) do { _Pragma("unroll") for (int m = 0; m < 4; ++m) _Pragma("unroll") for (int k = 0; k < 2; ++k) dst[m][k] = *(const PG8_LAS bf16x8*)(lds + PG8_SA(b, h) + aoff + m * 2048 + k * 1024); } while (0)
#define PG8_LDB(dst, b, h) do { _Pragma("unroll") for (int n = 0; n < 2; ++n) _Pragma("unroll") for (int k = 0; k < 2; ++k) dst[n][k] = *(const PG8_LAS bf16x8*)(lds + PG8_SB(b, h) + boff + n * 2048 + k * 1024); } while (0)
#define PG8_MMA(ai, bj, At, Bt) do { __builtin_amdgcn_s_setprio(1); _Pragma("unroll") for (int m = 0; m < 4; ++m) _Pragma("unroll") for (int n = 0; n < 2; ++n) _Pragma("unroll") for (int k = 0; k < 2; ++k) \
        acc[ai][bj][m][n] = __builtin_amdgcn_mfma_f32_16x16x32_bf16(Bt[n][k], At[m][k], acc[ai][bj][m][n], 0, 0, 0); __builtin_amdgcn_s_setprio(0); } while (0)
#define PG8_WAIT_V(n) asm volatile("s_waitcnt vmcnt(" #n ")" ::: "memory")
#define PG8_WAIT_L(n) asm volatile("s_waitcnt lgkmcnt(" #n ")" ::: "memory")
#define PG8_BAR __builtin_amdgcn_s_barrier()
#define PG8_SCHED __builtin_amdgcn_sched_barrier(0)
    Unit cur, nxt; int ui = 0;
    if (!S.next(0, cur)) return;
    f32x4 acc[2][2][4][2];
#pragma unroll
    for (int a = 0; a < 2; ++a)
#pragma unroll
        for (int b = 0; b < 2; ++b)
#pragma unroll
            for (int m = 0; m < 4; ++m)
#pragma unroll
                for (int n = 0; n < 2; ++n) acc[a][b][m][n] = (f32x4){0.f, 0.f, 0.f, 0.f};
    bf16x8 At[4][2], B0[2][2], B1[2][2];
    const char* cA = (const char*)g.A + (size_t)cur.pm * tstep; const char* cB = (const char*)g.Bt + (size_t)cur.pn * tstep;
    S.a_ready(cur);
    if constexpr (SP2) {
        PG8_STAGE(PG8_SB(0, 0), cB, voffB); PG8_STAGE(PG8_SB(0, 1), cB + hstep, voffB); PG8_STAGE(PG8_SA(0, 0), cA, voffA); PG8_STAGE(PG8_SA(0, 1), cA + hstep, voffA);
        if (wr == 1) PG8_BAR;
        PG8_WAIT_V(2); PG8_BAR;
        PG8_STAGE(PG8_SB(1, 0), cB + kstep, voffB); PG8_STAGE(PG8_SA(1, 0), cA + kstep, voffA); PG8_STAGE(PG8_SB(1, 1), cB + hstep + kstep, voffB);
        PG8_WAIT_V(6); PG8_BAR;
    } else {
        PG8_STAGE(PG8_SB(0, 0), cB, voffB); PG8_STAGE(PG8_SA(0, 0), cA, voffA); PG8_STAGE(PG8_SB(0, 1), cB + hstep, voffB); PG8_STAGE(PG8_SA(0, 1), cA + hstep, voffA);
        if (wr == 1) PG8_BAR;
        PG8_WAIT_V(4); PG8_BAR;
        PG8_STAGE(PG8_SB(1, 0), cB + kstep, voffB); PG8_STAGE(PG8_SA(1, 0), cA + kstep, voffA); PG8_STAGE(PG8_SB(1, 1), cB + hstep + kstep, voffB);
        PG8_WAIT_V(6); PG8_BAR;
    }
    for (;;) {
        const bool has_next = S.next(ui + 1, nxt);
        const char* nA = has_next ? (const char*)g.A + (size_t)nxt.pm * tstep : cA; const char* nB = has_next ? (const char*)g.Bt + (size_t)nxt.pn * tstep : cB;
        for (int t = 0; t < nt; t += 2) {
            const bool last = (t == nt - 2);
            const char* a1 = cA + (size_t)(t + 1) * kstep;
            const char* a2 = last ? nA : cA + (size_t)(t + 2) * kstep; const char* b2 = last ? nB : cB + (size_t)(t + 2) * kstep;
            const char* a3 = a2 + kstep; const char* b3 = b2 + kstep;
            if (last && has_next) S.a_ready(nxt);
            if constexpr (SP2) {
            PG8_LDB(B0, 0, 0); PG8_LDB(B1, 0, 1); PG8_SCHED; PG8_LDA(At, 0, 0); PG8_STAGE(PG8_SA(1, 1), a1 + hstep, voffA);
            PG8_WAIT_V(8); PG8_WAIT_L(0); PG8_BAR; PG8_MMA(0, 0, At, B0); PG8_MMA(0, 1, At, B1); PG8_BAR; PG8_SCHED;
            PG8_LDA(At, 0, 1); PG8_STAGE(PG8_SB(0, 0), b2, voffB); PG8_STAGE(PG8_SB(0, 1), b2 + hstep, voffB); PG8_STAGE(PG8_SA(0, 0), a2, voffA);
            PG8_WAIT_V(8); PG8_WAIT_L(0); PG8_BAR; PG8_MMA(1, 0, At, B0); PG8_MMA(1, 1, At, B1); PG8_BAR; PG8_SCHED;
            PG8_LDB(B0, 1, 0); PG8_LDB(B1, 1, 1); PG8_SCHED; PG8_LDA(At, 1, 0); PG8_STAGE(PG8_SA(0, 1), a2 + hstep, voffA);
            PG8_WAIT_V(8); PG8_WAIT_L(0); PG8_BAR; PG8_MMA(0, 0, At, B0); PG8_MMA(0, 1, At, B1); PG8_BAR; PG8_SCHED;
            PG8_LDA(At, 1, 1); PG8_STAGE(PG8_SB(1, 0), b3, voffB); PG8_STAGE(PG8_SB(1, 1), b3 + hstep, voffB); PG8_STAGE(PG8_SA(1, 0), a3, voffA);
            PG8_WAIT_V(8); PG8_WAIT_L(0); PG8_BAR; PG8_MMA(1, 0, At, B0); PG8_MMA(1, 1, At, B1); PG8_BAR; PG8_SCHED;
            } else {
            PG8_LDB(B0, 0, 0); PG8_SCHED; PG8_LDA(At, 0, 0); PG8_STAGE(PG8_SA(1, 1), a1 + hstep, voffA);
            PG8_WAIT_L(8); PG8_BAR; PG8_WAIT_L(0); PG8_MMA(0, 0, At, B0); PG8_BAR; PG8_SCHED;
            PG8_LDB(B1, 0, 1); PG8_STAGE(PG8_SB(0, 0), b2, voffB);
            PG8_BAR; PG8_WAIT_L(0); PG8_MMA(0, 1, At, B1); PG8_BAR;
            PG8_LDA(At, 0, 1); PG8_STAGE(PG8_SA(0, 0), a2, voffA);
            PG8_BAR; PG8_WAIT_L(0); PG8_MMA(1, 0, At, B0); PG8_BAR; PG8_SCHED;
            PG8_STAGE(PG8_SB(0, 1), b2 + hstep, voffB);
            PG8_WAIT_V(6); PG8_BAR; PG8_MMA(1, 1, At, B1); PG8_BAR;
            PG8_LDB(B0, 1, 0); PG8_SCHED; PG8_LDA(At, 1, 0); PG8_STAGE(PG8_SA(0, 1), a2 + hstep, voffA);
            PG8_WAIT_L(8); PG8_BAR; PG8_WAIT_L(0); PG8_MMA(0, 0, At, B0); PG8_BAR; PG8_SCHED;
            PG8_LDB(B1, 1, 1); PG8_STAGE(PG8_SB(1, 0), b3, voffB);
            PG8_BAR; PG8_WAIT_L(0); PG8_MMA(0, 1, At, B1); PG8_BAR;
            PG8_LDA(At, 1, 1); PG8_STAGE(PG8_SA(1, 0), a3, voffA);
            PG8_BAR; PG8_WAIT_L(0); PG8_MMA(1, 0, At, B0); PG8_BAR; PG8_SCHED;
            PG8_STAGE(PG8_SB(1, 1), b3 + hstep, voffB);
            PG8_WAIT_V(6); PG8_BAR; PG8_MMA(1, 1, At, B1); PG8_BAR;
            }
        }
        if constexpr (ALIGN_EPI) { if (wr == 0) PG8_BAR; }
        if constexpr (!Epi::AFTER_DRAIN) { E(acc, cur, wr, wc, fr, fq); S.done(cur); }
        if (!has_next) break;
#pragma unroll
        for (int a = 0; a < 2; ++a)
#pragma unroll
            for (int b = 0; b < 2; ++b)
#pragma unroll
                for (int m = 0; m < 4; ++m)
#pragma unroll
                    for (int n = 0; n < 2; ++n) acc[a][b][m][n] = (f32x4){0.f, 0.f, 0.f, 0.f};
        cur = nxt; cA = nA; cB = nB; ++ui;
        if constexpr (ALIGN_EPI) { if (wr == 1) PG8_BAR; }
    }
    PG8_WAIT_V(0);
    if constexpr (!ALIGN_EPI) { if (wr == 0) PG8_BAR; }
    PG8_BAR;
    if constexpr (Epi::AFTER_DRAIN) { E.fused(acc, cur, wr, wc, fr, fq, lds, wid, lane); S.done(cur); }
#undef PG8_SA
#undef PG8_SB
#undef PG8_STAGE
#undef PG8_LDA
#undef PG8_LDB
#undef PG8_MMA
#undef PG8_WAIT_V
#undef PG8_WAIT_L
#undef PG8_BAR
#undef PG8_SCHED
}
}

struct Ctx { int tid, bid, nb; size_t z; };
__device__ __forceinline__ int lane_id() { return (int)__builtin_amdgcn_mbcnt_hi(~0u, __builtin_amdgcn_mbcnt_lo(~0u, 0u)); }
__device__ __forceinline__ Ctx mkctx(const Params& p, int first = 0, int count = 0) { Ctx c; c.tid = (p.wave << 6) | lane_id(); c.bid = blockIdx.x; c.nb = gridDim.x; c.z = 0; asm volatile("" : "+v"(c.tid), "+s"(c.bid), "+s"(c.nb), "+s"(c.z));
    if (first > 0 || count > 0) { const int hi = count > 0 ? first + count : c.nb; c.bid = (c.bid >= first && c.bid < hi) ? c.bid - first : (1 << 20); c.nb = hi - first; } return c; }
#define PIN(i) (p.in[i] + z)
__device__ __forceinline__ void stage_init(const Params& p) {
    const Ctx cx = mkctx(p); const size_t z = cx.z;
    const unsigned gt = (unsigned)cx.bid * NTHREADS + cx.tid, GT = (unsigned)cx.nb * NTHREADS;
    typedef float f4 __attribute__((ext_vector_type(4)));
    f4* X = (f4*)(p.out + z); const f4* xp = (const f4*)PIN(I_XP); const f4* xs = (const f4*)PIN(I_XS);
    (void)xp;
    for (unsigned i = gt; i < (unsigned)NS * (D / 4); i += GT) X[(unsigned)MP * (D / 4) + i] = xs[i];
}
__device__ __forceinline__ void stage_mod(const Params& p, unsigned char* lds, int l_lo, int l_hi, int first = 0) {
    const Ctx cx = mkctx(p, first); const size_t z = cx.z;
    float* MOD = (float*)(p.ws + z + WS_MOD);
    bf16_t* SCs = (bf16_t*)lds;
    bf16_t* WTs = (bf16_t*)(lds + 39168);
    const int lane = cx.tid & 63, wave = __builtin_amdgcn_readfirstlane(cx.tid >> 6), r = lane & 15, q = lane >> 4;
    const int lk = cx.tid >> 4, lj = (cx.tid & 15) * 8;
    for (int item = cx.bid; item < (l_hi - l_lo) * 48; item += cx.nb) {
        const int l = l_lo + item / 48, j0 = (item % 48) * 128;
        const float* w = PIN(I_ADAW) + (size_t)l * D * 6144 + j0 + lj;
        f32x4 acc[9];
#pragma unroll
        for (int i = 0; i < 9; ++i) acc[i] = (f32x4){0.f, 0.f, 0.f, 0.f};
        f32x4 n0 = *(const f32x4*)(w + (size_t)lk * 6144), n1 = *(const f32x4*)(w + (size_t)lk * 6144 + 4);
        __syncthreads();
#pragma unroll
        for (int e = 0; e < 4; ++e) { WTs[(lj + e) * 40 + lk] = f2bf(n0[e]); WTs[(lj + 4 + e) * 40 + lk] = f2bf(n1[e]); }
#pragma unroll 1
        for (int t = 0; t < 32; ++t) {
            if ((t & 3) == 0) {
                __syncthreads();
                for (int i = cx.tid; i < 144 * 16; i += NTHREADS) { const int sidx = i >> 4, k8 = (i & 15) * 8; bf16x8 o;
                    if (sidx < NSEQ) { const float* c = (sidx < NP ? PIN(I_CP) + (size_t)sidx * D : PIN(I_CS) + (size_t)(sidx - NP) * D) + (t >> 2) * 128 + k8;
                        const f32x4 c0 = *(const f32x4*)c, c1 = *(const f32x4*)(c + 4);
#pragma unroll
                        for (int e = 0; e < 4; ++e) { o[e] = (short)f2bf(silu_f(c0[e])); o[4 + e] = (short)f2bf(silu_f(c1[e])); } }
                    else o = (bf16x8){0, 0, 0, 0, 0, 0, 0, 0};
                    *(bf16x8*)(SCs + sidx * LD2 + k8) = o; }
            }
            const int tn = t + 1 < 32 ? t + 1 : 31;
            n0 = *(const f32x4*)(w + (size_t)(tn * 32 + lk) * 6144); n1 = *(const f32x4*)(w + (size_t)(tn * 32 + lk) * 6144 + 4);
            __syncthreads();
            {
                const bf16x8 a = *(const bf16x8*)(WTs + (t & 1) * 5120 + (16 * wave + r) * 40 + 8 * q);
#pragma unroll
                for (int st = 0; st < 9; ++st) {
                    const bf16x8 b = *(const bf16x8*)(SCs + (16 * st + r) * LD2 + 32 * (t & 3) + 8 * q);
                    acc[st] = __builtin_amdgcn_mfma_f32_16x16x32_bf16(a, b, acc[st], 0, 0, 0);
                }
            }
            bf16_t* wn = WTs + ((t + 1) & 1) * 5120;
#pragma unroll
            for (int e = 0; e < 4; ++e) { wn[(lj + e) * 40 + lk] = f2bf(n0[e]); wn[(lj + 4 + e) * 40 + lk] = f2bf(n1[e]); }
        }
        const int j = j0 + 16 * wave + 4 * q;
        const f32x4 b0 = *(const f32x4*)(PIN(I_ADAB) + (size_t)l * 6144 + j);
#pragma unroll
        for (int st = 0; st < 9; ++st) { const int sidx = 16 * st + r; if (sidx < NSEQ) *(f32x4*)(MOD + ((size_t)l * NSEQ + sidx) * 6144 + j) = acc[st] + b0; }
    }
}

__device__ __forceinline__ void stage_norm(const Params& p, int l, int which, float* wl, bool prompt_f32) {
    const Ctx cx = mkctx(p); const size_t z = cx.z;
    const int lane = cx.tid & 63, gw = cx.bid * NWAVES + (cx.tid >> 6), GW = cx.nb * NWAVES;
    const float* X = (l == 0 && which == 0) ? PIN(I_XP) : (const float*)(p.out + z);
    const float* XS = (const float*)(p.out + z);
    bf16_t* H = (bf16_t*)(p.ws + z + WS_H);
    const float* MOD = (const float*)(p.ws + z + WS_MOD);
    const float* g = PIN(which ? I_NFFNG : I_NMIXG) + (size_t)l * D;
    f32x4 gg[4];
#pragma unroll
    for (int j = 0; j < 4; ++j) gg[j] = *(const f32x4*)(g + 4 * lane + 256 * j);
    f32x4 v[2][4], nv[2][4];
    const int rbeg = (prompt_f32 ? 0 : MP) + 2 * gw;
    if (rbeg < R) {
#pragma unroll
        for (int k = 0; k < 2; ++k)
#pragma unroll
            for (int j = 0; j < 4; ++j) v[k][j] = *(const f32x4*)((rbeg + k < MP ? X : XS) + (size_t)(rbeg + k) * D + 4 * lane + 256 * j);
    }
    for (int row0 = rbeg; row0 < R; row0 += 2 * GW) {
        const int rnext = row0 + 2 * GW < R ? row0 + 2 * GW : row0;
#pragma unroll
        for (int k = 0; k < 2; ++k)
#pragma unroll
            for (int j = 0; j < 4; ++j) nv[k][j] = *(const f32x4*)((rnext + k < MP ? X : XS) + (size_t)(rnext + k) * D + 4 * lane + 256 * j);
#pragma unroll
        for (int k = 0; k < 2; ++k) {
            const int row = row0 + k;
            const float* md = MOD + ((size_t)l * NSEQ + seq_of_row(row)) * 6144 + which * 3072 + 4 * lane;
            f32x4 sh[4], sc[4];
#pragma unroll
            for (int j = 0; j < 4; ++j) { sh[j] = *(const f32x4*)(md + 256 * j); sc[j] = *(const f32x4*)(md + 1024 + 256 * j); }
            float ss = 0.f;
#pragma unroll
            for (int j = 0; j < 4; ++j) ss += (v[k][j][0] * v[k][j][0] + v[k][j][1] * v[k][j][1]) + (v[k][j][2] * v[k][j][2] + v[k][j][3] * v[k][j][3]);
            ss = wave_sum(ss);
            const float rstd = rsqrtf(ss * (1.f / D) + NORM_EPS);
#pragma unroll
            for (int j = 0; j < 4; ++j) { v[k][j] = v[k][j] * rstd * gg[j] * (1.f + sc[j]) + sh[j];
                *(bf16x4*)(H + (size_t)row * D + 4 * lane + 256 * j) = (bf16x4){(short)f2bf(v[k][j][0]), (short)f2bf(v[k][j][1]), (short)f2bf(v[k][j][2]), (short)f2bf(v[k][j][3])}; }
        }
#pragma unroll
        for (int k = 0; k < 2; ++k)
#pragma unroll
            for (int j = 0; j < 4; ++j) v[k][j] = nv[k][j];
    }
}

__device__ __forceinline__ void stage_norm_b(const Params& p, int l, int which) {
    const Ctx cx = mkctx(p); const size_t z = cx.z;
    const int lane = cx.tid & 63, gw = cx.bid * NWAVES + (cx.tid >> 6), GW = cx.nb * NWAVES;
    const bf16_t* XB = (const bf16_t*)(p.ws + z + WS_XB);
    bf16_t* H = (bf16_t*)(p.ws + z + WS_H);
    const float* MOD = (const float*)(p.ws + z + WS_MOD);
    const float* g = PIN(which ? I_NFFNG : I_NMIXG) + (size_t)l * D;
    f32x4 gg[2][2];
#pragma unroll
    for (int j = 0; j < 2; ++j) { gg[j][0] = *(const f32x4*)(g + 8 * lane + 512 * j); gg[j][1] = *(const f32x4*)(g + 8 * lane + 512 * j + 4); }
    typedef pg8::u32x4 u32x4;
    u32x4 v[4][2], nv[4][2];
    if (4 * gw < MP) {
#pragma unroll
        for (int k = 0; k < 4; ++k)
#pragma unroll
            for (int j = 0; j < 2; ++j) v[k][j] = *(const u32x4*)(XB + (size_t)(4 * gw + k) * D + 8 * lane + 512 * j);
    }
    for (int row0 = 4 * gw; row0 < MP; row0 += 4 * GW) {
        const int rnext = row0 + 4 * GW < MP ? row0 + 4 * GW : row0;
#pragma unroll
        for (int k = 0; k < 4; ++k)
#pragma unroll
            for (int j = 0; j < 2; ++j) nv[k][j] = *(const u32x4*)(XB + (size_t)(rnext + k) * D + 8 * lane + 512 * j);
        const float* md = MOD + ((size_t)l * NSEQ + (row0 >> 13)) * 6144 + which * 3072 + 8 * lane;
        f32x4 sh[2][2], sc[2][2];
#pragma unroll
        for (int j = 0; j < 2; ++j)
#pragma unroll
            for (int h = 0; h < 2; ++h) { sh[j][h] = *(const f32x4*)(md + 512 * j + 4 * h); sc[j][h] = *(const f32x4*)(md + 1024 + 512 * j + 4 * h) + 1.f; sc[j][h] = sc[j][h] * gg[j][h]; }
#pragma unroll
        for (int k = 0; k < 4; ++k) {
            const int row = row0 + k;
            f32x4 x[2][2]; float ss = 0.f;
#pragma unroll
            for (int j = 0; j < 2; ++j) { const u32x4 w = v[k][j];
                x[j][0] = (f32x4){__builtin_bit_cast(float, w.x << 16), __builtin_bit_cast(float, w.x & 0xffff0000u), __builtin_bit_cast(float, w.y << 16), __builtin_bit_cast(float, w.y & 0xffff0000u)};
                x[j][1] = (f32x4){__builtin_bit_cast(float, w.z << 16), __builtin_bit_cast(float, w.z & 0xffff0000u), __builtin_bit_cast(float, w.w << 16), __builtin_bit_cast(float, w.w & 0xffff0000u)};
#pragma unroll
                for (int h = 0; h < 2; ++h) ss += (x[j][h][0] * x[j][h][0] + x[j][h][1] * x[j][h][1]) + (x[j][h][2] * x[j][h][2] + x[j][h][3] * x[j][h][3]); }
            ss = wave_sum(ss);
            const float rstd = rsqrtf(ss * (1.f / D) + NORM_EPS);
#pragma unroll
            for (int j = 0; j < 2; ++j) { const f32x4 o0 = x[j][0] * rstd * sc[j][0] + sh[j][0], o1 = x[j][1] * rstd * sc[j][1] + sh[j][1];
                u32x4 w; w.x = cvtpk(o0[0], o0[1]); w.y = cvtpk(o0[2], o0[3]); w.z = cvtpk(o1[0], o1[1]); w.w = cvtpk(o1[2], o1[3]);
                *(u32x4*)(H + (size_t)row * D + 8 * lane + 512 * j) = w; }
        }
#pragma unroll
        for (int k = 0; k < 4; ++k)
#pragma unroll
            for (int j = 0; j < 2; ++j) v[k][j] = nv[k][j];
    }
}

__device__ __forceinline__ f32x4 ld4bf(const bf16_t* p) { const bf16x4 v = *(const bf16x4*)p; return (f32x4){bf2f((bf16_t)v[0]), bf2f((bf16_t)v[1]), bf2f((bf16_t)v[2]), bf2f((bf16_t)v[3])}; }
__device__ __forceinline__ void stage_rwprep(const Params& p, int l, float* lds) {
    const Ctx cx = mkctx(p); const size_t z = cx.z;
    const bf16_t* P = (const bf16_t*)(p.ws + z + WS_P);
    bf16_t* RWH = (bf16_t*)(p.ws + z + WS_RW); float* RWD = (float*)(p.ws + z + WS_RWD);
    float* xs = lds; float* kk = lds + 1024;
    const int tid = cx.tid;
    const float* mu = PIN(I_MU) + (size_t)l * 1024;
    for (int row = MP + cx.bid; row < R; row += cx.nb) {
        const bool samp = row >= MP; const int n = samp ? row - MP : row >> 13, t = samp ? 0 : (row & (T - 1));
        __syncthreads();
        for (int c = tid; c < 1024; c += NTHREADS) {
            const float pa = bf2f(P[(size_t)row * PCOLS + c]);
            float prev;
            if (t > 0) prev = bf2f(P[(size_t)(row - 1) * PCOLS + c]);
            else prev = samp ? PIN(I_SHIFT)[((size_t)l * NS + n) * 1024 + c] : 0.f;
            float v = pa + (prev - pa) * mu[c];
            if (c >= 768 && c < 832) v = tanh_fast(v);
            if (c >= 896) v = sigmoid_f(v);
            xs[c] = v;
            if (samp) (p.out + z)[O_SSHIFT + ((size_t)l * NS + n) * 1024 + c] = pa;
            else if (t == T - 1) (p.out + z)[O_PSHIFT + ((size_t)l * NP + n) * 1024 + c] = pa;
        }
        __syncthreads();
        float av = 0.f, gv = 0.f, dec = 0.f, kraw = 0.f;
        if (tid < 256) {
            const int j = tid;
            float wl = PIN(I_W0)[(size_t)l * 256 + j], al = PIN(I_A0)[(size_t)l * 256 + j]; gv = 0.f;
            const bf16_t* W2T = (const bf16_t*)(p.ws + z + WS_LORA) + (size_t)l * 65536;
            bf16x8 fw[8], fa[8], fg[16];
#pragma unroll
            for (int c8 = 0; c8 < 8; ++c8) { fw[c8] = *(const bf16x8*)(W2T + j * 64 + c8 * 8); fa[c8] = *(const bf16x8*)(W2T + 16384 + j * 64 + c8 * 8); }
#pragma unroll
            for (int c8 = 0; c8 < 16; ++c8) fg[c8] = *(const bf16x8*)(W2T + 32768 + j * 128 + c8 * 8);
#pragma unroll
            for (int c8 = 0; c8 < 8; ++c8)
#pragma unroll
                for (int e = 0; e < 8; ++e) { wl += xs[768 + c8 * 8 + e] * bf2f((bf16_t)fw[c8][e]); al += xs[832 + c8 * 8 + e] * bf2f((bf16_t)fa[c8][e]); }
#pragma unroll
            for (int c8 = 0; c8 < 16; ++c8)
#pragma unroll
                for (int e = 0; e < 8; ++e) gv += xs[896 + c8 * 8 + e] * bf2f((bf16_t)fg[c8][e]);
            const float w_log = -softplus_fast(-wl) - 0.5f;
            dec = -__expf(w_log);
            av = sigmoid_f(al);
            kraw = xs[256 + j];
            kk[j] = kraw * PIN(I_KK)[(size_t)l * 256 + j];
        }
        __syncthreads();
        if (tid < 256) {
            const int j = tid, h0 = j & ~63;
            float s = 0.f;
#pragma unroll 4
            for (int i = 0; i < 64; ++i) s += kk[h0 + i] * kk[h0 + i];
            const float kkn = kk[j] / fmaxf(sqrtf(s), 1e-12f);
            const float kmod = kraw * (1.f + (av - 1.f) * PIN(I_KA)[(size_t)l * 256 + j]);
            bf16_t* rw = RWH + (size_t)row * 1536 + j;
            rw[0] = f2bf(xs[j]); rw[256] = f2bf(kmod); rw[512] = f2bf(xs[512 + j]); rw[768] = f2bf(-kkn); rw[1024] = f2bf(kkn * av); rw[1280] = f2bf(gv); RWD[(size_t)row * 256 + j] = dec;
        }
    }
}

__device__ __forceinline__ void stage_rwprep2(const Params& p, int l, unsigned char* lds) {
    const Ctx cx = mkctx(p); const size_t z = cx.z;
    const int tid = cx.tid, lane = tid & 63, wave = __builtin_amdgcn_readfirstlane(tid >> 6), r = lane & 15, q = lane >> 4;
    bf16_t* ACW = (bf16_t*)lds;
    bf16_t* ACA = (bf16_t*)(lds + 9216);
    bf16_t* ACG = (bf16_t*)(lds + 18432);
    const bf16_t* P = (const bf16_t*)(p.ws + z + WS_P);
    bf16_t* RWH = (bf16_t*)(p.ws + z + WS_RW); float* RWD = (float*)(p.ws + z + WS_RWD);
    const bf16_t* W2T = (const bf16_t*)(p.ws + z + WS_LORA) + (size_t)l * 65536; const bf16_t* A2T = W2T + 16384; const bf16_t* G2T = W2T + 32768;
    const float* mu = PIN(I_MU) + (size_t)l * 1024;
    for (int tile = cx.bid; tile < MP / 64; tile += cx.nb) {
        const int row0 = tile * 64;
#pragma unroll
        for (int it = 0; it < 4; ++it) {
            const int task = it * NTHREADS + tid, tok = task >> 5, ch = task & 31, c = 768 + ch * 8, row = row0 + tok;
            const bf16x8 pa = *(const bf16x8*)(P + (size_t)row * PCOLS + c);
            bf16x8 pv = {0, 0, 0, 0, 0, 0, 0, 0};
            if ((row & (T - 1)) != 0) pv = *(const bf16x8*)(P + (size_t)(row - 1) * PCOLS + c);
            bf16x8 o;
#pragma unroll
            for (int e = 0; e < 8; ++e) { const float a = bf2f((bf16_t)pa[e]), b = bf2f((bf16_t)pv[e]); float x = a + (b - a) * mu[c + e];
                x = ch < 8 ? tanh_fast(x) : (ch >= 16 ? sigmoid_f(x) : x); o[e] = (short)f2bf(x); }
            if (ch < 8) *(bf16x8*)(ACW + tok * LD + ch * 8) = o;
            else if (ch < 16) *(bf16x8*)(ACA + tok * LD + (ch - 8) * 8) = o;
            else *(bf16x8*)(ACG + tok * LD2 + (ch - 16) * 8) = o;
        }
        if ((row0 & (T - 1)) == T - 64) {
            const int n = row0 >> 13;
            for (int c = tid; c < 1024; c += NTHREADS) (p.out + z)[O_PSHIFT + ((size_t)l * NP + n) * 1024 + c] = bf2f(P[(size_t)(row0 + 63) * PCOLS + c]);
        }
        __syncthreads();
        {
            const int h = wave >> 1, th = wave & 1;
#pragma unroll 1
            for (int nt = 0; nt < 2; ++nt) {
                const int tb = 32 * th + 16 * nt, row = row0 + tb + r; const bool first = (row & (T - 1)) == 0;
                float kkv[4][4], avv[4][4]; float ssq = 0.f;
                bf16x4 pc[4][3], pp_[4][3];
#pragma unroll
                for (int mt = 0; mt < 4; ++mt) { const int j = h * 64 + 16 * mt + 4 * q; const bf16x4 zero4 = {0, 0, 0, 0};
#pragma unroll
                    for (int f = 0; f < 3; ++f) { pc[mt][f] = *(const bf16x4*)(P + (size_t)row * PCOLS + 256 * f + j); pp_[mt][f] = first ? zero4 : *(const bf16x4*)(P + (size_t)(row - 1) * PCOLS + 256 * f + j); } }
#pragma unroll
                for (int mt = 0; mt < 4; ++mt) {
                    const int j0 = h * 64 + 16 * mt, j = j0 + 4 * q;
                    f32x4 aw = {0.f, 0.f, 0.f, 0.f}, aa = {0.f, 0.f, 0.f, 0.f}, ag = {0.f, 0.f, 0.f, 0.f};
#pragma unroll
                    for (int s2 = 0; s2 < 2; ++s2) {
                        const bf16x8 fw = *(const bf16x8*)(W2T + (j0 + r) * 64 + 32 * s2 + 8 * q), fa = *(const bf16x8*)(A2T + (j0 + r) * 64 + 32 * s2 + 8 * q);
                        const bf16x8 bw = *(const bf16x8*)(ACW + (tb + r) * LD + 32 * s2 + 8 * q), ba = *(const bf16x8*)(ACA + (tb + r) * LD + 32 * s2 + 8 * q);
                        aw = __builtin_amdgcn_mfma_f32_16x16x32_bf16(fw, bw, aw, 0, 0, 0);
                        aa = __builtin_amdgcn_mfma_f32_16x16x32_bf16(fa, ba, aa, 0, 0, 0);
                    }
#pragma unroll
                    for (int s2 = 0; s2 < 4; ++s2) {
                        const bf16x8 fg = *(const bf16x8*)(G2T + (j0 + r) * 128 + 32 * s2 + 8 * q), bg = *(const bf16x8*)(ACG + (tb + r) * LD2 + 32 * s2 + 8 * q);
                        ag = __builtin_amdgcn_mfma_f32_16x16x32_bf16(fg, bg, ag, 0, 0, 0);
                    }
                    const bf16x4 par = pc[mt][0], pak = pc[mt][1], pav = pc[mt][2], pvr = pp_[mt][0], pvk = pp_[mt][1], pvv = pp_[mt][2];
                    const f32x4 mur = *(const f32x4*)(mu + j), muk = *(const f32x4*)(mu + 256 + j), muv = *(const f32x4*)(mu + 512 + j);
                    const f32x4 w0 = *(const f32x4*)(PIN(I_W0) + (size_t)l * 256 + j), a0 = *(const f32x4*)(PIN(I_A0) + (size_t)l * 256 + j);
                    const f32x4 kkw = *(const f32x4*)(PIN(I_KK) + (size_t)l * 256 + j), kaw = *(const f32x4*)(PIN(I_KA) + (size_t)l * 256 + j);
                    f32x4 fr_, fk_, fv_, fd_;
#pragma unroll
                    for (int e = 0; e < 4; ++e) {
                        const float ar = bf2f((bf16_t)par[e]), ak = bf2f((bf16_t)pak[e]), av_ = bf2f((bf16_t)pav[e]);
                        const float xr = ar + (bf2f((bf16_t)pvr[e]) - ar) * mur[e], xk = ak + (bf2f((bf16_t)pvk[e]) - ak) * muk[e], xv = av_ + (bf2f((bf16_t)pvv[e]) - av_) * muv[e];
                        const float w_log = -softplus_fast(-(w0[e] + aw[e])) - 0.5f;
                        const float av = sigmoid_f(a0[e] + aa[e]);
                        fd_[e] = -__expf(w_log);
                        fr_[e] = xr; fv_[e] = xv;
                        fk_[e] = xk * (1.f + (av - 1.f) * kaw[e]);
                        const float kv = xk * kkw[e]; kkv[mt][e] = kv; avv[mt][e] = av; ssq += kv * kv;
                    }
                    bf16_t* rw = RWH + (size_t)row * 1536 + j;
                    *(bf16x4*)rw = pack4(fr_); *(bf16x4*)(rw + 256) = pack4(fk_); *(bf16x4*)(rw + 512) = pack4(fv_); *(bf16x4*)(rw + 1280) = pack4(ag); *(f32x4*)(RWD + (size_t)row * 256 + j) = fd_;
                }
                ssq += __shfl_xor(ssq, 16); ssq += __shfl_xor(ssq, 32);
                const float rn = 1.f / fmaxf(sqrtf(ssq), 1e-12f);
#pragma unroll
                for (int mt = 0; mt < 4; ++mt) {
                    bf16_t* rw = RWH + (size_t)row * 1536 + h * 64 + 16 * mt + 4 * q;
                    f32x4 fa_, fb_;
#pragma unroll
                    for (int e = 0; e < 4; ++e) { const float kn = kkv[mt][e] * rn; fa_[e] = -kn; fb_[e] = kn * avv[mt][e]; }
                    *(bf16x4*)(rw + 768) = pack4(fa_); *(bf16x4*)(rw + 1024) = pack4(fb_);
                }
            }
        }
        __syncthreads();
    }
}

#define WAVE_LDS_SYNC() do { asm volatile("s_waitcnt lgkmcnt(0)" ::: "memory"); __builtin_amdgcn_wave_barrier(); } while (0)
__device__ __forceinline__ void stage_rwscan(const Params& p, int l, float* lds, int first = 0) {
    const Ctx cx = mkctx(p, first); const size_t z = cx.z;
    const int lane = cx.tid & 63, wave = cx.tid >> 6;
    const bf16_t* RWH = (const bf16_t*)(p.ws + z + WS_RW); const float* RWD = (const float*)(p.ws + z + WS_RWD);
    bf16_t* Y = (bf16_t*)(p.ws + z + WS_YCAT);
    float* wl = lds + wave * 512;
    for (int u = NP * 4 + cx.bid + cx.nb * wave; u < NSEQ * 4; u += cx.nb * NWAVES) {
        const int s = u >> 2, h = u & 3; const bool samp = s >= NP; const int n = samp ? s - NP : s;
        const int row0 = samp ? MP + n : n * T, nt = samp ? 1 : T;
        float S[64];
        if (samp) { const float* st = PIN(I_WKV) + ((((size_t)l * NS + n) * 4 + h) * 64 + lane) * 64;
#pragma unroll
            for (int k = 0; k < 64; k += 4) { const f32x4 v4 = *(const f32x4*)(st + k); S[k] = v4[0]; S[k + 1] = v4[1]; S[k + 2] = v4[2]; S[k + 3] = v4[3]; } }
        else {
#pragma unroll
            for (int k = 0; k < 64; ++k) S[k] = 0.f; }
        const float lng = PIN(I_LNG)[(size_t)l * 256 + h * 64 + lane], lnb = PIN(I_LNB)[(size_t)l * 256 + h * 64 + lane];
        const float rkl = PIN(I_RK)[(size_t)l * 256 + h * 64 + lane];
        for (int t = 0; t < nt; ++t) {
            const bf16_t* rw = RWH + (size_t)(row0 + t) * 1536 + h * 64 + lane;
            const float rl = bf2f(rw[0]), kl = bf2f(rw[256]), vl = bf2f(rw[512]), gl = bf2f(rw[1280]);
            WAVE_LDS_SYNC();
            wl[lane] = rl; wl[64 + lane] = kl; wl[128 + lane] = __expf(RWD[(size_t)(row0 + t) * 256 + h * 64 + lane]); wl[192 + lane] = bf2f(rw[768]); wl[256 + lane] = bf2f(rw[1024]);
            WAVE_LDS_SYNC();
            const float bd = wave_sum(rl * kl * rkl);
            float sa = 0.f;
#pragma unroll
            for (int k = 0; k < 64; ++k) sa += S[k] * wl[192 + k];
            float y = 0.f;
#pragma unroll
            for (int k = 0; k < 64; ++k) {
                S[k] = S[k] * wl[128 + k] + sa * wl[256 + k] + vl * wl[64 + k];
                y += S[k] * wl[k];
            }
            const float mean = wave_sum(y) * (1.f / 64.f), dl = y - mean;
            const float var = wave_sum(dl * dl) * (1.f / 64.f);
            const float yn = dl * rsqrtf(var + GN_EPS) * lng + lnb;
            Y[(size_t)(row0 + t) * D + h * 64 + lane] = f2bf((yn + bd * vl) * gl);
        }
        float* so = (p.out + z) + (samp ? O_SWKV + ((((size_t)l * NS + n) * 4 + h) * 64 + lane) * 64 : O_PWKV + ((((size_t)l * NP + n) * 4 + h) * 64 + lane) * 64);
#pragma unroll
        for (int k = 0; k < 64; k += 4) *(f32x4*)(so + k) = (f32x4){S[k], S[k + 1], S[k + 2], S[k + 3]};
    }
}

constexpr int RWL = 64, NCH = T / RWL, RW_UNITS = NP * 4 * NCH;
__device__ __forceinline__ f32x4 mma16_k64(const bf16_t* A, const bf16_t* Bt, f32x4 acc, int r, int q) {
    const bf16x8 a0 = *(const bf16x8*)(A + r * LD + 8 * q), a1 = *(const bf16x8*)(A + r * LD + 32 + 8 * q);
    const bf16x8 b0 = *(const bf16x8*)(Bt + r * LD + 8 * q), b1 = *(const bf16x8*)(Bt + r * LD + 32 + 8 * q);
    acc = __builtin_amdgcn_mfma_f32_16x16x32_bf16(a0, b0, acc, 0, 0, 0);
    acc = __builtin_amdgcn_mfma_f32_16x16x32_bf16(a1, b1, acc, 0, 0, 0);
    return acc;
}

__device__ __forceinline__ void stage_rw1(const Params& p, int l, unsigned char* lds) {
    const Ctx cx = mkctx(p); const size_t z = cx.z;
    const int tid = cx.tid, lane0 = tid & 63, wave = __builtin_amdgcn_readfirstlane(tid >> 6);
#define RELANE() int lane_ = lane0; asm volatile("" : "+v"(lane_)); const int lane = lane_, r = lane & 15, q = lane >> 4; (void)r; (void)q;
    bf16_t* M = (bf16_t*)lds;
    float* AT = (float*)(lds + 12 * MSZ * 2);
    float* psum = AT + 64 * 68;
    float* PLs = psum + 512;
    bf16_t* TA10 = (bf16_t*)(PLs + 64);
    bf16_t* TT00 = TA10 + 32 * LD; bf16_t* TYT = TT00 + 32 * LD;
    unsigned char* const wsz = p.ws + z;
    for (int uu = cx.bid; uu < RW_UNITS; uu += cx.nb) {
        const int tile = uu & 255, h = uu >> 8, n = tile >> 7, c = tile & (NCH - 1), unit = (n * 4 + h) * NCH + c;
        const int row0 = n * T + c * RWL;
        {
            RELANE();
            const int k = lane, tg = wave;
            const bf16_t* rw = (const bf16_t*)(wsz + WS_RW) + (size_t)(row0 + tg * 8) * 1536 + h * 64 + k; const float* rwd = (const float*)(wsz + WS_RWD) + (size_t)(row0 + tg * 8) * 256 + h * 64 + k;
            float ld[8], f_r[8], f_k[8], f_v[8], f_a[8], f_b[8]; float cs = 0.f;
#pragma unroll
            for (int j = 0; j < 8; ++j) { ld[j] = rwd[j * 256]; f_r[j] = bf2f(rw[j * 1536]); f_k[j] = bf2f(rw[j * 1536 + 256]); f_v[j] = bf2f(rw[j * 1536 + 512]); f_a[j] = bf2f(rw[j * 1536 + 768]); f_b[j] = bf2f(rw[j * 1536 + 1024]); }
#pragma unroll
            for (int j = 0; j < 8; ++j) { cs += ld[j]; ld[j] = cs; }
            psum[tg * 64 + k] = cs;
            __syncthreads();
            float off = 0.f, tot = 0.f;
#pragma unroll
            for (int g = 0; g < 8; ++g) { const float v_ = psum[g * 64 + k]; tot += v_; off += g < tg ? v_ : 0.f; }
            if (tg == 0) PLs[k] = __expf(tot);
            bf16x8 atT, bcT, kcT, vT;
#pragma unroll
            for (int j = 0; j < 8; ++j) {
                const float lp = off + ld[j], lpm1 = j ? off + ld[j - 1] : off;
                const float Pt = __expf(lp), Pinv = __expf(-lp), Pm1 = __expf(lpm1), E = __expf(tot - lp);
                const float rr = f_r[j], km = f_k[j], vv = f_v[j], av = f_a[j], bv = f_b[j];
                const int t = tg * 8 + j;
                const bf16_t at = f2bf(av * Pm1);
                M[0 * MSZ + t * LD + k] = at; atT[j] = (short)at;
                M[3 * MSZ + t * LD + k] = f2bf(rr * Pt);
                M[1 * MSZ + t * LD + k] = f2bf(bv * Pinv);
                M[2 * MSZ + t * LD + k] = f2bf(km * Pinv);
                bcT[j] = (short)f2bf(bv * E); kcT[j] = (short)f2bf(km * E); vT[j] = (short)f2bf(vv);
            }
            *(bf16x8*)(M + 4 * MSZ + k * LD + tg * 8) = atT;
            *(bf16x8*)(M + 5 * MSZ + k * LD + tg * 8) = bcT;
            *(bf16x8*)(M + 6 * MSZ + k * LD + tg * 8) = kcT;
            *(bf16x8*)(M + 7 * MSZ + k * LD + tg * 8) = vT;
        }
        __syncthreads();
        {
            RELANE();
            const int mm = wave >> 1, hh = wave & 1;
            const bf16_t* Asrc = M + (mm < 2 ? 0 : 3) * MSZ; const bf16_t* Bsrc = M + ((mm & 1) ? 2 : 1) * MSZ;
#pragma unroll
            for (int m2 = 0; m2 < 2; ++m2) {
                const int mt = hh * 2 + m2;
#pragma unroll
                for (int nt = 0; nt < 4; ++nt) {
                    float zf = 0.f; asm volatile("" : "+v"(zf));
                    f32x4 acc = {zf, zf, zf, zf};
                    if (nt <= mt) acc = mma16_k64(Asrc + mt * 16 * LD, Bsrc + nt * 16 * LD, acc, r, q);
                    const int i = 16 * nt + r;
#pragma unroll
                    for (int e = 0; e < 4; ++e) { const int t = 16 * mt + 4 * q + e; const bool keep = mm < 2 ? (i < t) : (i <= t); acc[e] = keep ? acc[e] : 0.f; }
                    if (mm == 0) { *(f32x4*)(AT + i * 68 + 16 * mt + 4 * q) = acc;
                        if (mt >= 2 && nt < 2) {
#pragma unroll
                            for (int e = 0; e < 4; ++e) TA10[(16 * (mt - 2) + 4 * q + e) * LD + i] = f2bf(acc[e]); } }
                    else {
                        bf16_t* dst = M + (7 + mm) * MSZ;
#pragma unroll
                        for (int e = 0; e < 4; ++e) dst[(16 * mt + 4 * q + e) * LD + i] = f2bf(acc[e]);
                    }
                }
            }
        }
        __syncthreads();
        if (wave == 0) {
            RELANE();
            const int blk = lane >> 5, jl = lane & 31;
            const float* ATl = AT + blk * (32 * 68 + 32);
            float tc[32];
#pragma unroll
            for (int t = 0; t < 32; ++t) tc[t] = (t == jl) ? 1.f : 0.f;
            int aoff = 0;
            float cur[31], nxt[31];
#pragma unroll
            for (int t = 1; t < 32; ++t) cur[t - 1] = ATl[t];
#pragma unroll
            for (int i = 0; i < 31; ++i) {
                asm volatile("" : "+v"(aoff), "+v"(tc[i]));
                if (i + 1 < 31) {
#pragma unroll
                    for (int t = i + 2; t < 32; ++t) nxt[t - i - 2] = ATl[aoff + (i + 1) * 68 + t];
                }
                const float ti = tc[i];
#pragma unroll
                for (int t = i + 1; t < 32; ++t) tc[t] += cur[t - i - 1] * ti;
#pragma unroll
                for (int t = 0; t < 30; ++t) cur[t] = nxt[t];
            }
            bf16_t* T11 = M + 11 * MSZ;
#pragma unroll
            for (int t = 0; t < 32; ++t) { T11[(blk * 32 + t) * LD + lane] = f2bf(tc[t]); if (blk) T11[t * LD + lane] = 0; }
            if (blk == 0) {
#pragma unroll
                for (int c8 = 0; c8 < 4; ++c8) { bf16x8 o;
#pragma unroll
                    for (int e = 0; e < 8; ++e) o[e] = (short)f2bf(tc[c8 * 8 + e]);
                    *(bf16x8*)(TT00 + jl * LD + c8 * 8) = o; }
            }
        } else if (wave >= 4) {
            RELANE();
            const int mt = wave - 4;
#pragma unroll
            for (int nt = 0; nt < 4; ++nt) {
                f32x4 acc = {0.f, 0.f, 0.f, 0.f};
                acc = mma16_k64(M + 7 * MSZ + mt * 16 * LD, M + 8 * MSZ + nt * 16 * LD, acc, r, q);
#pragma unroll
                for (int e = 0; e < 4; ++e) M[1 * MSZ + (16 * mt + 4 * q + e) * LD + 16 * nt + r] = f2bf(acc[e]);
            }
        }
        __syncthreads();
        if (wave < 4) {
            RELANE();
            const int mt = wave >> 1, nt = wave & 1;
            const bf16x8 a = *(const bf16x8*)(TA10 + (16 * mt + r) * LD + 8 * q), b = *(const bf16x8*)(TT00 + (16 * nt + r) * LD + 8 * q);
            f32x4 acc = {0.f, 0.f, 0.f, 0.f};
            acc = __builtin_amdgcn_mfma_f32_16x16x32_bf16(a, b, acc, 0, 0, 0);
#pragma unroll
            for (int e = 0; e < 4; ++e) TYT[(16 * nt + r) * LD + 16 * mt + 4 * q + e] = f2bf(acc[e]);
        }
        __syncthreads();
        if (wave < 4) {
            RELANE();
            const int mt = wave >> 1, nt = wave & 1;
            const bf16x8 a = *(const bf16x8*)(M + 11 * MSZ + (32 + 16 * mt + r) * LD + 32 + 8 * q), b = *(const bf16x8*)(TYT + (16 * nt + r) * LD + 8 * q);
            f32x4 acc = {0.f, 0.f, 0.f, 0.f};
            acc = __builtin_amdgcn_mfma_f32_16x16x32_bf16(a, b, acc, 0, 0, 0);
#pragma unroll
            for (int e = 0; e < 4; ++e) M[11 * MSZ + (32 + 16 * mt + 4 * q + e) * LD + 16 * nt + r] = f2bf(acc[e]);
        }
        __syncthreads();
        {
            RELANE();
            const int mt = wave & 3; const bf16_t* Asrc = M + (wave < 4 ? 4 : 1) * MSZ; bf16_t* dst = M + (wave < 4 ? 0 : 2) * MSZ;
#pragma unroll
            for (int nt = 0; nt < 4; ++nt) {
                f32x4 acc = {0.f, 0.f, 0.f, 0.f};
                acc = mma16_k64(Asrc + mt * 16 * LD, M + 11 * MSZ + nt * 16 * LD, acc, r, q);
#pragma unroll
                for (int e = 0; e < 4; ++e) dst[(16 * mt + 4 * q + e) * LD + 16 * nt + r] = f2bf(acc[e]);
            }
        }
        __syncthreads();
        {
            RELANE();
            const int job = wave >> 1;
            bf16_t* RPg = (bf16_t*)(wsz + WS_RWC_RP); bf16_t* MCg = (bf16_t*)(wsz + WS_RWC_MC); bf16_t* NCTg = (bf16_t*)(wsz + WS_RWC_NCT); float* Y0g = (float*)(wsz + WS_RWC_Y0);
#pragma unroll
            for (int m2 = 0; m2 < 2; ++m2) {
                const int mt = (wave & 1) * 2 + m2;
#pragma unroll
                for (int nt = 0; nt < 4; ++nt) {
                    const size_t ub = (size_t)unit * 4096;
                    if (job == 0) {
                        const bf16x4 in = *(const bf16x4*)(M + 3 * MSZ + (16 * nt + r) * LD + 16 * mt + 4 * q);
                        f32x4 acc = {bf2f((bf16_t)in[0]), bf2f((bf16_t)in[1]), bf2f((bf16_t)in[2]), bf2f((bf16_t)in[3])};
                        acc = mma16_k64(M + 0 * MSZ + mt * 16 * LD, M + 9 * MSZ + nt * 16 * LD, acc, r, q);
                        *(bf16x4*)(RPg + ub + (16 * nt + r) * 64 + 16 * mt + 4 * q) = pack4(acc);
                    } else if (job == 1) {
                        f32x4 acc = {0.f, 0.f, 0.f, 0.f};
                        acc = mma16_k64(M + 0 * MSZ + mt * 16 * LD, M + 5 * MSZ + nt * 16 * LD, acc, r, q);
                        const int k1 = 16 * nt + r; const float pl = PLs[k1];
#pragma unroll
                        for (int e = 0; e < 4; ++e) acc[e] += (16 * mt + 4 * q + e == k1) ? pl : 0.f;
                        *(bf16x4*)(MCg + ub + k1 * 64 + 32 * (mt >> 1) + 8 * q + 4 * (mt & 1)) = pack4(acc);
                    } else if (job == 2) {
                        f32x4 acc = {0.f, 0.f, 0.f, 0.f};
                        acc = mma16_k64(M + 2 * MSZ + mt * 16 * LD, M + 9 * MSZ + nt * 16 * LD, acc, r, q);
                        acc = mma16_k64(M + 7 * MSZ + mt * 16 * LD, M + 10 * MSZ + nt * 16 * LD, acc, r, q);
                        *(f32x4*)(Y0g + ub + (16 * nt + r) * 64 + 16 * mt + 4 * q) = acc;
                    } else {
                        f32x4 acc = {0.f, 0.f, 0.f, 0.f};
                        acc = mma16_k64(M + 5 * MSZ + mt * 16 * LD, M + 2 * MSZ + nt * 16 * LD, acc, r, q);
                        acc = mma16_k64(M + 6 * MSZ + mt * 16 * LD, M + 7 * MSZ + nt * 16 * LD, acc, r, q);
                        *(bf16x4*)(NCTg + ub + (16 * nt + r) * 64 + 16 * mt + 4 * q) = pack4(acc);
                    }
                }
            }
        }
        __syncthreads();
    }
}
#undef RELANE

constexpr int RW2_D = 8, RW2_SLOT = 2 * MSZ;
struct RwRegs { bf16x8 m0, m1, n0, n1; };
__device__ __forceinline__ void rw2_fetch(RwRegs& R, const bf16_t* mc, const bf16_t* nct, int c, int lt) {
    const int cc = c & (NCH - 1);
    R.m0 = *(const bf16x8*)(mc + (size_t)cc * 4096 + lt * 8); R.m1 = *(const bf16x8*)(mc + (size_t)cc * 4096 + 2048 + lt * 8);
    R.n0 = *(const bf16x8*)(nct + (size_t)cc * 4096 + lt * 8); R.n1 = *(const bf16x8*)(nct + (size_t)cc * 4096 + 2048 + lt * 8);
}
__device__ __forceinline__ void rw2_put(const RwRegs& R, bf16_t* slot, int lt) {
    const int row = lt >> 3, pc = lt & 7;
    *(bf16x8*)(slot + row * LD + pc * 8) = R.m0; *(bf16x8*)(slot + (row + 32) * LD + pc * 8) = R.m1;
    *(bf16x8*)(slot + MSZ + row * LD + pc * 8) = R.n0; *(bf16x8*)(slot + MSZ + (row + 32) * LD + pc * 8) = R.n1;
}
__device__ __forceinline__ void rw2_consume(f32x4 (&acc)[4], const bf16_t* slot, bf16_t* s0, int c, int r, int q, int v) {
    bf16x4 pk[4];
#pragma unroll
    for (int mt = 0; mt < 4; ++mt) { pk[mt] = pack4(acc[mt]); *(bf16x4*)(s0 + (size_t)c * 4096 + v * 64 + 16 * mt + 4 * q) = pk[mt]; }
    const bf16x8 b0 = {pk[0][0], pk[0][1], pk[0][2], pk[0][3], pk[1][0], pk[1][1], pk[1][2], pk[1][3]};
    const bf16x8 b1 = {pk[2][0], pk[2][1], pk[2][2], pk[2][3], pk[3][0], pk[3][1], pk[3][2], pk[3][3]};
#pragma unroll
    for (int mt = 0; mt < 4; ++mt) {
        const bf16x8 a0 = *(const bf16x8*)(slot + (16 * mt + r) * LD + 8 * q), a1 = *(const bf16x8*)(slot + (16 * mt + r) * LD + 32 + 8 * q);
        const bf16x4 nc = *(const bf16x4*)(slot + MSZ + v * LD + 16 * mt + 4 * q);
        f32x4 ci = {bf2f((bf16_t)nc[0]), bf2f((bf16_t)nc[1]), bf2f((bf16_t)nc[2]), bf2f((bf16_t)nc[3])};
        ci = __builtin_amdgcn_mfma_f32_16x16x32_bf16(a0, b0, ci, 0, 0, 0);
        acc[mt] = __builtin_amdgcn_mfma_f32_16x16x32_bf16(a1, b1, ci, 0, 0, 0);
    }
}
__device__ __forceinline__ void stage_rw2(const Params& p, int l, unsigned char* lds) {
    const Ctx cx = mkctx(p); const size_t z = cx.z;
    const int tid = cx.tid, lane = tid & 63, wave = __builtin_amdgcn_readfirstlane(tid >> 6), r = lane & 15, q = lane >> 4;
    if (cx.bid < NP * 4) {
        const int nh = cx.bid, v = 16 * (wave & 3) + r;
        const bf16_t* mc = (const bf16_t*)(p.ws + z + WS_RWC_MC) + (size_t)nh * NCH * 4096;
        bf16_t* nct = (bf16_t*)(p.ws + z + WS_RWC_NCT) + (size_t)nh * NCH * 4096;
        bf16_t* L0 = (bf16_t*)lds; bf16_t* L1 = L0 + RW2_SLOT;
        f32x4 acc[4];
#pragma unroll
        for (int mt = 0; mt < 4; ++mt) acc[mt] = (f32x4){0.f, 0.f, 0.f, 0.f};
        RwRegs R0, R1, R2, R3, R4, R5, R6, R7;
        const int lt = tid - 256;
        if (wave >= 4) {
            { RwRegs F; rw2_fetch(F, mc, nct, 0, lt); rw2_put(F, L0, lt); }
            rw2_fetch(R0, mc, nct, 1, lt); rw2_fetch(R1, mc, nct, 2, lt); rw2_fetch(R2, mc, nct, 3, lt); rw2_fetch(R3, mc, nct, 4, lt);
            rw2_fetch(R4, mc, nct, 5, lt); rw2_fetch(R5, mc, nct, 6, lt); rw2_fetch(R6, mc, nct, 7, lt); rw2_fetch(R7, mc, nct, 8, lt);
        }
        __syncthreads();
        if (wave >= 4) {
#define RW2_LSTEP(RR, c) do { rw2_put(RR, ((c) & 1) ? L0 : L1, lt); rw2_fetch(RR, mc, nct, (c) + 1 + RW2_D, lt); __syncthreads(); } while (0)
#pragma unroll 1
            for (int c = 0; c < NCH; c += 8) {
                RW2_LSTEP(R0, c); RW2_LSTEP(R1, c + 1); RW2_LSTEP(R2, c + 2); RW2_LSTEP(R3, c + 3);
                RW2_LSTEP(R4, c + 4); RW2_LSTEP(R5, c + 5); RW2_LSTEP(R6, c + 6); RW2_LSTEP(R7, c + 7);
            }
#undef RW2_LSTEP
        } else {
#pragma unroll 1
            for (int c = 0; c < NCH; c += 2) {
                rw2_consume(acc, L0, nct, c, r, q, v); __syncthreads();
                rw2_consume(acc, L1, nct, c + 1, r, q, v); __syncthreads();
            }
        }
#define RW2_STEP(RR, c)
#undef RW2_STEP
        if (wave < 4) {
            float* so = (p.out + z) + O_PWKV + ((size_t)l * NP * 4 + nh) * 4096 + v * 64 + 4 * q;
#pragma unroll
            for (int mt = 0; mt < 4; ++mt) *(f32x4*)(so + 16 * mt) = acc[mt];
        }
    }
}

__device__ __forceinline__ void stage_rw3(const Params& p, int l, int first = 0) {
    const Ctx cx = mkctx(p, first); const size_t z = cx.z;
    const int tid = cx.tid, lane = tid & 63, wave = tid >> 6, r = lane & 15, q = lane >> 4;
    const bf16_t* RWH = (const bf16_t*)(p.ws + z + WS_RW);
    const bf16_t* RPg = (const bf16_t*)(p.ws + z + WS_RWC_RP); const bf16_t* S0g = (const bf16_t*)(p.ws + z + WS_RWC_NCT);
    const float* Y0g = (const float*)(p.ws + z + WS_RWC_Y0);
    bf16_t* Y = (bf16_t*)(p.ws + z + WS_YCAT);
    for (int it = cx.bid; it < RW_UNITS / 2; it += cx.nb) {
        const int c = (it & 63) * 2 + (wave >> 2), nh = it >> 6, n = nh >> 2, h = nh & 3, unit = nh * NCH + c, nt = wave & 3;
        const int t = 16 * nt + r, row = n * T + c * RWL + t;
        const size_t ub = (size_t)unit * 4096;
        const bf16x8 rp0 = *(const bf16x8*)(RPg + ub + t * 64 + 8 * q), rp1 = *(const bf16x8*)(RPg + ub + t * 64 + 32 + 8 * q);
        const bf16_t* rw = RWH + (size_t)row * 1536 + h * 64;
        f32x4 y[4]; float sum = 0.f, bd = 0.f;
#pragma unroll
        for (int mt = 0; mt < 4; ++mt) {
            const bf16x8 s0 = *(const bf16x8*)(S0g + ub + (16 * mt + r) * 64 + 8 * q), s1 = *(const bf16x8*)(S0g + ub + (16 * mt + r) * 64 + 32 + 8 * q);
            f32x4 acc = *(const f32x4*)(Y0g + ub + t * 64 + 16 * mt + 4 * q);
            acc = __builtin_amdgcn_mfma_f32_16x16x32_bf16(s0, rp0, acc, 0, 0, 0);
            acc = __builtin_amdgcn_mfma_f32_16x16x32_bf16(s1, rp1, acc, 0, 0, 0);
            y[mt] = acc; sum += (acc[0] + acc[1]) + (acc[2] + acc[3]);
            const f32x4 rr = ld4bf(rw + 16 * mt + 4 * q), km = ld4bf(rw + 256 + 16 * mt + 4 * q), rk = *(const f32x4*)(PIN(I_RK) + (size_t)l * 256 + h * 64 + 16 * mt + 4 * q);
            bd += (rr[0] * km[0] * rk[0] + rr[1] * km[1] * rk[1]) + (rr[2] * km[2] * rk[2] + rr[3] * km[3] * rk[3]);
        }
        sum += __shfl_xor(sum, 16); sum += __shfl_xor(sum, 32);
        bd += __shfl_xor(bd, 16); bd += __shfl_xor(bd, 32);
        const float mean = sum * (1.f / 64.f); float vs = 0.f;
#pragma unroll
        for (int mt = 0; mt < 4; ++mt)
#pragma unroll
            for (int e = 0; e < 4; ++e) { const float d_ = y[mt][e] - mean; vs += d_ * d_; }
        vs += __shfl_xor(vs, 16); vs += __shfl_xor(vs, 32);
        const float rstd = rsqrtf(vs * (1.f / 64.f) + GN_EPS);
#pragma unroll
        for (int mt = 0; mt < 4; ++mt) {
            const int vi = 16 * mt + 4 * q;
            const f32x4 vv = ld4bf(rw + 512 + vi), gg = ld4bf(rw + 1280 + vi);
            const f32x4 lg = *(const f32x4*)(PIN(I_LNG) + (size_t)l * 256 + h * 64 + vi), lb = *(const f32x4*)(PIN(I_LNB) + (size_t)l * 256 + h * 64 + vi);
            f32x4 o;
#pragma unroll
            for (int e = 0; e < 4; ++e) o[e] = ((y[mt][e] - mean) * rstd * lg[e] + lb[e] + bd * vv[e]) * gg[e];
            *(bf16x4*)(Y + (size_t)row * D + h * 64 + vi) = pack4(o);
        }
    }
}

__device__ __forceinline__ void stage_qkn(const Params& p, int l) {
    const Ctx cx = mkctx(p); const size_t z = cx.z;
    const int lane = cx.tid & 63, gw = cx.bid * NWAVES + (cx.tid >> 6), GW = cx.nb * NWAVES;
    const bf16_t* P = (const bf16_t*)(p.ws + z + WS_P);
    float* QN = (float*)(p.ws + z + WS_QN); float* KN = (float*)(p.ws + z + WS_KN);
    for (int it = MP * 6 + gw; it < R * 6; it += GW) {
        const int row = it / 6, unit = it % 6;
        const bool samp = row >= MP; const int n = samp ? row - MP : row >> 13, t = samp ? 0 : (row & (T - 1));
        const float x = bf2f(P[(size_t)row * PCOLS + OFF_B + unit * 64 + lane]);
        const float ss = wave_sum(x * x) * (1.f / 64.f);
        const float g = unit < 4 ? PIN(I_QNG)[(size_t)l * 64 + lane] : PIN(I_KNG)[(size_t)l * 64 + lane];
        const float y = x * rsqrtf(ss + NORM_EPS) * g;
        if (unit < 4) QN[(size_t)row * 256 + unit * 64 + lane] = y;
        else {
            const int kvh = unit - 4;
            KN[(size_t)row * 128 + kvh * 64 + lane] = y;
            const float v = bf2f(P[(size_t)row * PCOLS + OFF_B + 384 + kvh * 64 + lane]);
            if (samp) { const size_t o = (((size_t)l * NS + n) * 128 + 127) * 128 + kvh * 64 + lane; (p.out + z)[O_SK + o] = y; (p.out + z)[O_SV + o] = v; }
            else if (t >= T - 128) { const size_t o = (((size_t)l * NP + n) * 128 + (t - (T - 128))) * 128 + kvh * 64 + lane; (p.out + z)[O_PK + o] = y; (p.out + z)[O_PV + o] = v; }
        }
    }
}

__device__ __forceinline__ void stage_cachecopy(const Params& p, int l, int first = 0) {
    const Ctx cx = mkctx(p, first); const size_t z = cx.z;
    {
        typedef float f4 __attribute__((ext_vector_type(4)));
        const unsigned gt4 = (unsigned)cx.bid * NTHREADS + cx.tid, GT4 = (unsigned)cx.nb * NTHREADS;
        for (unsigned i = gt4; i < (unsigned)NS * 4064; i += GT4) {
            const unsigned n = i / 4064u, o4 = i - n * 4064u;
            const size_t src = (((size_t)l * NS + n) * 128 + 1) * 128 + (size_t)o4 * 4, dst = ((size_t)l * NS + n) * 128 * 128 + (size_t)o4 * 4;
            *(f4*)((p.out + z) + O_SK + dst) = *(const f4*)(PIN(I_CK) + src); *(f4*)((p.out + z) + O_SV + dst) = *(const f4*)(PIN(I_CV) + src);
        }
    }
}

__device__ __forceinline__ void stage_att(const Params& p, int l, int first = 0) {
    const Ctx cx = mkctx(p, first); const size_t z = cx.z;
    const int lane = cx.tid & 63, gw = cx.bid * NWAVES + (cx.tid >> 6), GW = cx.nb * NWAVES;
    const bf16_t* P = (const bf16_t*)(p.ws + z + WS_P);
    const float* QN = (const float*)(p.ws + z + WS_QN); const float* KN = (const float*)(p.ws + z + WS_KN);
    bf16_t* Y = (bf16_t*)(p.ws + z + WS_YCAT);
    for (int it = MP * 4 + gw; it < R * 4; it += GW) {
        const int row = it >> 2, hq = it & 3, kvh = hq >> 1;
        const bool samp = row >= MP; const int n = samp ? row - MP : row >> 13, t = samp ? 0 : (row & (T - 1));
        const int rowbase = row - t;
        const float* q = QN + (size_t)row * 256 + hq * 64;
        const float sink = PIN(I_SINK)[(size_t)l * 4 + hq];
        f32x4 qreg[16];
#pragma unroll
        for (int d4 = 0; d4 < 16; ++d4) qreg[d4] = *(const f32x4*)(q + 4 * d4);
        float sc[3]; float mx = -INFINITY;
#pragma unroll
        for (int j = 0; j < 3; ++j) {
            const int i = lane + 64 * j; sc[j] = -INFINITY;
            if (i <= 128) {
                const int pos = t - 128 + i;
                const float* kp = nullptr;
                if (pos >= 0) kp = KN + (size_t)(rowbase + pos) * 128 + kvh * 64;
                else if (samp) kp = PIN(I_CK) + (((size_t)l * NS + n) * 128 + i) * 128 + kvh * 64;
                if (kp) { float s = 0.f;
#pragma unroll
                    for (int hf = 0; hf < 2; ++hf) {
                        f32x4 kv[8];
#pragma unroll
                        for (int d4 = 0; d4 < 8; ++d4) kv[d4] = *(const f32x4*)(kp + 32 * hf + 4 * d4);
#pragma unroll
                        for (int d4 = 0; d4 < 8; ++d4) { const f32x4 qv = qreg[8 * hf + d4]; s += (qv[0] * kv[d4][0] + qv[1] * kv[d4][1]) + (qv[2] * kv[d4][2] + qv[3] * kv[d4][3]); }
                        __builtin_amdgcn_sched_barrier(0);
                    }
                    sc[j] = s * 0.125f; }
            }
            mx = fmaxf(mx, sc[j]);
            __builtin_amdgcn_sched_barrier(0);
        }
        mx = fmaxf(wave_max(mx), sink);
        float pr[3]; float sum = 0.f;
#pragma unroll
        for (int j = 0; j < 3; ++j) { pr[j] = sc[j] == -INFINITY ? 0.f : __expf(sc[j] - mx); sum += pr[j]; }
        sum = wave_sum(sum) + __expf(sink - mx);
        float o = 0.f;
        for (int i = 0; i <= 128; ++i) {
            const float prs = i < 64 ? pr[0] : (i < 128 ? pr[1] : pr[2]);
            const float pi = __shfl(prs, i & 63);
            const int pos = t - 128 + i;
            float v = 0.f;
            if (pos >= 0) v = bf2f(P[(size_t)(rowbase + pos) * PCOLS + OFF_B + 384 + kvh * 64 + lane]);
            else if (samp) v = PIN(I_CV)[(((size_t)l * NS + n) * 128 + i) * 128 + kvh * 64 + lane];
            o += pi * v;
        }
        Y[(size_t)row * D + 256 + hq * 64 + lane] = f2bf(o / sum);
    }
}

constexpr int LDV = 264;
__device__ __forceinline__ void stage_attn(const Params& p, int l, unsigned char* lds, int first = 0) {
    const Ctx cx = mkctx(p, first); const size_t z = cx.z;
    const int tid = cx.tid, lane = tid & 63, wave = __builtin_amdgcn_readfirstlane(tid >> 6), r = lane & 15, q = lane >> 4;
    bf16_t* Ks = (bf16_t*)lds;
    bf16_t* Qs = (bf16_t*)(lds + 36864);
    bf16_t* Vt = (bf16_t*)(lds + 73728);
    const bf16_t* P = (const bf16_t*)(p.ws + z + WS_P);
    bf16_t* Y = (bf16_t*)(p.ws + z + WS_YCAT);
    for (int unit = cx.bid; unit < NP * 2 * (T / 128); unit += cx.nb) {
        const int b = unit & 63, kvh = (unit >> 6) & 1, n = unit >> 7, t0 = b * 128;
        const size_t rowb = (size_t)n * T;
        float gk[8], gq[8];
#pragma unroll
        for (int j = 0; j < 8; ++j) { gk[j] = PIN(I_KNG)[(size_t)l * 64 + (tid & 7) * 8 + j]; gq[j] = PIN(I_QNG)[(size_t)l * 64 + (tid & 7) * 8 + j]; }
        bf16x8 kraw[4], qraw[4], vraw[4];
#pragma unroll
        for (int it = 0; it < 4; ++it) {
            const int task = it * NTHREADS + tid, c8 = task & 7, kk = task >> 3, kp = t0 - 128 + kk, g = kk >> 7, tl = kk & 127;
            const bf16x8 zz = {0, 0, 0, 0, 0, 0, 0, 0};
            kraw[it] = kp >= 0 ? *(const bf16x8*)(P + (rowb + kp) * PCOLS + OFF_B + 256 + kvh * 64 + c8 * 8) : zz;
            qraw[it] = *(const bf16x8*)(P + (rowb + t0 + tl) * PCOLS + OFF_B + (kvh * 2 + g) * 64 + c8 * 8);
            const int d = task & 63, m0 = (task >> 6) * 8;
#pragma unroll
            for (int j = 0; j < 8; ++j) { const int vp = t0 - 128 + m0 + j; vraw[it][j] = vp >= 0 ? (short)P[(rowb + vp) * PCOLS + OFF_B + 384 + kvh * 64 + d] : (short)0; }
        }
#pragma unroll
        for (int it = 0; it < 4; ++it) {
            const int task = it * NTHREADS + tid, c8 = task & 7;
            {
                const int kk = task >> 3;
                float x[8]; float ss = 0.f;
#pragma unroll
                for (int j = 0; j < 8; ++j) { x[j] = bf2f((bf16_t)kraw[it][j]); ss += x[j] * x[j]; }
                ss += __shfl_xor(ss, 1); ss += __shfl_xor(ss, 2); ss += __shfl_xor(ss, 4);
                const float rstd = rsqrtf(ss * (1.f / 64.f) + NORM_EPS);
                bf16x8 o;
#pragma unroll
                for (int j = 0; j < 8; ++j) { x[j] = x[j] * rstd * gk[j]; o[j] = (short)f2bf(x[j]); }
                *(bf16x8*)(Ks + kk * LD + c8 * 8) = o;
                if (b == 63 && kk >= 128) { float* ko = (p.out + z) + O_PK + (((size_t)l * NP + n) * 128 + (kk - 128)) * 128 + kvh * 64 + c8 * 8;
#pragma unroll
                    for (int j = 0; j < 8; ++j) ko[j] = x[j]; }
            }
            {
                const int qr = task >> 3;
                float x[8]; float ss = 0.f;
#pragma unroll
                for (int j = 0; j < 8; ++j) { x[j] = bf2f((bf16_t)qraw[it][j]); ss += x[j] * x[j]; }
                ss += __shfl_xor(ss, 1); ss += __shfl_xor(ss, 2); ss += __shfl_xor(ss, 4);
                const float rstd = rsqrtf(ss * (1.f / 64.f) + NORM_EPS) * 0.125f;
                bf16x8 o;
#pragma unroll
                for (int j = 0; j < 8; ++j) o[j] = (short)f2bf(x[j] * rstd * gq[j]);
                *(bf16x8*)(Qs + qr * LD + c8 * 8) = o;
            }
            {
                const int d = task & 63, m0 = (task >> 6) * 8;
                *(bf16x8*)(Vt + d * LDV + m0) = vraw[it];
                if (b == 63 && m0 >= 128) { float* vo = (p.out + z) + O_PV + (((size_t)l * NP + n) * 128 + (m0 - 128)) * 128 + kvh * 64 + d;
#pragma unroll
                    for (int j = 0; j < 8; ++j) vo[j * 128] = bf2f((bf16_t)vraw[it][j]); }
            }
        }
        __syncthreads();
        {
            const int g = wave >> 2, sb = wave & 3, hq = kvh * 2 + g;
            const float sink = PIN(I_SINK)[(size_t)l * 4 + hq];
#pragma unroll 1
            for (int mt = 0; mt < 2; ++mt) {
                const int ql = 32 * sb + 16 * mt + r;
                const bf16_t* Qb = Qs + (g * 128 + 32 * sb + 16 * mt) * LD;
                f32x4 sacc[10]; float mx = -INFINITY;
#pragma unroll
                for (int j = 0; j < 10; ++j) {
                    f32x4 a = {0.f, 0.f, 0.f, 0.f};
                    a = mma16_k64(Ks + (32 * sb + 16 * j) * LD, Qb, a, r, q);
#pragma unroll
                    for (int e = 0; e < 4; ++e) { const int kk = 32 * sb + 16 * j + 4 * q + e, rel = ql + 128 - kk;
                        const bool ok = rel >= 0 && rel <= 128 && (t0 - 128 + kk) >= 0;
                        a[e] = ok ? a[e] : -INFINITY; mx = fmaxf(mx, a[e]); }
                    sacc[j] = a;
                    __builtin_amdgcn_sched_barrier(0);
                }
                mx = fmaxf(mx, __shfl_xor(mx, 16)); mx = fmaxf(mx, __shfl_xor(mx, 32)); mx = fmaxf(mx, sink);
                float sum = 0.f;
#pragma unroll
                for (int j = 0; j < 10; ++j)
#pragma unroll
                    for (int e = 0; e < 4; ++e) { const float pv = __expf(sacc[j][e] - mx); sacc[j][e] = pv; sum += pv; }
                sum += __shfl_xor(sum, 16); sum += __shfl_xor(sum, 32); sum += __expf(sink - mx);
                const float inv = 1.f / sum;
                f32x4 o[4];
#pragma unroll
                for (int dt = 0; dt < 4; ++dt) o[dt] = (f32x4){0.f, 0.f, 0.f, 0.f};
#pragma unroll
                for (int s2 = 0; s2 < 5; ++s2) {
                    const bf16x4 p0 = pack4(sacc[2 * s2]), p1 = pack4(sacc[2 * s2 + 1]);
                    const bf16x8 pb = {p0[0], p0[1], p0[2], p0[3], p1[0], p1[1], p1[2], p1[3]};
#pragma unroll
                    for (int dt = 0; dt < 4; ++dt) {
                        const bf16_t* vp = Vt + (16 * dt + r) * LDV + 32 * sb + 32 * s2 + 4 * q;
                        const bf16x4 v0 = *(const bf16x4*)vp, v1 = *(const bf16x4*)(vp + 16);
                        const bf16x8 va = {v0[0], v0[1], v0[2], v0[3], v1[0], v1[1], v1[2], v1[3]};
                        o[dt] = __builtin_amdgcn_mfma_f32_16x16x32_bf16(va, pb, o[dt], 0, 0, 0);
                    }
                    __builtin_amdgcn_sched_barrier(0);
                }
                bf16_t* yo = Y + (rowb + t0 + ql) * D + 256 + hq * 64 + 4 * q;
#pragma unroll
                for (int dt = 0; dt < 4; ++dt) { f32x4 ov = o[dt] * inv; *(bf16x4*)(yo + 16 * dt) = pack4(ov); }
            }
        }
        __syncthreads();
    }
}

__device__ __forceinline__ void mconv_unit(const Params& p, size_t z, int l, int n, int c, int g, int tid) {
    const bf16_t* P = (const bf16_t*)(p.ws + z + WS_P);
    bf16_t* XB = (bf16_t*)(p.ws + z + WS_XBCC);
    const float* cw = PIN(I_CONVW) + (size_t)l * 4 * 1024; const float* cb = PIN(I_CONVB) + (size_t)l * 1024;
#pragma unroll 1
    for (int i = tid; i < 1024; i += NTHREADS) {
        const int ch = i & 63, c0 = ch < 32 ? g * 256 + ch * 8 : (ch < 48 ? 512 + g * 128 + (ch - 32) * 8 : 768 + g * 128 + (ch - 48) * 8);
        const int row = n * T + c * 128 + (i >> 6) * 8, t = row & (T - 1);
        bf16x8 u[11];
#pragma unroll
        for (int k = 0; k < 11; ++k) { const bf16x8 zz = {0, 0, 0, 0, 0, 0, 0, 0}; u[k] = (t - 3 + k >= 0) ? *(const bf16x8*)(P + (size_t)(row - 3 + k) * PCOLS + OFF_XBC + c0) : zz; }
        float w[4][8], b[8];
#pragma unroll
        for (int e = 0; e < 8; ++e) { b[e] = cb[c0 + e];
#pragma unroll
            for (int j = 0; j < 4; ++j) w[j][e] = cw[j * 1024 + c0 + e]; }
#pragma unroll
        for (int r = 0; r < 8; ++r) { bf16x8 o;
#pragma unroll
            for (int e = 0; e < 8; ++e) { float acc = b[e];
#pragma unroll
                for (int j = 0; j < 4; ++j) acc += w[j][e] * bf2f((bf16_t)u[r + j][e]);
                o[e] = (short)f2bf(silu_f(acc)); }
            *(bf16x8*)(XB + (size_t)(row + r) * 1024 + c0) = o;
            if (t + r >= T - 3) { float* op = (p.out + z) + O_PCONV + (((size_t)l * NP + n) * 3 + (t + r - (T - 3))) * 1024 + c0;
#pragma unroll
                for (int e = 0; e < 8; ++e) op[e] = bf2f((bf16_t)u[3 + r][e]); }
        }
    }
}

__device__ __forceinline__ void stage_mconv(const Params& p, int l) {
    const Ctx cx = mkctx(p); const size_t z = cx.z;
    const unsigned gt = (unsigned)cx.bid * NTHREADS + cx.tid, GT = (unsigned)cx.nb * NTHREADS;
    const bf16_t* P = (const bf16_t*)(p.ws + z + WS_P);
    bf16_t* XB = (bf16_t*)(p.ws + z + WS_XBCC); float* DT = (float*)(p.ws + z + WS_DT);
    const float* cw = PIN(I_CONVW) + (size_t)l * 4 * 1024; const float* cb = PIN(I_CONVB) + (size_t)l * 1024;
    for (unsigned i = (unsigned)MP * 1024 + gt; i < (unsigned)R * 1024; i += GT) {
        const int c = (int)(i & 1023), row = (int)(i >> 10), n = row - MP;
        const float* st = PIN(I_SCONV) + ((size_t)l * NS + n) * 3 * 1024 + c;
        const float raw = bf2f(P[(size_t)row * PCOLS + OFF_XBC + c]);
        const float acc = cb[c] + cw[c] * st[0] + cw[1024 + c] * st[1024] + cw[2048 + c] * st[2048] + cw[3072 + c] * raw;
        XB[i] = f2bf(silu_f(acc));
        float* o = (p.out + z) + O_SCONV + ((size_t)l * NS + n) * 3 * 1024 + c;
        o[0] = st[1024]; o[1024] = st[2048]; o[2048] = raw;
    }
    float* DT2 = (float*)(p.ws + z + WS_DT2);
    for (unsigned i = (unsigned)MP * 8 + gt; i < (unsigned)R * 8; i += GT) DT2[i] = softplus_f(DT[i] + PIN(I_DTB)[(size_t)l * 8 + (i & 7)]);
}

__device__ __forceinline__ void stage_mscan(const Params& p, int l, float* lds, int first = 0) {
    const Ctx cx = mkctx(p, first); const size_t z = cx.z;
    const int lane = cx.tid & 63, wave = cx.tid >> 6;
    const bf16_t* XB = (const bf16_t*)(p.ws + z + WS_XBCC); const float* DT = (const float*)(p.ws + z + WS_DT2);
    float* YT = (float*)(p.ws + z + WS_YTMP);
    float* wl = lds + wave * 512;
    const int dh = lane & 1, pl = lane >> 1;
    for (int u = NP * 16 + cx.bid + cx.nb * wave; u < NSEQ * 16; u += cx.nb * NWAVES) {
        const int s = u >> 4, h = (u >> 1) & 7, ph = u & 1, g = h >> 2; const bool samp = s >= NP; const int n = samp ? s - NP : s;
        const int row0 = samp ? MP + n : n * T, nt = samp ? 1 : T, pp = ph * 32 + pl;
        float hs[64];
        if (samp) { const float* st = PIN(I_SSM) + ((((size_t)l * NS + n) * 8 + h) * 64 + pp) * 128 + dh * 64;
#pragma unroll
            for (int d = 0; d < 64; d += 4) { const f32x4 v4 = *(const f32x4*)(st + d); hs[d] = v4[0]; hs[d + 1] = v4[1]; hs[d + 2] = v4[2]; hs[d + 3] = v4[3]; } }
        else {
#pragma unroll
            for (int d = 0; d < 64; ++d) hs[d] = 0.f; }
        const float A = -__expf(PIN(I_ALOG)[(size_t)l * 8 + h]), Dh = PIN(I_SSMD)[(size_t)l * 8 + h];
        for (int t = 0; t < nt; ++t) {
            const size_t row = (size_t)row0 + t;
            const float dtv = DT[row * 8 + h], dA = __expf(dtv * A);
            const float x = bf2f(XB[row * 1024 + h * 64 + pp]), xdt = x * dtv;
            const bf16_t* b = XB + row * 1024 + 512 + g * 128; const bf16_t* c = XB + row * 1024 + 768 + g * 128;
            WAVE_LDS_SYNC();
            wl[lane] = bf2f(b[lane]); wl[64 + lane] = bf2f(b[64 + lane]); wl[128 + lane] = bf2f(c[lane]); wl[192 + lane] = bf2f(c[64 + lane]);
            WAVE_LDS_SYNC();
            float y = 0.f;
#pragma unroll
            for (int d = 0; d < 64; ++d) { hs[d] = hs[d] * dA + xdt * wl[dh * 64 + d]; y += hs[d] * wl[128 + dh * 64 + d]; }
            y += __shfl_xor(y, 1);
            if (dh == 0) YT[row * 512 + h * 64 + pp] = y + Dh * x;
        }
        float* so = (p.out + z) + (samp ? O_SSSM + ((((size_t)l * NS + n) * 8 + h) * 64 + pp) * 128 : O_PSSM + ((((size_t)l * NP + n) * 8 + h) * 64 + pp) * 128) + dh * 64;
#pragma unroll
        for (int d = 0; d < 64; d += 4) *(f32x4*)(so + d) = (f32x4){hs[d], hs[d + 1], hs[d + 2], hs[d + 3]};
    }
}

__device__ __forceinline__ void mgate_rows(const Params& p, size_t z, int l, int row_lo, int row_hi, int gw, int GW, int lane) {
    const bf16_t* P = (const bf16_t*)(p.ws + z + WS_P); const float* YT = (const float*)(p.ws + z + WS_YTMP);
    bf16_t* Y = (bf16_t*)(p.ws + z + WS_YCAT);
    const f32x4 g0 = *(const f32x4*)(PIN(I_SSMNG) + (size_t)l * 512 + lane * 8), g1 = *(const f32x4*)(PIN(I_SSMNG) + (size_t)l * 512 + lane * 8 + 4);
    for (int row = row_lo + 2 * gw; row < row_hi; row += 2 * GW) {
        f32x4 ya[2][2]; bf16x8 zz[2];
#pragma unroll
        for (int k = 0; k < 2; ++k) { ya[k][0] = *(const f32x4*)(YT + (size_t)(row + k) * 512 + lane * 8); ya[k][1] = *(const f32x4*)(YT + (size_t)(row + k) * 512 + lane * 8 + 4);
            zz[k] = *(const bf16x8*)(P + (size_t)(row + k) * PCOLS + OFF_Z + lane * 8); }
#pragma unroll
        for (int k = 0; k < 2; ++k) {
            float v[8]; float ss = 0.f;
#pragma unroll
            for (int e = 0; e < 8; ++e) { v[e] = ya[k][e >> 2][e & 3] * silu_f(bf2f((bf16_t)zz[k][e])); ss += v[e] * v[e]; }
            const float rstd = rsqrtf(wave_sum(ss) * (1.f / 512.f) + NORM_EPS);
            bf16x8 o;
#pragma unroll
            for (int e = 0; e < 8; ++e) o[e] = (short)f2bf(v[e] * rstd * (e < 4 ? g0[e & 3] : g1[e & 3]));
            *(bf16x8*)(Y + (size_t)(row + k) * D + 512 + lane * 8) = o;
        }
    }
}
constexpr int SL = 128, SNC = T / SL;
__device__ __forceinline__ f32x4 mma16(const bf16_t* A, const bf16_t* Bt, int nsteps, f32x4 acc, int r, int q) {
#pragma unroll
    for (int s = 0; s < 4; ++s) if (s < nsteps) {
        const bf16x8 a = *(const bf16x8*)(A + r * LD2 + 32 * s + 8 * q), b = *(const bf16x8*)(Bt + r * LD2 + 32 * s + 8 * q);
        acc = __builtin_amdgcn_mfma_f32_16x16x32_bf16(a, b, acc, 0, 0, 0);
    }
    return acc;
}
constexpr int SSD_OFF_AUX = 104448;
template <bool FROM_RAW>
__device__ __forceinline__ void ssd_aux(const Params& p, size_t z, int l, int g, int row0, float* aux, int tid) {
    float* DT2 = (float*)(p.ws + z + WS_DT2);
    const int t = tid & 127, e = tid >> 7, h = g * 4 + e;
    float dtv;
    if (FROM_RAW) { dtv = softplus_f(((const float*)(p.ws + z + WS_DT))[(size_t)(row0 + t) * 8 + h] + PIN(I_DTB)[(size_t)l * 8 + h]); DT2[(size_t)(row0 + t) * 8 + h] = dtv; }
    else dtv = DT2[(size_t)(row0 + t) * 8 + h];
    const float A = -__expf(PIN(I_ALOG)[(size_t)l * 8 + h]);
    aux[e * 128 + t] = dtv; aux[512 + e * 128 + t] = dtv * A;
    __syncthreads();
    float acc = 0.f;
    for (int i = 0; i <= t; ++i) acc += aux[512 + e * 128 + i];
    aux[1024 + e * 128 + t] = acc;
    __syncthreads();
}
__device__ __forceinline__ void stage_ssd1(const Params& p, int l, unsigned char* lds) {
    const Ctx cx = mkctx(p); const size_t z = cx.z;
    const int tid = cx.tid, lane = tid & 63, wave = __builtin_amdgcn_readfirstlane(tid >> 6), r = lane & 15, q = lane >> 4;
    bf16_t* BT = (bf16_t*)lds;
    bf16_t* XW = (bf16_t*)(lds + 34816);
    float* aux = (float*)(lds + SSD_OFF_AUX);
    const bf16_t* XB = (const bf16_t*)(p.ws + z + WS_XBCC);
    float* ST = (float*)(p.ws + z + WS_SST); float* CD = (float*)(p.ws + z + WS_SCD);
    for (int unit = cx.bid; unit < NP * SNC * 2; unit += cx.nb) {
        const int g = unit & 1, c = (unit >> 1) & (SNC - 1), n = unit >> 7, row0 = n * T + c * SL;
        mconv_unit(p, z, l, n, c, g, tid);
        asm volatile("s_waitcnt vmcnt(0)" ::: "memory"); __syncthreads();
        const int d = tid & 127, mg = tid >> 7, pp = tid & 63, mgp = tid >> 6;
        bf16x8 bv[4], xv[4][2];
#pragma unroll
        for (int it = 0; it < 4; ++it) { const int m0 = mg * 32 + it * 8;
#pragma unroll
            for (int j = 0; j < 8; ++j) bv[it][j] = (short)XB[(size_t)(row0 + m0 + j) * 1024 + 512 + g * 128 + d]; }
#pragma unroll
        for (int e = 0; e < 4; ++e)
#pragma unroll
            for (int it = 0; it < 2; ++it) { const int m0 = mgp * 16 + it * 8;
#pragma unroll
                for (int j = 0; j < 8; ++j) xv[e][it][j] = (short)XB[(size_t)(row0 + m0 + j) * 1024 + (g * 4 + e) * 64 + pp]; }
        ssd_aux<true>(p, z, l, g, row0, aux, tid);
        {
#pragma unroll
            for (int it = 0; it < 4; ++it) *(bf16x8*)(BT + d * LD2 + mg * 32 + it * 8) = bv[it];
#pragma unroll
            for (int e = 0; e < 4; ++e) { const float alast = aux[1024 + e * 128 + 127];
#pragma unroll
                for (int it = 0; it < 2; ++it) { const int m0 = mgp * 16 + it * 8; bf16x8 v;
#pragma unroll
                    for (int j = 0; j < 8; ++j) { const int m = m0 + j; v[j] = (short)f2bf(bf2f((bf16_t)xv[e][it][j]) * aux[e * 128 + m] * __expf(alast - aux[1024 + e * 128 + m])); }
                    *(bf16x8*)(XW + e * 64 * LD2 + pp * LD2 + m0) = v; } }
        }
        __syncthreads();
#pragma unroll
        for (int e = 0; e < 4; ++e) {
            float* st = ST + ((size_t)(n * SNC + c) * 8 + g * 4 + e) * 8192;
#pragma unroll
            for (int nt = 0; nt < 4; ++nt) {
                f32x4 acc = {0.f, 0.f, 0.f, 0.f};
                acc = mma16(BT + 16 * wave * LD2, XW + e * 64 * LD2 + 16 * nt * LD2, 4, acc, r, q);
                *(f32x4*)(st + (16 * nt + r) * 128 + 16 * wave + 4 * q) = acc;
            }
        }
        if (tid < 4) CD[(size_t)(n * SNC + c) * 8 + g * 4 + tid] = __expf(aux[1024 + tid * 128 + 127]);
        __syncthreads();
    }
}
__device__ __forceinline__ void stage_ssd2(const Params& p, int l) {
    const Ctx cx = mkctx(p); const size_t z = cx.z;
    const int first = cx.nb > 16 ? NP * 4 : 0;
    if (cx.bid >= first) {
        typedef float f32x2 __attribute__((ext_vector_type(2)));
        const float* ST = (const float*)(p.ws + z + WS_SST); const float* CD = (const float*)(p.ws + z + WS_SCD);
        unsigned* HPV = (unsigned*)(p.ws + z + WS_HPREV);
        for (int idx = (cx.bid - first) * NTHREADS + cx.tid; idx < NP * 8 * 4096; idx += (cx.nb - first) * NTHREADS) {
            const int n = idx >> 15, h = (idx >> 12) & 7, pd = (idx & 4095) * 2;
            const float* base = ST + ((size_t)(n * SNC) * 8 + h) * 8192 + pd; const float* cd = CD + (size_t)(n * SNC) * 8 + h;
            unsigned* hb = HPV + (((size_t)(n * SNC) * 8 + h) * 8192 + pd) / 2;
            f32x2 hc = {0.f, 0.f};
#pragma unroll 1
            for (int c0 = 0; c0 < SNC; c0 += 32) {
                f32x2 v[32]; float dcy[32];
#pragma unroll
                for (int k = 0; k < 32; ++k) { v[k] = *(const f32x2*)(base + (size_t)(c0 + k) * 65536); dcy[k] = cd[(c0 + k) * 8]; }
#pragma unroll
                for (int k = 0; k < 32; ++k) { hb[(size_t)(c0 + k) * 32768] = cvtpk(hc[0], hc[1]); hc = hc * dcy[k] + v[k]; }
            }
            *(f32x2*)((p.out + z) + O_PSSM + ((size_t)(l * NP + n) * 8 + h) * 8192 + pd) = hc;
        }
    }
}
__device__ __forceinline__ void stage_ssd3(const Params& p, int l, unsigned char* lds, int first = 0, int count = 0) {
    const Ctx cx = mkctx(p, first, count); const size_t z = cx.z;
    const int tid = cx.tid, lane = tid & 63, wave = __builtin_amdgcn_readfirstlane(tid >> 6), r = lane & 15, q = lane >> 4;
    bf16_t* CM = (bf16_t*)lds;
    bf16_t* BG = (bf16_t*)(lds + 34816);
    bf16_t* XT = (bf16_t*)(lds + 69632);
    bf16_t* HP = (bf16_t*)(lds + 87040);
    float* aux = (float*)(lds + SSD_OFF_AUX);
    const bf16_t* XB = (const bf16_t*)(p.ws + z + WS_XBCC);
    const bf16_t* HPV = (const bf16_t*)(p.ws + z + WS_HPREV);
    float* YT = (float*)(p.ws + z + WS_YTMP);
    for (int u2 = cx.bid; u2 < NP * SNC; u2 += cx.nb)
    for (int g = 0; g < 2; ++g) {
        const int c = u2 & (SNC - 1), n = u2 >> 6, row0 = n * T + c * SL;
        bf16x8 cc[4], bb[4];
        {
            const int d0 = (tid & 15) * 8;
#pragma unroll
            for (int it = 0; it < 4; ++it) { const int row = (tid >> 4) + 32 * it;
                cc[it] = *(const bf16x8*)(XB + (size_t)(row0 + row) * 1024 + 768 + g * 128 + d0); bb[it] = *(const bf16x8*)(XB + (size_t)(row0 + row) * 1024 + 512 + g * 128 + d0); }
        }
        ssd_aux<false>(p, z, l, g, row0, aux, tid);
        {
            const int d0 = (tid & 15) * 8;
#pragma unroll
            for (int it = 0; it < 4; ++it) { const int row = (tid >> 4) + 32 * it; *(bf16x8*)(CM + row * LD2 + d0) = cc[it]; *(bf16x8*)(BG + row * LD2 + d0) = bb[it]; }
        }
        __syncthreads();
        f32x4 cb[8];
#pragma unroll
        for (int nt = 0; nt < 8; ++nt) { cb[nt] = (f32x4){0.f, 0.f, 0.f, 0.f}; if (nt <= wave) cb[nt] = mma16(CM + 16 * wave * LD2, BG + 16 * nt * LD2, 4, cb[nt], r, q); }
        __syncthreads();
        const int xpp = tid & 63, xmg = tid >> 6, hpp = tid >> 3, hd0 = (tid & 7) * 16;
        bf16_t xr[16]; bf16x8 hv[2];
#define SSD3_FETCH(ee) do { const int hh_ = g * 4 + (ee); \
            _Pragma("unroll") for (int j_ = 0; j_ < 16; ++j_) xr[j_] = XB[(size_t)(row0 + xmg * 16 + j_) * 1024 + hh_ * 64 + xpp]; \
            const bf16_t* src_ = HPV + ((size_t)(n * SNC + c) * 8 + hh_) * 8192 + hpp * 128 + hd0; \
            hv[0] = *(const bf16x8*)src_; hv[1] = *(const bf16x8*)(src_ + 8); } while (0)
        SSD3_FETCH(0);
#pragma unroll 1
        for (int e = 0; e < 4; ++e) {
            const int h = g * 4 + e;
            {
#pragma unroll
                for (int nt = 0; nt < 8; ++nt) { const int m = 16 * nt + r; const float am = aux[1024 + e * 128 + m];
#pragma unroll
                    for (int e2 = 0; e2 < 4; ++e2) { const int li = 16 * wave + 4 * q + e2; const float v = (m <= li) ? cb[nt][e2] * __expf(aux[1024 + e * 128 + li] - am) : 0.f; BG[li * LD2 + m] = f2bf(v); } }
#pragma unroll
                for (int it = 0; it < 2; ++it) { const int m0 = xmg * 16 + it * 8; bf16x8 v;
#pragma unroll
                    for (int j = 0; j < 8; ++j) v[j] = (short)f2bf(bf2f(xr[it * 8 + j]) * aux[e * 128 + m0 + j]);
                    *(bf16x8*)(XT + xpp * LD2 + m0) = v; }
                *(bf16x8*)(HP + hpp * LD2 + hd0) = hv[0]; *(bf16x8*)(HP + hpp * LD2 + hd0 + 8) = hv[1];
                if (e + 1 < 4) SSD3_FETCH(e + 1);
            }
            __syncthreads();
            {
                const int li = 16 * wave + r; const size_t row = (size_t)row0 + li;
                const float sc = __expf(aux[1024 + e * 128 + li]), Dh = PIN(I_SSMD)[(size_t)l * 8 + h];
                bf16x4 xq[4];
#pragma unroll
                for (int mt = 0; mt < 4; ++mt) xq[mt] = *(const bf16x4*)(XB + row * 1024 + h * 64 + 16 * mt + 4 * q);
#pragma unroll
                for (int mt = 0; mt < 4; ++mt) {
                    f32x4 ad = {0.f, 0.f, 0.f, 0.f}, ao = {0.f, 0.f, 0.f, 0.f};
                    ad = mma16(XT + 16 * mt * LD2, BG + 16 * wave * LD2, (wave >> 1) + 1, ad, r, q);
                    ao = mma16(HP + 16 * mt * LD2, CM + 16 * wave * LD2, 4, ao, r, q);
                    const bf16x4 xv = xq[mt];
                    f32x4 y;
#pragma unroll
                    for (int e2 = 0; e2 < 4; ++e2) y[e2] = ad[e2] + sc * ao[e2] + Dh * bf2f((bf16_t)xv[e2]);
                    *(f32x4*)(YT + row * 512 + h * 64 + 16 * mt + 4 * q) = y;
                }
            }
            __syncthreads();
        }
        if (g == 1) { asm volatile("s_waitcnt vmcnt(0)" ::: "memory"); __syncthreads(); mgate_rows(p, z, l, row0, row0 + SL, wave, NWAVES, lane); }
#undef SSD3_FETCH
    }
}

__device__ __forceinline__ void stage_mgate_sample(const Params& p, int l, int first) {
    const Ctx cx = mkctx(p, first); const size_t z = cx.z;
    mgate_rows(p, z, l, MP, R, cx.bid * NWAVES + (cx.tid >> 6), cx.nb * NWAVES, cx.tid & 63);
}

__device__ __forceinline__ void stage_glu(const Params& p, int l) {
    const Ctx cx = mkctx(p); const size_t z = cx.z;
    const unsigned gt = (unsigned)cx.bid * NTHREADS + cx.tid, GT = (unsigned)cx.nb * NTHREADS;
    const bf16_t* GV = (const bf16_t*)(p.ws + z + WS_GV); bf16_t* U = (bf16_t*)(p.ws + z + WS_U);
    const float* cw = PIN(I_FCW) + (size_t)l * 3 * DFF; const float* cb = PIN(I_FCB) + (size_t)l * DFF;
    for (unsigned i = gt; i < (unsigned)(MP / 32) * (DFF / 8); i += GT) {
        const int hr = (int)(i / (unsigned)(DFF / 8)), c0 = (int)(i - (unsigned)hr * (DFF / 8)) * 8, row = (hr >> 1) * 64 + (hr & 1), t = row & (T - 1);
        const int cg = 256 * (c0 >> 7) + (c0 & 127);
        bf16x8 u[3];
#pragma unroll
        for (int k = 0; k < 3; ++k) { const bf16x8 zz = {0, 0, 0, 0, 0, 0, 0, 0}; u[k] = (t - 2 + k >= 0) ? *(const bf16x8*)(GV + (size_t)(row - 2 + k) * 5632 + cg) : zz; }
        const bf16x8 vv = *(const bf16x8*)(GV + (size_t)row * 5632 + cg + 128);
        bf16x8 o;
#pragma unroll
        for (int e = 0; e < 8; ++e) { const float acc = cb[c0 + e] + cw[c0 + e] * bf2f((bf16_t)u[0][e]) + cw[DFF + c0 + e] * bf2f((bf16_t)u[1][e]) + cw[2 * DFF + c0 + e] * bf2f((bf16_t)u[2][e]);
            o[e] = (short)f2bf(silu_f(acc) * bf2f((bf16_t)vv[e])); }
        *(bf16x8*)(U + (size_t)row * DFF + c0) = o;
    }
    for (unsigned i = gt; i < (unsigned)NP * 2 * DFF; i += GT) {
        const int c = (int)(i % (unsigned)DFF), j = (int)(i / (unsigned)DFF) & 1, n = (int)(i / (unsigned)(2 * DFF));
        (p.out + z)[O_PFFN + (((size_t)l * NP + n) * 2 + j) * DFF + c] = bf2f(GV[(size_t)(n * T + T - 2 + j) * 5632 + 256 * (c >> 7) + (c & 127)]);
    }
    for (unsigned i = (unsigned)MP * (DFF / 8) + gt; i < (unsigned)R * (DFF / 8); i += GT) {
        const int row = (int)(i / (unsigned)(DFF / 8)), c0 = (int)(i - (unsigned)row * (DFF / 8)) * 8;
        const int cg = 256 * (c0 >> 7) + (c0 & 127);
        const bool samp = row >= MP; const int n = samp ? row - MP : row >> 13, t = samp ? 0 : (row & (T - 1));
        float acc[8], raw[8];
#pragma unroll
        for (int e = 0; e < 8; ++e) acc[e] = cb[c0 + e];
#pragma unroll
        for (int j = 0; j < 3; ++j) {
            const int tau = t - 2 + j; float u[8];
            if (tau >= 0) { const bf16x8 v = *(const bf16x8*)(GV + (size_t)(row - 2 + j) * 5632 + cg);
#pragma unroll
                for (int e = 0; e < 8; ++e) u[e] = bf2f((bf16_t)v[e]); }
            else {
#pragma unroll
                for (int e = 0; e < 8; ++e) u[e] = samp ? PIN(I_FCONV)[(((size_t)l * NS + n) * 2 + (2 + tau)) * DFF + c0 + e] : 0.f; }
#pragma unroll
            for (int e = 0; e < 8; ++e) { acc[e] += cw[j * DFF + c0 + e] * u[e]; if (j == 2) raw[e] = u[e]; }
        }
        const bf16x8 vv = *(const bf16x8*)(GV + (size_t)row * 5632 + cg + 128);
        bf16x8 o;
#pragma unroll
        for (int e = 0; e < 8; ++e) o[e] = (short)f2bf(silu_f(acc[e]) * bf2f((bf16_t)vv[e]));
        *(bf16x8*)(U + (size_t)row * DFF + c0) = o;
        if (samp) { float* op = (p.out + z) + O_SFFN + ((size_t)l * NS + n) * 2 * DFF + c0;
#pragma unroll
            for (int e = 0; e < 8; ++e) { op[e] = PIN(I_FCONV)[(((size_t)l * NS + n) * 2 + 1) * DFF + c0 + e]; op[DFF + e] = raw[e]; } }
        else if (t >= T - 2) { float* op = (p.out + z) + O_PFFN + (((size_t)l * NP + n) * 2 + (t - (T - 2))) * DFF + c0;
#pragma unroll
            for (int e = 0; e < 8; ++e) op[e] = raw[e]; }
    }
}

__device__ __forceinline__ void stage_final(const Params& p) {
    const Ctx cx = mkctx(p); const size_t z = cx.z;
    const size_t gt = (size_t)cx.bid * NTHREADS + cx.tid, GT = (size_t)cx.nb * NTHREADS;
    const float* X = (const float*)(p.out + z);
    for (size_t i = gt; i < (size_t)R * D; i += GT) (p.out + z)[i] = X[i];
}

#define LAS __attribute__((address_space(3)))
typedef unsigned v4u __attribute__((ext_vector_type(4)));
__device__ __forceinline__ unsigned pk2(float lo, float hi) { return cvtpk(lo, hi); }
template <bool GV_PERM = false>
__device__ __forceinline__ void p0_transpose_item(const float* W, int ldw, int K, int nblk, bf16_t* WT, LAS float* scr, int item, int lane) {
    const int kb = item / nblk, nb = item % nblk, k0 = 64 * kb, n0 = 32 * nb;
    int nd = n0;
    if (GV_PERM) { const int bj = n0 >= DFF ? 1 : 0, rem = n0 - bj * DFF; nd = 256 * (rem >> 7) + 128 * bj + (rem & 127); }
#pragma unroll 8
    for (int i = 0; i < 32; ++i) { const int kk = 2 * i + (lane >> 5); scr[kk * 33 + (lane & 31)] = W[(size_t)(k0 + kk) * ldw + n0 + (lane & 31)]; }
    asm volatile("s_waitcnt lgkmcnt(0)" ::: "memory");
    const int c = lane & 7;
#pragma unroll
    for (int j = 0; j < 4; ++j) { const int n = (lane >> 3) + 8 * j; const LAS float* s = scr + (8 * c) * 33 + n;
        v4u o; o.x = pk2(s[0 * 33], s[1 * 33]); o.y = pk2(s[2 * 33], s[3 * 33]); o.z = pk2(s[4 * 33], s[5 * 33]); o.w = pk2(s[6 * 33], s[7 * 33]);
        *(v4u*)(WT + (size_t)(nd + n) * K + k0 + 8 * c) = o; }
    asm volatile("s_waitcnt lgkmcnt(0)" ::: "memory");
}
__device__ __forceinline__ void stage_wconv(const Params& p, unsigned char* lds, int l_lo, int l_hi, int first = 0) {
    const Ctx cx = mkctx(p, first); const size_t z = cx.z;
    if (l_lo == 0) {
        bf16_t* LT = (bf16_t*)(p.ws + z + WS_LORA);
        for (unsigned i = (unsigned)cx.bid * NTHREADS + cx.tid; i < (unsigned)L * 65536; i += (unsigned)cx.nb * NTHREADS) {
            const int l = i >> 16, e = i & 65535, j = e & 255, ii = e >> 8;
            float v; bf16_t* dst;
            if (ii < 64) { v = PIN(I_W2)[(size_t)l * 16384 + ii * 256 + j]; dst = LT + (size_t)l * 65536 + j * 64 + ii; }
            else if (ii < 128) { v = PIN(I_A2)[(size_t)l * 16384 + (ii - 64) * 256 + j]; dst = LT + (size_t)l * 65536 + 16384 + j * 64 + (ii - 64); }
            else { v = PIN(I_G2)[(size_t)l * 32768 + (ii - 128) * 256 + j]; dst = LT + (size_t)l * 65536 + 32768 + j * 128 + (ii - 128); }
            *dst = f2bf(v);
        }
        bf16_t* WD = (bf16_t*)(p.ws + z + WS_WDTT);
        for (unsigned i = (unsigned)cx.bid * NTHREADS + cx.tid; i < (unsigned)L * 16384; i += (unsigned)cx.nb * NTHREADS) {
            const int l = i >> 14, j = (i >> 10) & 15, k = i & 1023;
            WD[i] = j < 8 ? f2bf(PIN(I_WIN)[(size_t)l * D * PROJ + (size_t)k * PROJ + PCOLS + j]) : (bf16_t)0;
        }
    }
    const int lane = cx.tid & 63, wave = cx.tid >> 6;
    LAS float* scr = (LAS float*)(lds + wave * 16384);
    const int gw = cx.bid * NWAVES + wave, NGW = cx.nb * NWAVES;
    constexpr int I_IN = 16 * 96, I_OUT = 16 * 32, I_UP = 16 * 176, I_DN = 44 * 32, PER_L = I_IN + I_OUT + I_UP + I_DN;
    for (int it = gw; it < (l_hi - l_lo) * PER_L; it += NGW) {
        const int l = l_lo + it / PER_L; int r = it % PER_L;
        if (r < I_IN) { p0_transpose_item(PIN(I_WIN) + (size_t)l * D * PROJ, PROJ, D, 96, (bf16_t*)(p.ws + z + WS_WIN) + (size_t)l * PCOLS * D, scr, r, lane); continue; } r -= I_IN;
        if (r < I_OUT) { p0_transpose_item(PIN(I_WOUT) + (size_t)l * D * D, D, D, 32, (bf16_t*)(p.ws + z + WS_WOUT) + (size_t)l * D * D, scr, r, lane); continue; } r -= I_OUT;
        if (r < I_UP) { p0_transpose_item<true>(PIN(I_WUP) + (size_t)l * D * 5632, 5632, D, 176, (bf16_t*)(p.ws + z + WS_WUP) + (size_t)l * 5632 * D, scr, r, lane); continue; } r -= I_UP;
        p0_transpose_item(PIN(I_WDOWN) + (size_t)l * DFF * D, D, DFF, 32, (bf16_t*)(p.ws + z + WS_WDN) + (size_t)l * D * DFF, scr, r, lane);
    }
}

template <int NT, class F>
__device__ __forceinline__ void gemm_small(const Params& p, const bf16_t* A, int lda, const bf16_t* Bt, int N, int K, int ksplit, const F& epi) {
    const Ctx cx = mkctx(p); A += cx.z; Bt += cx.z;
    const int lane = cx.tid & 63, wave = __builtin_amdgcn_readfirstlane(cx.tid >> 6), r = lane & 15, q = lane >> 4;
    const int ntile = N / (16 * NT), kc = K / ksplit;
    for (int task = cx.nb - 1 - cx.bid; task < ntile * ksplit; task += cx.nb) {
        const int tn = task % ntile, ks = task / ntile, n0 = tn * 16 * NT, k0 = ks * kc;
        const bf16_t* ap = A + (size_t)(16 * wave + r) * lda + k0 + 8 * q;
        const bf16_t* bp = Bt + (size_t)(n0 + r) * K + k0 + 8 * q;
        f32x4 acc[NT];
#pragma unroll
        for (int nt = 0; nt < NT; ++nt) acc[nt] = (f32x4){0.f, 0.f, 0.f, 0.f};
#pragma unroll 8
        for (int s2 = 0; s2 < kc / 32; ++s2) {
            const bf16x8 fa = *(const bf16x8*)(ap + 32 * s2);
#pragma unroll
            for (int nt = 0; nt < NT; ++nt) { const bf16x8 fb = *(const bf16x8*)(bp + (size_t)nt * 16 * K + 32 * s2); acc[nt] = __builtin_amdgcn_mfma_f32_16x16x32_bf16(fb, fa, acc[nt], 0, 0, 0); }
        }
#pragma unroll
        for (int nt = 0; nt < NT; ++nt) epi(16 * wave + r, n0 + 16 * nt + 4 * q, acc[nt]);
    }
}
struct SmallBf { bf16_t* O; int ldc; __device__ __forceinline__ void operator()(int row, int col, f32x4 v) const { *(bf16x4*)(O + (size_t)(MP + row) * ldc + col) = pack4(v); } };
struct SmallRes { float* X; const float* gate;   __device__ __forceinline__ void operator()(int row, int col, f32x4 v) const {
    const f32x4 g = *(const f32x4*)(gate + (size_t)(NP + row) * 6144 + col); float* x = X + (size_t)(MP + row) * D + col;
#pragma unroll
    for (int e = 0; e < 4; ++e) unsafeAtomicAdd(x + e, g[e] * v[e]); } };

__device__ __forceinline__ void gemm_small_glu(const Params& p, int l) {
    const Ctx cx = mkctx(p); const size_t z = cx.z;
    const int lane = cx.tid & 63, wave = __builtin_amdgcn_readfirstlane(cx.tid >> 6), r = lane & 15, q = lane >> 4;
    const bf16_t* A = (const bf16_t*)(p.ws + z + WS_H) + (size_t)MP * D; const bf16_t* Bt = (const bf16_t*)(p.ws + z + WS_WUP) + (size_t)l * 5632 * D;
    bf16_t* U = (bf16_t*)(p.ws + z + WS_U);
    const float* cw = PIN(I_FCW) + (size_t)l * 3 * DFF; const float* cb = PIN(I_FCB) + (size_t)l * DFF;
    const int first = cx.nb >> 1;
    if (cx.bid < first) return;
    for (int task = cx.nb - 1 - cx.bid; task < DFF / 16; task += cx.nb - first) {
        const int ch0 = 16 * task, ng = 256 * (ch0 >> 7) + (ch0 & 127);
        const bf16_t* ap = A + (size_t)(16 * wave + r) * D + 8 * q;
        const bf16_t* bg = Bt + (size_t)(ng + r) * D + 8 * q;
        f32x4 ag = {0.f, 0.f, 0.f, 0.f}, av = {0.f, 0.f, 0.f, 0.f};
#pragma unroll 8
        for (int s2 = 0; s2 < D / 32; ++s2) {
            const bf16x8 fa = *(const bf16x8*)(ap + 32 * s2);
            const bf16x8 fg = *(const bf16x8*)(bg + 32 * s2), fv = *(const bf16x8*)(bg + (size_t)128 * D + 32 * s2);
            ag = __builtin_amdgcn_mfma_f32_16x16x32_bf16(fg, fa, ag, 0, 0, 0); av = __builtin_amdgcn_mfma_f32_16x16x32_bf16(fv, fa, av, 0, 0, 0);
        }
        const int n = 16 * wave + r, c = ch0 + 4 * q;
        const float* st = PIN(I_FCONV) + ((size_t)l * NS + n) * 2 * DFF + c;
        const f32x4 s0 = *(const f32x4*)st, s1 = *(const f32x4*)(st + DFF);
        const f32x4 w0 = *(const f32x4*)(cw + c), w1 = *(const f32x4*)(cw + DFF + c), w2 = *(const f32x4*)(cw + 2 * DFF + c), bb = *(const f32x4*)(cb + c);
        const f32x4 a = bb + w0 * s0 + w1 * s1 + w2 * ag;
        f32x4 o;
#pragma unroll
        for (int e = 0; e < 4; ++e) o[e] = silu_f(a[e]) * av[e];
        *(bf16x4*)(U + (size_t)(MP + n) * DFF + c) = pack4(o);
        float* op = (p.out + z) + O_SFFN + ((size_t)l * NS + n) * 2 * DFF + c;
        *(f32x4*)op = s1; *(f32x4*)(op + DFF) = ag;
    }
}
__device__ __forceinline__ void glufix_panel(const Params& p, int l, int pm) {
    const Ctx cx = mkctx(p); const size_t z = cx.z;
    const bf16_t* GV = (const bf16_t*)(p.ws + z + WS_GV); bf16_t* U = (bf16_t*)(p.ws + z + WS_U);
    const float* cw = PIN(I_FCW) + (size_t)l * 3 * DFF; const float* cb = PIN(I_FCB) + (size_t)l * DFF;
#pragma unroll 1
    for (int i = cx.tid; i < 8 * (DFF / 8); i += NTHREADS) {
        const int hr = i / (DFF / 8), c0 = (i - hr * (DFF / 8)) * 8, row = pm * 256 + (hr >> 1) * 64 + (hr & 1), t = row & (T - 1);
        const int cg = 256 * (c0 >> 7) + (c0 & 127);
        bf16x8 u[3];
#pragma unroll
        for (int k = 0; k < 3; ++k) { const bf16x8 zz = {0, 0, 0, 0, 0, 0, 0, 0}; u[k] = (t - 2 + k >= 0) ? *(const bf16x8*)(GV + (size_t)(row - 2 + k) * 5632 + cg) : zz; }
        const bf16x8 vv = *(const bf16x8*)(GV + (size_t)row * 5632 + cg + 128);
        f32x4 w0[2], w1[2], w2[2], bb[2];
#pragma unroll
        for (int h = 0; h < 2; ++h) { w0[h] = *(const f32x4*)(cw + c0 + 4 * h); w1[h] = *(const f32x4*)(cw + DFF + c0 + 4 * h); w2[h] = *(const f32x4*)(cw + 2 * DFF + c0 + 4 * h); bb[h] = *(const f32x4*)(cb + c0 + 4 * h); }
        bf16x8 o;
#pragma unroll
        for (int e = 0; e < 8; ++e) { const int h = e >> 2, ee = e & 3;
            const float acc = bb[h][ee] + w0[h][ee] * bf2f((bf16_t)u[0][e]) + w1[h][ee] * bf2f((bf16_t)u[1][e]) + w2[h][ee] * bf2f((bf16_t)u[2][e]);
            o[e] = (short)f2bf(silu_f(acc) * bf2f((bf16_t)vv[e])); }
        *(bf16x8*)(U + (size_t)row * DFF + c0) = o;
    }
}
__device__ __forceinline__ void stage_pffn(const Params& p, int l) {
    const Ctx cx = mkctx(p); const size_t z = cx.z;
    const unsigned gt = (unsigned)cx.bid * NTHREADS + cx.tid, GT = (unsigned)cx.nb * NTHREADS;
    const bf16_t* GV = (const bf16_t*)(p.ws + z + WS_GV);
    for (unsigned i = gt; i < (unsigned)NP * 2 * DFF; i += GT) {
        const int c = (int)(i % (unsigned)DFF), j = (int)(i / (unsigned)DFF) & 1, n = (int)(i / (unsigned)(2 * DFF));
        (p.out + z)[O_PFFN + (((size_t)l * NP + n) * 2 + j) * DFF + c] = bf2f(GV[(size_t)(n * T + T - 2 + j) * 5632 + 256 * (c >> 7) + (c & 127)]);
    }
}

__device__ __forceinline__ void stage_dtgemm(const Params& p, int l) {
    const Ctx cx = mkctx(p); const size_t z = cx.z;
    const int lane = cx.tid & 63, wave = __builtin_amdgcn_readfirstlane(cx.tid >> 6), r = lane & 15, q = lane >> 4;
    const bf16_t* H = (const bf16_t*)(p.ws + z + WS_H); const bf16_t* WD = (const bf16_t*)(p.ws + z + WS_WDTT) + (size_t)l * 16384;
    float* DT = (float*)(p.ws + z + WS_DT);
    for (int task = cx.nb - 1 - cx.bid; task < R / 128; task += cx.nb) {
        const int row = task * 128 + 16 * wave + r;
        const bf16_t* hp = H + (size_t)row * D + 8 * q; const bf16_t* wp = WD + r * 1024 + 8 * q;
        f32x4 acc = {0.f, 0.f, 0.f, 0.f};
#pragma unroll 8
        for (int s2 = 0; s2 < 32; ++s2) { const bf16x8 fa = *(const bf16x8*)(hp + 32 * s2), fb = *(const bf16x8*)(wp + 32 * s2); acc = __builtin_amdgcn_mfma_f32_16x16x32_bf16(fb, fa, acc, 0, 0, 0); }
        if (q < 2) *(f32x4*)(DT + (size_t)row * 8 + 4 * q) = acc;
    }
}

#define RLX_AGENT __ATOMIC_RELAXED, __HIP_MEMORY_SCOPE_AGENT
#define XB_TMO      128
#define XB_XCNT(j)  (256  + 64 * (j))
#define XB_XSUB(j)  (1280 + 64 * (j))
#define XB_XGEN(j)  (2304 + 64 * (j))
#define XB_TOP      3328
#define XB_TOPGEN   3392
#define XCD_BAR_WORDS 3456
#define XB_SPIN_CAP (1u << 18)

__device__ __forceinline__ unsigned xb_ld(unsigned* p)              { return __hip_atomic_load(p, __ATOMIC_RELAXED, __HIP_MEMORY_SCOPE_AGENT); }
__device__ __forceinline__ unsigned xb_add(unsigned* p, unsigned v) { return __hip_atomic_fetch_add(p, v, __ATOMIC_RELAXED, __HIP_MEMORY_SCOPE_AGENT); }
__device__ __forceinline__ unsigned xb_xcc_id() { return (unsigned)__builtin_amdgcn_s_getreg((3 << 11) | 20) & 0xFu; }
#define XB_SPIN(cond, bar) do { unsigned _sp = 0; while (cond) { __builtin_amdgcn_s_sleep(1); \
    if ((++_sp & 255u) == 0u) { if (xb_ld(&(bar)[XB_TMO])) break; if (_sp > XB_SPIN_CAP) { atomicAdd(&(bar)[XB_TMO], 1u); break; } } } } while (0)

struct XcdBarrier {
    unsigned* bar; unsigned x; int wave;
    volatile LAS unsigned* st;
};

__device__ __forceinline__ XcdBarrier xcd_barrier_post(unsigned* bar, volatile LAS unsigned* st, int wave) {
    XcdBarrier b; b.bar = bar; b.x = xb_xcc_id(); b.st = st; b.wave = wave;
    if (wave == 0 && lane_id() == 0) (void)xb_add(&bar[XB_XCNT(b.x)], 1u);
    return b;
}
__device__ __forceinline__ void xcd_barrier_complete(unsigned* bar, unsigned x, unsigned& nloc, unsigned& nx) {
    const unsigned G = gridDim.x * gridDim.y * gridDim.z;
    unsigned sum, cnt, mine, sp = 0u;
    for (;;) {
        sum = 0u; cnt = 0u; mine = 0u;
#pragma unroll
        for (unsigned j = 0; j < 16; ++j) { const unsigned c = xb_ld(&bar[XB_XCNT(j)]); sum += c; cnt += (c > 0u) ? 1u : 0u; mine = (j == x) ? c : mine; }
        if (sum == G) break;
        __builtin_amdgcn_s_sleep(1);
        if ((++sp & 255u) == 0u) { if (xb_ld(&bar[XB_TMO])) break; if (sp > XB_SPIN_CAP) { atomicAdd(&bar[XB_TMO], 1u); break; } }
    }
    nloc = mine > 0u ? mine : 1u; nx = cnt > 0u ? cnt : 1u;
}

__device__ __forceinline__ void xcd_barrier(const XcdBarrier& b) {
    asm volatile("s_waitcnt vmcnt(0)" ::: "memory");
    __syncthreads();
    if (b.wave == 0 && lane_id() == 0) {
        unsigned* bar = b.bar;
        __builtin_amdgcn_s_waitcnt(0);
        unsigned nloc = b.st[0], nx = b.st[1];
        if (nloc == 0u) { xcd_barrier_complete(bar, b.x, nloc, nx); b.st[0] = nloc; b.st[1] = nx; }
        const unsigned old = xb_add(&bar[XB_XSUB(b.x)], 1u);
        const unsigned gen = old / nloc;
        if (old + 1u == (gen + 1u) * nloc) {
            __builtin_amdgcn_fence(__ATOMIC_RELEASE, "agent");
            asm volatile("s_waitcnt vmcnt(0)" ::: "memory");
            const unsigned og = xb_add(&bar[XB_TOP], 1u);
            const unsigned tg = og / nx;
            if (og + 1u == (tg + 1u) * nx) xb_add(&bar[XB_TOPGEN], 1u);
            else XB_SPIN(xb_ld(&bar[XB_TOPGEN]) == tg, bar);
            __builtin_amdgcn_fence(__ATOMIC_ACQUIRE, "agent");
            xb_add(&bar[XB_XGEN(b.x)], 1u);
            asm volatile("s_waitcnt vmcnt(0)" ::: "memory");
        } else {
            XB_SPIN(xb_ld(&bar[XB_XGEN(b.x)]) == gen, bar);
            __builtin_amdgcn_fence(__ATOMIC_ACQUIRE, "agent");
            asm volatile("s_waitcnt vmcnt(0)" ::: "memory");
        }
    }
    __syncthreads();
}

namespace cg = cooperative_groups;
constexpr int LDS_BYTES = 153600;
__global__ void __launch_bounds__(NTHREADS, 2) fwd_mega(Params p_in) {
    Params p = p_in; p.wave = __builtin_amdgcn_readfirstlane((int)(threadIdx.x >> 6));
    extern __shared__ __attribute__((aligned(16))) unsigned char lds[];
    cg::grid_group grid = cg::this_grid();
    float* ldsf = (float*)lds;
    volatile LAS unsigned* MISC = (volatile LAS unsigned*)((LAS unsigned char*)lds + LDS_BYTES - 64);
    if (p.wave == 0 && lane_id() < 16) MISC[lane_id()] = 0u;
    __syncthreads();
    const XcdBarrier bar = xcd_barrier_post((unsigned*)(p.ws + WS_CTL), MISC, p.wave);
#define GSYNC() xcd_barrier(bar)
    stage_init(p); stage_wconv(p, lds, 0, 1); __syncthreads(); stage_mod(p, lds, 0, L); grid.sync();
    for (int l = 0; l < L; ++l) {
        const float* MODl = (const float*)(p.ws + WS_MOD) + (size_t)l * NSEQ * 6144;
        if (l > 0) stage_norm_b(p, l, 0);
        stage_norm(p, l, 0, ldsf, l == 0); GSYNC();
        { pg8::Gemm g{(const bf16_t*)(p.ws + WS_H), (const bf16_t*)(p.ws + WS_WIN) + (size_t)l * PCOLS * D, MP, PCOLS, D}; pg8::StaticOrder S; S.init(MP, PCOLS, (int)gridDim.x, (int)blockIdx.x);
          pg8::EpiBf16<0> E{(bf16_t*)(p.ws + WS_P), PCOLS, nullptr, 0, 0, 1.f};
          pg8::gemm_phase<pg8::EpiBf16<0>, pg8::StaticOrder, true, true>((LAS unsigned char*)lds, g, S, E, (p.wave << 6) | lane_id()); }
        gemm_small<1>(p, (const bf16_t*)(p.ws + WS_H) + (size_t)MP * D, D, (const bf16_t*)(p.ws + WS_WIN) + (size_t)l * PCOLS * D, PCOLS, D, 1, SmallBf{(bf16_t*)(p.ws + WS_P), PCOLS});
        stage_dtgemm(p, l);
        GSYNC();
        stage_rwprep(p, l, ldsf); __syncthreads(); stage_rwprep2(p, l, lds); asm volatile("s_waitcnt vmcnt(0)" ::: "memory"); __syncthreads();
        stage_rw1(p, l, lds); stage_mconv(p, l); stage_qkn(p, l); stage_ssd1(p, l, lds); GSYNC();
        stage_rw2(p, l, lds); stage_ssd2(p, l); stage_att(p, l, NP * 4); stage_rwscan(p, l, ldsf, NP * 4); stage_mscan(p, l, ldsf, NP * 4);
        if (l + 1 < L) { __syncthreads(); stage_wconv(p, lds, l + 1, l + 2, NP * 4); }
        GSYNC();
        stage_ssd3(p, l, lds, 0, 128); stage_rw3(p, l, 128); stage_attn(p, l, lds, 128); stage_mgate_sample(p, l, 128); GSYNC();
        { pg8::Gemm g{(const bf16_t*)(p.ws + WS_YCAT), (const bf16_t*)(p.ws + WS_WOUT) + (size_t)l * D * D, MP, D, D}; pg8::StaticOrder S; S.init(MP, D, (int)gridDim.x, (int)blockIdx.x);
          pg8::EpiResGate E{p.out, p.in[I_XP], (bf16_t*)(p.ws + WS_XB), MODl + 2048, l == 0, 0, 13, 6144};
          pg8::gemm_phase<pg8::EpiResGate, pg8::StaticOrder, true, true>((LAS unsigned char*)lds, g, S, E, (p.wave << 6) | lane_id()); }
        gemm_small<1>(p, (const bf16_t*)(p.ws + WS_YCAT) + (size_t)MP * D, D, (const bf16_t*)(p.ws + WS_WOUT) + (size_t)l * D * D, D, D, 4, SmallRes{p.out, MODl + 2048});
        GSYNC();
        stage_norm_b(p, l, 1); stage_norm(p, l, 1, ldsf, false); GSYNC();
        { pg8::Gemm g{(const bf16_t*)(p.ws + WS_H), (const bf16_t*)(p.ws + WS_WUP) + (size_t)l * 5632 * D, MP, 5632, D}; pg8::StaticOrder S; S.init(MP, 5632, (int)gridDim.x, (int)blockIdx.x);
          pg8::EpiGlu E{(bf16_t*)(p.ws + WS_GV), (bf16_t*)(p.ws + WS_U), p.in[I_FCW] + (size_t)l * 3 * DFF, p.in[I_FCB] + (size_t)l * DFF};
          pg8::gemm_phase<pg8::EpiGlu, pg8::StaticOrder, true, true>((LAS unsigned char*)lds, g, S, E, (p.wave << 6) | lane_id()); }
        gemm_small_glu(p, l);
        stage_cachecopy(p, l, 128);
        GSYNC();
        if (gridDim.x == 256) glufix_panel(p, l, 8 * ((int)blockIdx.x & 7) + (((int)blockIdx.x >> 3) & 7));
        else { for (int pm = 0; pm < MP / 256; ++pm) glufix_panel(p, l, pm); }
        asm volatile("s_waitcnt vmcnt(0)" ::: "memory"); __syncthreads();
        { pg8::Gemm g{(const bf16_t*)(p.ws + WS_U), (const bf16_t*)(p.ws + WS_WDN) + (size_t)l * D * DFF, MP, D, DFF}; pg8::StaticOrder S; S.init(MP, D, (int)gridDim.x, (int)blockIdx.x);
          pg8::EpiResGate E{p.out, p.in[I_XP], (bf16_t*)(p.ws + WS_XB), MODl + 5120, 0, l == L - 1, 13, 6144};
          pg8::gemm_phase<pg8::EpiResGate, pg8::StaticOrder, true, true>((LAS unsigned char*)lds, g, S, E, (p.wave << 6) | lane_id()); }
        gemm_small<1>(p, (const bf16_t*)(p.ws + WS_U) + (size_t)MP * DFF, DFF, (const bf16_t*)(p.ws + WS_WDN) + (size_t)l * D * DFF, D, DFF, 11, SmallRes{p.out, MODl + 5120});
        stage_pffn(p, l);
        GSYNC();
    }
}

extern "C" void kernel_launch(void* const* d_in, const int* in_sizes, int n_in, void* d_out, int out_size, void* d_ws, size_t ws_size, hipStream_t stream) {
    static int grid = 0;
    if (grid == 0) {
        if (n_in != N_IN || (size_t)out_size != O_END || ws_size < WS_END) { fprintf(stderr, "kernel_launch: unexpected sizes n_in %d out %d ws %zu\n", n_in, out_size, ws_size); grid = -1; return; }
        int dev = 0, cus = 0, per_cu = 0;
        hipGetDevice(&dev); hipDeviceGetAttribute(&cus, hipDeviceAttributeMultiprocessorCount, dev);
        if (hipFuncSetAttribute((const void*)fwd_mega, hipFuncAttributeMaxDynamicSharedMemorySize, LDS_BYTES) != hipSuccess) { fprintf(stderr, "hipFuncSetAttribute failed\n"); grid = -1; return; }
        hipOccupancyMaxActiveBlocksPerMultiprocessor(&per_cu, (const void*)fwd_mega, NTHREADS, LDS_BYTES);
        if (per_cu < 1) { fprintf(stderr, "occupancy query says %d blocks per CU\n", per_cu); grid = -1; return; }
        grid = cus;
    }
    if (grid < 0) return;
    Params p{};
    for (int i = 0; i < N_IN; ++i) p.in[i] = (const float*)d_in[i];
    p.out = (float*)d_out; p.ws = (unsigned char*)d_ws;
    if (hipMemsetAsync((char*)d_ws + WS_CTL, 0, 16384, stream) != hipSuccess) { fprintf(stderr, "memset of the barrier words failed\n"); return; }
    void* args[] = {&p};
    hipError_t e = hipLaunchCooperativeKernel((void*)fwd_mega, dim3(grid), dim3(NTHREADS), args, LDS_BYTES, stream);
    if (e != hipSuccess) fprintf(stderr, "cooperative launch failed: %s\n", hipGetErrorString(e));
}
```

```cpp
#include <hip/hip_runtime.h>
#include <hip/hip_cooperative_groups.h>
#include <cstdint>
#include <cstdio>

typedef unsigned short bf16_t;
__device__ __forceinline__ float bf2f(bf16_t v) { return __uint_as_float(((unsigned)v) << 16); }
typedef float f32x2_t __attribute__((ext_vector_type(2)));
typedef __bf16 bf16x2_t __attribute__((ext_vector_type(2)));
__device__ __forceinline__ unsigned cvtpk(float lo, float hi) { const f32x2_t v = {lo, hi}; const bf16x2_t b = __builtin_convertvector(v, bf16x2_t); return __builtin_bit_cast(unsigned, b); }
__device__ __forceinline__ bf16_t f2bf(float f) { return (bf16_t)cvtpk(f, 0.f); }

constexpr int D = 1024, NP = 2, T = 8192, MP = NP * T, NS = 128, R = MP + NS, NSEQ = NP + NS, L = 4;
constexpr int PROJ = 3080, PCOLS = 3072, DFF = 2816;
constexpr int OFF_B = 1024, OFF_Z = 1536, OFF_XBC = 2048;
constexpr float NORM_EPS = 1e-6f, GN_EPS = 64e-5f;
constexpr int NTHREADS = 512, NWAVES = 8;
typedef short bf16x8 __attribute__((ext_vector_type(8)));
typedef short bf16x4 __attribute__((ext_vector_type(4)));
typedef float f32x4 __attribute__((ext_vector_type(4)));
__device__ __forceinline__ bf16x4 pack4(f32x4 v) { typedef unsigned u32x2_t __attribute__((ext_vector_type(2))); const u32x2_t w = {cvtpk(v[0], v[1]), cvtpk(v[2], v[3])}; return __builtin_bit_cast(bf16x4, w); }
constexpr int LD = 72, MSZ = 64 * LD;
constexpr int LD2 = 136;

enum { I_XP = 0, I_XS, I_CP, I_CS, I_SHIFT, I_WKV, I_CK, I_CV, I_SCONV, I_SSM, I_FCONV, I_ADAW, I_ADAB, I_NMIXG, I_NFFNG, I_WIN, I_WOUT,
       I_MU, I_W0, I_W2, I_A0, I_A2, I_G2, I_KK, I_KA, I_RK, I_LNG, I_LNB, I_QNG, I_KNG, I_SINK, I_CONVW, I_CONVB, I_DTB, I_ALOG, I_SSMD, I_SSMNG,
       I_WUP, I_FCW, I_FCB, I_WDOWN, N_IN };

constexpr size_t O_YP = 0;
constexpr size_t O_YS = O_YP + (size_t)MP * D;
constexpr size_t O_PSHIFT = O_YS + (size_t)NS * D;
constexpr size_t O_PWKV = O_PSHIFT + (size_t)L * NP * 1024;
constexpr size_t O_PK = O_PWKV + (size_t)L * NP * 4 * 64 * 64;
constexpr size_t O_PV = O_PK + (size_t)L * NP * 128 * 128;
constexpr size_t O_PCONV = O_PV + (size_t)L * NP * 128 * 128;
constexpr size_t O_PSSM = O_PCONV + (size_t)L * NP * 3 * 1024;
constexpr size_t O_PFFN = O_PSSM + (size_t)L * NP * 8 * 64 * 128;
constexpr size_t O_SSHIFT = O_PFFN + (size_t)L * NP * 2 * DFF;
constexpr size_t O_SWKV = O_SSHIFT + (size_t)L * NS * 1024;
constexpr size_t O_SK = O_SWKV + (size_t)L * NS * 4 * 64 * 64;
constexpr size_t O_SV = O_SK + (size_t)L * NS * 128 * 128;
constexpr size_t O_SCONV = O_SV + (size_t)L * NS * 128 * 128;
constexpr size_t O_SSSM = O_SCONV + (size_t)L * NS * 3 * 1024;
constexpr size_t O_SFFN = O_SSSM + (size_t)L * NS * 8 * 64 * 128;
constexpr size_t O_END = O_SFFN + (size_t)L * NS * 2 * DFF;

constexpr size_t MiB = 1u << 20;
constexpr int MPAD = 16640;
constexpr size_t WS_XB = 0;
constexpr size_t WS_X = 0;
constexpr size_t WS_H = 65 * MiB;
constexpr size_t WS_YCAT = WS_H;
constexpr size_t WS_MOD = 98 * MiB;
constexpr size_t WS_P = 111 * MiB;
constexpr size_t WS_DT = 209 * MiB;
constexpr size_t WS_GV = 210 * MiB;
constexpr size_t WS_U = 389 * MiB;
constexpr size_t WS_WIN = 479 * MiB;
constexpr size_t WS_WOUT = 503 * MiB;
constexpr size_t WS_WUP = 511 * MiB;
constexpr size_t WS_WDN = 555 * MiB;
constexpr size_t WS_RWC_Y0 = 578 * MiB;
constexpr size_t WS_CTL = 595 * MiB;
constexpr size_t WS_LORA = 596 * MiB;
constexpr size_t WS_WDTT = WS_LORA + 512 * 1024;
constexpr size_t WS_DT2 = 597 * MiB;
constexpr size_t WS_END = 598 * MiB;
constexpr size_t WS_RWC_RP = WS_U + 65 * MiB;
constexpr size_t WS_RWC_MC = WS_RWC_RP + 8 * MiB;
constexpr size_t WS_RWC_NCT = WS_RWC_MC + 8 * MiB;
static_assert(WS_RWC_NCT + 8 * MiB <= WS_WIN, "rwkv chunk buffers fit the U region tail");
constexpr size_t WS_RW = WS_GV;
constexpr size_t WS_RWD = WS_RW + 49 * MiB;
constexpr size_t WS_HPREV = WS_RW + 70 * MiB;
constexpr size_t WS_QN = WS_RW + 113 * MiB;
constexpr size_t WS_KN = WS_QN + 17 * MiB;
constexpr size_t WS_YTMP = WS_KN + 9 * MiB;
static_assert(WS_YTMP + (size_t)R * 512 * 4 <= WS_U, "mixer temporaries fit the GV region");
constexpr size_t WS_XBCC = WS_U;
constexpr size_t WS_SST = WS_U + 33 * MiB;
static_assert(WS_XBCC + (size_t)R * 1024 * 2 <= WS_SST && WS_SST + 32 * MiB <= WS_RWC_RP, "xbc / ssd states fit the U region");
constexpr size_t WS_SCD = WS_RWC_Y0 + 16 * MiB;

struct Params {
    const float* in[N_IN];
    float* out;
    unsigned char* ws;
    int wave, pad;
};

__device__ __forceinline__ int seq_of_row(int row) { return row < MP ? (row >> 13) : (NP + row - MP); }
__device__ __forceinline__ float wave_sum(float v) {
#pragma unroll
    for (int o = 1; o < 64; o <<= 1) v += __shfl_xor(v, o);
    return v;
}
__device__ __forceinline__ float wave_max(float v) {
#pragma unroll
    for (int o = 1; o < 64; o <<= 1) v = fmaxf(v, __shfl_xor(v, o));
    return v;
}
__device__ __forceinline__ float silu_f(float x) { return x * __builtin_amdgcn_rcpf(1.f + __expf(-x)); }
__device__ __forceinline__ float sigmoid_f(float x) { return __builtin_amdgcn_rcpf(1.f + __expf(-x)); }
__device__ __forceinline__ float tanh_fast(float x) { return 1.f - 2.f * __builtin_amdgcn_rcpf(1.f + __expf(2.f * x)); }
__device__ __forceinline__ float softplus_fast(float x) { return fmaxf(x, 0.f) + __logf(1.f + __expf(-fabsf(x))); }
__device__ __forceinline__ float softplus_f(float x) { return fmaxf(x, 0.f) + log1pf(__expf(-fabsf(x))); }

namespace pg8 {
#define PG8_LAS __attribute__((address_space(3)))
typedef unsigned short bf16_t;
typedef short bf16x8 __attribute__((ext_vector_type(8)));
typedef float f32x4 __attribute__((ext_vector_type(4)));
typedef unsigned u32x4 __attribute__((ext_vector_type(4)));
constexpr int BM = 256, BK = 64, HALF = 128, HTB = HALF * BK * 2  , STAGE_BYTES = 8 * HTB, NXCD = 8, WGM = 8;

__host__ __device__ __forceinline__ int lds_byte(int r, int c) { const int st = (r >> 4) * 2 + (c >> 5), rr = r & 15, cc = c & 31, ob = rr * 64 + cc * 2; return st * 1024 + (ob ^ (((ob >> 9) & 1) << 5)); }
__host__ __device__ __forceinline__ void stage_rc(int b, int& R, int& C) { const int st = b / 1024, sb = b % 1024, swz = sb ^ (((sb >> 9) & 1) << 5); R = (st >> 1) * 16 + swz / 64; C = (st & 1) * 32 + (swz % 64) / 2; }
__host__ __device__ __forceinline__ int perm32(int rho) { const int n = rho >> 4, i = rho & 15; return 8 * (i >> 2) + 4 * n + (i & 3); }

struct Unit { int pm, pn; };
struct Gemm { const bf16_t* A; const bf16_t* Bt; int M, N, K; };

struct StaticOrder {
    int nM, nN, nwg, G, c;
    __host__ __device__ void init(int M, int N, int G_, int c_) { nM = M / BM; nN = N / BM; nwg = nM * nN; G = G_; c = c_; }
    __host__ __device__ bool next(int i, Unit& u) const {
        const long L = (long)i * G + c; if (L >= nwg) return false;
        int wgid = (int)L; { const int q = nwg / NXCD, r = nwg % NXCD, xcd = wgid % NXCD, off = wgid / NXCD; wgid = (xcd < r ? xcd * (q + 1) : r * (q + 1) + (xcd - r) * q) + off; }
        const int nig = WGM * nN, gid = wgid / nig, fm = gid * WGM, gsz = (nM - fm) < WGM ? (nM - fm) : WGM;
        u.pm = fm + ((wgid % nig) % gsz); u.pn = (wgid % nig) / gsz; return true;
    }
    __device__ __forceinline__ void a_ready(const Unit&) const {}
    __device__ __forceinline__ void done(const Unit&) const {}
};

__device__ __forceinline__ unsigned cvt_pk_bf16(float lo, float hi) { unsigned r; asm volatile("v_cvt_pk_bf16_f32 %0, %1, %2" : "=v"(r) : "v"(lo), "v"(hi)); return r; }
typedef float f32x2 __attribute__((ext_vector_type(2)));
__device__ __forceinline__ f32x2 gelu_pk(f32x2 v) {
    const f32x2 av = __builtin_elementwise_abs(v), d = av * 0.2316418882f + 1.0f;
    f32x2 t; t.x = __builtin_amdgcn_rcpf(d.x); t.y = __builtin_amdgcn_rcpf(d.y);
    f32x2 q = t * 0.5307027145f + (-0.7265760135f); q = q * t + 0.7107068705f; q = q * t + (-0.142248368f); q = q * t + 0.127414796f; q = q * t;
    const f32x2 s = (v * v) * (-0.72134752044f);
    f32x2 e; e.x = __builtin_amdgcn_exp2f(s.x); e.y = __builtin_amdgcn_exp2f(s.y);
    const f32x2 m = v * (q * e), r = v - m;
    f32x2 o; o.x = v.x < 0.f ? m.x : r.x; o.y = v.y < 0.f ? m.y : r.y; return o;
}

template <int ACT  > struct EpiBf16 {
    static constexpr bool PERM = true, AFTER_DRAIN = false; static_assert(ACT == 0 || ACT == 1, "EpiBf16: ACT is 0 (none) or 1 (gelu_pk)");
    bf16_t* O; int ldc; const float* bias; int split_cols; size_t split_stride; float scale0;
    __device__ __forceinline__ void operator()(const f32x4 (&acc)[2][2][4][2], const Unit& u, int wr, int wc, int fr, int fq) const {
        const int row0 = u.pm * BM + wr * 64 + fr; int colt = u.pn * BM; bf16_t* base = O;
        float sc = 1.f; if (split_cols) { const int t = colt / split_cols; base += (size_t)t * split_stride; colt -= t * split_cols; if (t == 0) sc = scale0; }
        const int col0 = colt + wc * 32 + 8 * fq, bcol0 = u.pn * BM + wc * 32 + 8 * fq;
        f32x4 bv[2][2];
#pragma unroll
        for (int bj = 0; bj < 2; ++bj)
#pragma unroll
            for (int n = 0; n < 2; ++n) bv[bj][n] = bias ? *(const f32x4*)(bias + bcol0 + bj * HALF + 4 * n) : (f32x4){0.f, 0.f, 0.f, 0.f};
#pragma unroll
        for (int ai = 0; ai < 2; ++ai)
#pragma unroll
            for (int m = 0; m < 4; ++m) { bf16_t* rowp = base + (size_t)(row0 + ai * HALF + m * 16) * ldc + col0;
#pragma unroll
                for (int bj = 0; bj < 2; ++bj) { f32x4 v0 = acc[ai][bj][m][0] + bv[bj][0], v1 = acc[ai][bj][m][1] + bv[bj][1];
                    if (ACT == 1) { f32x2 a = gelu_pk((f32x2){v0[0], v0[1]}), b = gelu_pk((f32x2){v0[2], v0[3]}), c = gelu_pk((f32x2){v1[0], v1[1]}), d = gelu_pk((f32x2){v1[2], v1[3]});
                        v0 = (f32x4){a.x, a.y, b.x, b.y}; v1 = (f32x4){c.x, c.y, d.x, d.y}; }
                    v0 = v0 * sc; v1 = v1 * sc; u32x4 w; w.x = cvt_pk_bf16(v0[0], v0[1]); w.y = cvt_pk_bf16(v0[2], v0[3]); w.z = cvt_pk_bf16(v1[0], v1[1]); w.w = cvt_pk_bf16(v1[2], v1[3]);
                    *(u32x4*)(rowp + bj * HALF) = w; } }
    }
};

__device__ __forceinline__ float dpp_shr(float cur, float prevblk, int n  ) {
    const int c = __builtin_bit_cast(int, cur), pb = __builtin_bit_cast(int, prevblk);
    int t;
    if (n == 1) { t = __builtin_amdgcn_update_dpp(0, pb, 0x121, 0xf, 0xf, false); t = __builtin_amdgcn_update_dpp(t, c, 0x111, 0xf, 0xf, false); }
    else        { t = __builtin_amdgcn_update_dpp(0, pb, 0x122, 0xf, 0xf, false); t = __builtin_amdgcn_update_dpp(t, c, 0x112, 0xf, 0xf, false); }
    return __builtin_bit_cast(float, t);
}
struct EpiGlu {
    static constexpr bool PERM = true, AFTER_DRAIN = false;
    bf16_t* GV; bf16_t* U; const float* cw; const float* cb;
    __device__ __forceinline__ void operator()(const f32x4 (&acc)[2][2][4][2], const Unit& u, int wr, int wc, int fr, int fq) const {
        const int row0 = u.pm * BM + wr * 64 + fr, x0 = wc * 32 + 8 * fq, ch0 = u.pn * HALF + x0;
        f32x4 w0[2], w1[2], w2[2], bb[2];
#pragma unroll
        for (int n = 0; n < 2; ++n) { w0[n] = *(const f32x4*)(cw + ch0 + 4 * n); w1[n] = *(const f32x4*)(cw + 2816 + ch0 + 4 * n); w2[n] = *(const f32x4*)(cw + 5632 + ch0 + 4 * n); bb[n] = *(const f32x4*)(cb + ch0 + 4 * n); }
#pragma unroll
        for (int ai = 0; ai < 2; ++ai)
#pragma unroll
            for (int m = 0; m < 4; ++m) {
                const int row = row0 + ai * HALF + m * 16;
                bf16_t* gp = GV + (size_t)row * 5632 + u.pn * BM + x0;
                u32x4 wu;
#pragma unroll
                for (int n = 0; n < 2; ++n) {
                    const f32x4 g = acc[ai][0][m][n], v = acc[ai][1][m][n], pv = acc[ai][0][m > 0 ? m - 1 : 0][n];
                    float o[4];
#pragma unroll
                    for (int e = 0; e < 4; ++e) {
                        const float g1 = dpp_shr(g[e], pv[e], 1), g2 = dpp_shr(g[e], pv[e], 2);
                        const float a = bb[n][e] + w0[n][e] * g2 + w1[n][e] * g1 + w2[n][e] * g[e];
                        o[e] = a * __builtin_amdgcn_rcpf(1.f + __expf(-a)) * v[e];
                    }
                    if (n == 0) { wu.x = cvt_pk_bf16(o[0], o[1]); wu.y = cvt_pk_bf16(o[2], o[3]); } else { wu.z = cvt_pk_bf16(o[0], o[1]); wu.w = cvt_pk_bf16(o[2], o[3]); }
                }
                if (m > 0 || fr >= 2) *(u32x4*)(U + (size_t)row * 2816 + ch0) = wu;
                u32x4 wg, wv;
                wg.x = cvt_pk_bf16(acc[ai][0][m][0][0], acc[ai][0][m][0][1]); wg.y = cvt_pk_bf16(acc[ai][0][m][0][2], acc[ai][0][m][0][3]); wg.z = cvt_pk_bf16(acc[ai][0][m][1][0], acc[ai][0][m][1][1]); wg.w = cvt_pk_bf16(acc[ai][0][m][1][2], acc[ai][0][m][1][3]);
                wv.x = cvt_pk_bf16(acc[ai][1][m][0][0], acc[ai][1][m][0][1]); wv.y = cvt_pk_bf16(acc[ai][1][m][0][2], acc[ai][1][m][0][3]); wv.z = cvt_pk_bf16(acc[ai][1][m][1][0], acc[ai][1][m][1][1]); wv.w = cvt_pk_bf16(acc[ai][1][m][1][2], acc[ai][1][m][1][3]);
                if ((m == 0 && fr < 2) || (m == 3 && fr >= 14)) { *(u32x4*)gp = wg; *(u32x4*)(gp + HALF) = wv; }
            }
    }
};

struct EpiResGate {
    static constexpr bool PERM = true, AFTER_DRAIN = false;
    float* Xf; const float* Xinf; bf16_t* Xb; const float* gate; int src_f32, dst_f32, seq_shift, gate_ld;
    __device__ __forceinline__ void operator()(const f32x4 (&acc)[2][2][4][2], const Unit& u, int wr, int wc, int fr, int fq) const {
        const int col0 = u.pn * BM + wc * 32 + 8 * fq;
#pragma unroll
        for (int ai = 0; ai < 2; ++ai)
#pragma unroll
            for (int m = 0; m < 4; ++m) {
                const int row = u.pm * BM + ai * HALF + wr * 64 + m * 16 + fr;
                const float* gp = gate + (size_t)(row >> seq_shift) * gate_ld + col0; const size_t off = (size_t)row * 1024 + col0;
#pragma unroll
                for (int bj = 0; bj < 2; ++bj) {
                    const f32x4 g0 = *(const f32x4*)(gp + bj * HALF), g1 = *(const f32x4*)(gp + bj * HALF + 4);
                    f32x4 x0, x1;
                    if (src_f32) { x0 = *(const f32x4*)(Xinf + off + bj * HALF); x1 = *(const f32x4*)(Xinf + off + bj * HALF + 4); }
                    else { const u32x4 w = *(const u32x4*)(Xb + off + bj * HALF);
                        x0 = (f32x4){__builtin_bit_cast(float, w.x << 16), __builtin_bit_cast(float, w.x & 0xffff0000u), __builtin_bit_cast(float, w.y << 16), __builtin_bit_cast(float, w.y & 0xffff0000u)};
                        x1 = (f32x4){__builtin_bit_cast(float, w.z << 16), __builtin_bit_cast(float, w.z & 0xffff0000u), __builtin_bit_cast(float, w.w << 16), __builtin_bit_cast(float, w.w & 0xffff0000u)}; }
                    x0 = x0 + g0 * acc[ai][bj][m][0]; x1 = x1 + g1 * acc[ai][bj][m][1];
                    if (dst_f32) { *(f32x4*)(Xf + off + bj * HALF) = x0; *(f32x4*)(Xf + off + bj * HALF + 4) = x1; }
                    else { u32x4 w; w.x = cvt_pk_bf16(x0[0], x0[1]); w.y = cvt_pk_bf16(x0[2], x0[3]); w.z = cvt_pk_bf16(x1[0], x1[1]); w.w = cvt_pk_bf16(x1[2], x1[3]); *(u32x4*)(Xb + off + bj * HALF) = w; }
                }
            }
    }
};
template <class Epi, class Sched, bool ALIGN_EPI = false, bool SP2 = false>
__device__ __forceinline__ void gemm_phase(PG8_LAS unsigned char* lds, const Gemm g, const Sched& S, const Epi& E, int tid_in) {
    int tid_ = tid_in; asm volatile("" : "+v"(tid_));
    const int tid = tid_, wid = __builtin_amdgcn_readfirstlane(tid >> 6), lane = tid & 63, wr = wid >> 2, wc = wid & 3, fr = lane & 15, fq = lane >> 4;
    const int K = g.K, nt = K / BK;
    unsigned voffA[2], voffB[2];
#pragma unroll
    for (int i = 0; i < 2; ++i) { int R, C; stage_rc(tid * 16 + i * 8192, R, C); const int Rb = Epi::PERM ? ((R & ~31) + perm32(R & 31)) : R;
        voffA[i] = (unsigned)(R * K + C) * 2u; voffB[i] = (unsigned)(Rb * K + C) * 2u; }
    const size_t kstep = (size_t)(BK * 2);
    const size_t hstep = (size_t)HALF * K * 2;
    const size_t tstep = 2 * hstep;
    const unsigned ldsw = (unsigned)wid * 1024u;
    const int aoff = lds_byte(wr * 64 + fr, fq * 8), boff = lds_byte(wc * 32 + fr, fq * 8);
#define PG8_SA(b, h) (((b) * 2 + (h)) * HTB)
#define PG8_SB(b, h) ((4 + (b) * 2 + (h)) * HTB)
#define PG8_STAGE(bufoff, gbase, voff) do { _Pragma("unroll") for (int _i = 0; _i < 2; ++_i) \
        __builtin_amdgcn_global_load_lds((const unsigned*)((const char*)(gbase) + (voff)[_i]), (PG8_LAS unsigned*)(lds + (bufoff) + ldsw + _i * 8192), 16, 0, 0); } while (0)
#define PG8_LDA(dst, b, h) do { _Pragma("unroll") for (int m = 0; m < 4; ++m) _Pragma("unroll") for (int k = 0; k < 2; ++k) dst[m][k] = *(const PG8_LAS bf16x8*)(lds + PG8_SA(b, h) + aoff + m * 2048 + k * 1024); } while (0)
#define PG8_LDB(dst, b, h) do { _Pragma("unroll") for (int n = 0; n < 2; ++n) _Pragma("unroll") for (int k = 0; k < 2; ++k) dst[n][k] = *(const PG8_LAS bf16x8*)(lds + PG8_SB(b, h) + boff + n * 2048 + k * 1024); } while (0)
#define PG8_MMA(ai, bj, At, Bt) do { __builtin_amdgcn_s_setprio(1); _Pragma("unroll") for (int m = 0; m < 4; ++m) _Pragma("unroll") for (int n = 0; n < 2; ++n) _Pragma("unroll") for (int k = 0; k < 2; ++k) \
        acc[ai][bj][m][n] = __builtin_amdgcn_mfma_f32_16x16x32_bf16(Bt[n][k], At[m][k], acc[ai][bj][m][n], 0, 0, 0); __builtin_amdgcn_s_setprio(0); } while (0)
#define PG8_WAIT_V(n) asm volatile("s_waitcnt vmcnt(" #n ")" ::: "memory")
#define PG8_WAIT_L(n) asm volatile("s_waitcnt lgkmcnt(" #n ")" ::: "memory")
#define PG8_BAR __builtin_amdgcn_s_barrier()
#define PG8_SCHED __builtin_amdgcn_sched_barrier(0)
    Unit cur, nxt; int ui = 0;
    if (!S.next(0, cur)) return;
    f32x4 acc[2][2][4][2];
#pragma unroll
    for (int a = 0; a < 2; ++a)
#pragma unroll
        for (int b = 0; b < 2; ++b)
#pragma unroll
            for (int m = 0; m < 4; ++m)
#pragma unroll
                for (int n = 0; n < 2; ++n) acc[a][b][m][n] = (f32x4){0.f, 0.f, 0.f, 0.f};
    bf16x8 At[4][2], B0[2][2], B1[2][2];
    const char* cA = (const char*)g.A + (size_t)cur.pm * tstep; const char* cB = (const char*)g.Bt + (size_t)cur.pn * tstep;
    S.a_ready(cur);
    if constexpr (SP2) {
        PG8_STAGE(PG8_SB(0, 0), cB, voffB); PG8_STAGE(PG8_SB(0, 1), cB + hstep, voffB); PG8_STAGE(PG8_SA(0, 0), cA, voffA); PG8_STAGE(PG8_SA(0, 1), cA + hstep, voffA);
        if (wr == 1) PG8_BAR;
        PG8_WAIT_V(2); PG8_BAR;
        PG8_STAGE(PG8_SB(1, 0), cB + kstep, voffB); PG8_STAGE(PG8_SA(1, 0), cA + kstep, voffA); PG8_STAGE(PG8_SB(1, 1), cB + hstep + kstep, voffB);
        PG8_WAIT_V(6); PG8_BAR;
    } else {
        PG8_STAGE(PG8_SB(0, 0), cB, voffB); PG8_STAGE(PG8_SA(0, 0), cA, voffA); PG8_STAGE(PG8_SB(0, 1), cB + hstep, voffB); PG8_STAGE(PG8_SA(0, 1), cA + hstep, voffA);
        if (wr == 1) PG8_BAR;
        PG8_WAIT_V(4); PG8_BAR;
        PG8_STAGE(PG8_SB(1, 0), cB + kstep, voffB); PG8_STAGE(PG8_SA(1, 0), cA + kstep, voffA); PG8_STAGE(PG8_SB(1, 1), cB + hstep + kstep, voffB);
        PG8_WAIT_V(6); PG8_BAR;
    }
    for (;;) {
        const bool has_next = S.next(ui + 1, nxt);
        const char* nA = has_next ? (const char*)g.A + (size_t)nxt.pm * tstep : cA; const char* nB = has_next ? (const char*)g.Bt + (size_t)nxt.pn * tstep : cB;
        for (int t = 0; t < nt; t += 2) {
            const bool last = (t == nt - 2);
            const char* a1 = cA + (size_t)(t + 1) * kstep;
            const char* a2 = last ? nA : cA + (size_t)(t + 2) * kstep; const char* b2 = last ? nB : cB + (size_t)(t + 2) * kstep;
            const char* a3 = a2 + kstep; const char* b3 = b2 + kstep;
            if (last && has_next) S.a_ready(nxt);
            if constexpr (SP2) {
            PG8_LDB(B0, 0, 0); PG8_LDB(B1, 0, 1); PG8_SCHED; PG8_LDA(At, 0, 0); PG8_STAGE(PG8_SA(1, 1), a1 + hstep, voffA);
            PG8_WAIT_V(8); PG8_WAIT_L(0); PG8_BAR; PG8_MMA(0, 0, At, B0); PG8_MMA(0, 1, At, B1); PG8_BAR; PG8_SCHED;
            PG8_LDA(At, 0, 1); PG8_STAGE(PG8_SB(0, 0), b2, voffB); PG8_STAGE(PG8_SB(0, 1), b2 + hstep, voffB); PG8_STAGE(PG8_SA(0, 0), a2, voffA);
            PG8_WAIT_V(8); PG8_WAIT_L(0); PG8_BAR; PG8_MMA(1, 0, At, B0); PG8_MMA(1, 1, At, B1); PG8_BAR; PG8_SCHED;
            PG8_LDB(B0, 1, 0); PG8_LDB(B1, 1, 1); PG8_SCHED; PG8_LDA(At, 1, 0); PG8_STAGE(PG8_SA(0, 1), a2 + hstep, voffA);
            PG8_WAIT_V(8); PG8_WAIT_L(0); PG8_BAR; PG8_MMA(0, 0, At, B0); PG8_MMA(0, 1, At, B1); PG8_BAR; PG8_SCHED;
            PG8_LDA(At, 1, 1); PG8_STAGE(PG8_SB(1, 0), b3, voffB); PG8_STAGE(PG8_SB(1, 1), b3 + hstep, voffB); PG8_STAGE(PG8_SA(1, 0), a3, voffA);
            PG8_WAIT_V(8); PG8_WAIT_L(0); PG8_BAR; PG8_MMA(1, 0, At, B0); PG8_MMA(1, 1, At, B1); PG8_BAR; PG8_SCHED;
            } else {
            PG8_LDB(B0, 0, 0); PG8_SCHED; PG8_LDA(At, 0, 0); PG8_STAGE(PG8_SA(1, 1), a1 + hstep, voffA);
            PG8_WAIT_L(8); PG8_BAR; PG8_WAIT_L(0); PG8_MMA(0, 0, At, B0); PG8_BAR; PG8_SCHED;
            PG8_LDB(B1, 0, 1); PG8_STAGE(PG8_SB(0, 0), b2, voffB);
            PG8_BAR; PG8_WAIT_L(0); PG8_MMA(0, 1, At, B1); PG8_BAR;
            PG8_LDA(At, 0, 1); PG8_STAGE(PG8_SA(0, 0), a2, voffA);
            PG8_BAR; PG8_WAIT_L(0); PG8_MMA(1, 0, At, B0); PG8_BAR; PG8_SCHED;
            PG8_STAGE(PG8_SB(0, 1), b2 + hstep, voffB);
            PG8_WAIT_V(6); PG8_BAR; PG8_MMA(1, 1, At, B1); PG8_BAR;
            PG8_LDB(B0, 1, 0); PG8_SCHED; PG8_LDA(At, 1, 0); PG8_STAGE(PG8_SA(0, 1), a2 + hstep, voffA);
            PG8_WAIT_L(8); PG8_BAR; PG8_WAIT_L(0); PG8_MMA(0, 0, At, B0); PG8_BAR; PG8_SCHED;
            PG8_LDB(B1, 1, 1); PG8_STAGE(PG8_SB(1, 0), b3, voffB);
            PG8_BAR; PG8_WAIT_L(0); PG8_MMA(0, 1, At, B1); PG8_BAR;
            PG8_LDA(At, 1, 1); PG8_STAGE(PG8_SA(1, 0), a3, voffA);
            PG8_BAR; PG8_WAIT_L(0); PG8_MMA(1, 0, At, B0); PG8_BAR; PG8_SCHED;
            PG8_STAGE(PG8_SB(1, 1), b3 + hstep, voffB);
            PG8_WAIT_V(6); PG8_BAR; PG8_MMA(1, 1, At, B1); PG8_BAR;
            }
        }
        if constexpr (ALIGN_EPI) { if (wr == 0) PG8_BAR; }
        if constexpr (!Epi::AFTER_DRAIN) { E(acc, cur, wr, wc, fr, fq); S.done(cur); }
        if (!has_next) break;
#pragma unroll
        for (int a = 0; a < 2; ++a)
#pragma unroll
            for (int b = 0; b < 2; ++b)
#pragma unroll
                for (int m = 0; m < 4; ++m)
#pragma unroll
                    for (int n = 0; n < 2; ++n) acc[a][b][m][n] = (f32x4){0.f, 0.f, 0.f, 0.f};
        cur = nxt; cA = nA; cB = nB; ++ui;
        if constexpr (ALIGN_EPI) { if (wr == 1) PG8_BAR; }
    }
    PG8_WAIT_V(0);
    if constexpr (!ALIGN_EPI) { if (wr == 0) PG8_BAR; }
    PG8_BAR;
    if constexpr (Epi::AFTER_DRAIN) { E.fused(acc, cur, wr, wc, fr, fq, lds, wid, lane); S.done(cur); }
#undef PG8_SA
#undef PG8_SB
#undef PG8_STAGE
#undef PG8_LDA
#undef PG8_LDB
#undef PG8_MMA
#undef PG8_WAIT_V
#undef PG8_WAIT_L
#undef PG8_BAR
#undef PG8_SCHED
}
}

struct Ctx { int tid, bid, nb; size_t z; };
__device__ __forceinline__ int lane_id() { return (int)__builtin_amdgcn_mbcnt_hi(~0u, __builtin_amdgcn_mbcnt_lo(~0u, 0u)); }
__device__ __forceinline__ Ctx mkctx(const Params& p, int first = 0, int count = 0) { Ctx c; c.tid = (p.wave << 6) | lane_id(); c.bid = blockIdx.x; c.nb = gridDim.x; c.z = 0; asm volatile("" : "+v"(c.tid), "+s"(c.bid), "+s"(c.nb), "+s"(c.z));
    if (first > 0 || count > 0) { const int hi = count > 0 ? first + count : c.nb; c.bid = (c.bid >= first && c.bid < hi) ? c.bid - first : (1 << 20); c.nb = hi - first; } return c; }
#define PIN(i) (p.in[i] + z)
__device__ __forceinline__ void stage_init(const Params& p) {
    const Ctx cx = mkctx(p); const size_t z = cx.z;
    const unsigned gt = (unsigned)cx.bid * NTHREADS + cx.tid, GT = (unsigned)cx.nb * NTHREADS;
    typedef float f4 __attribute__((ext_vector_type(4)));
    f4* X = (f4*)(p.out + z); const f4* xp = (const f4*)PIN(I_XP); const f4* xs = (const f4*)PIN(I_XS);
    (void)xp;
    for (unsigned i = gt; i < (unsigned)NS * (D / 4); i += GT) X[(unsigned)MP * (D / 4) + i] = xs[i];
}
__device__ __forceinline__ void stage_mod(const Params& p, unsigned char* lds, int l_lo, int l_hi, int first = 0) {
    const Ctx cx = mkctx(p, first); const size_t z = cx.z;
    float* MOD = (float*)(p.ws + z + WS_MOD);
    bf16_t* SCs = (bf16_t*)lds;
    bf16_t* WTs = (bf16_t*)(lds + 39168);
    const int lane = cx.tid & 63, wave = __builtin_amdgcn_readfirstlane(cx.tid >> 6), r = lane & 15, q = lane >> 4;
    const int lk = cx.tid >> 4, lj = (cx.tid & 15) * 8;
    for (int item = cx.bid; item < (l_hi - l_lo) * 48; item += cx.nb) {
        const int l = l_lo + item / 48, j0 = (item % 48) * 128;
        const float* w = PIN(I_ADAW) + (size_t)l * D * 6144 + j0 + lj;
        f32x4 acc[9];
#pragma unroll
        for (int i = 0; i < 9; ++i) acc[i] = (f32x4){0.f, 0.f, 0.f, 0.f};
        f32x4 n0 = *(const f32x4*)(w + (size_t)lk * 6144), n1 = *(const f32x4*)(w + (size_t)lk * 6144 + 4);
        __syncthreads();
#pragma unroll
        for (int e = 0; e < 4; ++e) { WTs[(lj + e) * 40 + lk] = f2bf(n0[e]); WTs[(lj + 4 + e) * 40 + lk] = f2bf(n1[e]); }
#pragma unroll 1
        for (int t = 0; t < 32; ++t) {
            if ((t & 3) == 0) {
                __syncthreads();
                for (int i = cx.tid; i < 144 * 16; i += NTHREADS) { const int sidx = i >> 4, k8 = (i & 15) * 8; bf16x8 o;
                    if (sidx < NSEQ) { const float* c = (sidx < NP ? PIN(I_CP) + (size_t)sidx * D : PIN(I_CS) + (size_t)(sidx - NP) * D) + (t >> 2) * 128 + k8;
                        const f32x4 c0 = *(const f32x4*)c, c1 = *(const f32x4*)(c + 4);
#pragma unroll
                        for (int e = 0; e < 4; ++e) { o[e] = (short)f2bf(silu_f(c0[e])); o[4 + e] = (short)f2bf(silu_f(c1[e])); } }
                    else o = (bf16x8){0, 0, 0, 0, 0, 0, 0, 0};
                    *(bf16x8*)(SCs + sidx * LD2 + k8) = o; }
            }
            const int tn = t + 1 < 32 ? t + 1 : 31;
            n0 = *(const f32x4*)(w + (size_t)(tn * 32 + lk) * 6144); n1 = *(const f32x4*)(w + (size_t)(tn * 32 + lk) * 6144 + 4);
            __syncthreads();
            {
                const bf16x8 a = *(const bf16x8*)(WTs + (t & 1) * 5120 + (16 * wave + r) * 40 + 8 * q);
#pragma unroll
                for (int st = 0; st < 9; ++st) {
                    const bf16x8 b = *(const bf16x8*)(SCs + (16 * st + r) * LD2 + 32 * (t & 3) + 8 * q);
                    acc[st] = __builtin_amdgcn_mfma_f32_16x16x32_bf16(a, b, acc[st], 0, 0, 0);
                }
            }
            bf16_t* wn = WTs + ((t + 1) & 1) * 5120;
#pragma unroll
            for (int e = 0; e < 4; ++e) { wn[(lj + e) * 40 + lk] = f2bf(n0[e]); wn[(lj + 4 + e) * 40 + lk] = f2bf(n1[e]); }
        }
        const int j = j0 + 16 * wave + 4 * q;
        const f32x4 b0 = *(const f32x4*)(PIN(I_ADAB) + (size_t)l * 6144 + j);
#pragma unroll
        for (int st = 0; st < 9; ++st) { const int sidx = 16 * st + r; if (sidx < NSEQ) *(f32x4*)(MOD + ((size_t)l * NSEQ + sidx) * 6144 + j) = acc[st] + b0; }
    }
}

__device__ __forceinline__ void stage_norm(const Params& p, int l, int which, float* wl, bool prompt_f32) {
    const Ctx cx = mkctx(p); const size_t z = cx.z;
    const int lane = cx.tid & 63, gw = cx.bid * NWAVES + (cx.tid >> 6), GW = cx.nb * NWAVES;
    const float* X = (l == 0 && which == 0) ? PIN(I_XP) : (const float*)(p.out + z);
    const float* XS = (const float*)(p.out + z);
    bf16_t* H = (bf16_t*)(p.ws + z + WS_H);
    const float* MOD = (const float*)(p.ws + z + WS_MOD);
    const float* g = PIN(which ? I_NFFNG : I_NMIXG) + (size_t)l * D;
    f32x4 gg[4];
#pragma unroll
    for (int j = 0; j < 4; ++j) gg[j] = *(const f32x4*)(g + 4 * lane + 256 * j);
    f32x4 v[2][4], nv[2][4];
    const int rbeg = (prompt_f32 ? 0 : MP) + 2 * gw;
    if (rbeg < R) {
#pragma unroll
        for (int k = 0; k < 2; ++k)
#pragma unroll
            for (int j = 0; j < 4; ++j) v[k][j] = *(const f32x4*)((rbeg + k < MP ? X : XS) + (size_t)(rbeg + k) * D + 4 * lane + 256 * j);
    }
    for (int row0 = rbeg; row0 < R; row0 += 2 * GW) {
        const int rnext = row0 + 2 * GW < R ? row0 + 2 * GW : row0;
#pragma unroll
        for (int k = 0; k < 2; ++k)
#pragma unroll
            for (int j = 0; j < 4; ++j) nv[k][j] = *(const f32x4*)((rnext + k < MP ? X : XS) + (size_t)(rnext + k) * D + 4 * lane + 256 * j);
#pragma unroll
        for (int k = 0; k < 2; ++k) {
            const int row = row0 + k;
            const float* md = MOD + ((size_t)l * NSEQ + seq_of_row(row)) * 6144 + which * 3072 + 4 * lane;
            f32x4 sh[4], sc[4];
#pragma unroll
            for (int j = 0; j < 4; ++j) { sh[j] = *(const f32x4*)(md + 256 * j); sc[j] = *(const f32x4*)(md + 1024 + 256 * j); }
            float ss = 0.f;
#pragma unroll
            for (int j = 0; j < 4; ++j) ss += (v[k][j][0] * v[k][j][0] + v[k][j][1] * v[k][j][1]) + (v[k][j][2] * v[k][j][2] + v[k][j][3] * v[k][j][3]);
            ss = wave_sum(ss);
            const float rstd = rsqrtf(ss * (1.f / D) + NORM_EPS);
#pragma unroll
            for (int j = 0; j < 4; ++j) { v[k][j] = v[k][j] * rstd * gg[j] * (1.f + sc[j]) + sh[j];
                *(bf16x4*)(H + (size_t)row * D + 4 * lane + 256 * j) = (bf16x4){(short)f2bf(v[k][j][0]), (short)f2bf(v[k][j][1]), (short)f2bf(v[k][j][2]), (short)f2bf(v[k][j][3])}; }
        }
#pragma unroll
        for (int k = 0; k < 2; ++k)
#pragma unroll
            for (int j = 0; j < 4; ++j) v[k][j] = nv[k][j];
    }
}

__device__ __forceinline__ void stage_norm_b(const Params& p, int l, int which) {
    const Ctx cx = mkctx(p); const size_t z = cx.z;
    const int lane = cx.tid & 63, gw = cx.bid * NWAVES + (cx.tid >> 6), GW = cx.nb * NWAVES;
    const bf16_t* XB = (const bf16_t*)(p.ws + z + WS_XB);
    bf16_t* H = (bf16_t*)(p.ws + z + WS_H);
    const float* MOD = (const float*)(p.ws + z + WS_MOD);
    const float* g = PIN(which ? I_NFFNG : I_NMIXG) + (size_t)l * D;
    f32x4 gg[2][2];
#pragma unroll
    for (int j = 0; j < 2; ++j) { gg[j][0] = *(const f32x4*)(g + 8 * lane + 512 * j); gg[j][1] = *(const f32x4*)(g + 8 * lane + 512 * j + 4); }
    typedef pg8::u32x4 u32x4;
    u32x4 v[4][2], nv[4][2];
    if (4 * gw < MP) {
#pragma unroll
        for (int k = 0; k < 4; ++k)
#pragma unroll
            for (int j = 0; j < 2; ++j) v[k][j] = *(const u32x4*)(XB + (size_t)(4 * gw + k) * D + 8 * lane + 512 * j);
    }
    for (int row0 = 4 * gw; row0 < MP; row0 += 4 * GW) {
        const int rnext = row0 + 4 * GW < MP ? row0 + 4 * GW : row0;
#pragma unroll
        for (int k = 0; k < 4; ++k)
#pragma unroll
            for (int j = 0; j < 2; ++j) nv[k][j] = *(const u32x4*)(XB + (size_t)(rnext + k) * D + 8 * lane + 512 * j);
        const float* md = MOD + ((size_t)l * NSEQ + (row0 >> 13)) * 6144 + which * 3072 + 8 * lane;
        f32x4 sh[2][2], sc[2][2];
#pragma unroll
        for (int j = 0; j < 2; ++j)
#pragma unroll
            for (int h = 0; h < 2; ++h) { sh[j][h] = *(const f32x4*)(md + 512 * j + 4 * h); sc[j][h] = *(const f32x4*)(md + 1024 + 512 * j + 4 * h) + 1.f; sc[j][h] = sc[j][h] * gg[j][h]; }
#pragma unroll
        for (int k = 0; k < 4; ++k) {
            const int row = row0 + k;
            f32x4 x[2][2]; float ss = 0.f;
#pragma unroll
            for (int j = 0; j < 2; ++j) { const u32x4 w = v[k][j];
                x[j][0] = (f32x4){__builtin_bit_cast(float, w.x << 16), __builtin_bit_cast(float, w.x & 0xffff0000u), __builtin_bit_cast(float, w.y << 16), __builtin_bit_cast(float, w.y & 0xffff0000u)};
                x[j][1] = (f32x4){__builtin_bit_cast(float, w.z << 16), __builtin_bit_cast(float, w.z & 0xffff0000u), __builtin_bit_cast(float, w.w << 16), __builtin_bit_cast(float, w.w & 0xffff0000u)};
#pragma unroll
                for (int h = 0; h < 2; ++h) ss += (x[j][h][0] * x[j][h][0] + x[j][h][1] * x[j][h][1]) + (x[j][h][2] * x[j][h][2] + x[j][h][3] * x[j][h][3]); }
            ss = wave_sum(ss);
            const float rstd = rsqrtf(ss * (1.f / D) + NORM_EPS);
#pragma unroll
            for (int j = 0; j < 2; ++j) { const f32x4 o0 = x[j][0] * rstd * sc[j][0] + sh[j][0], o1 = x[j][1] * rstd * sc[j][1] + sh[j][1];
                u32x4 w; w.x = cvtpk(o0[0], o0[1]); w.y = cvtpk(o0[2], o0[3]); w.z = cvtpk(o1[0], o1[1]); w.w = cvtpk(o1[2], o1[3]);
                *(u32x4*)(H + (size_t)row * D + 8 * lane + 512 * j) = w; }
        }
#pragma unroll
        for (int k = 0; k < 4; ++k)
#pragma unroll
            for (int j = 0; j < 2; ++j) v[k][j] = nv[k][j];
    }
}

__device__ __forceinline__ f32x4 ld4bf(const bf16_t* p) { const bf16x4 v = *(const bf16x4*)p; return (f32x4){bf2f((bf16_t)v[0]), bf2f((bf16_t)v[1]), bf2f((bf16_t)v[2]), bf2f((bf16_t)v[3])}; }
__device__ __forceinline__ void stage_rwprep(const Params& p, int l, float* lds) {
    const Ctx cx = mkctx(p); const size_t z = cx.z;
    const bf16_t* P = (const bf16_t*)(p.ws + z + WS_P);
    bf16_t* RWH = (bf16_t*)(p.ws + z + WS_RW); float* RWD = (float*)(p.ws + z + WS_RWD);
    float* xs = lds; float* kk = lds + 1024;
    const int tid = cx.tid;
    const float* mu = PIN(I_MU) + (size_t)l * 1024;
    for (int row = MP + cx.bid; row < R; row += cx.nb) {
        const bool samp = row >= MP; const int n = samp ? row - MP : row >> 13, t = samp ? 0 : (row & (T - 1));
        __syncthreads();
        for (int c = tid; c < 1024; c += NTHREADS) {
            const float pa = bf2f(P[(size_t)row * PCOLS + c]);
            float prev;
            if (t > 0) prev = bf2f(P[(size_t)(row - 1) * PCOLS + c]);
            else prev = samp ? PIN(I_SHIFT)[((size_t)l * NS + n) * 1024 + c] : 0.f;
            float v = pa + (prev - pa) * mu[c];
            if (c >= 768 && c < 832) v = tanh_fast(v);
            if (c >= 896) v = sigmoid_f(v);
            xs[c] = v;
            if (samp) (p.out + z)[O_SSHIFT + ((size_t)l * NS + n) * 1024 + c] = pa;
            else if (t == T - 1) (p.out + z)[O_PSHIFT + ((size_t)l * NP + n) * 1024 + c] = pa;
        }
        __syncthreads();
        float av = 0.f, gv = 0.f, dec = 0.f, kraw = 0.f;
        if (tid < 256) {
            const int j = tid;
            float wl = PIN(I_W0)[(size_t)l * 256 + j], al = PIN(I_A0)[(size_t)l * 256 + j]; gv = 0.f;
            const bf16_t* W2T = (const bf16_t*)(p.ws + z + WS_LORA) + (size_t)l * 65536;
            bf16x8 fw[8], fa[8], fg[16];
#pragma unroll
            for (int c8 = 0; c8 < 8; ++c8) { fw[c8] = *(const bf16x8*)(W2T + j * 64 + c8 * 8); fa[c8] = *(const bf16x8*)(W2T + 16384 + j * 64 + c8 * 8); }
#pragma unroll
            for (int c8 = 0; c8 < 16; ++c8) fg[c8] = *(const bf16x8*)(W2T + 32768 + j * 128 + c8 * 8);
#pragma unroll
            for (int c8 = 0; c8 < 8; ++c8)
#pragma unroll
                for (int e = 0; e < 8; ++e) { wl += xs[768 + c8 * 8 + e] * bf2f((bf16_t)fw[c8][e]); al += xs[832 + c8 * 8 + e] * bf2f((bf16_t)fa[c8][e]); }
#pragma unroll
            for (int c8 = 0; c8 < 16; ++c8)
#pragma unroll
                for (int e = 0; e < 8; ++e) gv += xs[896 + c8 * 8 + e] * bf2f((bf16_t)fg[c8][e]);
            const float w_log = -softplus_fast(-wl) - 0.5f;
            dec = -__expf(w_log);
            av = sigmoid_f(al);
            kraw = xs[256 + j];
            kk[j] = kraw * PIN(I_KK)[(size_t)l * 256 + j];
        }
        __syncthreads();
        if (tid < 256) {
            const int j = tid, h0 = j & ~63;
            float s = 0.f;
#pragma unroll 4
            for (int i = 0; i < 64; ++i) s += kk[h0 + i] * kk[h0 + i];
            const float kkn = kk[j] / fmaxf(sqrtf(s), 1e-12f);
            const float kmod = kraw * (1.f + (av - 1.f) * PIN(I_KA)[(size_t)l * 256 + j]);
            bf16_t* rw = RWH + (size_t)row * 1536 + j;
            rw[0] = f2bf(xs[j]); rw[256] = f2bf(kmod); rw[512] = f2bf(xs[512 + j]); rw[768] = f2bf(-kkn); rw[1024] = f2bf(kkn * av); rw[1280] = f2bf(gv); RWD[(size_t)row * 256 + j] = dec;
        }
    }
}

__device__ __forceinline__ void stage_rwprep2(const Params& p, int l, unsigned char* lds) {
    const Ctx cx = mkctx(p); const size_t z = cx.z;
    const int tid = cx.tid, lane = tid & 63, wave = __builtin_amdgcn_readfirstlane(tid >> 6), r = lane & 15, q = lane >> 4;
    bf16_t* ACW = (bf16_t*)lds;
    bf16_t* ACA = (bf16_t*)(lds + 9216);
    bf16_t* ACG = (bf16_t*)(lds + 18432);
    const bf16_t* P = (const bf16_t*)(p.ws + z + WS_P);
    bf16_t* RWH = (bf16_t*)(p.ws + z + WS_RW); float* RWD = (float*)(p.ws + z + WS_RWD);
    const bf16_t* W2T = (const bf16_t*)(p.ws + z + WS_LORA) + (size_t)l * 65536; const bf16_t* A2T = W2T + 16384; const bf16_t* G2T = W2T + 32768;
    const float* mu = PIN(I_MU) + (size_t)l * 1024;
    for (int tile = cx.bid; tile < MP / 64; tile += cx.nb) {
        const int row0 = tile * 64;
#pragma unroll
        for (int it = 0; it < 4; ++it) {
            const int task = it * NTHREADS + tid, tok = task >> 5, ch = task & 31, c = 768 + ch * 8, row = row0 + tok;
            const bf16x8 pa = *(const bf16x8*)(P + (size_t)row * PCOLS + c);
            bf16x8 pv = {0, 0, 0, 0, 0, 0, 0, 0};
            if ((row & (T - 1)) != 0) pv = *(const bf16x8*)(P + (size_t)(row - 1) * PCOLS + c);
            bf16x8 o;
#pragma unroll
            for (int e = 0; e < 8; ++e) { const float a = bf2f((bf16_t)pa[e]), b = bf2f((bf16_t)pv[e]); float x = a + (b - a) * mu[c + e];
                x = ch < 8 ? tanh_fast(x) : (ch >= 16 ? sigmoid_f(x) : x); o[e] = (short)f2bf(x); }
            if (ch < 8) *(bf16x8*)(ACW + tok * LD + ch * 8) = o;
            else if (ch < 16) *(bf16x8*)(ACA + tok * LD + (ch - 8) * 8) = o;
            else *(bf16x8*)(ACG + tok * LD2 + (ch - 16) * 8) = o;
        }
        if ((row0 & (T - 1)) == T - 64) {
            const int n = row0 >> 13;
            for (int c = tid; c < 1024; c += NTHREADS) (p.out + z)[O_PSHIFT + ((size_t)l * NP + n) * 1024 + c] = bf2f(P[(size_t)(row0 + 63) * PCOLS + c]);
        }
        __syncthreads();
        {
            const int h = wave >> 1, th = wave & 1;
#pragma unroll 1
            for (int nt = 0; nt < 2; ++nt) {
                const int tb = 32 * th + 16 * nt, row = row0 + tb + r; const bool first = (row & (T - 1)) == 0;
                float kkv[4][4], avv[4][4]; float ssq = 0.f;
                bf16x4 pc[4][3], pp_[4][3];
#pragma unroll
                for (int mt = 0; mt < 4; ++mt) { const int j = h * 64 + 16 * mt + 4 * q; const bf16x4 zero4 = {0, 0, 0, 0};
#pragma unroll
                    for (int f = 0; f < 3; ++f) { pc[mt][f] = *(const bf16x4*)(P + (size_t)row * PCOLS + 256 * f + j); pp_[mt][f] = first ? zero4 : *(const bf16x4*)(P + (size_t)(row - 1) * PCOLS + 256 * f + j); } }
#pragma unroll
                for (int mt = 0; mt < 4; ++mt) {
                    const int j0 = h * 64 + 16 * mt, j = j0 + 4 * q;
                    f32x4 aw = {0.f, 0.f, 0.f, 0.f}, aa = {0.f, 0.f, 0.f, 0.f}, ag = {0.f, 0.f, 0.f, 0.f};
#pragma unroll
                    for (int s2 = 0; s2 < 2; ++s2) {
                        const bf16x8 fw = *(const bf16x8*)(W2T + (j0 + r) * 64 + 32 * s2 + 8 * q), fa = *(const bf16x8*)(A2T + (j0 + r) * 64 + 32 * s2 + 8 * q);
                        const bf16x8 bw = *(const bf16x8*)(ACW + (tb + r) * LD + 32 * s2 + 8 * q), ba = *(const bf16x8*)(ACA + (tb + r) * LD + 32 * s2 + 8 * q);
                        aw = __builtin_amdgcn_mfma_f32_16x16x32_bf16(fw, bw, aw, 0, 0, 0);
                        aa = __builtin_amdgcn_mfma_f32_16x16x32_bf16(fa, ba, aa, 0, 0, 0);
                    }
#pragma unroll
                    for (int s2 = 0; s2 < 4; ++s2) {
                        const bf16x8 fg = *(const bf16x8*)(G2T + (j0 + r) * 128 + 32 * s2 + 8 * q), bg = *(const bf16x8*)(ACG + (tb + r) * LD2 + 32 * s2 + 8 * q);
                        ag = __builtin_amdgcn_mfma_f32_16x16x32_bf16(fg, bg, ag, 0, 0, 0);
                    }
                    const bf16x4 par = pc[mt][0], pak = pc[mt][1], pav = pc[mt][2], pvr = pp_[mt][0], pvk = pp_[mt][1], pvv = pp_[mt][2];
                    const f32x4 mur = *(const f32x4*)(mu + j), muk = *(const f32x4*)(mu + 256 + j), muv = *(const f32x4*)(mu + 512 + j);
                    const f32x4 w0 = *(const f32x4*)(PIN(I_W0) + (size_t)l * 256 + j), a0 = *(const f32x4*)(PIN(I_A0) + (size_t)l * 256 + j);
                    const f32x4 kkw = *(const f32x4*)(PIN(I_KK) + (size_t)l * 256 + j), kaw = *(const f32x4*)(PIN(I_KA) + (size_t)l * 256 + j);
                    f32x4 fr_, fk_, fv_, fd_;
#pragma unroll
                    for (int e = 0; e < 4; ++e) {
                        const float ar = bf2f((bf16_t)par[e]), ak = bf2f((bf16_t)pak[e]), av_ = bf2f((bf16_t)pav[e]);
                        const float xr = ar + (bf2f((bf16_t)pvr[e]) - ar) * mur[e], xk = ak + (bf2f((bf16_t)pvk[e]) - ak) * muk[e], xv = av_ + (bf2f((bf16_t)pvv[e]) - av_) * muv[e];
                        const float w_log = -softplus_fast(-(w0[e] + aw[e])) - 0.5f;
                        const float av = sigmoid_f(a0[e] + aa[e]);
                        fd_[e] = -__expf(w_log);
                        fr_[e] = xr; fv_[e] = xv;
                        fk_[e] = xk * (1.f + (av - 1.f) * kaw[e]);
                        const float kv = xk * kkw[e]; kkv[mt][e] = kv; avv[mt][e] = av; ssq += kv * kv;
                    }
                    bf16_t* rw = RWH + (size_t)row * 1536 + j;
                    *(bf16x4*)rw = pack4(fr_); *(bf16x4*)(rw + 256) = pack4(fk_); *(bf16x4*)(rw + 512) = pack4(fv_); *(bf16x4*)(rw + 1280) = pack4(ag); *(f32x4*)(RWD + (size_t)row * 256 + j) = fd_;
                }
                ssq += __shfl_xor(ssq, 16); ssq += __shfl_xor(ssq, 32);
                const float rn = 1.f / fmaxf(sqrtf(ssq), 1e-12f);
#pragma unroll
                for (int mt = 0; mt < 4; ++mt) {
                    bf16_t* rw = RWH + (size_t)row * 1536 + h * 64 + 16 * mt + 4 * q;
                    f32x4 fa_, fb_;
#pragma unroll
                    for (int e = 0; e < 4; ++e) { const float kn = kkv[mt][e] * rn; fa_[e] = -kn; fb_[e] = kn * avv[mt][e]; }
                    *(bf16x4*)(rw + 768) = pack4(fa_); *(bf16x4*)(rw + 1024) = pack4(fb_);
                }
            }
        }
        __syncthreads();
    }
}

#define WAVE_LDS_SYNC() do { asm volatile("s_waitcnt lgkmcnt(0)" ::: "memory"); __builtin_amdgcn_wave_barrier(); } while (0)
__device__ __forceinline__ void stage_rwscan(const Params& p, int l, float* lds, int first = 0) {
    const Ctx cx = mkctx(p, first); const size_t z = cx.z;
    const int lane = cx.tid & 63, wave = cx.tid >> 6;
    const bf16_t* RWH = (const bf16_t*)(p.ws + z + WS_RW); const float* RWD = (const float*)(p.ws + z + WS_RWD);
    bf16_t* Y = (bf16_t*)(p.ws + z + WS_YCAT);
    float* wl = lds + wave * 512;
    for (int u = NP * 4 + cx.bid + cx.nb * wave; u < NSEQ * 4; u += cx.nb * NWAVES) {
        const int s = u >> 2, h = u & 3; const bool samp = s >= NP; const int n = samp ? s - NP : s;
        const int row0 = samp ? MP + n : n * T, nt = samp ? 1 : T;
        float S[64];
        if (samp) { const float* st = PIN(I_WKV) + ((((size_t)l * NS + n) * 4 + h) * 64 + lane) * 64;
#pragma unroll
            for (int k = 0; k < 64; k += 4) { const f32x4 v4 = *(const f32x4*)(st + k); S[k] = v4[0]; S[k + 1] = v4[1]; S[k + 2] = v4[2]; S[k + 3] = v4[3]; } }
        else {
#pragma unroll
            for (int k = 0; k < 64; ++k) S[k] = 0.f; }
        const float lng = PIN(I_LNG)[(size_t)l * 256 + h * 64 + lane], lnb = PIN(I_LNB)[(size_t)l * 256 + h * 64 + lane];
        const float rkl = PIN(I_RK)[(size_t)l * 256 + h * 64 + lane];
        for (int t = 0; t < nt; ++t) {
            const bf16_t* rw = RWH + (size_t)(row0 + t) * 1536 + h * 64 + lane;
            const float rl = bf2f(rw[0]), kl = bf2f(rw[256]), vl = bf2f(rw[512]), gl = bf2f(rw[1280]);
            WAVE_LDS_SYNC();
            wl[lane] = rl; wl[64 + lane] = kl; wl[128 + lane] = __expf(RWD[(size_t)(row0 + t) * 256 + h * 64 + lane]); wl[192 + lane] = bf2f(rw[768]); wl[256 + lane] = bf2f(rw[1024]);
            WAVE_LDS_SYNC();
            const float bd = wave_sum(rl * kl * rkl);
            float sa = 0.f;
#pragma unroll
            for (int k = 0; k < 64; ++k) sa += S[k] * wl[192 + k];
            float y = 0.f;
#pragma unroll
            for (int k = 0; k < 64; ++k) {
                S[k] = S[k] * wl[128 + k] + sa * wl[256 + k] + vl * wl[64 + k];
                y += S[k] * wl[k];
            }
            const float mean = wave_sum(y) * (1.f / 64.f), dl = y - mean;
            const float var = wave_sum(dl * dl) * (1.f / 64.f);
            const float yn = dl * rsqrtf(var + GN_EPS) * lng + lnb;
            Y[(size_t)(row0 + t) * D + h * 64 + lane] = f2bf((yn + bd * vl) * gl);
        }
        float* so = (p.out + z) + (samp ? O_SWKV + ((((size_t)l * NS + n) * 4 + h) * 64 + lane) * 64 : O_PWKV + ((((size_t)l * NP + n) * 4 + h) * 64 + lane) * 64);
#pragma unroll
        for (int k = 0; k < 64; k += 4) *(f32x4*)(so + k) = (f32x4){S[k], S[k + 1], S[k + 2], S[k + 3]};
    }
}

constexpr int RWL = 64, NCH = T / RWL, RW_UNITS = NP * 4 * NCH;
__device__ __forceinline__ f32x4 mma16_k64(const bf16_t* A, const bf16_t* Bt, f32x4 acc, int r, int q) {
    const bf16x8 a0 = *(const bf16x8*)(A + r * LD + 8 * q), a1 = *(const bf16x8*)(A + r * LD + 32 + 8 * q);
    const bf16x8 b0 = *(const bf16x8*)(Bt + r * LD + 8 * q), b1 = *(const bf16x8*)(Bt + r * LD + 32 + 8 * q);
    acc = __builtin_amdgcn_mfma_f32_16x16x32_bf16(a0, b0, acc, 0, 0, 0);
    acc = __builtin_amdgcn_mfma_f32_16x16x32_bf16(a1, b1, acc, 0, 0, 0);
    return acc;
}

__device__ __forceinline__ void stage_rw1(const Params& p, int l, unsigned char* lds) {
    const Ctx cx = mkctx(p); const size_t z = cx.z;
    const int tid = cx.tid, lane0 = tid & 63, wave = __builtin_amdgcn_readfirstlane(tid >> 6);
#define RELANE() int lane_ = lane0; asm volatile("" : "+v"(lane_)); const int lane = lane_, r = lane & 15, q = lane >> 4; (void)r; (void)q;
    bf16_t* M = (bf16_t*)lds;
    float* AT = (float*)(lds + 12 * MSZ * 2);
    float* psum = AT + 64 * 68;
    float* PLs = psum + 512;
    bf16_t* TA10 = (bf16_t*)(PLs + 64);
    bf16_t* TT00 = TA10 + 32 * LD; bf16_t* TYT = TT00 + 32 * LD;
    unsigned char* const wsz = p.ws + z;
    for (int uu = cx.bid; uu < RW_UNITS; uu += cx.nb) {
        const int tile = uu & 255, h = uu >> 8, n = tile >> 7, c = tile & (NCH - 1), unit = (n * 4 + h) * NCH + c;
        const int row0 = n * T + c * RWL;
        {
            RELANE();
            const int k = lane, tg = wave;
            const bf16_t* rw = (const bf16_t*)(wsz + WS_RW) + (size_t)(row0 + tg * 8) * 1536 + h * 64 + k; const float* rwd = (const float*)(wsz + WS_RWD) + (size_t)(row0 + tg * 8) * 256 + h * 64 + k;
            float ld[8], f_r[8], f_k[8], f_v[8], f_a[8], f_b[8]; float cs = 0.f;
#pragma unroll
            for (int j = 0; j < 8; ++j) { ld[j] = rwd[j * 256]; f_r[j] = bf2f(rw[j * 1536]); f_k[j] = bf2f(rw[j * 1536 + 256]); f_v[j] = bf2f(rw[j * 1536 + 512]); f_a[j] = bf2f(rw[j * 1536 + 768]); f_b[j] = bf2f(rw[j * 1536 + 1024]); }
#pragma unroll
            for (int j = 0; j < 8; ++j) { cs += ld[j]; ld[j] = cs; }
            psum[tg * 64 + k] = cs;
            __syncthreads();
            float off = 0.f, tot = 0.f;
#pragma unroll
            for (int g = 0; g < 8; ++g) { const float v_ = psum[g * 64 + k]; tot += v_; off += g < tg ? v_ : 0.f; }
            if (tg == 0) PLs[k] = __expf(tot);
            bf16x8 atT, bcT, kcT, vT;
#pragma unroll
            for (int j = 0; j < 8; ++j) {
                const float lp = off + ld[j], lpm1 = j ? off + ld[j - 1] : off;
                const float Pt = __expf(lp), Pinv = __expf(-lp), Pm1 = __expf(lpm1), E = __expf(tot - lp);
                const float rr = f_r[j], km = f_k[j], vv = f_v[j], av = f_a[j], bv = f_b[j];
                const int t = tg * 8 + j;
                const bf16_t at = f2bf(av * Pm1);
                M[0 * MSZ + t * LD + k] = at; atT[j] = (short)at;
                M[3 * MSZ + t * LD + k] = f2bf(rr * Pt);
                M[1 * MSZ + t * LD + k] = f2bf(bv * Pinv);
                M[2 * MSZ + t * LD + k] = f2bf(km * Pinv);
                bcT[j] = (short)f2bf(bv * E); kcT[j] = (short)f2bf(km * E); vT[j] = (short)f2bf(vv);
            }
            *(bf16x8*)(M + 4 * MSZ + k * LD + tg * 8) = atT;
            *(bf16x8*)(M + 5 * MSZ + k * LD + tg * 8) = bcT;
            *(bf16x8*)(M + 6 * MSZ + k * LD + tg * 8) = kcT;
            *(bf16x8*)(M + 7 * MSZ + k * LD + tg * 8) = vT;
        }
        __syncthreads();
        {
            RELANE();
            const int mm = wave >> 1, hh = wave & 1;
            const bf16_t* Asrc = M + (mm < 2 ? 0 : 3) * MSZ; const bf16_t* Bsrc = M + ((mm & 1) ? 2 : 1) * MSZ;
#pragma unroll
            for (int m2 = 0; m2 < 2; ++m2) {
                const int mt = hh * 2 + m2;
#pragma unroll
                for (int nt = 0; nt < 4; ++nt) {
                    float zf = 0.f; asm volatile("" : "+v"(zf));
                    f32x4 acc = {zf, zf, zf, zf};
                    if (nt <= mt) acc = mma16_k64(Asrc + mt * 16 * LD, Bsrc + nt * 16 * LD, acc, r, q);
                    const int i = 16 * nt + r;
#pragma unroll
                    for (int e = 0; e < 4; ++e) { const int t = 16 * mt + 4 * q + e; const bool keep = mm < 2 ? (i < t) : (i <= t); acc[e] = keep ? acc[e] : 0.f; }
                    if (mm == 0) { *(f32x4*)(AT + i * 68 + 16 * mt + 4 * q) = acc;
                        if (mt >= 2 && nt < 2) {
#pragma unroll
                            for (int e = 0; e < 4; ++e) TA10[(16 * (mt - 2) + 4 * q + e) * LD + i] = f2bf(acc[e]); } }
                    else {
                        bf16_t* dst = M + (7 + mm) * MSZ;
#pragma unroll
                        for (int e = 0; e < 4; ++e) dst[(16 * mt + 4 * q + e) * LD + i] = f2bf(acc[e]);
                    }
                }
            }
        }
        __syncthreads();
        if (wave == 0) {
            RELANE();
            const int blk = lane >> 5, jl = lane & 31;
            const float* ATl = AT + blk * (32 * 68 + 32);
            float tc[32];
#pragma unroll
            for (int t = 0; t < 32; ++t) tc[t] = (t == jl) ? 1.f : 0.f;
            int aoff = 0;
            float cur[31], nxt[31];
#pragma unroll
            for (int t = 1; t < 32; ++t) cur[t - 1] = ATl[t];
#pragma unroll
            for (int i = 0; i < 31; ++i) {
                asm volatile("" : "+v"(aoff), "+v"(tc[i]));
                if (i + 1 < 31) {
#pragma unroll
                    for (int t = i + 2; t < 32; ++t) nxt[t - i - 2] = ATl[aoff + (i + 1) * 68 + t];
                }
                const float ti = tc[i];
#pragma unroll
                for (int t = i + 1; t < 32; ++t) tc[t] += cur[t - i - 1] * ti;
#pragma unroll
                for (int t = 0; t < 30; ++t) cur[t] = nxt[t];
            }
            bf16_t* T11 = M + 11 * MSZ;
#pragma unroll
            for (int t = 0; t < 32; ++t) { T11[(blk * 32 + t) * LD + lane] = f2bf(tc[t]); if (blk) T11[t * LD + lane] = 0; }
            if (blk == 0) {
#pragma unroll
                for (int c8 = 0; c8 < 4; ++c8) { bf16x8 o;
#pragma unroll
                    for (int e = 0; e < 8; ++e) o[e] = (short)f2bf(tc[c8 * 8 + e]);
                    *(bf16x8*)(TT00 + jl * LD + c8 * 8) = o; }
            }
        } else if (wave >= 4) {
            RELANE();
            const int mt = wave - 4;
#pragma unroll
            for (int nt = 0; nt < 4; ++nt) {
                f32x4 acc = {0.f, 0.f, 0.f, 0.f};
                acc = mma16_k64(M + 7 * MSZ + mt * 16 * LD, M + 8 * MSZ + nt * 16 * LD, acc, r, q);
#pragma unroll
                for (int e = 0; e < 4; ++e) M[1 * MSZ + (16 * mt + 4 * q + e) * LD + 16 * nt + r] = f2bf(acc[e]);
            }
        }
        __syncthreads();
        if (wave < 4) {
            RELANE();
            const int mt = wave >> 1, nt = wave & 1;
            const bf16x8 a = *(const bf16x8*)(TA10 + (16 * mt + r) * LD + 8 * q), b = *(const bf16x8*)(TT00 + (16 * nt + r) * LD + 8 * q);
            f32x4 acc = {0.f, 0.f, 0.f, 0.f};
            acc = __builtin_amdgcn_mfma_f32_16x16x32_bf16(a, b, acc, 0, 0, 0);
#pragma unroll
            for (int e = 0; e < 4; ++e) TYT[(16 * nt + r) * LD + 16 * mt + 4 * q + e] = f2bf(acc[e]);
        }
        __syncthreads();
        if (wave < 4) {
            RELANE();
            const int mt = wave >> 1, nt = wave & 1;
            const bf16x8 a = *(const bf16x8*)(M + 11 * MSZ + (32 + 16 * mt + r) * LD + 32 + 8 * q), b = *(const bf16x8*)(TYT + (16 * nt + r) * LD + 8 * q);
            f32x4 acc = {0.f, 0.f, 0.f, 0.f};
            acc = __builtin_amdgcn_mfma_f32_16x16x32_bf16(a, b, acc, 0, 0, 0);
#pragma unroll
            for (int e = 0; e < 4; ++e) M[11 * MSZ + (32 + 16 * mt + 4 * q + e) * LD + 16 * nt + r] = f2bf(acc[e]);
        }
        __syncthreads();
        {
            RELANE();
            const int mt = wave & 3; const bf16_t* Asrc = M + (wave < 4 ? 4 : 1) * MSZ; bf16_t* dst = M + (wave < 4 ? 0 : 2) * MSZ;
#pragma unroll
            for (int nt = 0; nt < 4; ++nt) {
                f32x4 acc = {0.f, 0.f, 0.f, 0.f};
                acc = mma16_k64(Asrc + mt * 16 * LD, M + 11 * MSZ + nt * 16 * LD, acc, r, q);
#pragma unroll
                for (int e = 0; e < 4; ++e) dst[(16 * mt + 4 * q + e) * LD + 16 * nt + r] = f2bf(acc[e]);
            }
        }
        __syncthreads();
        {
            RELANE();
            const int job = wave >> 1;
            bf16_t* RPg = (bf16_t*)(wsz + WS_RWC_RP); bf16_t* MCg = (bf16_t*)(wsz + WS_RWC_MC); bf16_t* NCTg = (bf16_t*)(wsz + WS_RWC_NCT); float* Y0g = (float*)(wsz + WS_RWC_Y0);
#pragma unroll
            for (int m2 = 0; m2 < 2; ++m2) {
                const int mt = (wave & 1) * 2 + m2;
#pragma unroll
                for (int nt = 0; nt < 4; ++nt) {
                    const size_t ub = (size_t)unit * 4096;
                    if (job == 0) {
                        const bf16x4 in = *(const bf16x4*)(M + 3 * MSZ + (16 * nt + r) * LD + 16 * mt + 4 * q);
                        f32x4 acc = {bf2f((bf16_t)in[0]), bf2f((bf16_t)in[1]), bf2f((bf16_t)in[2]), bf2f((bf16_t)in[3])};
                        acc = mma16_k64(M + 0 * MSZ + mt * 16 * LD, M + 9 * MSZ + nt * 16 * LD, acc, r, q);
                        *(bf16x4*)(RPg + ub + (16 * nt + r) * 64 + 16 * mt + 4 * q) = pack4(acc);
                    } else if (job == 1) {
                        f32x4 acc = {0.f, 0.f, 0.f, 0.f};
                        acc = mma16_k64(M + 0 * MSZ + mt * 16 * LD, M + 5 * MSZ + nt * 16 * LD, acc, r, q);
                        const int k1 = 16 * nt + r; const float pl = PLs[k1];
#pragma unroll
                        for (int e = 0; e < 4; ++e) acc[e] += (16 * mt + 4 * q + e == k1) ? pl : 0.f;
                        *(bf16x4*)(MCg + ub + k1 * 64 + 32 * (mt >> 1) + 8 * q + 4 * (mt & 1)) = pack4(acc);
                    } else if (job == 2) {
                        f32x4 acc = {0.f, 0.f, 0.f, 0.f};
                        acc = mma16_k64(M + 2 * MSZ + mt * 16 * LD, M + 9 * MSZ + nt * 16 * LD, acc, r, q);
                        acc = mma16_k64(M + 7 * MSZ + mt * 16 * LD, M + 10 * MSZ + nt * 16 * LD, acc, r, q);
                        *(f32x4*)(Y0g + ub + (16 * nt + r) * 64 + 16 * mt + 4 * q) = acc;
                    } else {
                        f32x4 acc = {0.f, 0.f, 0.f, 0.f};
                        acc = mma16_k64(M + 5 * MSZ + mt * 16 * LD, M + 2 * MSZ + nt * 16 * LD, acc, r, q);
                        acc = mma16_k64(M + 6 * MSZ + mt * 16 * LD, M + 7 * MSZ + nt * 16 * LD, acc, r, q);
                        *(bf16x4*)(NCTg + ub + (16 * nt + r) * 64 + 16 * mt + 4 * q) = pack4(acc);
                    }
                }
            }
        }
        __syncthreads();
    }
}
#undef RELANE

constexpr int RW2_D = 8, RW2_SLOT = 2 * MSZ;
struct RwRegs { bf16x8 m0, m1, n0, n1; };
__device__ __forceinline__ void rw2_fetch(RwRegs& R, const bf16_t* mc, const bf16_t* nct, int c, int lt) {
    const int cc = c & (NCH - 1);
    R.m0 = *(const bf16x8*)(mc + (size_t)cc * 4096 + lt * 8); R.m1 = *(const bf16x8*)(mc + (size_t)cc * 4096 + 2048 + lt * 8);
    R.n0 = *(const bf16x8*)(nct + (size_t)cc * 4096 + lt * 8); R.n1 = *(const bf16x8*)(nct + (size_t)cc * 4096 + 2048 + lt * 8);
}
__device__ __forceinline__ void rw2_put(const RwRegs& R, bf16_t* slot, int lt) {
    const int row = lt >> 3, pc = lt & 7;
    *(bf16x8*)(slot + row * LD + pc * 8) = R.m0; *(bf16x8*)(slot + (row + 32) * LD + pc * 8) = R.m1;
    *(bf16x8*)(slot + MSZ + row * LD + pc * 8) = R.n0; *(bf16x8*)(slot + MSZ + (row + 32) * LD + pc * 8) = R.n1;
}
__device__ __forceinline__ void rw2_consume(f32x4 (&acc)[4], const bf16_t* slot, bf16_t* s0, int c, int r, int q, int v) {
    bf16x4 pk[4];
#pragma unroll
    for (int mt = 0; mt < 4; ++mt) { pk[mt] = pack4(acc[mt]); *(bf16x4*)(s0 + (size_t)c * 4096 + v * 64 + 16 * mt + 4 * q) = pk[mt]; }
    const bf16x8 b0 = {pk[0][0], pk[0][1], pk[0][2], pk[0][3], pk[1][0], pk[1][1], pk[1][2], pk[1][3]};
    const bf16x8 b1 = {pk[2][0], pk[2][1], pk[2][2], pk[2][3], pk[3][0], pk[3][1], pk[3][2], pk[3][3]};
#pragma unroll
    for (int mt = 0; mt < 4; ++mt) {
        const bf16x8 a0 = *(const bf16x8*)(slot + (16 * mt + r) * LD + 8 * q), a1 = *(const bf16x8*)(slot + (16 * mt + r) * LD + 32 + 8 * q);
        const bf16x4 nc = *(const bf16x4*)(slot + MSZ + v * LD + 16 * mt + 4 * q);
        f32x4 ci = {bf2f((bf16_t)nc[0]), bf2f((bf16_t)nc[1]), bf2f((bf16_t)nc[2]), bf2f((bf16_t)nc[3])};
        ci = __builtin_amdgcn_mfma_f32_16x16x32_bf16(a0, b0, ci, 0, 0, 0);
        acc[mt] = __builtin_amdgcn_mfma_f32_16x16x32_bf16(a1, b1, ci, 0, 0, 0);
    }
}
__device__ __forceinline__ void stage_rw2(const Params& p, int l, unsigned char* lds) {
    const Ctx cx = mkctx(p); const size_t z = cx.z;
    const int tid = cx.tid, lane = tid & 63, wave = __builtin_amdgcn_readfirstlane(tid >> 6), r = lane & 15, q = lane >> 4;
    if (cx.bid < NP * 4) {
        const int nh = cx.bid, v = 16 * (wave & 3) + r;
        const bf16_t* mc = (const bf16_t*)(p.ws + z + WS_RWC_MC) + (size_t)nh * NCH * 4096;
        bf16_t* nct = (bf16_t*)(p.ws + z + WS_RWC_NCT) + (size_t)nh * NCH * 4096;
        bf16_t* L0 = (bf16_t*)lds; bf16_t* L1 = L0 + RW2_SLOT;
        f32x4 acc[4];
#pragma unroll
        for (int mt = 0; mt < 4; ++mt) acc[mt] = (f32x4){0.f, 0.f, 0.f, 0.f};
        RwRegs R0, R1, R2, R3, R4, R5, R6, R7;
        const int lt = tid - 256;
        if (wave >= 4) {
            { RwRegs F; rw2_fetch(F, mc, nct, 0, lt); rw2_put(F, L0, lt); }
            rw2_fetch(R0, mc, nct, 1, lt); rw2_fetch(R1, mc, nct, 2, lt); rw2_fetch(R2, mc, nct, 3, lt); rw2_fetch(R3, mc, nct, 4, lt);
            rw2_fetch(R4, mc, nct, 5, lt); rw2_fetch(R5, mc, nct, 6, lt); rw2_fetch(R6, mc, nct, 7, lt); rw2_fetch(R7, mc, nct, 8, lt);
        }
        __syncthreads();
        if (wave >= 4) {
#define RW2_LSTEP(RR, c) do { rw2_put(RR, ((c) & 1) ? L0 : L1, lt); rw2_fetch(RR, mc, nct, (c) + 1 + RW2_D, lt); __syncthreads(); } while (0)
#pragma unroll 1
            for (int c = 0; c < NCH; c += 8) {
                RW2_LSTEP(R0, c); RW2_LSTEP(R1, c + 1); RW2_LSTEP(R2, c + 2); RW2_LSTEP(R3, c + 3);
                RW2_LSTEP(R4, c + 4); RW2_LSTEP(R5, c + 5); RW2_LSTEP(R6, c + 6); RW2_LSTEP(R7, c + 7);
            }
#undef RW2_LSTEP
        } else {
#pragma unroll 1
            for (int c = 0; c < NCH; c += 2) {
                rw2_consume(acc, L0, nct, c, r, q, v); __syncthreads();
                rw2_consume(acc, L1, nct, c + 1, r, q, v); __syncthreads();
            }
        }
#define RW2_STEP(RR, c)
#undef RW2_STEP
        if (wave < 4) {
            float* so = (p.out + z) + O_PWKV + ((size_t)l * NP * 4 + nh) * 4096 + v * 64 + 4 * q;
#pragma unroll
            for (int mt = 0; mt < 4; ++mt) *(f32x4*)(so + 16 * mt) = acc[mt];
        }
    }
}

__device__ __forceinline__ void stage_rw3(const Params& p, int l, int first = 0) {
    const Ctx cx = mkctx(p, first); const size_t z = cx.z;
    const int tid = cx.tid, lane = tid & 63, wave = tid >> 6, r = lane & 15, q = lane >> 4;
    const bf16_t* RWH = (const bf16_t*)(p.ws + z + WS_RW);
    const bf16_t* RPg = (const bf16_t*)(p.ws + z + WS_RWC_RP); const bf16_t* S0g = (const bf16_t*)(p.ws + z + WS_RWC_NCT);
    const float* Y0g = (const float*)(p.ws + z + WS_RWC_Y0);
    bf16_t* Y = (bf16_t*)(p.ws + z + WS_YCAT);
    for (int it = cx.bid; it < RW_UNITS / 2; it += cx.nb) {
        const int c = (it & 63) * 2 + (wave >> 2), nh = it >> 6, n = nh >> 2, h = nh & 3, unit = nh * NCH + c, nt = wave & 3;
        const int t = 16 * nt + r, row = n * T + c * RWL + t;
        const size_t ub = (size_t)unit * 4096;
        const bf16x8 rp0 = *(const bf16x8*)(RPg + ub + t * 64 + 8 * q), rp1 = *(const bf16x8*)(RPg + ub + t * 64 + 32 + 8 * q);
        const bf16_t* rw = RWH + (size_t)row * 1536 + h * 64;
        f32x4 y[4]; float sum = 0.f, bd = 0.f;
#pragma unroll
        for (int mt = 0; mt < 4; ++mt) {
            const bf16x8 s0 = *(const bf16x8*)(S0g + ub + (16 * mt + r) * 64 + 8 * q), s1 = *(const bf16x8*)(S0g + ub + (16 * mt + r) * 64 + 32 + 8 * q);
            f32x4 acc = *(const f32x4*)(Y0g + ub + t * 64 + 16 * mt + 4 * q);
            acc = __builtin_amdgcn_mfma_f32_16x16x32_bf16(s0, rp0, acc, 0, 0, 0);
            acc = __builtin_amdgcn_mfma_f32_16x16x32_bf16(s1, rp1, acc, 0, 0, 0);
            y[mt] = acc; sum += (acc[0] + acc[1]) + (acc[2] + acc[3]);
            const f32x4 rr = ld4bf(rw + 16 * mt + 4 * q), km = ld4bf(rw + 256 + 16 * mt + 4 * q), rk = *(const f32x4*)(PIN(I_RK) + (size_t)l * 256 + h * 64 + 16 * mt + 4 * q);
            bd += (rr[0] * km[0] * rk[0] + rr[1] * km[1] * rk[1]) + (rr[2] * km[2] * rk[2] + rr[3] * km[3] * rk[3]);
        }
        sum += __shfl_xor(sum, 16); sum += __shfl_xor(sum, 32);
        bd += __shfl_xor(bd, 16); bd += __shfl_xor(bd, 32);
        const float mean = sum * (1.f / 64.f); float vs = 0.f;
#pragma unroll
        for (int mt = 0; mt < 4; ++mt)
#pragma unroll
            for (int e = 0; e < 4; ++e) { const float d_ = y[mt][e] - mean; vs += d_ * d_; }
        vs += __shfl_xor(vs, 16); vs += __shfl_xor(vs, 32);
        const float rstd = rsqrtf(vs * (1.f / 64.f) + GN_EPS);
#pragma unroll
        for (int mt = 0; mt < 4; ++mt) {
            const int vi = 16 * mt + 4 * q;
            const f32x4 vv = ld4bf(rw + 512 + vi), gg = ld4bf(rw + 1280 + vi);
            const f32x4 lg = *(const f32x4*)(PIN(I_LNG) + (size_t)l * 256 + h * 64 + vi), lb = *(const f32x4*)(PIN(I_LNB) + (size_t)l * 256 + h * 64 + vi);
            f32x4 o;
#pragma unroll
            for (int e = 0; e < 4; ++e) o[e] = ((y[mt][e] - mean) * rstd * lg[e] + lb[e] + bd * vv[e]) * gg[e];
            *(bf16x4*)(Y + (size_t)row * D + h * 64 + vi) = pack4(o);
        }
    }
}

__device__ __forceinline__ void stage_qkn(const Params& p, int l) {
    const Ctx cx = mkctx(p); const size_t z = cx.z;
    const int lane = cx.tid & 63, gw = cx.bid * NWAVES + (cx.tid >> 6), GW = cx.nb * NWAVES;
    const bf16_t* P = (const bf16_t*)(p.ws + z + WS_P);
    float* QN = (float*)(p.ws + z + WS_QN); float* KN = (float*)(p.ws + z + WS_KN);
    for (int it = MP * 6 + gw; it < R * 6; it += GW) {
        const int row = it / 6, unit = it % 6;
        const bool samp = row >= MP; const int n = samp ? row - MP : row >> 13, t = samp ? 0 : (row & (T - 1));
        const float x = bf2f(P[(size_t)row * PCOLS + OFF_B + unit * 64 + lane]);
        const float ss = wave_sum(x * x) * (1.f / 64.f);
        const float g = unit < 4 ? PIN(I_QNG)[(size_t)l * 64 + lane] : PIN(I_KNG)[(size_t)l * 64 + lane];
        const float y = x * rsqrtf(ss + NORM_EPS) * g;
        if (unit < 4) QN[(size_t)row * 256 + unit * 64 + lane] = y;
        else {
            const int kvh = unit - 4;
            KN[(size_t)row * 128 + kvh * 64 + lane] = y;
            const float v = bf2f(P[(size_t)row * PCOLS + OFF_B + 384 + kvh * 64 + lane]);
            if (samp) { const size_t o = (((size_t)l * NS + n) * 128 + 127) * 128 + kvh * 64 + lane; (p.out + z)[O_SK + o] = y; (p.out + z)[O_SV + o] = v; }
            else if (t >= T - 128) { const size_t o = (((size_t)l * NP + n) * 128 + (t - (T - 128))) * 128 + kvh * 64 + lane; (p.out + z)[O_PK + o] = y; (p.out + z)[O_PV + o] = v; }
        }
    }
}

__device__ __forceinline__ void stage_cachecopy(const Params& p, int l, int first = 0) {
    const Ctx cx = mkctx(p, first); const size_t z = cx.z;
    {
        typedef float f4 __attribute__((ext_vector_type(4)));
        const unsigned gt4 = (unsigned)cx.bid * NTHREADS + cx.tid, GT4 = (unsigned)cx.nb * NTHREADS;
        for (unsigned i = gt4; i < (unsigned)NS * 4064; i += GT4) {
            const unsigned n = i / 4064u, o4 = i - n * 4064u;
            const size_t src = (((size_t)l * NS + n) * 128 + 1) * 128 + (size_t)o4 * 4, dst = ((size_t)l * NS + n) * 128 * 128 + (size_t)o4 * 4;
            *(f4*)((p.out + z) + O_SK + dst) = *(const f4*)(PIN(I_CK) + src); *(f4*)((p.out + z) + O_SV + dst) = *(const f4*)(PIN(I_CV) + src);
        }
    }
}

__device__ __forceinline__ void stage_att(const Params& p, int l, int first = 0) {
    const Ctx cx = mkctx(p, first); const size_t z = cx.z;
    const int lane = cx.tid & 63, gw = cx.bid * NWAVES + (cx.tid >> 6), GW = cx.nb * NWAVES;
    const bf16_t* P = (const bf16_t*)(p.ws + z + WS_P);
    const float* QN = (const float*)(p.ws + z + WS_QN); const float* KN = (const float*)(p.ws + z + WS_KN);
    bf16_t* Y = (bf16_t*)(p.ws + z + WS_YCAT);
    for (int it = MP * 4 + gw; it < R * 4; it += GW) {
        const int row = it >> 2, hq = it & 3, kvh = hq >> 1;
        const bool samp = row >= MP; const int n = samp ? row - MP : row >> 13, t = samp ? 0 : (row & (T - 1));
        const int rowbase = row - t;
        const float* q = QN + (size_t)row * 256 + hq * 64;
        const float sink = PIN(I_SINK)[(size_t)l * 4 + hq];
        f32x4 qreg[16];
#pragma unroll
        for (int d4 = 0; d4 < 16; ++d4) qreg[d4] = *(const f32x4*)(q + 4 * d4);
        float sc[3]; float mx = -INFINITY;
#pragma unroll
        for (int j = 0; j < 3; ++j) {
            const int i = lane + 64 * j; sc[j] = -INFINITY;
            if (i <= 128) {
                const int pos = t - 128 + i;
                const float* kp = nullptr;
                if (pos >= 0) kp = KN + (size_t)(rowbase + pos) * 128 + kvh * 64;
                else if (samp) kp = PIN(I_CK) + (((size_t)l * NS + n) * 128 + i) * 128 + kvh * 64;
                if (kp) { float s = 0.f;
#pragma unroll
                    for (int hf = 0; hf < 2; ++hf) {
                        f32x4 kv[8];
#pragma unroll
                        for (int d4 = 0; d4 < 8; ++d4) kv[d4] = *(const f32x4*)(kp + 32 * hf + 4 * d4);
#pragma unroll
                        for (int d4 = 0; d4 < 8; ++d4) { const f32x4 qv = qreg[8 * hf + d4]; s += (qv[0] * kv[d4][0] + qv[1] * kv[d4][1]) + (qv[2] * kv[d4][2] + qv[3] * kv[d4][3]); }
                        __builtin_amdgcn_sched_barrier(0);
                    }
                    sc[j] = s * 0.125f; }
            }
            mx = fmaxf(mx, sc[j]);
            __builtin_amdgcn_sched_barrier(0);
        }
        mx = fmaxf(wave_max(mx), sink);
        float pr[3]; float sum = 0.f;
#pragma unroll
        for (int j = 0; j < 3; ++j) { pr[j] = sc[j] == -INFINITY ? 0.f : __expf(sc[j] - mx); sum += pr[j]; }
        sum = wave_sum(sum) + __expf(sink - mx);
        float o = 0.f;
        for (int i = 0; i <= 128; ++i) {
            const float prs = i < 64 ? pr[0] : (i < 128 ? pr[1] : pr[2]);
            const float pi = __shfl(prs, i & 63);
            const int pos = t - 128 + i;
            float v = 0.f;
            if (pos >= 0) v = bf2f(P[(size_t)(rowbase + pos) * PCOLS + OFF_B + 384 + kvh * 64 + lane]);
            else if (samp) v = PIN(I_CV)[(((size_t)l * NS + n) * 128 + i) * 128 + kvh * 64 + lane];
            o += pi * v;
        }
        Y[(size_t)row * D + 256 + hq * 64 + lane] = f2bf(o / sum);
    }
}

constexpr int LDV = 264;
__device__ __forceinline__ void stage_attn(const Params& p, int l, unsigned char* lds, int first = 0) {
    const Ctx cx = mkctx(p, first); const size_t z = cx.z;
    const int tid = cx.tid, lane = tid & 63, wave = __builtin_amdgcn_readfirstlane(tid >> 6), r = lane & 15, q = lane >> 4;
    bf16_t* Ks = (bf16_t*)lds;
    bf16_t* Qs = (bf16_t*)(lds + 36864);
    bf16_t* Vt = (bf16_t*)(lds + 73728);
    const bf16_t* P = (const bf16_t*)(p.ws + z + WS_P);
    bf16_t* Y = (bf16_t*)(p.ws + z + WS_YCAT);
    for (int unit = cx.bid; unit < NP * 2 * (T / 128); unit += cx.nb) {
        const int b = unit & 63, kvh = (unit >> 6) & 1, n = unit >> 7, t0 = b * 128;
        const size_t rowb = (size_t)n * T;
        float gk[8], gq[8];
#pragma unroll
        for (int j = 0; j < 8; ++j) { gk[j] = PIN(I_KNG)[(size_t)l * 64 + (tid & 7) * 8 + j]; gq[j] = PIN(I_QNG)[(size_t)l * 64 + (tid & 7) * 8 + j]; }
        bf16x8 kraw[4], qraw[4], vraw[4];
#pragma unroll
        for (int it = 0; it < 4; ++it) {
            const int task = it * NTHREADS + tid, c8 = task & 7, kk = task >> 3, kp = t0 - 128 + kk, g = kk >> 7, tl = kk & 127;
            const bf16x8 zz = {0, 0, 0, 0, 0, 0, 0, 0};
            kraw[it] = kp >= 0 ? *(const bf16x8*)(P + (rowb + kp) * PCOLS + OFF_B + 256 + kvh * 64 + c8 * 8) : zz;
            qraw[it] = *(const bf16x8*)(P + (rowb + t0 + tl) * PCOLS + OFF_B + (kvh * 2 + g) * 64 + c8 * 8);
            const int d = task & 63, m0 = (task >> 6) * 8;
#pragma unroll
            for (int j = 0; j < 8; ++j) { const int vp = t0 - 128 + m0 + j; vraw[it][j] = vp >= 0 ? (short)P[(rowb + vp) * PCOLS + OFF_B + 384 + kvh * 64 + d] : (short)0; }
        }
#pragma unroll
        for (int it = 0; it < 4; ++it) {
            const int task = it * NTHREADS + tid, c8 = task & 7;
            {
                const int kk = task >> 3;
                float x[8]; float ss = 0.f;
#pragma unroll
                for (int j = 0; j < 8; ++j) { x[j] = bf2f((bf16_t)kraw[it][j]); ss += x[j] * x[j]; }
                ss += __shfl_xor(ss, 1); ss += __shfl_xor(ss, 2); ss += __shfl_xor(ss, 4);
                const float rstd = rsqrtf(ss * (1.f / 64.f) + NORM_EPS);
                bf16x8 o;
#pragma unroll
                for (int j = 0; j < 8; ++j) { x[j] = x[j] * rstd * gk[j]; o[j] = (short)f2bf(x[j]); }
                *(bf16x8*)(Ks + kk * LD + c8 * 8) = o;
                if (b == 63 && kk >= 128) { float* ko = (p.out + z) + O_PK + (((size_t)l * NP + n) * 128 + (kk - 128)) * 128 + kvh * 64 + c8 * 8;
#pragma unroll
                    for (int j = 0; j < 8; ++j) ko[j] = x[j]; }
            }
            {
                const int qr = task >> 3;
                float x[8]; float ss = 0.f;
#pragma unroll
                for (int j = 0; j < 8; ++j) { x[j] = bf2f((bf16_t)qraw[it][j]); ss += x[j] * x[j]; }
                ss += __shfl_xor(ss, 1); ss += __shfl_xor(ss, 2); ss += __shfl_xor(ss, 4);
                const float rstd = rsqrtf(ss * (1.f / 64.f) + NORM_EPS) * 0.125f;
                bf16x8 o;
#pragma unroll
                for (int j = 0; j < 8; ++j) o[j] = (short)f2bf(x[j] * rstd * gq[j]);
                *(bf16x8*)(Qs + qr * LD + c8 * 8) = o;
            }
            {
                const int d = task & 63, m0 = (task >> 6) * 8;
                *(bf16x8*)(Vt + d * LDV + m0) = vraw[it];
                if (b == 63 && m0 >= 128) { float* vo = (p.out + z) + O_PV + (((size_t)l * NP + n) * 128 + (m0 - 128)) * 128 + kvh * 64 + d;
#pragma unroll
                    for (int j = 0; j < 8; ++j) vo[j * 128] = bf2f((bf16_t)vraw[it][j]); }
            }
        }
        __syncthreads();
        {
            const int g = wave >> 2, sb = wave & 3, hq = kvh * 2 + g;
            const float sink = PIN(I_SINK)[(size_t)l * 4 + hq];
#pragma unroll 1
            for (int mt = 0; mt < 2; ++mt) {
                const int ql = 32 * sb + 16 * mt + r;
                const bf16_t* Qb = Qs + (g * 128 + 32 * sb + 16 * mt) * LD;
                f32x4 sacc[10]; float mx = -INFINITY;
#pragma unroll
                for (int j = 0; j < 10; ++j) {
                    f32x4 a = {0.f, 0.f, 0.f, 0.f};
                    a = mma16_k64(Ks + (32 * sb + 16 * j) * LD, Qb, a, r, q);
#pragma unroll
                    for (int e = 0; e < 4; ++e) { const int kk = 32 * sb + 16 * j + 4 * q + e, rel = ql + 128 - kk;
                        const bool ok = rel >= 0 && rel <= 128 && (t0 - 128 + kk) >= 0;
                        a[e] = ok ? a[e] : -INFINITY; mx = fmaxf(mx, a[e]); }
                    sacc[j] = a;
                    __builtin_amdgcn_sched_barrier(0);
                }
                mx = fmaxf(mx, __shfl_xor(mx, 16)); mx = fmaxf(mx, __shfl_xor(mx, 32)); mx = fmaxf(mx, sink);
                float sum = 0.f;
#pragma unroll
                for (int j = 0; j < 10; ++j)
#pragma unroll
                    for (int e = 0; e < 4; ++e) { const float pv = __expf(sacc[j][e] - mx); sacc[j][e] = pv; sum += pv; }
                sum += __shfl_xor(sum, 16); sum += __shfl_xor(sum, 32); sum += __expf(sink - mx);
                const float inv = 1.f / sum;
                f32x4 o[4];
#pragma unroll
                for (int dt = 0; dt < 4; ++dt) o[dt] = (f32x4){0.f, 0.f, 0.f, 0.f};
#pragma unroll
                for (int s2 = 0; s2 < 5; ++s2) {
                    const bf16x4 p0 = pack4(sacc[2 * s2]), p1 = pack4(sacc[2 * s2 + 1]);
                    const bf16x8 pb = {p0[0], p0[1], p0[2], p0[3], p1[0], p1[1], p1[2], p1[3]};
#pragma unroll
                    for (int dt = 0; dt < 4; ++dt) {
                        const bf16_t* vp = Vt + (16 * dt + r) * LDV + 32 * sb + 32 * s2 + 4 * q;
                        const bf16x4 v0 = *(const bf16x4*)vp, v1 = *(const bf16x4*)(vp + 16);
                        const bf16x8 va = {v0[0], v0[1], v0[2], v0[3], v1[0], v1[1], v1[2], v1[3]};
                        o[dt] = __builtin_amdgcn_mfma_f32_16x16x32_bf16(va, pb, o[dt], 0, 0, 0);
                    }
                    __builtin_amdgcn_sched_barrier(0);
                }
                bf16_t* yo = Y + (rowb + t0 + ql) * D + 256 + hq * 64 + 4 * q;
#pragma unroll
                for (int dt = 0; dt < 4; ++dt) { f32x4 ov = o[dt] * inv; *(bf16x4*)(yo + 16 * dt) = pack4(ov); }
            }
        }
        __syncthreads();
    }
}

__device__ __forceinline__ void mconv_unit(const Params& p, size_t z, int l, int n, int c, int g, int tid) {
    const bf16_t* P = (const bf16_t*)(p.ws + z + WS_P);
    bf16_t* XB = (bf16_t*)(p.ws + z + WS_XBCC);
    const float* cw = PIN(I_CONVW) + (size_t)l * 4 * 1024; const float* cb = PIN(I_CONVB) + (size_t)l * 1024;
#pragma unroll 1
    for (int i = tid; i < 1024; i += NTHREADS) {
        const int ch = i & 63, c0 = ch < 32 ? g * 256 + ch * 8 : (ch < 48 ? 512 + g * 128 + (ch - 32) * 8 : 768 + g * 128 + (ch - 48) * 8);
        const int row = n * T + c * 128 + (i >> 6) * 8, t = row & (T - 1);
        bf16x8 u[11];
#pragma unroll
        for (int k = 0; k < 11; ++k) { const bf16x8 zz = {0, 0, 0, 0, 0, 0, 0, 0}; u[k] = (t - 3 + k >= 0) ? *(const bf16x8*)(P + (size_t)(row - 3 + k) * PCOLS + OFF_XBC + c0) : zz; }
        float w[4][8], b[8];
#pragma unroll
        for (int e = 0; e < 8; ++e) { b[e] = cb[c0 + e];
#pragma unroll
            for (int j = 0; j < 4; ++j) w[j][e] = cw[j * 1024 + c0 + e]; }
#pragma unroll
        for (int r = 0; r < 8; ++r) { bf16x8 o;
#pragma unroll
            for (int e = 0; e < 8; ++e) { float acc = b[e];
#pragma unroll
                for (int j = 0; j < 4; ++j) acc += w[j][e] * bf2f((bf16_t)u[r + j][e]);
                o[e] = (short)f2bf(silu_f(acc)); }
            *(bf16x8*)(XB + (size_t)(row + r) * 1024 + c0) = o;
            if (t + r >= T - 3) { float* op = (p.out + z) + O_PCONV + (((size_t)l * NP + n) * 3 + (t + r - (T - 3))) * 1024 + c0;
#pragma unroll
                for (int e = 0; e < 8; ++e) op[e] = bf2f((bf16_t)u[3 + r][e]); }
        }
    }
}

__device__ __forceinline__ void stage_mconv(const Params& p, int l) {
    const Ctx cx = mkctx(p); const size_t z = cx.z;
    const unsigned gt = (unsigned)cx.bid * NTHREADS + cx.tid, GT = (unsigned)cx.nb * NTHREADS;
    const bf16_t* P = (const bf16_t*)(p.ws + z + WS_P);
    bf16_t* XB = (bf16_t*)(p.ws + z + WS_XBCC); float* DT = (float*)(p.ws + z + WS_DT);
    const float* cw = PIN(I_CONVW) + (size_t)l * 4 * 1024; const float* cb = PIN(I_CONVB) + (size_t)l * 1024;
    for (unsigned i = (unsigned)MP * 1024 + gt; i < (unsigned)R * 1024; i += GT) {
        const int c = (int)(i & 1023), row = (int)(i >> 10), n = row - MP;
        const float* st = PIN(I_SCONV) + ((size_t)l * NS + n) * 3 * 1024 + c;
        const float raw = bf2f(P[(size_t)row * PCOLS + OFF_XBC + c]);
        const float acc = cb[c] + cw[c] * st[0] + cw[1024 + c] * st[1024] + cw[2048 + c] * st[2048] + cw[3072 + c] * raw;
        XB[i] = f2bf(silu_f(acc));
        float* o = (p.out + z) + O_SCONV + ((size_t)l * NS + n) * 3 * 1024 + c;
        o[0] = st[1024]; o[1024] = st[2048]; o[2048] = raw;
    }
    float* DT2 = (float*)(p.ws + z + WS_DT2);
    for (unsigned i = (unsigned)MP * 8 + gt; i < (unsigned)R * 8; i += GT) DT2[i] = softplus_f(DT[i] + PIN(I_DTB)[(size_t)l * 8 + (i & 7)]);
}

__device__ __forceinline__ void stage_mscan(const Params& p, int l, float* lds, int first = 0) {
    const Ctx cx = mkctx(p, first); const size_t z = cx.z;
    const int lane = cx.tid & 63, wave = cx.tid >> 6;
    const bf16_t* XB = (const bf16_t*)(p.ws + z + WS_XBCC); const float* DT = (const float*)(p.ws + z + WS_DT2);
    float* YT = (float*)(p.ws + z + WS_YTMP);
    float* wl = lds + wave * 512;
    const int dh = lane & 1, pl = lane >> 1;
    for (int u = NP * 16 + cx.bid + cx.nb * wave; u < NSEQ * 16; u += cx.nb * NWAVES) {
        const int s = u >> 4, h = (u >> 1) & 7, ph = u & 1, g = h >> 2; const bool samp = s >= NP; const int n = samp ? s - NP : s;
        const int row0 = samp ? MP + n : n * T, nt = samp ? 1 : T, pp = ph * 32 + pl;
        float hs[64];
        if (samp) { const float* st = PIN(I_SSM) + ((((size_t)l * NS + n) * 8 + h) * 64 + pp) * 128 + dh * 64;
#pragma unroll
            for (int d = 0; d < 64; d += 4) { const f32x4 v4 = *(const f32x4*)(st + d); hs[d] = v4[0]; hs[d + 1] = v4[1]; hs[d + 2] = v4[2]; hs[d + 3] = v4[3]; } }
        else {
#pragma unroll
            for (int d = 0; d < 64; ++d) hs[d] = 0.f; }
        const float A = -__expf(PIN(I_ALOG)[(size_t)l * 8 + h]), Dh = PIN(I_SSMD)[(size_t)l * 8 + h];
        for (int t = 0; t < nt; ++t) {
            const size_t row = (size_t)row0 + t;
            const float dtv = DT[row * 8 + h], dA = __expf(dtv * A);
            const float x = bf2f(XB[row * 1024 + h * 64 + pp]), xdt = x * dtv;
            const bf16_t* b = XB + row * 1024 + 512 + g * 128; const bf16_t* c = XB + row * 1024 + 768 + g * 128;
            WAVE_LDS_SYNC();
            wl[lane] = bf2f(b[lane]); wl[64 + lane] = bf2f(b[64 + lane]); wl[128 + lane] = bf2f(c[lane]); wl[192 + lane] = bf2f(c[64 + lane]);
            WAVE_LDS_SYNC();
            float y = 0.f;
#pragma unroll
            for (int d = 0; d < 64; ++d) { hs[d] = hs[d] * dA + xdt * wl[dh * 64 + d]; y += hs[d] * wl[128 + dh * 64 + d]; }
            y += __shfl_xor(y, 1);
            if (dh == 0) YT[row * 512 + h * 64 + pp] = y + Dh * x;
        }
        float* so = (p.out + z) + (samp ? O_SSSM + ((((size_t)l * NS + n) * 8 + h) * 64 + pp) * 128 : O_PSSM + ((((size_t)l * NP + n) * 8 + h) * 64 + pp) * 128) + dh * 64;
#pragma unroll
        for (int d = 0; d < 64; d += 4) *(f32x4*)(so + d) = (f32x4){hs[d], hs[d + 1], hs[d + 2], hs[d + 3]};
    }
}

__device__ __forceinline__ void mgate_rows(const Params& p, size_t z, int l, int row_lo, int row_hi, int gw, int GW, int lane) {
    const bf16_t* P = (const bf16_t*)(p.ws + z + WS_P); const float* YT = (const float*)(p.ws + z + WS_YTMP);
    bf16_t* Y = (bf16_t*)(p.ws + z + WS_YCAT);
    const f32x4 g0 = *(const f32x4*)(PIN(I_SSMNG) + (size_t)l * 512 + lane * 8), g1 = *(const f32x4*)(PIN(I_SSMNG) + (size_t)l * 512 + lane * 8 + 4);
    for (int row = row_lo + 2 * gw; row < row_hi; row += 2 * GW) {
        f32x4 ya[2][2]; bf16x8 zz[2];
#pragma unroll
        for (int k = 0; k < 2; ++k) { ya[k][0] = *(const f32x4*)(YT + (size_t)(row + k) * 512 + lane * 8); ya[k][1] = *(const f32x4*)(YT + (size_t)(row + k) * 512 + lane * 8 + 4);
            zz[k] = *(const bf16x8*)(P + (size_t)(row + k) * PCOLS + OFF_Z + lane * 8); }
#pragma unroll
        for (int k = 0; k < 2; ++k) {
            float v[8]; float ss = 0.f;
#pragma unroll
            for (int e = 0; e < 8; ++e) { v[e] = ya[k][e >> 2][e & 3] * silu_f(bf2f((bf16_t)zz[k][e])); ss += v[e] * v[e]; }
            const float rstd = rsqrtf(wave_sum(ss) * (1.f / 512.f) + NORM_EPS);
            bf16x8 o;
#pragma unroll
            for (int e = 0; e < 8; ++e) o[e] = (short)f2bf(v[e] * rstd * (e < 4 ? g0[e & 3] : g1[e & 3]));
            *(bf16x8*)(Y + (size_t)(row + k) * D + 512 + lane * 8) = o;
        }
    }
}
constexpr int SL = 128, SNC = T / SL;
__device__ __forceinline__ f32x4 mma16(const bf16_t* A, const bf16_t* Bt, int nsteps, f32x4 acc, int r, int q) {
#pragma unroll
    for (int s = 0; s < 4; ++s) if (s < nsteps) {
        const bf16x8 a = *(const bf16x8*)(A + r * LD2 + 32 * s + 8 * q), b = *(const bf16x8*)(Bt + r * LD2 + 32 * s + 8 * q);
        acc = __builtin_amdgcn_mfma_f32_16x16x32_bf16(a, b, acc, 0, 0, 0);
    }
    return acc;
}
constexpr int SSD_OFF_AUX = 104448;
template <bool FROM_RAW>
__device__ __forceinline__ void ssd_aux(const Params& p, size_t z, int l, int g, int row0, float* aux, int tid) {
    float* DT2 = (float*)(p.ws + z + WS_DT2);
    const int t = tid & 127, e = tid >> 7, h = g * 4 + e;
    float dtv;
    if (FROM_RAW) { dtv = softplus_f(((const float*)(p.ws + z + WS_DT))[(size_t)(row0 + t) * 8 + h] + PIN(I_DTB)[(size_t)l * 8 + h]); DT2[(size_t)(row0 + t) * 8 + h] = dtv; }
    else dtv = DT2[(size_t)(row0 + t) * 8 + h];
    const float A = -__expf(PIN(I_ALOG)[(size_t)l * 8 + h]);
    aux[e * 128 + t] = dtv; aux[512 + e * 128 + t] = dtv * A;
    __syncthreads();
    float acc = 0.f;
    for (int i = 0; i <= t; ++i) acc += aux[512 + e * 128 + i];
    aux[1024 + e * 128 + t] = acc;
    __syncthreads();
}
__device__ __forceinline__ void stage_ssd1(const Params& p, int l, unsigned char* lds) {
    const Ctx cx = mkctx(p); const size_t z = cx.z;
    const int tid = cx.tid, lane = tid & 63, wave = __builtin_amdgcn_readfirstlane(tid >> 6), r = lane & 15, q = lane >> 4;
    bf16_t* BT = (bf16_t*)lds;
    bf16_t* XW = (bf16_t*)(lds + 34816);
    float* aux = (float*)(lds + SSD_OFF_AUX);
    const bf16_t* XB = (const bf16_t*)(p.ws + z + WS_XBCC);
    float* ST = (float*)(p.ws + z + WS_SST); float* CD = (float*)(p.ws + z + WS_SCD);
    for (int unit = cx.bid; unit < NP * SNC * 2; unit += cx.nb) {
        const int g = unit & 1, c = (unit >> 1) & (SNC - 1), n = unit >> 7, row0 = n * T + c * SL;
        mconv_unit(p, z, l, n, c, g, tid);
        asm volatile("s_waitcnt vmcnt(0)" ::: "memory"); __syncthreads();
        const int d = tid & 127, mg = tid >> 7, pp = tid & 63, mgp = tid >> 6;
        bf16x8 bv[4], xv[4][2];
#pragma unroll
        for (int it = 0; it < 4; ++it) { const int m0 = mg * 32 + it * 8;
#pragma unroll
            for (int j = 0; j < 8; ++j) bv[it][j] = (short)XB[(size_t)(row0 + m0 + j) * 1024 + 512 + g * 128 + d]; }
#pragma unroll
        for (int e = 0; e < 4; ++e)
#pragma unroll
            for (int it = 0; it < 2; ++it) { const int m0 = mgp * 16 + it * 8;
#pragma unroll
                for (int j = 0; j < 8; ++j) xv[e][it][j] = (short)XB[(size_t)(row0 + m0 + j) * 1024 + (g * 4 + e) * 64 + pp]; }
        ssd_aux<true>(p, z, l, g, row0, aux, tid);
        {
#pragma unroll
            for (int it = 0; it < 4; ++it) *(bf16x8*)(BT + d * LD2 + mg * 32 + it * 8) = bv[it];
#pragma unroll
            for (int e = 0; e < 4; ++e) { const float alast = aux[1024 + e * 128 + 127];
#pragma unroll
                for (int it = 0; it < 2; ++it) { const int m0 = mgp * 16 + it * 8; bf16x8 v;
#pragma unroll
                    for (int j = 0; j < 8; ++j) { const int m = m0 + j; v[j] = (short)f2bf(bf2f((bf16_t)xv[e][it][j]) * aux[e * 128 + m] * __expf(alast - aux[1024 + e * 128 + m])); }
                    *(bf16x8*)(XW + e * 64 * LD2 + pp * LD2 + m0) = v; } }
        }
        __syncthreads();
#pragma unroll
        for (int e = 0; e < 4; ++e) {
            float* st = ST + ((size_t)(n * SNC + c) * 8 + g * 4 + e) * 8192;
#pragma unroll
            for (int nt = 0; nt < 4; ++nt) {
                f32x4 acc = {0.f, 0.f, 0.f, 0.f};
                acc = mma16(BT + 16 * wave * LD2, XW + e * 64 * LD2 + 16 * nt * LD2, 4, acc, r, q);
                *(f32x4*)(st + (16 * nt + r) * 128 + 16 * wave + 4 * q) = acc;
            }
        }
        if (tid < 4) CD[(size_t)(n * SNC + c) * 8 + g * 4 + tid] = __expf(aux[1024 + tid * 128 + 127]);
        __syncthreads();
    }
}
__device__ __forceinline__ void stage_ssd2(const Params& p, int l) {
    const Ctx cx = mkctx(p); const size_t z = cx.z;
    const int first = cx.nb > 16 ? NP * 4 : 0;
    if (cx.bid >= first) {
        typedef float f32x2 __attribute__((ext_vector_type(2)));
        const float* ST = (const float*)(p.ws + z + WS_SST); const float* CD = (const float*)(p.ws + z + WS_SCD);
        unsigned* HPV = (unsigned*)(p.ws + z + WS_HPREV);
        for (int idx = (cx.bid - first) * NTHREADS + cx.tid; idx < NP * 8 * 4096; idx += (cx.nb - first) * NTHREADS) {
            const int n = idx >> 15, h = (idx >> 12) & 7, pd = (idx & 4095) * 2;
            const float* base = ST + ((size_t)(n * SNC) * 8 + h) * 8192 + pd; const float* cd = CD + (size_t)(n * SNC) * 8 + h;
            unsigned* hb = HPV + (((size_t)(n * SNC) * 8 + h) * 8192 + pd) / 2;
            f32x2 hc = {0.f, 0.f};
#pragma unroll 1
            for (int c0 = 0; c0 < SNC; c0 += 32) {
                f32x2 v[32]; float dcy[32];
#pragma unroll
                for (int k = 0; k < 32; ++k) { v[k] = *(const f32x2*)(base + (size_t)(c0 + k) * 65536); dcy[k] = cd[(c0 + k) * 8]; }
#pragma unroll
                for (int k = 0; k < 32; ++k) { hb[(size_t)(c0 + k) * 32768] = cvtpk(hc[0], hc[1]); hc = hc * dcy[k] + v[k]; }
            }
            *(f32x2*)((p.out + z) + O_PSSM + ((size_t)(l * NP + n) * 8 + h) * 8192 + pd) = hc;
        }
    }
}
__device__ __forceinline__ void stage_ssd3(const Params& p, int l, unsigned char* lds, int first = 0, int count = 0) {
    const Ctx cx = mkctx(p, first, count); const size_t z = cx.z;
    const int tid = cx.tid, lane = tid & 63, wave = __builtin_amdgcn_readfirstlane(tid >> 6), r = lane & 15, q = lane >> 4;
    bf16_t* CM = (bf16_t*)lds;
    bf16_t* BG = (bf16_t*)(lds + 34816);
    bf16_t* XT = (bf16_t*)(lds + 69632);
    bf16_t* HP = (bf16_t*)(lds + 87040);
    float* aux = (float*)(lds + SSD_OFF_AUX);
    const bf16_t* XB = (const bf16_t*)(p.ws + z + WS_XBCC);
    const bf16_t* HPV = (const bf16_t*)(p.ws + z + WS_HPREV);
    float* YT = (float*)(p.ws + z + WS_YTMP);
    for (int u2 = cx.bid; u2 < NP * SNC; u2 += cx.nb)
    for (int g = 0; g < 2; ++g) {
        const int c = u2 & (SNC - 1), n = u2 >> 6, row0 = n * T + c * SL;
        bf16x8 cc[4], bb[4];
        {
            const int d0 = (tid & 15) * 8;
#pragma unroll
            for (int it = 0; it < 4; ++it) { const int row = (tid >> 4) + 32 * it;
                cc[it] = *(const bf16x8*)(XB + (size_t)(row0 + row) * 1024 + 768 + g * 128 + d0); bb[it] = *(const bf16x8*)(XB + (size_t)(row0 + row) * 1024 + 512 + g * 128 + d0); }
        }
        ssd_aux<false>(p, z, l, g, row0, aux, tid);
        {
            const int d0 = (tid & 15) * 8;
#pragma unroll
            for (int it = 0; it < 4; ++it) { const int row = (tid >> 4) + 32 * it; *(bf16x8*)(CM + row * LD2 + d0) = cc[it]; *(bf16x8*)(BG + row * LD2 + d0) = bb[it]; }
        }
        __syncthreads();
        f32x4 cb[8];
#pragma unroll
        for (int nt = 0; nt < 8; ++nt) { cb[nt] = (f32x4){0.f, 0.f, 0.f, 0.f}; if (nt <= wave) cb[nt] = mma16(CM + 16 * wave * LD2, BG + 16 * nt * LD2, 4, cb[nt], r, q); }
        __syncthreads();
        const int xpp = tid & 63, xmg = tid >> 6, hpp = tid >> 3, hd0 = (tid & 7) * 16;
        bf16_t xr[16]; bf16x8 hv[2];
#define SSD3_FETCH(ee) do { const int hh_ = g * 4 + (ee); \
            _Pragma("unroll") for (int j_ = 0; j_ < 16; ++j_) xr[j_] = XB[(size_t)(row0 + xmg * 16 + j_) * 1024 + hh_ * 64 + xpp]; \
            const bf16_t* src_ = HPV + ((size_t)(n * SNC + c) * 8 + hh_) * 8192 + hpp * 128 + hd0; \
            hv[0] = *(const bf16x8*)src_; hv[1] = *(const bf16x8*)(src_ + 8); } while (0)
        SSD3_FETCH(0);
#pragma unroll 1
        for (int e = 0; e < 4; ++e) {
            const int h = g * 4 + e;
            {
#pragma unroll
                for (int nt = 0; nt < 8; ++nt) { const int m = 16 * nt + r; const float am = aux[1024 + e * 128 + m];
#pragma unroll
                    for (int e2 = 0; e2 < 4; ++e2) { const int li = 16 * wave + 4 * q + e2; const float v = (m <= li) ? cb[nt][e2] * __expf(aux[1024 + e * 128 + li] - am) : 0.f; BG[li * LD2 + m] = f2bf(v); } }
#pragma unroll
                for (int it = 0; it < 2; ++it) { const int m0 = xmg * 16 + it * 8; bf16x8 v;
#pragma unroll
                    for (int j = 0; j < 8; ++j) v[j] = (short)f2bf(bf2f(xr[it * 8 + j]) * aux[e * 128 + m0 + j]);
                    *(bf16x8*)(XT + xpp * LD2 + m0) = v; }
                *(bf16x8*)(HP + hpp * LD2 + hd0) = hv[0]; *(bf16x8*)(HP + hpp * LD2 + hd0 + 8) = hv[1];
                if (e + 1 < 4) SSD3_FETCH(e + 1);
            }
            __syncthreads();
            {
                const int li = 16 * wave + r; const size_t row = (size_t)row0 + li;
                const float sc = __expf(aux[1024 + e * 128 + li]), Dh = PIN(I_SSMD)[(size_t)l * 8 + h];
                bf16x4 xq[4];
#pragma unroll
                for (int mt = 0; mt < 4; ++mt) xq[mt] = *(const bf16x4*)(XB + row * 1024 + h * 64 + 16 * mt + 4 * q);
#pragma unroll
                for (int mt = 0; mt < 4; ++mt) {
                    f32x4 ad = {0.f, 0.f, 0.f, 0.f}, ao = {0.f, 0.f, 0.f, 0.f};
                    ad = mma16(XT + 16 * mt * LD2, BG + 16 * wave * LD2, (wave >> 1) + 1, ad, r, q);
                    ao = mma16(HP + 16 * mt * LD2, CM + 16 * wave * LD2, 4, ao, r, q);
                    const bf16x4 xv = xq[mt];
                    f32x4 y;
#pragma unroll
                    for (int e2 = 0; e2 < 4; ++e2) y[e2] = ad[e2] + sc * ao[e2] + Dh * bf2f((bf16_t)xv[e2]);
                    *(f32x4*)(YT + row * 512 + h * 64 + 16 * mt + 4 * q) = y;
                }
            }
            __syncthreads();
        }
        if (g == 1) { asm volatile("s_waitcnt vmcnt(0)" ::: "memory"); __syncthreads(); mgate_rows(p, z, l, row0, row0 + SL, wave, NWAVES, lane); }
#undef SSD3_FETCH
    }
}

__device__ __forceinline__ void stage_mgate_sample(const Params& p, int l, int first) {
    const Ctx cx = mkctx(p, first); const size_t z = cx.z;
    mgate_rows(p, z, l, MP, R, cx.bid * NWAVES + (cx.tid >> 6), cx.nb * NWAVES, cx.tid & 63);
}

__device__ __forceinline__ void stage_glu(const Params& p, int l) {
    const Ctx cx = mkctx(p); const size_t z = cx.z;
    const unsigned gt = (unsigned)cx.bid * NTHREADS + cx.tid, GT = (unsigned)cx.nb * NTHREADS;
    const bf16_t* GV = (const bf16_t*)(p.ws + z + WS_GV); bf16_t* U = (bf16_t*)(p.ws + z + WS_U);
    const float* cw = PIN(I_FCW) + (size_t)l * 3 * DFF; const float* cb = PIN(I_FCB) + (size_t)l * DFF;
    for (unsigned i = gt; i < (unsigned)(MP / 32) * (DFF / 8); i += GT) {
        const int hr = (int)(i / (unsigned)(DFF / 8)), c0 = (int)(i - (unsigned)hr * (DFF / 8)) * 8, row = (hr >> 1) * 64 + (hr & 1), t = row & (T - 1);
        const int cg = 256 * (c0 >> 7) + (c0 & 127);
        bf16x8 u[3];
#pragma unroll
        for (int k = 0; k < 3; ++k) { const bf16x8 zz = {0, 0, 0, 0, 0, 0, 0, 0}; u[k] = (t - 2 + k >= 0) ? *(const bf16x8*)(GV + (size_t)(row - 2 + k) * 5632 + cg) : zz; }
        const bf16x8 vv = *(const bf16x8*)(GV + (size_t)row * 5632 + cg + 128);
        bf16x8 o;
#pragma unroll
        for (int e = 0; e < 8; ++e) { const float acc = cb[c0 + e] + cw[c0 + e] * bf2f((bf16_t)u[0][e]) + cw[DFF + c0 + e] * bf2f((bf16_t)u[1][e]) + cw[2 * DFF + c0 + e] * bf2f((bf16_t)u[2][e]);
            o[e] = (short)f2bf(silu_f(acc) * bf2f((bf16_t)vv[e])); }
        *(bf16x8*)(U + (size_t)row * DFF + c0) = o;
    }
    for (unsigned i = gt; i < (unsigned)NP * 2 * DFF; i += GT) {
        const int c = (int)(i % (unsigned)DFF), j = (int)(i / (unsigned)DFF) & 1, n = (int)(i / (unsigned)(2 * DFF));
        (p.out + z)[O_PFFN + (((size_t)l * NP + n) * 2 + j) * DFF + c] = bf2f(GV[(size_t)(n * T + T - 2 + j) * 5632 + 256 * (c >> 7) + (c & 127)]);
    }
    for (unsigned i = (unsigned)MP * (DFF / 8) + gt; i < (unsigned)R * (DFF / 8); i += GT) {
        const int row = (int)(i / (unsigned)(DFF / 8)), c0 = (int)(i - (unsigned)row * (DFF / 8)) * 8;
        const int cg = 256 * (c0 >> 7) + (c0 & 127);
        const bool samp = row >= MP; const int n = samp ? row - MP : row >> 13, t = samp ? 0 : (row & (T - 1));
        float acc[8], raw[8];
#pragma unroll
        for (int e = 0; e < 8; ++e) acc[e] = cb[c0 + e];
#pragma unroll
        for (int j = 0; j < 3; ++j) {
            const int tau = t - 2 + j; float u[8];
            if (tau >= 0) { const bf16x8 v = *(const bf16x8*)(GV + (size_t)(row - 2 + j) * 5632 + cg);
#pragma unroll
                for (int e = 0; e < 8; ++e) u[e] = bf2f((bf16_t)v[e]); }
            else {
#pragma unroll
                for (int e = 0; e < 8; ++e) u[e] = samp ? PIN(I_FCONV)[(((size_t)l * NS + n) * 2 + (2 + tau)) * DFF + c0 + e] : 0.f; }
#pragma unroll
            for (int e = 0; e < 8; ++e) { acc[e] += cw[j * DFF + c0 + e] * u[e]; if (j == 2) raw[e] = u[e]; }
        }
        const bf16x8 vv = *(const bf16x8*)(GV + (size_t)row * 5632 + cg + 128);
        bf16x8 o;
#pragma unroll
        for (int e = 0; e < 8; ++e) o[e] = (short)f2bf(silu_f(acc[e]) * bf2f((bf16_t)vv[e]));
        *(bf16x8*)(U + (size_t)row * DFF + c0) = o;
        if (samp) { float* op = (p.out + z) + O_SFFN + ((size_t)l * NS + n) * 2 * DFF + c0;
#pragma unroll
            for (int e = 0; e < 8; ++e) { op[e] = PIN(I_FCONV)[(((size_t)l * NS + n) * 2 + 1) * DFF + c0 + e]; op[DFF + e] = raw[e]; } }
        else if (t >= T - 2) { float* op = (p.out + z) + O_PFFN + (((size_t)l * NP + n) * 2 + (t - (T - 2))) * DFF + c0;
#pragma unroll
            for (int e = 0; e < 8; ++e) op[e] = raw[e]; }
    }
}

__device__ __forceinline__ void stage_final(const Params& p) {
    const Ctx cx = mkctx(p); const size_t z = cx.z;
    const size_t gt = (size_t)cx.bid * NTHREADS + cx.tid, GT = (size_t)cx.nb * NTHREADS;
    const float* X = (const float*)(p.out + z);
    for (size_t i = gt; i < (size_t)R * D; i += GT) (p.out + z)[i] = X[i];
}

#define LAS __attribute__((address_space(3)))
typedef unsigned v4u __attribute__((ext_vector_type(4)));
__device__ __forceinline__ unsigned pk2(float lo, float hi) { return cvtpk(lo, hi); }
template <bool GV_PERM = false>
__device__ __forceinline__ void p0_transpose_item(const float* W, int ldw, int K, int nblk, bf16_t* WT, LAS float* scr, int item, int lane) {
    const int kb = item / nblk, nb = item % nblk, k0 = 64 * kb, n0 = 32 * nb;
    int nd = n0;
    if (GV_PERM) { const int bj = n0 >= DFF ? 1 : 0, rem = n0 - bj * DFF; nd = 256 * (rem >> 7) + 128 * bj + (rem & 127); }
#pragma unroll 8
    for (int i = 0; i < 32; ++i) { const int kk = 2 * i + (lane >> 5); scr[kk * 33 + (lane & 31)] = W[(size_t)(k0 + kk) * ldw + n0 + (lane & 31)]; }
    asm volatile("s_waitcnt lgkmcnt(0)" ::: "memory");
    const int c = lane & 7;
#pragma unroll
    for (int j = 0; j < 4; ++j) { const int n = (lane >> 3) + 8 * j; const LAS float* s = scr + (8 * c) * 33 + n;
        v4u o; o.x = pk2(s[0 * 33], s[1 * 33]); o.y = pk2(s[2 * 33], s[3 * 33]); o.z = pk2(s[4 * 33], s[5 * 33]); o.w = pk2(s[6 * 33], s[7 * 33]);
        *(v4u*)(WT + (size_t)(nd + n) * K + k0 + 8 * c) = o; }
    asm volatile("s_waitcnt lgkmcnt(0)" ::: "memory");
}
__device__ __forceinline__ void stage_wconv(const Params& p, unsigned char* lds, int l_lo, int l_hi, int first = 0) {
    const Ctx cx = mkctx(p, first); const size_t z = cx.z;
    if (l_lo == 0) {
        bf16_t* LT = (bf16_t*)(p.ws + z + WS_LORA);
        for (unsigned i = (unsigned)cx.bid * NTHREADS + cx.tid; i < (unsigned)L * 65536; i += (unsigned)cx.nb * NTHREADS) {
            const int l = i >> 16, e = i & 65535, j = e & 255, ii = e >> 8;
            float v; bf16_t* dst;
            if (ii < 64) { v = PIN(I_W2)[(size_t)l * 16384 + ii * 256 + j]; dst = LT + (size_t)l * 65536 + j * 64 + ii; }
            else if (ii < 128) { v = PIN(I_A2)[(size_t)l * 16384 + (ii - 64) * 256 + j]; dst = LT + (size_t)l * 65536 + 16384 + j * 64 + (ii - 64); }
            else { v = PIN(I_G2)[(size_t)l * 32768 + (ii - 128) * 256 + j]; dst = LT + (size_t)l * 65536 + 32768 + j * 128 + (ii - 128); }
            *dst = f2bf(v);
        }
        bf16_t* WD = (bf16_t*)(p.ws + z + WS_WDTT);
        for (unsigned i = (unsigned)cx.bid * NTHREADS + cx.tid; i < (unsigned)L * 16384; i += (unsigned)cx.nb * NTHREADS) {
            const int l = i >> 14, j = (i >> 10) & 15, k = i & 1023;
            WD[i] = j < 8 ? f2bf(PIN(I_WIN)[(size_t)l * D * PROJ + (size_t)k * PROJ + PCOLS + j]) : (bf16_t)0;
        }
    }
    const int lane = cx.tid & 63, wave = cx.tid >> 6;
    LAS float* scr = (LAS float*)(lds + wave * 16384);
    const int gw = cx.bid * NWAVES + wave, NGW = cx.nb * NWAVES;
    constexpr int I_IN = 16 * 96, I_OUT = 16 * 32, I_UP = 16 * 176, I_DN = 44 * 32, PER_L = I_IN + I_OUT + I_UP + I_DN;
    for (int it = gw; it < (l_hi - l_lo) * PER_L; it += NGW) {
        const int l = l_lo + it / PER_L; int r = it % PER_L;
        if (r < I_IN) { p0_transpose_item(PIN(I_WIN) + (size_t)l * D * PROJ, PROJ, D, 96, (bf16_t*)(p.ws + z + WS_WIN) + (size_t)l * PCOLS * D, scr, r, lane); continue; } r -= I_IN;
        if (r < I_OUT) { p0_transpose_item(PIN(I_WOUT) + (size_t)l * D * D, D, D, 32, (bf16_t*)(p.ws + z + WS_WOUT) + (size_t)l * D * D, scr, r, lane); continue; } r -= I_OUT;
        if (r < I_UP) { p0_transpose_item<true>(PIN(I_WUP) + (size_t)l * D * 5632, 5632, D, 176, (bf16_t*)(p.ws + z + WS_WUP) + (size_t)l * 5632 * D, scr, r, lane); continue; } r -= I_UP;
        p0_transpose_item(PIN(I_WDOWN) + (size_t)l * DFF * D, D, DFF, 32, (bf16_t*)(p.ws + z + WS_WDN) + (size_t)l * D * DFF, scr, r, lane);
    }
}

template <int NT, class F>
__device__ __forceinline__ void gemm_small(const Params& p, const bf16_t* A, int lda, const bf16_t* Bt, int N, int K, int ksplit, const F& epi) {
    const Ctx cx = mkctx(p); A += cx.z; Bt += cx.z;
    const int lane = cx.tid & 63, wave = __builtin_amdgcn_readfirstlane(cx.tid >> 6), r = lane & 15, q = lane >> 4;
    const int ntile = N / (16 * NT), kc = K / ksplit;
    for (int task = cx.nb - 1 - cx.bid; task < ntile * ksplit; task += cx.nb) {
        const int tn = task % ntile, ks = task / ntile, n0 = tn * 16 * NT, k0 = ks * kc;
        const bf16_t* ap = A + (size_t)(16 * wave + r) * lda + k0 + 8 * q;
        const bf16_t* bp = Bt + (size_t)(n0 + r) * K + k0 + 8 * q;
        f32x4 acc[NT];
#pragma unroll
        for (int nt = 0; nt < NT; ++nt) acc[nt] = (f32x4){0.f, 0.f, 0.f, 0.f};
#pragma unroll 8
        for (int s2 = 0; s2 < kc / 32; ++s2) {
            const bf16x8 fa = *(const bf16x8*)(ap + 32 * s2);
#pragma unroll
            for (int nt = 0; nt < NT; ++nt) { const bf16x8 fb = *(const bf16x8*)(bp + (size_t)nt * 16 * K + 32 * s2); acc[nt] = __builtin_amdgcn_mfma_f32_16x16x32_bf16(fb, fa, acc[nt], 0, 0, 0); }
        }
#pragma unroll
        for (int nt = 0; nt < NT; ++nt) epi(16 * wave + r, n0 + 16 * nt + 4 * q, acc[nt]);
    }
}
struct SmallBf { bf16_t* O; int ldc; __device__ __forceinline__ void operator()(int row, int col, f32x4 v) const { *(bf16x4*)(O + (size_t)(MP + row) * ldc + col) = pack4(v); } };
struct SmallRes { float* X; const float* gate;   __device__ __forceinline__ void operator()(int row, int col, f32x4 v) const {
    const f32x4 g = *(const f32x4*)(gate + (size_t)(NP + row) * 6144 + col); float* x = X + (size_t)(MP + row) * D + col;
#pragma unroll
    for (int e = 0; e < 4; ++e) unsafeAtomicAdd(x + e, g[e] * v[e]); } };

__device__ __forceinline__ void stage_dtgemm(const Params& p, int l) {
    const Ctx cx = mkctx(p); const size_t z = cx.z;
    const int lane = cx.tid & 63, wave = __builtin_amdgcn_readfirstlane(cx.tid >> 6), r = lane & 15, q = lane >> 4;
    const bf16_t* H = (const bf16_t*)(p.ws + z + WS_H); const bf16_t* WD = (const bf16_t*)(p.ws + z + WS_WDTT) + (size_t)l * 16384;
    float* DT = (float*)(p.ws + z + WS_DT);
    for (int task = cx.nb - 1 - cx.bid; task < R / 128; task += cx.nb) {
        const int row = task * 128 + 16 * wave + r;
        const bf16_t* hp = H + (size_t)row * D + 8 * q; const bf16_t* wp = WD + r * 1024 + 8 * q;
        f32x4 acc = {0.f, 0.f, 0.f, 0.f};
#pragma unroll 8
        for (int s2 = 0; s2 < 32; ++s2) { const bf16x8 fa = *(const bf16x8*)(hp + 32 * s2), fb = *(const bf16x8*)(wp + 32 * s2); acc = __builtin_amdgcn_mfma_f32_16x16x32_bf16(fb, fa, acc, 0, 0, 0); }
        if (q < 2) *(f32x4*)(DT + (size_t)row * 8 + 4 * q) = acc;
    }
}

#define RLX_AGENT __ATOMIC_RELAXED, __HIP_MEMORY_SCOPE_AGENT
#define XB_TMO      128
#define XB_XCNT(j)  (256  + 64 * (j))
#define XB_XSUB(j)  (1280 + 64 * (j))
#define XB_XGEN(j)  (2304 + 64 * (j))
#define XB_TOP      3328
#define XB_TOPGEN   3392
#define XCD_BAR_WORDS 3456
#define XB_SPIN_CAP (1u << 18)

__device__ __forceinline__ unsigned xb_ld(unsigned* p)              { return __hip_atomic_load(p, __ATOMIC_RELAXED, __HIP_MEMORY_SCOPE_AGENT); }
__device__ __forceinline__ unsigned xb_add(unsigned* p, unsigned v) { return __hip_atomic_fetch_add(p, v, __ATOMIC_RELAXED, __HIP_MEMORY_SCOPE_AGENT); }
__device__ __forceinline__ unsigned xb_xcc_id() { return (unsigned)__builtin_amdgcn_s_getreg((3 << 11) | 20) & 0xFu; }
#define XB_SPIN(cond, bar) do { unsigned _sp = 0; while (cond) { __builtin_amdgcn_s_sleep(1); \
    if ((++_sp & 255u) == 0u) { if (xb_ld(&(bar)[XB_TMO])) break; if (_sp > XB_SPIN_CAP) { atomicAdd(&(bar)[XB_TMO], 1u); break; } } } } while (0)

struct XcdBarrier {
    unsigned* bar; unsigned x; int wave;
    volatile LAS unsigned* st;
};

__device__ __forceinline__ XcdBarrier xcd_barrier_post(unsigned* bar, volatile LAS unsigned* st, int wave) {
    XcdBarrier b; b.bar = bar; b.x = xb_xcc_id(); b.st = st; b.wave = wave;
    if (wave == 0 && lane_id() == 0) (void)xb_add(&bar[XB_XCNT(b.x)], 1u);
    return b;
}
__device__ __forceinline__ void xcd_barrier_complete(unsigned* bar, unsigned x, unsigned& nloc, unsigned& nx) {
    const unsigned G = gridDim.x * gridDim.y * gridDim.z;
    unsigned sum, cnt, mine, sp = 0u;
    for (;;) {
        sum = 0u; cnt = 0u; mine = 0u;
#pragma unroll
        for (unsigned j = 0; j < 16; ++j) { const unsigned c = xb_ld(&bar[XB_XCNT(j)]); sum += c; cnt += (c > 0u) ? 1u : 0u; mine = (j == x) ? c : mine; }
        if (sum == G) break;
        __builtin_amdgcn_s_sleep(1);
        if ((++sp & 255u) == 0u) { if (xb_ld(&bar[XB_TMO])) break; if (sp > XB_SPIN_CAP) { atomicAdd(&bar[XB_TMO], 1u); break; } }
    }
    nloc = mine > 0u ? mine : 1u; nx = cnt > 0u ? cnt : 1u;
}

__device__ __forceinline__ void xcd_barrier(const XcdBarrier& b) {
    asm volatile("s_waitcnt vmcnt(0)" ::: "memory");
    __syncthreads();
    if (b.wave == 0 && lane_id() == 0) {
        unsigned* bar = b.bar;
        __builtin_amdgcn_s_waitcnt(0);
        unsigned nloc = b.st[0], nx = b.st[1];
        if (nloc == 0u) { xcd_barrier_complete(bar, b.x, nloc, nx); b.st[0] = nloc; b.st[1] = nx; }
        const unsigned old = xb_add(&bar[XB_XSUB(b.x)], 1u);
        const unsigned gen = old / nloc;
        if (old + 1u == (gen + 1u) * nloc) {
            __builtin_amdgcn_fence(__ATOMIC_RELEASE, "agent");
            asm volatile("s_waitcnt vmcnt(0)" ::: "memory");
            const unsigned og = xb_add(&bar[XB_TOP], 1u);
            const unsigned tg = og / nx;
            if (og + 1u == (tg + 1u) * nx) xb_add(&bar[XB_TOPGEN], 1u);
            else XB_SPIN(xb_ld(&bar[XB_TOPGEN]) == tg, bar);
            __builtin_amdgcn_fence(__ATOMIC_ACQUIRE, "agent");
            xb_add(&bar[XB_XGEN(b.x)], 1u);
            asm volatile("s_waitcnt vmcnt(0)" ::: "memory");
        } else {
            XB_SPIN(xb_ld(&bar[XB_XGEN(b.x)]) == gen, bar);
            __builtin_amdgcn_fence(__ATOMIC_ACQUIRE, "agent");
            asm volatile("s_waitcnt vmcnt(0)" ::: "memory");
        }
    }
    __syncthreads();
}

namespace cg = cooperative_groups;
constexpr int LDS_BYTES = 153600;
__global__ void __launch_bounds__(NTHREADS, 2) fwd_mega(Params p_in) {
    Params p = p_in; p.wave = __builtin_amdgcn_readfirstlane((int)(threadIdx.x >> 6));
    extern __shared__ __attribute__((aligned(16))) unsigned char lds[];
    cg::grid_group grid = cg::this_grid();
    float* ldsf = (float*)lds;
    volatile LAS unsigned* MISC = (volatile LAS unsigned*)((LAS unsigned char*)lds + LDS_BYTES - 64);
    if (p.wave == 0 && lane_id() < 16) MISC[lane_id()] = 0u;
    __syncthreads();
    const XcdBarrier bar = xcd_barrier_post((unsigned*)(p.ws + WS_CTL), MISC, p.wave);
#define GSYNC() xcd_barrier(bar)
    stage_init(p); stage_wconv(p, lds, 0, 1); __syncthreads(); stage_mod(p, lds, 0, L); grid.sync();
    for (int l = 0; l < L; ++l) {
        const float* MODl = (const float*)(p.ws + WS_MOD) + (size_t)l * NSEQ * 6144;
        if (l > 0) stage_norm_b(p, l, 0);
        stage_norm(p, l, 0, ldsf, l == 0); GSYNC();
        { pg8::Gemm g{(const bf16_t*)(p.ws + WS_H), (const bf16_t*)(p.ws + WS_WIN) + (size_t)l * PCOLS * D, MP, PCOLS, D}; pg8::StaticOrder S; S.init(MP, PCOLS, (int)gridDim.x, (int)blockIdx.x);
          pg8::EpiBf16<0> E{(bf16_t*)(p.ws + WS_P), PCOLS, nullptr, 0, 0, 1.f};
          pg8::gemm_phase<pg8::EpiBf16<0>, pg8::StaticOrder, true, true>((LAS unsigned char*)lds, g, S, E, (p.wave << 6) | lane_id()); }
        gemm_small<1>(p, (const bf16_t*)(p.ws + WS_H) + (size_t)MP * D, D, (const bf16_t*)(p.ws + WS_WIN) + (size_t)l * PCOLS * D, PCOLS, D, 1, SmallBf{(bf16_t*)(p.ws + WS_P), PCOLS});
        stage_dtgemm(p, l);
        GSYNC();
#pragma unroll 1
        for (int ph = 0; ph < 2; ++ph) {
            if ((ph ^ (((int)blockIdx.x >> 3) & 1)) == 0) {
                stage_rwprep(p, l, ldsf); __syncthreads(); stage_rwprep2(p, l, lds); asm volatile("s_waitcnt vmcnt(0)" ::: "memory"); __syncthreads();
                stage_rw1(p, l, lds);
            } else { stage_mconv(p, l); stage_qkn(p, l); stage_ssd1(p, l, lds); }
            __syncthreads();
        }
        GSYNC();
        stage_rw2(p, l, lds); stage_ssd2(p, l); stage_att(p, l, NP * 4); stage_rwscan(p, l, ldsf, NP * 4); stage_mscan(p, l, ldsf, NP * 4);
        if (l + 1 < L) { __syncthreads(); stage_wconv(p, lds, l + 1, l + 2, NP * 4); }
        GSYNC();
        stage_ssd3(p, l, lds, 0, 128); stage_rw3(p, l, 128); stage_attn(p, l, lds, 128); stage_mgate_sample(p, l, 128); GSYNC();
        { pg8::Gemm g{(const bf16_t*)(p.ws + WS_YCAT), (const bf16_t*)(p.ws + WS_WOUT) + (size_t)l * D * D, MP, D, D}; pg8::StaticOrder S; S.init(MP, D, (int)gridDim.x, (int)blockIdx.x);
          pg8::EpiResGate E{p.out, p.in[I_XP], (bf16_t*)(p.ws + WS_XB), MODl + 2048, l == 0, 0, 13, 6144};
          pg8::gemm_phase<pg8::EpiResGate, pg8::StaticOrder, true, true>((LAS unsigned char*)lds, g, S, E, (p.wave << 6) | lane_id()); }
        gemm_small<1>(p, (const bf16_t*)(p.ws + WS_YCAT) + (size_t)MP * D, D, (const bf16_t*)(p.ws + WS_WOUT) + (size_t)l * D * D, D, D, 4, SmallRes{p.out, MODl + 2048});
        GSYNC();
        stage_norm_b(p, l, 1); stage_norm(p, l, 1, ldsf, false); GSYNC();
        { pg8::Gemm g{(const bf16_t*)(p.ws + WS_H), (const bf16_t*)(p.ws + WS_WUP) + (size_t)l * 5632 * D, MP, 5632, D}; pg8::StaticOrder S; S.init(MP, 5632, (int)gridDim.x, (int)blockIdx.x);
          pg8::EpiGlu E{(bf16_t*)(p.ws + WS_GV), (bf16_t*)(p.ws + WS_U), p.in[I_FCW] + (size_t)l * 3 * DFF, p.in[I_FCB] + (size_t)l * DFF};
          pg8::gemm_phase<pg8::EpiGlu, pg8::StaticOrder, true, true>((LAS unsigned char*)lds, g, S, E, (p.wave << 6) | lane_id()); }
        gemm_small<1>(p, (const bf16_t*)(p.ws + WS_H) + (size_t)MP * D, D, (const bf16_t*)(p.ws + WS_WUP) + (size_t)l * 5632 * D, 5632, D, 1, SmallBf{(bf16_t*)(p.ws + WS_GV), 5632});
        stage_cachecopy(p, l, 128);
        GSYNC();
        stage_glu(p, l); GSYNC();
        { pg8::Gemm g{(const bf16_t*)(p.ws + WS_U), (const bf16_t*)(p.ws + WS_WDN) + (size_t)l * D * DFF, MP, D, DFF}; pg8::StaticOrder S; S.init(MP, D, (int)gridDim.x, (int)blockIdx.x);
          pg8::EpiResGate E{p.out, p.in[I_XP], (bf16_t*)(p.ws + WS_XB), MODl + 5120, 0, l == L - 1, 13, 6144};
          pg8::gemm_phase<pg8::EpiResGate, pg8::StaticOrder, true, true>((LAS unsigned char*)lds, g, S, E, (p.wave << 6) | lane_id()); }
        gemm_small<1>(p, (const bf16_t*)(p.ws + WS_U) + (size_t)MP * DFF, DFF, (const bf16_t*)(p.ws + WS_WDN) + (size_t)l * D * DFF, D, DFF, 11, SmallRes{p.out, MODl + 5120});
        GSYNC();
    }
}

extern "C" void kernel_launch(void* const* d_in, const int* in_sizes, int n_in, void* d_out, int out_size, void* d_ws, size_t ws_size, hipStream_t stream) {
    static int grid = 0;
    if (grid == 0) {
        if (n_in != N_IN || (size_t)out_size != O_END || ws_size < WS_END) { fprintf(stderr, "kernel_launch: unexpected sizes n_in %d out %d ws %zu\n", n_in, out_size, ws_size); grid = -1; return; }
        int dev = 0, cus = 0, per_cu = 0;
        hipGetDevice(&dev); hipDeviceGetAttribute(&cus, hipDeviceAttributeMultiprocessorCount, dev);
        if (hipFuncSetAttribute((const void*)fwd_mega, hipFuncAttributeMaxDynamicSharedMemorySize, LDS_BYTES) != hipSuccess) { fprintf(stderr, "hipFuncSetAttribute failed\n"); grid = -1; return; }
        hipOccupancyMaxActiveBlocksPerMultiprocessor(&per_cu, (const void*)fwd_mega, NTHREADS, LDS_BYTES);
        if (per_cu < 1) { fprintf(stderr, "occupancy query says %d blocks per CU\n", per_cu); grid = -1; return; }
        grid = cus;
    }
    if (grid < 0) return;
    Params p{};
    for (int i = 0; i < N_IN; ++i) p.in[i] = (const float*)d_in[i];
    p.out = (float*)d_out; p.ws = (unsigned char*)d_ws;
    if (hipMemsetAsync((char*)d_ws + WS_CTL, 0, 16384, stream) != hipSuccess) { fprintf(stderr, "memset of the barrier words failed\n"); return; }
    void* args[] = {&p};
    hipError_t e = hipLaunchCooperativeKernel((void*)fwd_mega, dim3(grid), dim3(NTHREADS), args, LDS_BYTES, stream);
    if (e != hipSuccess) fprintf(stderr, "cooperative launch failed: %s\n", hipGetErrorString(e));
}
```

```cpp
#include <hip/hip_runtime.h>
#include <hip/hip_cooperative_groups.h>
#include <cstdint>
#include <cstdio>

typedef unsigned short bf16_t;
__device__ __forceinline__ float bf2f(bf16_t v) { return __uint_as_float(((unsigned)v) << 16); }
typedef float f32x2_t __attribute__((ext_vector_type(2)));
typedef __bf16 bf16x2_t __attribute__((ext_vector_type(2)));
__device__ __forceinline__ unsigned cvtpk(float lo, float hi) { const f32x2_t v = {lo, hi}; const bf16x2_t b = __builtin_convertvector(v, bf16x2_t); return __builtin_bit_cast(unsigned, b); }
__device__ __forceinline__ bf16_t f2bf(float f) { return (bf16_t)cvtpk(f, 0.f); }

constexpr int D = 1024, NP = 2, T = 8192, MP = NP * T, NS = 128, R = MP + NS, NSEQ = NP + NS, L = 4;
constexpr int PROJ = 3080, PCOLS = 3072, DFF = 2816;
constexpr int OFF_B = 1024, OFF_Z = 1536, OFF_XBC = 2048;
constexpr float NORM_EPS = 1e-6f, GN_EPS = 64e-5f;
constexpr int NTHREADS = 512, NWAVES = 8;
typedef short bf16x8 __attribute__((ext_vector_type(8)));
typedef short bf16x4 __attribute__((ext_vector_type(4)));
typedef float f32x4 __attribute__((ext_vector_type(4)));
__device__ __forceinline__ bf16x4 pack4(f32x4 v) { typedef unsigned u32x2_t __attribute__((ext_vector_type(2))); const u32x2_t w = {cvtpk(v[0], v[1]), cvtpk(v[2], v[3])}; return __builtin_bit_cast(bf16x4, w); }
constexpr int LD = 72, MSZ = 64 * LD;
constexpr int LD2 = 136;

enum { I_XP = 0, I_XS, I_CP, I_CS, I_SHIFT, I_WKV, I_CK, I_CV, I_SCONV, I_SSM, I_FCONV, I_ADAW, I_ADAB, I_NMIXG, I_NFFNG, I_WIN, I_WOUT,
       I_MU, I_W0, I_W2, I_A0, I_A2, I_G2, I_KK, I_KA, I_RK, I_LNG, I_LNB, I_QNG, I_KNG, I_SINK, I_CONVW, I_CONVB, I_DTB, I_ALOG, I_SSMD, I_SSMNG,
       I_WUP, I_FCW, I_FCB, I_WDOWN, N_IN };

constexpr size_t O_YP = 0;
constexpr size_t O_YS = O_YP + (size_t)MP * D;
constexpr size_t O_PSHIFT = O_YS + (size_t)NS * D;
constexpr size_t O_PWKV = O_PSHIFT + (size_t)L * NP * 1024;
constexpr size_t O_PK = O_PWKV + (size_t)L * NP * 4 * 64 * 64;
constexpr size_t O_PV = O_PK + (size_t)L * NP * 128 * 128;
constexpr size_t O_PCONV = O_PV + (size_t)L * NP * 128 * 128;
constexpr size_t O_PSSM = O_PCONV + (size_t)L * NP * 3 * 1024;
constexpr size_t O_PFFN = O_PSSM + (size_t)L * NP * 8 * 64 * 128;
constexpr size_t O_SSHIFT = O_PFFN + (size_t)L * NP * 2 * DFF;
constexpr size_t O_SWKV = O_SSHIFT + (size_t)L * NS * 1024;
constexpr size_t O_SK = O_SWKV + (size_t)L * NS * 4 * 64 * 64;
constexpr size_t O_SV = O_SK + (size_t)L * NS * 128 * 128;
constexpr size_t O_SCONV = O_SV + (size_t)L * NS * 128 * 128;
constexpr size_t O_SSSM = O_SCONV + (size_t)L * NS * 3 * 1024;
constexpr size_t O_SFFN = O_SSSM + (size_t)L * NS * 8 * 64 * 128;
constexpr size_t O_END = O_SFFN + (size_t)L * NS * 2 * DFF;

constexpr size_t MiB = 1u << 20;
constexpr int MPAD = 16640;
constexpr size_t WS_XB = 0;
constexpr size_t WS_X = 0;
constexpr size_t WS_H = 65 * MiB;
constexpr size_t WS_YCAT = WS_H;
constexpr size_t WS_MOD = 98 * MiB;
constexpr size_t WS_P = 111 * MiB;
constexpr size_t WS_DT = 209 * MiB;
constexpr size_t WS_GV = 210 * MiB;
constexpr size_t WS_U = 389 * MiB;
constexpr size_t WS_WIN = 479 * MiB;
constexpr size_t WS_WOUT = 503 * MiB;
constexpr size_t WS_WUP = 511 * MiB;
constexpr size_t WS_WDN = 555 * MiB;
constexpr size_t WS_RWC_Y0 = 578 * MiB;
constexpr size_t WS_CTL = 595 * MiB;
constexpr size_t WS_LORA = 596 * MiB;
constexpr size_t WS_WDTT = WS_LORA + 512 * 1024;
constexpr size_t WS_DT2 = 597 * MiB;
constexpr size_t WS_END = 598 * MiB;
constexpr size_t WS_RWC_RP = WS_U + 65 * MiB;
constexpr size_t WS_RWC_MC = WS_RWC_RP + 8 * MiB;
constexpr size_t WS_RWC_NCT = WS_RWC_MC + 8 * MiB;
static_assert(WS_RWC_NCT + 8 * MiB <= WS_WIN, "rwkv chunk buffers fit the U region tail");
constexpr size_t WS_RW = WS_GV;
constexpr size_t WS_RWD = WS_RW + 49 * MiB;
constexpr size_t WS_HPREV = WS_RW + 70 * MiB;
constexpr size_t WS_QN = WS_RW + 113 * MiB;
constexpr size_t WS_KN = WS_QN + 17 * MiB;
constexpr size_t WS_YTMP = WS_KN + 9 * MiB;
static_assert(WS_YTMP + (size_t)R * 512 * 4 <= WS_U, "mixer temporaries fit the GV region");
constexpr size_t WS_XBCC = WS_U;
constexpr size_t WS_SST = WS_U + 33 * MiB;
static_assert(WS_XBCC + (size_t)R * 1024 * 2 <= WS_SST && WS_SST + 32 * MiB <= WS_RWC_RP, "xbc / ssd states fit the U region");
constexpr size_t WS_SCD = WS_RWC_Y0 + 16 * MiB;

struct Params {
    const float* in[N_IN];
    float* out;
    unsigned char* ws;
    int wave, pad;
};

__device__ __forceinline__ int seq_of_row(int row) { return row < MP ? (row >> 13) : (NP + row - MP); }
__device__ __forceinline__ float wave_sum(float v) {
#pragma unroll
    for (int o = 1; o < 64; o <<= 1) v += __shfl_xor(v, o);
    return v;
}
__device__ __forceinline__ float wave_max(float v) {
#pragma unroll
    for (int o = 1; o < 64; o <<= 1) v = fmaxf(v, __shfl_xor(v, o));
    return v;
}
__device__ __forceinline__ float silu_f(float x) { return x * __builtin_amdgcn_rcpf(1.f + __expf(-x)); }
__device__ __forceinline__ float sigmoid_f(float x) { return __builtin_amdgcn_rcpf(1.f + __expf(-x)); }
__device__ __forceinline__ float tanh_fast(float x) { return 1.f - 2.f * __builtin_amdgcn_rcpf(1.f + __expf(2.f * x)); }
__device__ __forceinline__ float softplus_fast(float x) { return fmaxf(x, 0.f) + __logf(1.f + __expf(-fabsf(x))); }
__device__ __forceinline__ float softplus_f(float x) { return fmaxf(x, 0.f) + log1pf(__expf(-fabsf(x))); }

namespace pg8 {
#define PG8_LAS __attribute__((address_space(3)))
typedef unsigned short bf16_t;
typedef short bf16x8 __attribute__((ext_vector_type(8)));
typedef float f32x4 __attribute__((ext_vector_type(4)));
typedef unsigned u32x4 __attribute__((ext_vector_type(4)));
constexpr int BM = 256, BK = 64, HALF = 128, HTB = HALF * BK * 2  , STAGE_BYTES = 8 * HTB, NXCD = 8, WGM = 8;

__host__ __device__ __forceinline__ int lds_byte(int r, int c) { const int st = (r >> 4) * 2 + (c >> 5), rr = r & 15, cc = c & 31, ob = rr * 64 + cc * 2; return st * 1024 + (ob ^ (((ob >> 9) & 1) << 5)); }
__host__ __device__ __forceinline__ void stage_rc(int b, int& R, int& C) { const int st = b / 1024, sb = b % 1024, swz = sb ^ (((sb >> 9) & 1) << 5); R = (st >> 1) * 16 + swz / 64; C = (st & 1) * 32 + (swz % 64) / 2; }
__host__ __device__ __forceinline__ int perm32(int rho) { const int n = rho >> 4, i = rho & 15; return 8 * (i >> 2) + 4 * n + (i & 3); }

struct Unit { int pm, pn; };
struct Gemm { const bf16_t* A; const bf16_t* Bt; int M, N, K; };

struct StaticOrder {
    int nM, nN, nwg, G, c;
    __host__ __device__ void init(int M, int N, int G_, int c_) { nM = M / BM; nN = N / BM; nwg = nM * nN; G = G_; c = c_; }
    __host__ __device__ bool next(int i, Unit& u) const {
        const long L = (long)i * G + c; if (L >= nwg) return false;
        int wgid = (int)L; { const int q = nwg / NXCD, r = nwg % NXCD, xcd = wgid % NXCD, off = wgid / NXCD; wgid = (xcd < r ? xcd * (q + 1) : r * (q + 1) + (xcd - r) * q) + off; }
        const int nig = WGM * nN, gid = wgid / nig, fm = gid * WGM, gsz = (nM - fm) < WGM ? (nM - fm) : WGM;
        u.pm = fm + ((wgid % nig) % gsz); u.pn = (wgid % nig) / gsz; return true;
    }
    __device__ __forceinline__ void a_ready(const Unit&) const {}
    __device__ __forceinline__ void done(const Unit&) const {}
};

__device__ __forceinline__ unsigned cvt_pk_bf16(float lo, float hi) { unsigned r; asm volatile("v_cvt_pk_bf16_f32 %0, %1, %2" : "=v"(r) : "v"(lo), "v"(hi)); return r; }
typedef float f32x2 __attribute__((ext_vector_type(2)));
__device__ __forceinline__ f32x2 gelu_pk(f32x2 v) {
    const f32x2 av = __builtin_elementwise_abs(v), d = av * 0.2316418882f + 1.0f;
    f32x2 t; t.x = __builtin_amdgcn_rcpf(d.x); t.y = __builtin_amdgcn_rcpf(d.y);
    f32x2 q = t * 0.5307027145f + (-0.7265760135f); q = q * t + 0.7107068705f; q = q * t + (-0.142248368f); q = q * t + 0.127414796f; q = q * t;
    const f32x2 s = (v * v) * (-0.72134752044f);
    f32x2 e; e.x = __builtin_amdgcn_exp2f(s.x); e.y = __builtin_amdgcn_exp2f(s.y);
    const f32x2 m = v * (q * e), r = v - m;
    f32x2 o; o.x = v.x < 0.f ? m.x : r.x; o.y = v.y < 0.f ? m.y : r.y; return o;
}

template <int ACT  > struct EpiBf16 {
    static constexpr bool PERM = true, AFTER_DRAIN = false; static_assert(ACT == 0 || ACT == 1, "EpiBf16: ACT is 0 (none) or 1 (gelu_pk)");
    bf16_t* O; int ldc; const float* bias; int split_cols; size_t split_stride; float scale0;
    __device__ __forceinline__ void operator()(const f32x4 (&acc)[2][2][4][2], const Unit& u, int wr, int wc, int fr, int fq) const {
        const int row0 = u.pm * BM + wr * 64 + fr; int colt = u.pn * BM; bf16_t* base = O;
        float sc = 1.f; if (split_cols) { const int t = colt / split_cols; base += (size_t)t * split_stride; colt -= t * split_cols; if (t == 0) sc = scale0; }
        const int col0 = colt + wc * 32 + 8 * fq, bcol0 = u.pn * BM + wc * 32 + 8 * fq;
        f32x4 bv[2][2];
#pragma unroll
        for (int bj = 0; bj < 2; ++bj)
#pragma unroll
            for (int n = 0; n < 2; ++n) bv[bj][n] = bias ? *(const f32x4*)(bias + bcol0 + bj * HALF + 4 * n) : (f32x4){0.f, 0.f, 0.f, 0.f};
#pragma unroll
        for (int ai = 0; ai < 2; ++ai)
#pragma unroll
            for (int m = 0; m < 4; ++m) { bf16_t* rowp = base + (size_t)(row0 + ai * HALF + m * 16) * ldc + col0;
#pragma unroll
                for (int bj = 0; bj < 2; ++bj) { f32x4 v0 = acc[ai][bj][m][0] + bv[bj][0], v1 = acc[ai][bj][m][1] + bv[bj][1];
                    if (ACT == 1) { f32x2 a = gelu_pk((f32x2){v0[0], v0[1]}), b = gelu_pk((f32x2){v0[2], v0[3]}), c = gelu_pk((f32x2){v1[0], v1[1]}), d = gelu_pk((f32x2){v1[2], v1[3]});
                        v0 = (f32x4){a.x, a.y, b.x, b.y}; v1 = (f32x4){c.x, c.y, d.x, d.y}; }
                    v0 = v0 * sc; v1 = v1 * sc; u32x4 w; w.x = cvt_pk_bf16(v0[0], v0[1]); w.y = cvt_pk_bf16(v0[2], v0[3]); w.z = cvt_pk_bf16(v1[0], v1[1]); w.w = cvt_pk_bf16(v1[2], v1[3]);
                    *(u32x4*)(rowp + bj * HALF) = w; } }
    }
};

__device__ __forceinline__ float dpp_shr(float cur, float prevblk, int n  ) {
    const int c = __builtin_bit_cast(int, cur), pb = __builtin_bit_cast(int, prevblk);
    int t;
    if (n == 1) { t = __builtin_amdgcn_update_dpp(0, pb, 0x121, 0xf, 0xf, false); t = __builtin_amdgcn_update_dpp(t, c, 0x111, 0xf, 0xf, false); }
    else        { t = __builtin_amdgcn_update_dpp(0, pb, 0x122, 0xf, 0xf, false); t = __builtin_amdgcn_update_dpp(t, c, 0x112, 0xf, 0xf, false); }
    return __builtin_bit_cast(float, t);
}
struct EpiGlu {
    static constexpr bool PERM = true, AFTER_DRAIN = false;
    bf16_t* GV; bf16_t* U; const float* cw; const float* cb;
    __device__ __forceinline__ void operator()(const f32x4 (&acc)[2][2][4][2], const Unit& u, int wr, int wc, int fr, int fq) const {
        const int row0 = u.pm * BM + wr * 64 + fr, x0 = wc * 32 + 8 * fq, ch0 = u.pn * HALF + x0;
        f32x4 w0[2], w1[2], w2[2], bb[2];
#pragma unroll
        for (int n = 0; n < 2; ++n) { w0[n] = *(const f32x4*)(cw + ch0 + 4 * n); w1[n] = *(const f32x4*)(cw + 2816 + ch0 + 4 * n); w2[n] = *(const f32x4*)(cw + 5632 + ch0 + 4 * n); bb[n] = *(const f32x4*)(cb + ch0 + 4 * n); }
#pragma unroll
        for (int ai = 0; ai < 2; ++ai)
#pragma unroll
            for (int m = 0; m < 4; ++m) {
                const int row = row0 + ai * HALF + m * 16;
                bf16_t* gp = GV + (size_t)row * 5632 + u.pn * BM + x0;
                u32x4 wu;
#pragma unroll
                for (int n = 0; n < 2; ++n) {
                    const f32x4 g = acc[ai][0][m][n], v = acc[ai][1][m][n], pv = acc[ai][0][m > 0 ? m - 1 : 0][n];
                    float o[4];
#pragma unroll
                    for (int e = 0; e < 4; ++e) {
                        const float g1 = dpp_shr(g[e], pv[e], 1), g2 = dpp_shr(g[e], pv[e], 2);
                        const float a = bb[n][e] + w0[n][e] * g2 + w1[n][e] * g1 + w2[n][e] * g[e];
                        o[e] = a * __builtin_amdgcn_rcpf(1.f + __expf(-a)) * v[e];
                    }
                    if (n == 0) { wu.x = cvt_pk_bf16(o[0], o[1]); wu.y = cvt_pk_bf16(o[2], o[3]); } else { wu.z = cvt_pk_bf16(o[0], o[1]); wu.w = cvt_pk_bf16(o[2], o[3]); }
                }
                if (m > 0 || fr >= 2) *(u32x4*)(U + (size_t)row * 2816 + ch0) = wu;
                u32x4 wg, wv;
                wg.x = cvt_pk_bf16(acc[ai][0][m][0][0], acc[ai][0][m][0][1]); wg.y = cvt_pk_bf16(acc[ai][0][m][0][2], acc[ai][0][m][0][3]); wg.z = cvt_pk_bf16(acc[ai][0][m][1][0], acc[ai][0][m][1][1]); wg.w = cvt_pk_bf16(acc[ai][0][m][1][2], acc[ai][0][m][1][3]);
                wv.x = cvt_pk_bf16(acc[ai][1][m][0][0], acc[ai][1][m][0][1]); wv.y = cvt_pk_bf16(acc[ai][1][m][0][2], acc[ai][1][m][0][3]); wv.z = cvt_pk_bf16(acc[ai][1][m][1][0], acc[ai][1][m][1][1]); wv.w = cvt_pk_bf16(acc[ai][1][m][1][2], acc[ai][1][m][1][3]);
                if ((m == 0 && fr < 2) || (m == 3 && fr >= 14)) { *(u32x4*)gp = wg; *(u32x4*)(gp + HALF) = wv; }
            }
    }
};

struct EpiResGate {
    static constexpr bool PERM = true, AFTER_DRAIN = false;
    float* Xf; const float* Xinf; bf16_t* Xb; const float* gate; int src_f32, dst_f32, seq_shift, gate_ld;
    __device__ __forceinline__ void operator()(const f32x4 (&acc)[2][2][4][2], const Unit& u, int wr, int wc, int fr, int fq) const {
        const int col0 = u.pn * BM + wc * 32 + 8 * fq;
#pragma unroll
        for (int ai = 0; ai < 2; ++ai)
#pragma unroll
            for (int m = 0; m < 4; ++m) {
                const int row = u.pm * BM + ai * HALF + wr * 64 + m * 16 + fr;
                const float* gp = gate + (size_t)(row >> seq_shift) * gate_ld + col0; const size_t off = (size_t)row * 1024 + col0;
#pragma unroll
                for (int bj = 0; bj < 2; ++bj) {
                    const f32x4 g0 = *(const f32x4*)(gp + bj * HALF), g1 = *(const f32x4*)(gp + bj * HALF + 4);
                    f32x4 x0, x1;
                    if (src_f32) { x0 = *(const f32x4*)(Xinf + off + bj * HALF); x1 = *(const f32x4*)(Xinf + off + bj * HALF + 4); }
                    else { const u32x4 w = *(const u32x4*)(Xb + off + bj * HALF);
                        x0 = (f32x4){__builtin_bit_cast(float, w.x << 16), __builtin_bit_cast(float, w.x & 0xffff0000u), __builtin_bit_cast(float, w.y << 16), __builtin_bit_cast(float, w.y & 0xffff0000u)};
                        x1 = (f32x4){__builtin_bit_cast(float, w.z << 16), __builtin_bit_cast(float, w.z & 0xffff0000u), __builtin_bit_cast(float, w.w << 16), __builtin_bit_cast(float, w.w & 0xffff0000u)}; }
                    x0 = x0 + g0 * acc[ai][bj][m][0]; x1 = x1 + g1 * acc[ai][bj][m][1];
                    if (dst_f32) { *(f32x4*)(Xf + off + bj * HALF) = x0; *(f32x4*)(Xf + off + bj * HALF + 4) = x1; }
                    else { u32x4 w; w.x = cvt_pk_bf16(x0[0], x0[1]); w.y = cvt_pk_bf16(x0[2], x0[3]); w.z = cvt_pk_bf16(x1[0], x1[1]); w.w = cvt_pk_bf16(x1[2], x1[3]); *(u32x4*)(Xb + off + bj * HALF) = w; }
                }
            }
    }
};
template <class Epi, class Sched, bool ALIGN_EPI = false, bool SP2 = false>
__device__ __forceinline__ void gemm_phase(PG8_LAS unsigned char* lds, const Gemm g, const Sched& S, const Epi& E, int tid_in) {
    int tid_ = tid_in; asm volatile("" : "+v"(tid_));
    const int tid = tid_, wid = __builtin_amdgcn_readfirstlane(tid >> 6), lane = tid & 63, wr = wid >> 2, wc = wid & 3, fr = lane & 15, fq = lane >> 4;
    const int K = g.K, nt = K / BK;
    unsigned voffA[2], voffB[2];
#pragma unroll
    for (int i = 0; i < 2; ++i) { int R, C; stage_rc(tid * 16 + i * 8192, R, C); const int Rb = Epi::PERM ? ((R & ~31) + perm32(R & 31)) : R;
        voffA[i] = (unsigned)(R * K + C) * 2u; voffB[i] = (unsigned)(Rb * K + C) * 2u; }
    const size_t kstep = (size_t)(BK * 2);
    const size_t hstep = (size_t)HALF * K * 2;
    const size_t tstep = 2 * hstep;
    const unsigned ldsw = (unsigned)wid * 1024u;
    const int aoff = lds_byte(wr * 64 + fr, fq * 8), boff = lds_byte(wc * 32 + fr, fq * 8);
#define PG8_SA(b, h) (((b) * 2 + (h)) * HTB)
#define PG8_SB(b, h) ((4 + (b) * 2 + (h)) * HTB)
#define PG8_STAGE(bufoff, gbase, voff) do { _Pragma("unroll") for (int _i = 0; _i < 2; ++_i) \
        __builtin_amdgcn_global_load_lds((const unsigned*)((const char*)(gbase) + (voff)[_i]), (PG8_LAS unsigned*)(lds + (bufoff) + ldsw + _i * 8192), 16, 0, 0); } while (0)
#define PG8_LDA(dst, b, h) do { _Pragma("unroll") for (int m = 0; m < 4; ++m) _Pragma("unroll") for (int k = 0; k < 2; ++k) dst[m][k] = *(const PG8_LAS bf16x8*)(lds + PG8_SA(b, h) + aoff + m * 2048 + k * 1024); } while (0)
#define PG8_LDB(dst, b, h) do { _Pragma("unroll") for (int n = 0; n < 2; ++n) _Pragma("unroll") for (int k = 0; k < 2; ++k) dst[n][k] = *(const PG8_LAS bf16x8*)(lds + PG8_SB(b, h) + boff + n * 2048 + k * 1024); } while (0)
#define PG8_MMA(ai, bj, At, Bt) do { __builtin_amdgcn_s_setprio(1); _Pragma("unroll") for (int m = 0; m < 4; ++m) _Pragma("unroll") for (int n = 0; n < 2; ++n) _Pragma("unroll") for (int k = 0; k < 2; ++k) \
        acc[ai][bj][m][n] = __builtin_amdgcn_mfma_f32_16x16x32_bf16(Bt[n][k], At[m][k], acc[ai][bj][m][n], 0, 0, 0); __builtin_amdgcn_s_setprio(0); } while (0)
#define PG8_WAIT_V(n) asm volatile("s_waitcnt vmcnt(" #n ")" ::: "memory")
#define PG8_WAIT_L(n) asm volatile("s_waitcnt lgkmcnt(" #n ")" ::: "memory")
#define PG8_BAR __builtin_amdgcn_s_barrier()
#define PG8_SCHED __builtin_amdgcn_sched_barrier(0)
    Unit cur, nxt; int ui = 0;
    if (!S.next(0, cur)) return;
    f32x4 acc[2][2][4][2];
#pragma unroll
    for (int a = 0; a < 2; ++a)
#pragma unroll
        for (int b = 0; b < 2; ++b)
#pragma unroll
            for (int m = 0; m < 4; ++m)
#pragma unroll
                for (int n = 0; n < 2; ++n) acc[a][b][m][n] = (f32x4){0.f, 0.f, 0.f, 0.f};
    bf16x8 At[4][2], B0[2][2], B1[2][2];
    const char* cA = (const char*)g.A + (size_t)cur.pm * tstep; const char* cB = (const char*)g.Bt + (size_t)cur.pn * tstep;
    S.a_ready(cur);
    if constexpr (SP2) {
        PG8_STAGE(PG8_SB(0, 0), cB, voffB); PG8_STAGE(PG8_SB(0, 1), cB + hstep, voffB); PG8_STAGE(PG8_SA(0, 0), cA, voffA); PG8_STAGE(PG8_SA(0, 1), cA + hstep, voffA);
        if (wr == 1) PG8_BAR;
        PG8_WAIT_V(2); PG8_BAR;
        PG8_STAGE(PG8_SB(1, 0), cB + kstep, voffB); PG8_STAGE(PG8_SA(1, 0), cA + kstep, voffA); PG8_STAGE(PG8_SB(1, 1), cB + hstep + kstep, voffB);
        PG8_WAIT_V(6); PG8_BAR;
    } else {
        PG8_STAGE(PG8_SB(0, 0), cB, voffB); PG8_STAGE(PG8_SA(0, 0), cA, voffA); PG8_STAGE(PG8_SB(0, 1), cB + hstep, voffB); PG8_STAGE(PG8_SA(0, 1), cA + hstep, voffA);
        if (wr == 1) PG8_BAR;
        PG8_WAIT_V(4); PG8_BAR;
        PG8_STAGE(PG8_SB(1, 0), cB + kstep, voffB); PG8_STAGE(PG8_SA(1, 0), cA + kstep, voffA); PG8_STAGE(PG8_SB(1, 1), cB + hstep + kstep, voffB);
        PG8_WAIT_V(6); PG8_BAR;
    }
    for (;;) {
        const bool has_next = S.next(ui + 1, nxt);
        const char* nA = has_next ? (const char*)g.A + (size_t)nxt.pm * tstep : cA; const char* nB = has_next ? (const char*)g.Bt + (size_t)nxt.pn * tstep : cB;
        for (int t = 0; t < nt; t += 2) {
            const bool last = (t == nt - 2);
            const char* a1 = cA + (size_t)(t + 1) * kstep;
            const char* a2 = last ? nA : cA + (size_t)(t + 2) * kstep; const char* b2 = last ? nB : cB + (size_t)(t + 2) * kstep;
            const char* a3 = a2 + kstep; const char* b3 = b2 + kstep;
            if (last && has_next) S.a_ready(nxt);
            if constexpr (SP2) {
            PG8_LDB(B0, 0, 0); PG8_LDB(B1, 0, 1); PG8_SCHED; PG8_LDA(At, 0, 0); PG8_STAGE(PG8_SA(1, 1), a1 + hstep, voffA);
            PG8_WAIT_V(8); PG8_WAIT_L(0); PG8_BAR; PG8_MMA(0, 0, At, B0); PG8_MMA(0, 1, At, B1); PG8_BAR; PG8_SCHED;
            PG8_LDA(At, 0, 1); PG8_STAGE(PG8_SB(0, 0), b2, voffB); PG8_STAGE(PG8_SB(0, 1), b2 + hstep, voffB); PG8_STAGE(PG8_SA(0, 0), a2, voffA);
            PG8_WAIT_V(8); PG8_WAIT_L(0); PG8_BAR; PG8_MMA(1, 0, At, B0); PG8_MMA(1, 1, At, B1); PG8_BAR; PG8_SCHED;
            PG8_LDB(B0, 1, 0); PG8_LDB(B1, 1, 1); PG8_SCHED; PG8_LDA(At, 1, 0); PG8_STAGE(PG8_SA(0, 1), a2 + hstep, voffA);
            PG8_WAIT_V(8); PG8_WAIT_L(0); PG8_BAR; PG8_MMA(0, 0, At, B0); PG8_MMA(0, 1, At, B1); PG8_BAR; PG8_SCHED;
            PG8_LDA(At, 1, 1); PG8_STAGE(PG8_SB(1, 0), b3, voffB); PG8_STAGE(PG8_SB(1, 1), b3 + hstep, voffB); PG8_STAGE(PG8_SA(1, 0), a3, voffA);
            PG8_WAIT_V(8); PG8_WAIT_L(0); PG8_BAR; PG8_MMA(1, 0, At, B0); PG8_MMA(1, 1, At, B1); PG8_BAR; PG8_SCHED;
            } else {
            PG8_LDB(B0, 0, 0); PG8_SCHED; PG8_LDA(At, 0, 0); PG8_STAGE(PG8_SA(1, 1), a1 + hstep, voffA);
            PG8_WAIT_L(8); PG8_BAR; PG8_WAIT_L(0); PG8_MMA(0, 0, At, B0); PG8_BAR; PG8_SCHED;
            PG8_LDB(B1, 0, 1); PG8_STAGE(PG8_SB(0, 0), b2, voffB);
            PG8_BAR; PG8_WAIT_L(0); PG8_MMA(0, 1, At, B1); PG8_BAR;
            PG8_LDA(At, 0, 1); PG8_STAGE(PG8_SA(0, 0), a2, voffA);
            PG8_BAR; PG8_WAIT_L(0); PG8_MMA(1, 0, At, B0); PG8_BAR; PG8_SCHED;
            PG8_STAGE(PG8_SB(0, 1), b2 + hstep, voffB);
            PG8_WAIT_V(6); PG8_BAR; PG8_MMA(1, 1, At, B1); PG8_BAR;
            PG8_LDB(B0, 1, 0); PG8_SCHED; PG8_LDA(At, 1, 0); PG8_STAGE(PG8_SA(0, 1), a2 + hstep, voffA);
            PG8_WAIT_L(8); PG8_BAR; PG8_WAIT_L(0); PG8_MMA(0, 0, At, B0); PG8_BAR; PG8_SCHED;
            PG8_LDB(B1, 1, 1); PG8_STAGE(PG8_SB(1, 0), b3, voffB);
            PG8_BAR; PG8_WAIT_L(0); PG8_MMA(0, 1, At, B1); PG8_BAR;
            PG8_LDA(At, 1, 1); PG8_STAGE(PG8_SA(1, 0), a3, voffA);
            PG8_BAR; PG8_WAIT_L(0); PG8_MMA(1, 0, At, B0); PG8_BAR; PG8_SCHED;
            PG8_STAGE(PG8_SB(1, 1), b3 + hstep, voffB);
            PG8_WAIT_V(6); PG8_BAR; PG8_MMA(1, 1, At, B1); PG8_BAR;
            }
        }
        if constexpr (ALIGN_EPI) { if (wr == 0) PG8_BAR; }
        if constexpr (!Epi::AFTER_DRAIN) { E(acc, cur, wr, wc, fr, fq); S.done(cur); }
        if (!has_next) break;
#pragma unroll
        for (int a = 0; a < 2; ++a)
#pragma unroll
            for (int b = 0; b < 2; ++b)
#pragma unroll
                for (int m = 0; m < 4; ++m)
#pragma unroll
                    for (int n = 0; n < 2; ++n) acc[a][b][m][n] = (f32x4){0.f, 0.f, 0.f, 0.f};
        cur = nxt; cA = nA; cB = nB; ++ui;
        if constexpr (ALIGN_EPI) { if (wr == 1) PG8_BAR; }
    }
    PG8_WAIT_V(0);
    if constexpr (!ALIGN_EPI) { if (wr == 0) PG8_BAR; }
    PG8_BAR;
    if constexpr (Epi::AFTER_DRAIN) { E.fused(acc, cur, wr, wc, fr, fq, lds, wid, lane); S.done(cur); }
#undef PG8_SA
#undef PG8_SB
#undef PG8_STAGE
#undef PG8_LDA
#undef PG8_LDB
#undef PG8_MMA
#undef PG8_WAIT_V
#undef PG8_WAIT_L
#undef PG8_BAR
#undef PG8_SCHED
}
}

struct Ctx { int tid, bid, nb; size_t z; };
__device__ __forceinline__ int lane_id() { return (int)__builtin_amdgcn_mbcnt_hi(~0u, __builtin_amdgcn_mbcnt_lo(~0u, 0u)); }
__device__ __forceinline__ Ctx mkctx(const Params& p, int first = 0, int count = 0) { Ctx c; c.tid = (p.wave << 6) | lane_id(); c.bid = blockIdx.x; c.nb = gridDim.x; c.z = 0; asm volatile("" : "+v"(c.tid), "+s"(c.bid), "+s"(c.nb), "+s"(c.z));
    if (first > 0 || count > 0) { const int hi = count > 0 ? first + count : c.nb; c.bid = (c.bid >= first && c.bid < hi) ? c.bid - first : (1 << 20); c.nb = hi - first; } return c; }
#define PIN(i) (p.in[i] + z)
__device__ __forceinline__ void stage_init(const Params& p) {
    const Ctx cx = mkctx(p); const size_t z = cx.z;
    const unsigned gt = (unsigned)cx.bid * NTHREADS + cx.tid, GT = (unsigned)cx.nb * NTHREADS;
    typedef float f4 __attribute__((ext_vector_type(4)));
    f4* X = (f4*)(p.out + z); const f4* xp = (const f4*)PIN(I_XP); const f4* xs = (const f4*)PIN(I_XS);
    (void)xp;
    for (unsigned i = gt; i < (unsigned)NS * (D / 4); i += GT) X[(unsigned)MP * (D / 4) + i] = xs[i];
}
__device__ __forceinline__ void stage_mod(const Params& p, unsigned char* lds, int l_lo, int l_hi, int first = 0) {
    const Ctx cx = mkctx(p, first); const size_t z = cx.z;
    float* MOD = (float*)(p.ws + z + WS_MOD);
    bf16_t* SCs = (bf16_t*)lds;
    bf16_t* WTs = (bf16_t*)(lds + 39168);
    const int lane = cx.tid & 63, wave = __builtin_amdgcn_readfirstlane(cx.tid >> 6), r = lane & 15, q = lane >> 4;
    const int lk = cx.tid >> 4, lj = (cx.tid & 15) * 8;
    for (int item = cx.bid; item < (l_hi - l_lo) * 48; item += cx.nb) {
        const int l = l_lo + item / 48, j0 = (item % 48) * 128;
        const float* w = PIN(I_ADAW) + (size_t)l * D * 6144 + j0 + lj;
        f32x4 acc[9];
#pragma unroll
        for (int i = 0; i < 9; ++i) acc[i] = (f32x4){0.f, 0.f, 0.f, 0.f};
        f32x4 n0 = *(const f32x4*)(w + (size_t)lk * 6144), n1 = *(const f32x4*)(w + (size_t)lk * 6144 + 4);
        __syncthreads();
#pragma unroll
        for (int e = 0; e < 4; ++e) { WTs[(lj + e) * 40 + lk] = f2bf(n0[e]); WTs[(lj + 4 + e) * 40 + lk] = f2bf(n1[e]); }
#pragma unroll 1
        for (int t = 0; t < 32; ++t) {
            if ((t & 3) == 0) {
                __syncthreads();
                for (int i = cx.tid; i < 144 * 16; i += NTHREADS) { const int sidx = i >> 4, k8 = (i & 15) * 8; bf16x8 o;
                    if (sidx < NSEQ) { const float* c = (sidx < NP ? PIN(I_CP) + (size_t)sidx * D : PIN(I_CS) + (size_t)(sidx - NP) * D) + (t >> 2) * 128 + k8;
                        const f32x4 c0 = *(const f32x4*)c, c1 = *(const f32x4*)(c + 4);
#pragma unroll
                        for (int e = 0; e < 4; ++e) { o[e] = (short)f2bf(silu_f(c0[e])); o[4 + e] = (short)f2bf(silu_f(c1[e])); } }
                    else o = (bf16x8){0, 0, 0, 0, 0, 0, 0, 0};
                    *(bf16x8*)(SCs + sidx * LD2 + k8) = o; }
            }
            const int tn = t + 1 < 32 ? t + 1 : 31;
            n0 = *(const f32x4*)(w + (size_t)(tn * 32 + lk) * 6144); n1 = *(const f32x4*)(w + (size_t)(tn * 32 + lk) * 6144 + 4);
            __syncthreads();
            {
                const bf16x8 a = *(const bf16x8*)(WTs + (t & 1) * 5120 + (16 * wave + r) * 40 + 8 * q);
#pragma unroll
                for (int st = 0; st < 9; ++st) {
                    const bf16x8 b = *(const bf16x8*)(SCs + (16 * st + r) * LD2 + 32 * (t & 3) + 8 * q);
                    acc[st] = __builtin_amdgcn_mfma_f32_16x16x32_bf16(a, b, acc[st], 0, 0, 0);
                }
            }
            bf16_t* wn = WTs + ((t + 1) & 1) * 5120;
#pragma unroll
            for (int e = 0; e < 4; ++e) { wn[(lj + e) * 40 + lk] = f2bf(n0[e]); wn[(lj + 4 + e) * 40 + lk] = f2bf(n1[e]); }
        }
        const int j = j0 + 16 * wave + 4 * q;
        const f32x4 b0 = *(const f32x4*)(PIN(I_ADAB) + (size_t)l * 6144 + j);
#pragma unroll
        for (int st = 0; st < 9; ++st) { const int sidx = 16 * st + r; if (sidx < NSEQ) *(f32x4*)(MOD + ((size_t)l * NSEQ + sidx) * 6144 + j) = acc[st] + b0; }
    }
}

__device__ __forceinline__ void stage_norm(const Params& p, int l, int which, float* wl, bool prompt_f32) {
    const Ctx cx = mkctx(p); const size_t z = cx.z;
    const int lane = cx.tid & 63, gw = cx.bid * NWAVES + (cx.tid >> 6), GW = cx.nb * NWAVES;
    const float* X = (l == 0 && which == 0) ? PIN(I_XP) : (const float*)(p.out + z);
    const float* XS = (const float*)(p.out + z);
    bf16_t* H = (bf16_t*)(p.ws + z + WS_H);
    const float* MOD = (const float*)(p.ws + z + WS_MOD);
    const float* g = PIN(which ? I_NFFNG : I_NMIXG) + (size_t)l * D;
    f32x4 gg[4];
#pragma unroll
    for (int j = 0; j < 4; ++j) gg[j] = *(const f32x4*)(g + 4 * lane + 256 * j);
    f32x4 v[2][4], nv[2][4];
    const int rbeg = (prompt_f32 ? 0 : MP) + 2 * gw;
    if (rbeg < R) {
#pragma unroll
        for (int k = 0; k < 2; ++k)
#pragma unroll
            for (int j = 0; j < 4; ++j) v[k][j] = *(const f32x4*)((rbeg + k < MP ? X : XS) + (size_t)(rbeg + k) * D + 4 * lane + 256 * j);
    }
    for (int row0 = rbeg; row0 < R; row0 += 2 * GW) {
        const int rnext = row0 + 2 * GW < R ? row0 + 2 * GW : row0;
#pragma unroll
        for (int k = 0; k < 2; ++k)
#pragma unroll
            for (int j = 0; j < 4; ++j) nv[k][j] = *(const f32x4*)((rnext + k < MP ? X : XS) + (size_t)(rnext + k) * D + 4 * lane + 256 * j);
#pragma unroll
        for (int k = 0; k < 2; ++k) {
            const int row = row0 + k;
            const float* md = MOD + ((size_t)l * NSEQ + seq_of_row(row)) * 6144 + which * 3072 + 4 * lane;
            f32x4 sh[4], sc[4];
#pragma unroll
            for (int j = 0; j < 4; ++j) { sh[j] = *(const f32x4*)(md + 256 * j); sc[j] = *(const f32x4*)(md + 1024 + 256 * j); }
            float ss = 0.f;
#pragma unroll
            for (int j = 0; j < 4; ++j) ss += (v[k][j][0] * v[k][j][0] + v[k][j][1] * v[k][j][1]) + (v[k][j][2] * v[k][j][2] + v[k][j][3] * v[k][j][3]);
            ss = wave_sum(ss);
            const float rstd = rsqrtf(ss * (1.f / D) + NORM_EPS);
#pragma unroll
            for (int j = 0; j < 4; ++j) { v[k][j] = v[k][j] * rstd * gg[j] * (1.f + sc[j]) + sh[j];
                *(bf16x4*)(H + (size_t)row * D + 4 * lane + 256 * j) = (bf16x4){(short)f2bf(v[k][j][0]), (short)f2bf(v[k][j][1]), (short)f2bf(v[k][j][2]), (short)f2bf(v[k][j][3])}; }
        }
#pragma unroll
        for (int k = 0; k < 2; ++k)
#pragma unroll
            for (int j = 0; j < 4; ++j) v[k][j] = nv[k][j];
    }
}

__device__ __forceinline__ void stage_norm_b(const Params& p, int l, int which) {
    const Ctx cx = mkctx(p); const size_t z = cx.z;
    const int lane = cx.tid & 63, gw = cx.bid * NWAVES + (cx.tid >> 6), GW = cx.nb * NWAVES;
    const bf16_t* XB = (const bf16_t*)(p.ws + z + WS_XB);
    bf16_t* H = (bf16_t*)(p.ws + z + WS_H);
    const float* MOD = (const float*)(p.ws + z + WS_MOD);
    const float* g = PIN(which ? I_NFFNG : I_NMIXG) + (size_t)l * D;
    f32x4 gg[2][2];
#pragma unroll
    for (int j = 0; j < 2; ++j) { gg[j][0] = *(const f32x4*)(g + 8 * lane + 512 * j); gg[j][1] = *(const f32x4*)(g + 8 * lane + 512 * j + 4); }
    typedef pg8::u32x4 u32x4;
    u32x4 v[4][2], nv[4][2];
    if (4 * gw < MP) {
#pragma unroll
        for (int k = 0; k < 4; ++k)
#pragma unroll
            for (int j = 0; j < 2; ++j) v[k][j] = *(const u32x4*)(XB + (size_t)(4 * gw + k) * D + 8 * lane + 512 * j);
    }
    for (int row0 = 4 * gw; row0 < MP; row0 += 4 * GW) {
        const int rnext = row0 + 4 * GW < MP ? row0 + 4 * GW : row0;
#pragma unroll
        for (int k = 0; k < 4; ++k)
#pragma unroll
            for (int j = 0; j < 2; ++j) nv[k][j] = *(const u32x4*)(XB + (size_t)(rnext + k) * D + 8 * lane + 512 * j);
        const float* md = MOD + ((size_t)l * NSEQ + (row0 >> 13)) * 6144 + which * 3072 + 8 * lane;
        f32x4 sh[2][2], sc[2][2];
#pragma unroll
        for (int j = 0; j < 2; ++j)
#pragma unroll
            for (int h = 0; h < 2; ++h) { sh[j][h] = *(const f32x4*)(md + 512 * j + 4 * h); sc[j][h] = *(const f32x4*)(md + 1024 + 512 * j + 4 * h) + 1.f; sc[j][h] = sc[j][h] * gg[j][h]; }
#pragma unroll
        for (int k = 0; k < 4; ++k) {
            const int row = row0 + k;
            f32x4 x[2][2]; float ss = 0.f;
#pragma unroll
            for (int j = 0; j < 2; ++j) { const u32x4 w = v[k][j];
                x[j][0] = (f32x4){__builtin_bit_cast(float, w.x << 16), __builtin_bit_cast(float, w.x & 0xffff0000u), __builtin_bit_cast(float, w.y << 16), __builtin_bit_cast(float, w.y & 0xffff0000u)};
                x[j][1] = (f32x4){__builtin_bit_cast(float, w.z << 16), __builtin_bit_cast(float, w.z & 0xffff0000u), __builtin_bit_cast(float, w.w << 16), __builtin_bit_cast(float, w.w & 0xffff0000u)};
#pragma unroll
                for (int h = 0; h < 2; ++h) ss += (x[j][h][0] * x[j][h][0] + x[j][h][1] * x[j][h][1]) + (x[j][h][2] * x[j][h][2] + x[j][h][3] * x[j][h][3]); }
            ss = wave_sum(ss);
            const float rstd = rsqrtf(ss * (1.f / D) + NORM_EPS);
#pragma unroll
            for (int j = 0; j < 2; ++j) { const f32x4 o0 = x[j][0] * rstd * sc[j][0] + sh[j][0], o1 = x[j][1] * rstd * sc[j][1] + sh[j][1];
                u32x4 w; w.x = cvtpk(o0[0], o0[1]); w.y = cvtpk(o0[2], o0[3]); w.z = cvtpk(o1[0], o1[1]); w.w = cvtpk(o1[2], o1[3]);
                *(u32x4*)(H + (size_t)row * D + 8 * lane + 512 * j) = w; }
        }
#pragma unroll
        for (int k = 0; k < 4; ++k)
#pragma unroll
            for (int j = 0; j < 2; ++j) v[k][j] = nv[k][j];
    }
}

__device__ __forceinline__ f32x4 ld4bf(const bf16_t* p) { const bf16x4 v = *(const bf16x4*)p; return (f32x4){bf2f((bf16_t)v[0]), bf2f((bf16_t)v[1]), bf2f((bf16_t)v[2]), bf2f((bf16_t)v[3])}; }
__device__ __forceinline__ void stage_rwprep(const Params& p, int l, float* lds) {
    const Ctx cx = mkctx(p); const size_t z = cx.z;
    const bf16_t* P = (const bf16_t*)(p.ws + z + WS_P);
    bf16_t* RWH = (bf16_t*)(p.ws + z + WS_RW); float* RWD = (float*)(p.ws + z + WS_RWD);
    float* xs = lds; float* kk = lds + 1024;
    const int tid = cx.tid;
    const float* mu = PIN(I_MU) + (size_t)l * 1024;
    for (int row = MP + cx.bid; row < R; row += cx.nb) {
        const bool samp = row >= MP; const int n = samp ? row - MP : row >> 13, t = samp ? 0 : (row & (T - 1));
        __syncthreads();
        for (int c = tid; c < 1024; c += NTHREADS) {
            const float pa = bf2f(P[(size_t)row * PCOLS + c]);
            float prev;
            if (t > 0) prev = bf2f(P[(size_t)(row - 1) * PCOLS + c]);
            else prev = samp ? PIN(I_SHIFT)[((size_t)l * NS + n) * 1024 + c] : 0.f;
            float v = pa + (prev - pa) * mu[c];
            if (c >= 768 && c < 832) v = tanh_fast(v);
            if (c >= 896) v = sigmoid_f(v);
            xs[c] = v;
            if (samp) (p.out + z)[O_SSHIFT + ((size_t)l * NS + n) * 1024 + c] = pa;
            else if (t == T - 1) (p.out + z)[O_PSHIFT + ((size_t)l * NP + n) * 1024 + c] = pa;
        }
        __syncthreads();
        float av = 0.f, gv = 0.f, dec = 0.f, kraw = 0.f;
        if (tid < 256) {
            const int j = tid;
            float wl = PIN(I_W0)[(size_t)l * 256 + j], al = PIN(I_A0)[(size_t)l * 256 + j]; gv = 0.f;
            const bf16_t* W2T = (const bf16_t*)(p.ws + z + WS_LORA) + (size_t)l * 65536;
            bf16x8 fw[8], fa[8], fg[16];
#pragma unroll
            for (int c8 = 0; c8 < 8; ++c8) { fw[c8] = *(const bf16x8*)(W2T + j * 64 + c8 * 8); fa[c8] = *(const bf16x8*)(W2T + 16384 + j * 64 + c8 * 8); }
#pragma unroll
            for (int c8 = 0; c8 < 16; ++c8) fg[c8] = *(const bf16x8*)(W2T + 32768 + j * 128 + c8 * 8);
#pragma unroll
            for (int c8 = 0; c8 < 8; ++c8)
#pragma unroll
                for (int e = 0; e < 8; ++e) { wl += xs[768 + c8 * 8 + e] * bf2f((bf16_t)fw[c8][e]); al += xs[832 + c8 * 8 + e] * bf2f((bf16_t)fa[c8][e]); }
#pragma unroll
            for (int c8 = 0; c8 < 16; ++c8)
#pragma unroll
                for (int e = 0; e < 8; ++e) gv += xs[896 + c8 * 8 + e] * bf2f((bf16_t)fg[c8][e]);
            const float w_log = -softplus_fast(-wl) - 0.5f;
            dec = -__expf(w_log);
            av = sigmoid_f(al);
            kraw = xs[256 + j];
            kk[j] = kraw * PIN(I_KK)[(size_t)l * 256 + j];
        }
        __syncthreads();
        if (tid < 256) {
            const int j = tid, h0 = j & ~63;
            float s = 0.f;
#pragma unroll 4
            for (int i = 0; i < 64; ++i) s += kk[h0 + i] * kk[h0 + i];
            const float kkn = kk[j] / fmaxf(sqrtf(s), 1e-12f);
            const float kmod = kraw * (1.f + (av - 1.f) * PIN(I_KA)[(size_t)l * 256 + j]);
            bf16_t* rw = RWH + (size_t)row * 1536 + j;
            rw[0] = f2bf(xs[j]); rw[256] = f2bf(kmod); rw[512] = f2bf(xs[512 + j]); rw[768] = f2bf(-kkn); rw[1024] = f2bf(kkn * av); rw[1280] = f2bf(gv); RWD[(size_t)row * 256 + j] = dec;
        }
    }
}

__device__ __forceinline__ void stage_rwprep2(const Params& p, int l, unsigned char* lds) {
    const Ctx cx = mkctx(p); const size_t z = cx.z;
    const int tid = cx.tid, lane = tid & 63, wave = __builtin_amdgcn_readfirstlane(tid >> 6), r = lane & 15, q = lane >> 4;
    bf16_t* ACW = (bf16_t*)lds;
    bf16_t* ACA = (bf16_t*)(lds + 9216);
    bf16_t* ACG = (bf16_t*)(lds + 18432);
    const bf16_t* P = (const bf16_t*)(p.ws + z + WS_P);
    bf16_t* RWH = (bf16_t*)(p.ws + z + WS_RW); float* RWD = (float*)(p.ws + z + WS_RWD);
    const bf16_t* W2T = (const bf16_t*)(p.ws + z + WS_LORA) + (size_t)l * 65536; const bf16_t* A2T = W2T + 16384; const bf16_t* G2T = W2T + 32768;
    const float* mu = PIN(I_MU) + (size_t)l * 1024;
    for (int tile = cx.bid; tile < MP / 64; tile += cx.nb) {
        const int row0 = tile * 64;
#pragma unroll
        for (int it = 0; it < 4; ++it) {
            const int task = it * NTHREADS + tid, tok = task >> 5, ch = task & 31, c = 768 + ch * 8, row = row0 + tok;
            const bf16x8 pa = *(const bf16x8*)(P + (size_t)row * PCOLS + c);
            bf16x8 pv = {0, 0, 0, 0, 0, 0, 0, 0};
            if ((row & (T - 1)) != 0) pv = *(const bf16x8*)(P + (size_t)(row - 1) * PCOLS + c);
            bf16x8 o;
#pragma unroll
            for (int e = 0; e < 8; ++e) { const float a = bf2f((bf16_t)pa[e]), b = bf2f((bf16_t)pv[e]); float x = a + (b - a) * mu[c + e];
                x = ch < 8 ? tanh_fast(x) : (ch >= 16 ? sigmoid_f(x) : x); o[e] = (short)f2bf(x); }
            if (ch < 8) *(bf16x8*)(ACW + tok * LD + ch * 8) = o;
            else if (ch < 16) *(bf16x8*)(ACA + tok * LD + (ch - 8) * 8) = o;
            else *(bf16x8*)(ACG + tok * LD2 + (ch - 16) * 8) = o;
        }
        if ((row0 & (T - 1)) == T - 64) {
            const int n = row0 >> 13;
            for (int c = tid; c < 1024; c += NTHREADS) (p.out + z)[O_PSHIFT + ((size_t)l * NP + n) * 1024 + c] = bf2f(P[(size_t)(row0 + 63) * PCOLS + c]);
        }
        __syncthreads();
        {
            const int h = wave >> 1, th = wave & 1;
#pragma unroll 1
            for (int nt = 0; nt < 2; ++nt) {
                const int tb = 32 * th + 16 * nt, row = row0 + tb + r; const bool first = (row & (T - 1)) == 0;
                float kkv[4][4], avv[4][4]; float ssq = 0.f;
                bf16x4 pc[4][3], pp_[4][3];
#pragma unroll
                for (int mt = 0; mt < 4; ++mt) { const int j = h * 64 + 16 * mt + 4 * q; const bf16x4 zero4 = {0, 0, 0, 0};
#pragma unroll
                    for (int f = 0; f < 3; ++f) { pc[mt][f] = *(const bf16x4*)(P + (size_t)row * PCOLS + 256 * f + j); pp_[mt][f] = first ? zero4 : *(const bf16x4*)(P + (size_t)(row - 1) * PCOLS + 256 * f + j); } }
#pragma unroll
                for (int mt = 0; mt < 4; ++mt) {
                    const int j0 = h * 64 + 16 * mt, j = j0 + 4 * q;
                    f32x4 aw = {0.f, 0.f, 0.f, 0.f}, aa = {0.f, 0.f, 0.f, 0.f}, ag = {0.f, 0.f, 0.f, 0.f};
#pragma unroll
                    for (int s2 = 0; s2 < 2; ++s2) {
                        const bf16x8 fw = *(const bf16x8*)(W2T + (j0 + r) * 64 + 32 * s2 + 8 * q), fa = *(const bf16x8*)(A2T + (j0 + r) * 64 + 32 * s2 + 8 * q);
                        const bf16x8 bw = *(const bf16x8*)(ACW + (tb + r) * LD + 32 * s2 + 8 * q), ba = *(const bf16x8*)(ACA + (tb + r) * LD + 32 * s2 + 8 * q);
                        aw = __builtin_amdgcn_mfma_f32_16x16x32_bf16(fw, bw, aw, 0, 0, 0);
                        aa = __builtin_amdgcn_mfma_f32_16x16x32_bf16(fa, ba, aa, 0, 0, 0);
                    }
#pragma unroll
                    for (int s2 = 0; s2 < 4; ++s2) {
                        const bf16x8 fg = *(const bf16x8*)(G2T + (j0 + r) * 128 + 32 * s2 + 8 * q), bg = *(const bf16x8*)(ACG + (tb + r) * LD2 + 32 * s2 + 8 * q);
                        ag = __builtin_amdgcn_mfma_f32_16x16x32_bf16(fg, bg, ag, 0, 0, 0);
                    }
                    const bf16x4 par = pc[mt][0], pak = pc[mt][1], pav = pc[mt][2], pvr = pp_[mt][0], pvk = pp_[mt][1], pvv = pp_[mt][2];
                    const f32x4 mur = *(const f32x4*)(mu + j), muk = *(const f32x4*)(mu + 256 + j), muv = *(const f32x4*)(mu + 512 + j);
                    const f32x4 w0 = *(const f32x4*)(PIN(I_W0) + (size_t)l * 256 + j), a0 = *(const f32x4*)(PIN(I_A0) + (size_t)l * 256 + j);
                    const f32x4 kkw = *(const f32x4*)(PIN(I_KK) + (size_t)l * 256 + j), kaw = *(const f32x4*)(PIN(I_KA) + (size_t)l * 256 + j);
                    f32x4 fr_, fk_, fv_, fd_;
#pragma unroll
                    for (int e = 0; e < 4; ++e) {
                        const float ar = bf2f((bf16_t)par[e]), ak = bf2f((bf16_t)pak[e]), av_ = bf2f((bf16_t)pav[e]);
                        const float xr = ar + (bf2f((bf16_t)pvr[e]) - ar) * mur[e], xk = ak + (bf2f((bf16_t)pvk[e]) - ak) * muk[e], xv = av_ + (bf2f((bf16_t)pvv[e]) - av_) * muv[e];
                        const float w_log = -softplus_fast(-(w0[e] + aw[e])) - 0.5f;
                        const float av = sigmoid_f(a0[e] + aa[e]);
                        fd_[e] = -__expf(w_log);
                        fr_[e] = xr; fv_[e] = xv;
                        fk_[e] = xk * (1.f + (av - 1.f) * kaw[e]);
                        const float kv = xk * kkw[e]; kkv[mt][e] = kv; avv[mt][e] = av; ssq += kv * kv;
                    }
                    bf16_t* rw = RWH + (size_t)row * 1536 + j;
                    *(bf16x4*)rw = pack4(fr_); *(bf16x4*)(rw + 256) = pack4(fk_); *(bf16x4*)(rw + 512) = pack4(fv_); *(bf16x4*)(rw + 1280) = pack4(ag); *(f32x4*)(RWD + (size_t)row * 256 + j) = fd_;
                }
                ssq += __shfl_xor(ssq, 16); ssq += __shfl_xor(ssq, 32);
                const float rn = 1.f / fmaxf(sqrtf(ssq), 1e-12f);
#pragma unroll
                for (int mt = 0; mt < 4; ++mt) {
                    bf16_t* rw = RWH + (size_t)row * 1536 + h * 64 + 16 * mt + 4 * q;
                    f32x4 fa_, fb_;
#pragma unroll
                    for (int e = 0; e < 4; ++e) { const float kn = kkv[mt][e] * rn; fa_[e] = -kn; fb_[e] = kn * avv[mt][e]; }
                    *(bf16x4*)(rw + 768) = pack4(fa_); *(bf16x4*)(rw + 1024) = pack4(fb_);
                }
            }
        }
        __syncthreads();
    }
}

#define WAVE_LDS_SYNC() do { asm volatile("s_waitcnt lgkmcnt(0)" ::: "memory"); __builtin_amdgcn_wave_barrier(); } while (0)
__device__ __forceinline__ void stage_rwscan(const Params& p, int l, float* lds, int first = 0) {
    const Ctx cx = mkctx(p, first); const size_t z = cx.z;
    const int lane = cx.tid & 63, wave = cx.tid >> 6;
    const bf16_t* RWH = (const bf16_t*)(p.ws + z + WS_RW); const float* RWD = (const float*)(p.ws + z + WS_RWD);
    bf16_t* Y = (bf16_t*)(p.ws + z + WS_YCAT);
    float* wl = lds + wave * 512;
    for (int u = NP * 4 + cx.bid + cx.nb * wave; u < NSEQ * 4; u += cx.nb * NWAVES) {
        const int s = u >> 2, h = u & 3; const bool samp = s >= NP; const int n = samp ? s - NP : s;
        const int row0 = samp ? MP + n : n * T, nt = samp ? 1 : T;
        float S[64];
        if (samp) { const float* st = PIN(I_WKV) + ((((size_t)l * NS + n) * 4 + h) * 64 + lane) * 64;
#pragma unroll
            for (int k = 0; k < 64; k += 4) { const f32x4 v4 = *(const f32x4*)(st + k); S[k] = v4[0]; S[k + 1] = v4[1]; S[k + 2] = v4[2]; S[k + 3] = v4[3]; } }
        else {
#pragma unroll
            for (int k = 0; k < 64; ++k) S[k] = 0.f; }
        const float lng = PIN(I_LNG)[(size_t)l * 256 + h * 64 + lane], lnb = PIN(I_LNB)[(size_t)l * 256 + h * 64 + lane];
        const float rkl = PIN(I_RK)[(size_t)l * 256 + h * 64 + lane];
        for (int t = 0; t < nt; ++t) {
            const bf16_t* rw = RWH + (size_t)(row0 + t) * 1536 + h * 64 + lane;
            const float rl = bf2f(rw[0]), kl = bf2f(rw[256]), vl = bf2f(rw[512]), gl = bf2f(rw[1280]);
            WAVE_LDS_SYNC();
            wl[lane] = rl; wl[64 + lane] = kl; wl[128 + lane] = __expf(RWD[(size_t)(row0 + t) * 256 + h * 64 + lane]); wl[192 + lane] = bf2f(rw[768]); wl[256 + lane] = bf2f(rw[1024]);
            WAVE_LDS_SYNC();
            const float bd = wave_sum(rl * kl * rkl);
            float sa = 0.f;
#pragma unroll
            for (int k = 0; k < 64; ++k) sa += S[k] * wl[192 + k];
            float y = 0.f;
#pragma unroll
            for (int k = 0; k < 64; ++k) {
                S[k] = S[k] * wl[128 + k] + sa * wl[256 + k] + vl * wl[64 + k];
                y += S[k] * wl[k];
            }
            const float mean = wave_sum(y) * (1.f / 64.f), dl = y - mean;
            const float var = wave_sum(dl * dl) * (1.f / 64.f);
            const float yn = dl * rsqrtf(var + GN_EPS) * lng + lnb;
            Y[(size_t)(row0 + t) * D + h * 64 + lane] = f2bf((yn + bd * vl) * gl);
        }
        float* so = (p.out + z) + (samp ? O_SWKV + ((((size_t)l * NS + n) * 4 + h) * 64 + lane) * 64 : O_PWKV + ((((size_t)l * NP + n) * 4 + h) * 64 + lane) * 64);
#pragma unroll
        for (int k = 0; k < 64; k += 4) *(f32x4*)(so + k) = (f32x4){S[k], S[k + 1], S[k + 2], S[k + 3]};
    }
}

constexpr int RWL = 64, NCH = T / RWL, RW_UNITS = NP * 4 * NCH;
__device__ __forceinline__ f32x4 mma16_k64(const bf16_t* A, const bf16_t* Bt, f32x4 acc, int r, int q) {
    const bf16x8 a0 = *(const bf16x8*)(A + r * LD + 8 * q), a1 = *(const bf16x8*)(A + r * LD + 32 + 8 * q);
    const bf16x8 b0 = *(const bf16x8*)(Bt + r * LD + 8 * q), b1 = *(const bf16x8*)(Bt + r * LD + 32 + 8 * q);
    acc = __builtin_amdgcn_mfma_f32_16x16x32_bf16(a0, b0, acc, 0, 0, 0);
    acc = __builtin_amdgcn_mfma_f32_16x16x32_bf16(a1, b1, acc, 0, 0, 0);
    return acc;
}

__device__ __forceinline__ void stage_rw1(const Params& p, int l, unsigned char* lds) {
    const Ctx cx = mkctx(p); const size_t z = cx.z;
    const int tid = cx.tid, lane0 = tid & 63, wave = __builtin_amdgcn_readfirstlane(tid >> 6);
#define RELANE() int lane_ = lane0; asm volatile("" : "+v"(lane_)); const int lane = lane_, r = lane & 15, q = lane >> 4; (void)r; (void)q;
    bf16_t* M = (bf16_t*)lds;
    float* AT = (float*)(lds + 12 * MSZ * 2);
    float* psum = AT + 64 * 68;
    float* PLs = psum + 512;
    bf16_t* TA10 = (bf16_t*)(PLs + 64);
    bf16_t* TT00 = TA10 + 32 * LD; bf16_t* TYT = TT00 + 32 * LD;
    unsigned char* const wsz = p.ws + z;
    for (int uu = cx.bid; uu < RW_UNITS; uu += cx.nb) {
        const int tile = uu & 255, h = uu >> 8, n = tile >> 7, c = tile & (NCH - 1), unit = (n * 4 + h) * NCH + c;
        const int row0 = n * T + c * RWL;
        {
            RELANE();
            const int k = lane, tg = wave;
            const bf16_t* rw = (const bf16_t*)(wsz + WS_RW) + (size_t)(row0 + tg * 8) * 1536 + h * 64 + k; const float* rwd = (const float*)(wsz + WS_RWD) + (size_t)(row0 + tg * 8) * 256 + h * 64 + k;
            float ld[8], f_r[8], f_k[8], f_v[8], f_a[8], f_b[8]; float cs = 0.f;
#pragma unroll
            for (int j = 0; j < 8; ++j) { ld[j] = rwd[j * 256]; f_r[j] = bf2f(rw[j * 1536]); f_k[j] = bf2f(rw[j * 1536 + 256]); f_v[j] = bf2f(rw[j * 1536 + 512]); f_a[j] = bf2f(rw[j * 1536 + 768]); f_b[j] = bf2f(rw[j * 1536 + 1024]); }
#pragma unroll
            for (int j = 0; j < 8; ++j) { cs += ld[j]; ld[j] = cs; }
            psum[tg * 64 + k] = cs;
            __syncthreads();
            float off = 0.f, tot = 0.f;
#pragma unroll
            for (int g = 0; g < 8; ++g) { const float v_ = psum[g * 64 + k]; tot += v_; off += g < tg ? v_ : 0.f; }
            if (tg == 0) PLs[k] = __expf(tot);
            bf16x8 atT, bcT, kcT, vT;
#pragma unroll
            for (int j = 0; j < 8; ++j) {
                const float lp = off + ld[j], lpm1 = j ? off + ld[j - 1] : off;
                const float Pt = __expf(lp), Pinv = __expf(-lp), Pm1 = __expf(lpm1), E = __expf(tot - lp);
                const float rr = f_r[j], km = f_k[j], vv = f_v[j], av = f_a[j], bv = f_b[j];
                const int t = tg * 8 + j;
                const bf16_t at = f2bf(av * Pm1);
                M[0 * MSZ + t * LD + k] = at; atT[j] = (short)at;
                M[3 * MSZ + t * LD + k] = f2bf(rr * Pt);
                M[1 * MSZ + t * LD + k] = f2bf(bv * Pinv);
                M[2 * MSZ + t * LD + k] = f2bf(km * Pinv);
                bcT[j] = (short)f2bf(bv * E); kcT[j] = (short)f2bf(km * E); vT[j] = (short)f2bf(vv);
            }
            *(bf16x8*)(M + 4 * MSZ + k * LD + tg * 8) = atT;
            *(bf16x8*)(M + 5 * MSZ + k * LD + tg * 8) = bcT;
            *(bf16x8*)(M + 6 * MSZ + k * LD + tg * 8) = kcT;
            *(bf16x8*)(M + 7 * MSZ + k * LD + tg * 8) = vT;
        }
        __syncthreads();
        {
            RELANE();
            const int mm = wave >> 1, hh = wave & 1;
            const bf16_t* Asrc = M + (mm < 2 ? 0 : 3) * MSZ; const bf16_t* Bsrc = M + ((mm & 1) ? 2 : 1) * MSZ;
#pragma unroll
            for (int m2 = 0; m2 < 2; ++m2) {
                const int mt = hh * 2 + m2;
#pragma unroll
                for (int nt = 0; nt < 4; ++nt) {
                    float zf = 0.f; asm volatile("" : "+v"(zf));
                    f32x4 acc = {zf, zf, zf, zf};
                    if (nt <= mt) acc = mma16_k64(Asrc + mt * 16 * LD, Bsrc + nt * 16 * LD, acc, r, q);
                    const int i = 16 * nt + r;
#pragma unroll
                    for (int e = 0; e < 4; ++e) { const int t = 16 * mt + 4 * q + e; const bool keep = mm < 2 ? (i < t) : (i <= t); acc[e] = keep ? acc[e] : 0.f; }
                    if (mm == 0) { *(f32x4*)(AT + i * 68 + 16 * mt + 4 * q) = acc;
                        if (mt >= 2 && nt < 2) {
#pragma unroll
                            for (int e = 0; e < 4; ++e) TA10[(16 * (mt - 2) + 4 * q + e) * LD + i] = f2bf(acc[e]); } }
                    else {
                        bf16_t* dst = M + (7 + mm) * MSZ;
#pragma unroll
                        for (int e = 0; e < 4; ++e) dst[(16 * mt + 4 * q + e) * LD + i] = f2bf(acc[e]);
                    }
                }
            }
        }
        __syncthreads();
        if (wave == 0) {
            RELANE();
            const int blk = lane >> 5, jl = lane & 31;
            const float* ATl = AT + blk * (32 * 68 + 32);
            float tc[32];
#pragma unroll
            for (int t = 0; t < 32; ++t) tc[t] = (t == jl) ? 1.f : 0.f;
            int aoff = 0;
            float cur[31], nxt[31];
#pragma unroll
            for (int t = 1; t < 32; ++t) cur[t - 1] = ATl[t];
#pragma unroll
            for (int i = 0; i < 31; ++i) {
                asm volatile("" : "+v"(aoff), "+v"(tc[i]));
                if (i + 1 < 31) {
#pragma unroll
                    for (int t = i + 2; t < 32; ++t) nxt[t - i - 2] = ATl[aoff + (i + 1) * 68 + t];
                }
                const float ti = tc[i];
#pragma unroll
                for (int t = i + 1; t < 32; ++t) tc[t] += cur[t - i - 1] * ti;
#pragma unroll
                for (int t = 0; t < 30; ++t) cur[t] = nxt[t];
            }
            bf16_t* T11 = M + 11 * MSZ;
#pragma unroll
            for (int t = 0; t < 32; ++t) { T11[(blk * 32 + t) * LD + lane] = f2bf(tc[t]); if (blk) T11[t * LD + lane] = 0; }
            if (blk == 0) {
#pragma unroll
                for (int c8 = 0; c8 < 4; ++c8) { bf16x8 o;
#pragma unroll
                    for (int e = 0; e < 8; ++e) o[e] = (short)f2bf(tc[c8 * 8 + e]);
                    *(bf16x8*)(TT00 + jl * LD + c8 * 8) = o; }
            }
        } else if (wave >= 4) {
            RELANE();
            const int mt = wave - 4;
#pragma unroll
            for (int nt = 0; nt < 4; ++nt) {
                f32x4 acc = {0.f, 0.f, 0.f, 0.f};
                acc = mma16_k64(M + 7 * MSZ + mt * 16 * LD, M + 8 * MSZ + nt * 16 * LD, acc, r, q);
#pragma unroll
                for (int e = 0; e < 4; ++e) M[1 * MSZ + (16 * mt + 4 * q + e) * LD + 16 * nt + r] = f2bf(acc[e]);
            }
        }
        __syncthreads();
        if (wave < 4) {
            RELANE();
            const int mt = wave >> 1, nt = wave & 1;
            const bf16x8 a = *(const bf16x8*)(TA10 + (16 * mt + r) * LD + 8 * q), b = *(const bf16x8*)(TT00 + (16 * nt + r) * LD + 8 * q);
            f32x4 acc = {0.f, 0.f, 0.f, 0.f};
            acc = __builtin_amdgcn_mfma_f32_16x16x32_bf16(a, b, acc, 0, 0, 0);
#pragma unroll
            for (int e = 0; e < 4; ++e) TYT[(16 * nt + r) * LD + 16 * mt + 4 * q + e] = f2bf(acc[e]);
        }
        __syncthreads();
        if (wave < 4) {
            RELANE();
            const int mt = wave >> 1, nt = wave & 1;
            const bf16x8 a = *(const bf16x8*)(M + 11 * MSZ + (32 + 16 * mt + r) * LD + 32 + 8 * q), b = *(const bf16x8*)(TYT + (16 * nt + r) * LD + 8 * q);
            f32x4 acc = {0.f, 0.f, 0.f, 0.f};
            acc = __builtin_amdgcn_mfma_f32_16x16x32_bf16(a, b, acc, 0, 0, 0);
#pragma unroll
            for (int e = 0; e < 4; ++e) M[11 * MSZ + (32 + 16 * mt + 4 * q + e) * LD + 16 * nt + r] = f2bf(acc[e]);
        }
        __syncthreads();
        {
            RELANE();
            const int mt = wave & 3; const bf16_t* Asrc = M + (wave < 4 ? 4 : 1) * MSZ; bf16_t* dst = M + (wave < 4 ? 0 : 2) * MSZ;
#pragma unroll
            for (int nt = 0; nt < 4; ++nt) {
                f32x4 acc = {0.f, 0.f, 0.f, 0.f};
                acc = mma16_k64(Asrc + mt * 16 * LD, M + 11 * MSZ + nt * 16 * LD, acc, r, q);
#pragma unroll
                for (int e = 0; e < 4; ++e) dst[(16 * mt + 4 * q + e) * LD + 16 * nt + r] = f2bf(acc[e]);
            }
        }
        __syncthreads();
        {
            RELANE();
            const int job = wave >> 1;
            bf16_t* RPg = (bf16_t*)(wsz + WS_RWC_RP); bf16_t* MCg = (bf16_t*)(wsz + WS_RWC_MC); bf16_t* NCTg = (bf16_t*)(wsz + WS_RWC_NCT); float* Y0g = (float*)(wsz + WS_RWC_Y0);
#pragma unroll
            for (int m2 = 0; m2 < 2; ++m2) {
                const int mt = (wave & 1) * 2 + m2;
#pragma unroll
                for (int nt = 0; nt < 4; ++nt) {
                    const size_t ub = (size_t)unit * 4096;
                    if (job == 0) {
                        const bf16x4 in = *(const bf16x4*)(M + 3 * MSZ + (16 * nt + r) * LD + 16 * mt + 4 * q);
                        f32x4 acc = {bf2f((bf16_t)in[0]), bf2f((bf16_t)in[1]), bf2f((bf16_t)in[2]), bf2f((bf16_t)in[3])};
                        acc = mma16_k64(M + 0 * MSZ + mt * 16 * LD, M + 9 * MSZ + nt * 16 * LD, acc, r, q);
                        *(bf16x4*)(RPg + ub + (16 * nt + r) * 64 + 16 * mt + 4 * q) = pack4(acc);
                    } else if (job == 1) {
                        f32x4 acc = {0.f, 0.f, 0.f, 0.f};
                        acc = mma16_k64(M + 0 * MSZ + mt * 16 * LD, M + 5 * MSZ + nt * 16 * LD, acc, r, q);
                        const int k1 = 16 * nt + r; const float pl = PLs[k1];
#pragma unroll
                        for (int e = 0; e < 4; ++e) acc[e] += (16 * mt + 4 * q + e == k1) ? pl : 0.f;
                        *(bf16x4*)(MCg + ub + k1 * 64 + 32 * (mt >> 1) + 8 * q + 4 * (mt & 1)) = pack4(acc);
                    } else if (job == 2) {
                        f32x4 acc = {0.f, 0.f, 0.f, 0.f};
                        acc = mma16_k64(M + 2 * MSZ + mt * 16 * LD, M + 9 * MSZ + nt * 16 * LD, acc, r, q);
                        acc = mma16_k64(M + 7 * MSZ + mt * 16 * LD, M + 10 * MSZ + nt * 16 * LD, acc, r, q);
                        *(f32x4*)(Y0g + ub + (16 * nt + r) * 64 + 16 * mt + 4 * q) = acc;
                    } else {
                        f32x4 acc = {0.f, 0.f, 0.f, 0.f};
                        acc = mma16_k64(M + 5 * MSZ + mt * 16 * LD, M + 2 * MSZ + nt * 16 * LD, acc, r, q);
                        acc = mma16_k64(M + 6 * MSZ + mt * 16 * LD, M + 7 * MSZ + nt * 16 * LD, acc, r, q);
                        *(bf16x4*)(NCTg + ub + (16 * nt + r) * 64 + 16 * mt + 4 * q) = pack4(acc);
                    }
                }
            }
        }
        __syncthreads();
    }
}
#undef RELANE

constexpr int RW2_WGS = NP * 4 * 2;
constexpr int RW2_D = 8, RW2_SLOT = 2 * MSZ;
struct RwRegs { bf16x8 m0, m1, n0, n1; };
__device__ __forceinline__ void rw2_fetch(RwRegs& R, const bf16_t* mc, const bf16_t* nct, int c, int lt) {
    const int cc = c & (NCH - 1);
    R.m0 = *(const bf16x8*)(mc + (size_t)cc * 4096 + lt * 8); R.m1 = *(const bf16x8*)(mc + (size_t)cc * 4096 + 2048 + lt * 8);
    R.n0 = *(const bf16x8*)(nct + (size_t)cc * 4096 + lt * 8); R.n1 = *(const bf16x8*)(nct + (size_t)cc * 4096 + 2048 + lt * 8);
}
__device__ __forceinline__ void rw2_put(const RwRegs& R, bf16_t* slot, int lt) {
    const int row = lt >> 3, pc = lt & 7;
    *(bf16x8*)(slot + row * LD + pc * 8) = R.m0; *(bf16x8*)(slot + (row + 32) * LD + pc * 8) = R.m1;
    *(bf16x8*)(slot + MSZ + row * LD + pc * 8) = R.n0; *(bf16x8*)(slot + MSZ + (row + 32) * LD + pc * 8) = R.n1;
}
__device__ __forceinline__ void rw2_consume(f32x4 (&acc)[4], const bf16_t* slot, bf16_t* s0, int c, int r, int q, int v) {
    bf16x4 pk[4];
#pragma unroll
    for (int mt = 0; mt < 4; ++mt) { pk[mt] = pack4(acc[mt]); *(bf16x4*)(s0 + (size_t)c * 4096 + v * 64 + 16 * mt + 4 * q) = pk[mt]; }
    const bf16x8 b0 = {pk[0][0], pk[0][1], pk[0][2], pk[0][3], pk[1][0], pk[1][1], pk[1][2], pk[1][3]};
    const bf16x8 b1 = {pk[2][0], pk[2][1], pk[2][2], pk[2][3], pk[3][0], pk[3][1], pk[3][2], pk[3][3]};
#pragma unroll
    for (int mt = 0; mt < 4; ++mt) {
        const bf16x8 a0 = *(const bf16x8*)(slot + (16 * mt + r) * LD + 8 * q), a1 = *(const bf16x8*)(slot + (16 * mt + r) * LD + 32 + 8 * q);
        const bf16x4 nc = *(const bf16x4*)(slot + MSZ + v * LD + 16 * mt + 4 * q);
        f32x4 ci = {bf2f((bf16_t)nc[0]), bf2f((bf16_t)nc[1]), bf2f((bf16_t)nc[2]), bf2f((bf16_t)nc[3])};
        ci = __builtin_amdgcn_mfma_f32_16x16x32_bf16(a0, b0, ci, 0, 0, 0);
        acc[mt] = __builtin_amdgcn_mfma_f32_16x16x32_bf16(a1, b1, ci, 0, 0, 0);
    }
}
__device__ __forceinline__ void stage_rw2(const Params& p, int l, unsigned char* lds) {
    const Ctx cx = mkctx(p); const size_t z = cx.z;
    const int tid = cx.tid, lane = tid & 63, wave = __builtin_amdgcn_readfirstlane(tid >> 6), r = lane & 15, q = lane >> 4;
    if (cx.bid < RW2_WGS) {
        const int nh = cx.bid & (NP * 4 - 1), vh = cx.bid >> 3, v = 32 * vh + 16 * (wave & 1) + r;
        const bf16_t* mc = (const bf16_t*)(p.ws + z + WS_RWC_MC) + (size_t)nh * NCH * 4096;
        bf16_t* nct = (bf16_t*)(p.ws + z + WS_RWC_NCT) + (size_t)nh * NCH * 4096;
        bf16_t* L0 = (bf16_t*)lds; bf16_t* L1 = L0 + RW2_SLOT;
        f32x4 acc[4];
#pragma unroll
        for (int mt = 0; mt < 4; ++mt) acc[mt] = (f32x4){0.f, 0.f, 0.f, 0.f};
        const int lt = tid - 128;
        const bool b_is_m = lt < 128;
        const int pb = b_is_m ? lt + 384 : lt - 128;
        const bf16_t* srcA = mc + lt * 8;
        const bf16_t* srcB = b_is_m ? mc + pb * 8 : nct + (32 * vh) * 64 + pb * 8;
        const int dstA = (lt >> 3) * LD + (lt & 7) * 8;
        const int dstB = b_is_m ? (pb >> 3) * LD + (pb & 7) * 8 : MSZ + (32 * vh + (pb >> 3)) * LD + (pb & 7) * 8;
        struct RwHalf { bf16x8 a, b; };
        RwHalf H0, H1, H2, H3, H4, H5, H6, H7, H8, H9, H10, H11, H12, H13, H14, H15;
#define RW2_FETCH(HH, c) do { HH.a = *(const bf16x8*)(srcA + (size_t)(c) * 4096); HH.b = *(const bf16x8*)(srcB + (size_t)(c) * 4096); } while (0)
#define RW2_PUT(HH, slot) do { *(bf16x8*)((slot) + dstA) = HH.a; *(bf16x8*)((slot) + dstB) = HH.b; } while (0)
        if (wave >= 2) {
            { RwHalf F; RW2_FETCH(F, 0); RW2_PUT(F, L0); }
            RW2_FETCH(H0, 1); RW2_FETCH(H1, 2); RW2_FETCH(H2, 3); RW2_FETCH(H3, 4); RW2_FETCH(H4, 5); RW2_FETCH(H5, 6); RW2_FETCH(H6, 7); RW2_FETCH(H7, 8);
            RW2_FETCH(H8, 9); RW2_FETCH(H9, 10); RW2_FETCH(H10, 11); RW2_FETCH(H11, 12); RW2_FETCH(H12, 13); RW2_FETCH(H13, 14); RW2_FETCH(H14, 15); RW2_FETCH(H15, 16);
        }
        __syncthreads();
        if (wave >= 2) {
#define RW2_LSTEP(HH, c) do { RW2_PUT(HH, ((c) & 1) ? L0 : L1); RW2_FETCH(HH, (c) + 17); __syncthreads(); } while (0)
#pragma unroll 1
            for (int c = 0; c < NCH; c += 16) {
                RW2_LSTEP(H0, c); RW2_LSTEP(H1, c + 1); RW2_LSTEP(H2, c + 2); RW2_LSTEP(H3, c + 3); RW2_LSTEP(H4, c + 4); RW2_LSTEP(H5, c + 5); RW2_LSTEP(H6, c + 6); RW2_LSTEP(H7, c + 7);
                RW2_LSTEP(H8, c + 8); RW2_LSTEP(H9, c + 9); RW2_LSTEP(H10, c + 10); RW2_LSTEP(H11, c + 11); RW2_LSTEP(H12, c + 12); RW2_LSTEP(H13, c + 13); RW2_LSTEP(H14, c + 14); RW2_LSTEP(H15, c + 15);
            }
#undef RW2_LSTEP
        } else {
#pragma unroll 1
            for (int c = 0; c < NCH; c += 2) {
                rw2_consume(acc, L0, nct, c, r, q, v); __syncthreads();
                rw2_consume(acc, L1, nct, c + 1, r, q, v); __syncthreads();
            }
        }
#undef RW2_FETCH
#undef RW2_PUT
        if (wave < 2) {
            float* so = (p.out + z) + O_PWKV + ((size_t)l * NP * 4 + nh) * 4096 + v * 64 + 4 * q;
#pragma unroll
            for (int mt = 0; mt < 4; ++mt) *(f32x4*)(so + 16 * mt) = acc[mt];
        }
    }
}

__device__ __forceinline__ void stage_rw3(const Params& p, int l, int first = 0) {
    const Ctx cx = mkctx(p, first); const size_t z = cx.z;
    const int tid = cx.tid, lane = tid & 63, wave = tid >> 6, r = lane & 15, q = lane >> 4;
    const bf16_t* RWH = (const bf16_t*)(p.ws + z + WS_RW);
    const bf16_t* RPg = (const bf16_t*)(p.ws + z + WS_RWC_RP); const bf16_t* S0g = (const bf16_t*)(p.ws + z + WS_RWC_NCT);
    const float* Y0g = (const float*)(p.ws + z + WS_RWC_Y0);
    bf16_t* Y = (bf16_t*)(p.ws + z + WS_YCAT);
    for (int it = cx.bid; it < RW_UNITS / 2; it += cx.nb) {
        const int c = (it & 63) * 2 + (wave >> 2), nh = it >> 6, n = nh >> 2, h = nh & 3, unit = nh * NCH + c, nt = wave & 3;
        const int t = 16 * nt + r, row = n * T + c * RWL + t;
        const size_t ub = (size_t)unit * 4096;
        const bf16x8 rp0 = *(const bf16x8*)(RPg + ub + t * 64 + 8 * q), rp1 = *(const bf16x8*)(RPg + ub + t * 64 + 32 + 8 * q);
        const bf16_t* rw = RWH + (size_t)row * 1536 + h * 64;
        f32x4 y[4]; float sum = 0.f, bd = 0.f;
#pragma unroll
        for (int mt = 0; mt < 4; ++mt) {
            const bf16x8 s0 = *(const bf16x8*)(S0g + ub + (16 * mt + r) * 64 + 8 * q), s1 = *(const bf16x8*)(S0g + ub + (16 * mt + r) * 64 + 32 + 8 * q);
            f32x4 acc = *(const f32x4*)(Y0g + ub + t * 64 + 16 * mt + 4 * q);
            acc = __builtin_amdgcn_mfma_f32_16x16x32_bf16(s0, rp0, acc, 0, 0, 0);
            acc = __builtin_amdgcn_mfma_f32_16x16x32_bf16(s1, rp1, acc, 0, 0, 0);
            y[mt] = acc; sum += (acc[0] + acc[1]) + (acc[2] + acc[3]);
            const f32x4 rr = ld4bf(rw + 16 * mt + 4 * q), km = ld4bf(rw + 256 + 16 * mt + 4 * q), rk = *(const f32x4*)(PIN(I_RK) + (size_t)l * 256 + h * 64 + 16 * mt + 4 * q);
            bd += (rr[0] * km[0] * rk[0] + rr[1] * km[1] * rk[1]) + (rr[2] * km[2] * rk[2] + rr[3] * km[3] * rk[3]);
        }
        sum += __shfl_xor(sum, 16); sum += __shfl_xor(sum, 32);
        bd += __shfl_xor(bd, 16); bd += __shfl_xor(bd, 32);
        const float mean = sum * (1.f / 64.f); float vs = 0.f;
#pragma unroll
        for (int mt = 0; mt < 4; ++mt)
#pragma unroll
            for (int e = 0; e < 4; ++e) { const float d_ = y[mt][e] - mean; vs += d_ * d_; }
        vs += __shfl_xor(vs, 16); vs += __shfl_xor(vs, 32);
        const float rstd = rsqrtf(vs * (1.f / 64.f) + GN_EPS);
#pragma unroll
        for (int mt = 0; mt < 4; ++mt) {
            const int vi = 16 * mt + 4 * q;
            const f32x4 vv = ld4bf(rw + 512 + vi), gg = ld4bf(rw + 1280 + vi);
            const f32x4 lg = *(const f32x4*)(PIN(I_LNG) + (size_t)l * 256 + h * 64 + vi), lb = *(const f32x4*)(PIN(I_LNB) + (size_t)l * 256 + h * 64 + vi);
            f32x4 o;
#pragma unroll
            for (int e = 0; e < 4; ++e) o[e] = ((y[mt][e] - mean) * rstd * lg[e] + lb[e] + bd * vv[e]) * gg[e];
            *(bf16x4*)(Y + (size_t)row * D + h * 64 + vi) = pack4(o);
        }
    }
}

__device__ __forceinline__ void stage_qkn(const Params& p, int l) {
    const Ctx cx = mkctx(p); const size_t z = cx.z;
    const int lane = cx.tid & 63, gw = cx.bid * NWAVES + (cx.tid >> 6), GW = cx.nb * NWAVES;
    const bf16_t* P = (const bf16_t*)(p.ws + z + WS_P);
    float* QN = (float*)(p.ws + z + WS_QN); float* KN = (float*)(p.ws + z + WS_KN);
    for (int it = MP * 6 + gw; it < R * 6; it += GW) {
        const int row = it / 6, unit = it % 6;
        const bool samp = row >= MP; const int n = samp ? row - MP : row >> 13, t = samp ? 0 : (row & (T - 1));
        const float x = bf2f(P[(size_t)row * PCOLS + OFF_B + unit * 64 + lane]);
        const float ss = wave_sum(x * x) * (1.f / 64.f);
        const float g = unit < 4 ? PIN(I_QNG)[(size_t)l * 64 + lane] : PIN(I_KNG)[(size_t)l * 64 + lane];
        const float y = x * rsqrtf(ss + NORM_EPS) * g;
        if (unit < 4) QN[(size_t)row * 256 + unit * 64 + lane] = y;
        else {
            const int kvh = unit - 4;
            KN[(size_t)row * 128 + kvh * 64 + lane] = y;
            const float v = bf2f(P[(size_t)row * PCOLS + OFF_B + 384 + kvh * 64 + lane]);
            if (samp) { const size_t o = (((size_t)l * NS + n) * 128 + 127) * 128 + kvh * 64 + lane; (p.out + z)[O_SK + o] = y; (p.out + z)[O_SV + o] = v; }
            else if (t >= T - 128) { const size_t o = (((size_t)l * NP + n) * 128 + (t - (T - 128))) * 128 + kvh * 64 + lane; (p.out + z)[O_PK + o] = y; (p.out + z)[O_PV + o] = v; }
        }
    }
}

__device__ __forceinline__ void stage_cachecopy(const Params& p, int l, int first = 0) {
    const Ctx cx = mkctx(p, first); const size_t z = cx.z;
    {
        typedef float f4 __attribute__((ext_vector_type(4)));
        const unsigned gt4 = (unsigned)cx.bid * NTHREADS + cx.tid, GT4 = (unsigned)cx.nb * NTHREADS;
        for (unsigned i = gt4; i < (unsigned)NS * 4064; i += GT4) {
            const unsigned n = i / 4064u, o4 = i - n * 4064u;
            const size_t src = (((size_t)l * NS + n) * 128 + 1) * 128 + (size_t)o4 * 4, dst = ((size_t)l * NS + n) * 128 * 128 + (size_t)o4 * 4;
            *(f4*)((p.out + z) + O_SK + dst) = *(const f4*)(PIN(I_CK) + src); *(f4*)((p.out + z) + O_SV + dst) = *(const f4*)(PIN(I_CV) + src);
        }
    }
}

__device__ __forceinline__ void stage_att(const Params& p, int l, int first = 0) {
    const Ctx cx = mkctx(p, first); const size_t z = cx.z;
    const int lane = cx.tid & 63, gw = cx.bid * NWAVES + (cx.tid >> 6), GW = cx.nb * NWAVES;
    const bf16_t* P = (const bf16_t*)(p.ws + z + WS_P);
    const float* QN = (const float*)(p.ws + z + WS_QN); const float* KN = (const float*)(p.ws + z + WS_KN);
    bf16_t* Y = (bf16_t*)(p.ws + z + WS_YCAT);
    for (int it = MP * 4 + gw; it < R * 4; it += GW) {
        const int row = it >> 2, hq = it & 3, kvh = hq >> 1;
        const bool samp = row >= MP; const int n = samp ? row - MP : row >> 13, t = samp ? 0 : (row & (T - 1));
        const int rowbase = row - t;
        const float* q = QN + (size_t)row * 256 + hq * 64;
        const float sink = PIN(I_SINK)[(size_t)l * 4 + hq];
        f32x4 qreg[16];
#pragma unroll
        for (int d4 = 0; d4 < 16; ++d4) qreg[d4] = *(const f32x4*)(q + 4 * d4);
        float sc[3]; float mx = -INFINITY;
#pragma unroll
        for (int j = 0; j < 3; ++j) {
            const int i = lane + 64 * j; sc[j] = -INFINITY;
            if (i <= 128) {
                const int pos = t - 128 + i;
                const float* kp = nullptr;
                if (pos >= 0) kp = KN + (size_t)(rowbase + pos) * 128 + kvh * 64;
                else if (samp) kp = PIN(I_CK) + (((size_t)l * NS + n) * 128 + i) * 128 + kvh * 64;
                if (kp) { float s = 0.f;
#pragma unroll
                    for (int hf = 0; hf < 2; ++hf) {
                        f32x4 kv[8];
#pragma unroll
                        for (int d4 = 0; d4 < 8; ++d4) kv[d4] = *(const f32x4*)(kp + 32 * hf + 4 * d4);
#pragma unroll
                        for (int d4 = 0; d4 < 8; ++d4) { const f32x4 qv = qreg[8 * hf + d4]; s += (qv[0] * kv[d4][0] + qv[1] * kv[d4][1]) + (qv[2] * kv[d4][2] + qv[3] * kv[d4][3]); }
                        __builtin_amdgcn_sched_barrier(0);
                    }
                    sc[j] = s * 0.125f; }
            }
            mx = fmaxf(mx, sc[j]);
            __builtin_amdgcn_sched_barrier(0);
        }
        mx = fmaxf(wave_max(mx), sink);
        float pr[3]; float sum = 0.f;
#pragma unroll
        for (int j = 0; j < 3; ++j) { pr[j] = sc[j] == -INFINITY ? 0.f : __expf(sc[j] - mx); sum += pr[j]; }
        sum = wave_sum(sum) + __expf(sink - mx);
        float o = 0.f;
        for (int i = 0; i <= 128; ++i) {
            const float prs = i < 64 ? pr[0] : (i < 128 ? pr[1] : pr[2]);
            const float pi = __shfl(prs, i & 63);
            const int pos = t - 128 + i;
            float v = 0.f;
            if (pos >= 0) v = bf2f(P[(size_t)(rowbase + pos) * PCOLS + OFF_B + 384 + kvh * 64 + lane]);
            else if (samp) v = PIN(I_CV)[(((size_t)l * NS + n) * 128 + i) * 128 + kvh * 64 + lane];
            o += pi * v;
        }
        Y[(size_t)row * D + 256 + hq * 64 + lane] = f2bf(o / sum);
    }
}

constexpr int LDV = 264;
__device__ __forceinline__ void stage_attn(const Params& p, int l, unsigned char* lds, int first = 0) {
    const Ctx cx = mkctx(p, first); const size_t z = cx.z;
    const int tid = cx.tid, lane = tid & 63, wave = __builtin_amdgcn_readfirstlane(tid >> 6), r = lane & 15, q = lane >> 4;
    bf16_t* Ks = (bf16_t*)lds;
    bf16_t* Qs = (bf16_t*)(lds + 36864);
    bf16_t* Vt = (bf16_t*)(lds + 73728);
    const bf16_t* P = (const bf16_t*)(p.ws + z + WS_P);
    bf16_t* Y = (bf16_t*)(p.ws + z + WS_YCAT);
    for (int unit = cx.bid; unit < NP * 2 * (T / 128); unit += cx.nb) {
        const int b = unit & 63, kvh = (unit >> 6) & 1, n = unit >> 7, t0 = b * 128;
        const size_t rowb = (size_t)n * T;
        float gk[8], gq[8];
#pragma unroll
        for (int j = 0; j < 8; ++j) { gk[j] = PIN(I_KNG)[(size_t)l * 64 + (tid & 7) * 8 + j]; gq[j] = PIN(I_QNG)[(size_t)l * 64 + (tid & 7) * 8 + j]; }
        bf16x8 kraw[4], qraw[4], vraw[4];
#pragma unroll
        for (int it = 0; it < 4; ++it) {
            const int task = it * NTHREADS + tid, c8 = task & 7, kk = task >> 3, kp = t0 - 128 + kk, g = kk >> 7, tl = kk & 127;
            const bf16x8 zz = {0, 0, 0, 0, 0, 0, 0, 0};
            kraw[it] = kp >= 0 ? *(const bf16x8*)(P + (rowb + kp) * PCOLS + OFF_B + 256 + kvh * 64 + c8 * 8) : zz;
            qraw[it] = *(const bf16x8*)(P + (rowb + t0 + tl) * PCOLS + OFF_B + (kvh * 2 + g) * 64 + c8 * 8);
            const int d = task & 63, m0 = (task >> 6) * 8;
#pragma unroll
            for (int j = 0; j < 8; ++j) { const int vp = t0 - 128 + m0 + j; vraw[it][j] = vp >= 0 ? (short)P[(rowb + vp) * PCOLS + OFF_B + 384 + kvh * 64 + d] : (short)0; }
        }
#pragma unroll
        for (int it = 0; it < 4; ++it) {
            const int task = it * NTHREADS + tid, c8 = task & 7;
            {
                const int kk = task >> 3;
                float x[8]; float ss = 0.f;
#pragma unroll
                for (int j = 0; j < 8; ++j) { x[j] = bf2f((bf16_t)kraw[it][j]); ss += x[j] * x[j]; }
                ss += __shfl_xor(ss, 1); ss += __shfl_xor(ss, 2); ss += __shfl_xor(ss, 4);
                const float rstd = rsqrtf(ss * (1.f / 64.f) + NORM_EPS);
                bf16x8 o;
#pragma unroll
                for (int j = 0; j < 8; ++j) { x[j] = x[j] * rstd * gk[j]; o[j] = (short)f2bf(x[j]); }
                *(bf16x8*)(Ks + kk * LD + c8 * 8) = o;
                if (b == 63 && kk >= 128) { float* ko = (p.out + z) + O_PK + (((size_t)l * NP + n) * 128 + (kk - 128)) * 128 + kvh * 64 + c8 * 8;
#pragma unroll
                    for (int j = 0; j < 8; ++j) ko[j] = x[j]; }
            }
            {
                const int qr = task >> 3;
                float x[8]; float ss = 0.f;
#pragma unroll
                for (int j = 0; j < 8; ++j) { x[j] = bf2f((bf16_t)qraw[it][j]); ss += x[j] * x[j]; }
                ss += __shfl_xor(ss, 1); ss += __shfl_xor(ss, 2); ss += __shfl_xor(ss, 4);
                const float rstd = rsqrtf(ss * (1.f / 64.f) + NORM_EPS) * 0.125f;
                bf16x8 o;
#pragma unroll
                for (int j = 0; j < 8; ++j) o[j] = (short)f2bf(x[j] * rstd * gq[j]);
                *(bf16x8*)(Qs + qr * LD + c8 * 8) = o;
            }
            {
                const int d = task & 63, m0 = (task >> 6) * 8;
                *(bf16x8*)(Vt + d * LDV + m0) = vraw[it];
                if (b == 63 && m0 >= 128) { float* vo = (p.out + z) + O_PV + (((size_t)l * NP + n) * 128 + (m0 - 128)) * 128 + kvh * 64 + d;
#pragma unroll
                    for (int j = 0; j < 8; ++j) vo[j * 128] = bf2f((bf16_t)vraw[it][j]); }
            }
        }
        __syncthreads();
        {
            const int g = wave >> 2, sb = wave & 3, hq = kvh * 2 + g;
            const float sink = PIN(I_SINK)[(size_t)l * 4 + hq];
#pragma unroll 1
            for (int mt = 0; mt < 2; ++mt) {
                const int ql = 32 * sb + 16 * mt + r;
                const bf16_t* Qb = Qs + (g * 128 + 32 * sb + 16 * mt) * LD;
                f32x4 sacc[10]; float mx = -INFINITY;
#pragma unroll
                for (int j = 0; j < 10; ++j) {
                    f32x4 a = {0.f, 0.f, 0.f, 0.f};
                    a = mma16_k64(Ks + (32 * sb + 16 * j) * LD, Qb, a, r, q);
#pragma unroll
                    for (int e = 0; e < 4; ++e) { const int kk = 32 * sb + 16 * j + 4 * q + e, rel = ql + 128 - kk;
                        const bool ok = rel >= 0 && rel <= 128 && (t0 - 128 + kk) >= 0;
                        a[e] = ok ? a[e] : -INFINITY; mx = fmaxf(mx, a[e]); }
                    sacc[j] = a;
                    __builtin_amdgcn_sched_barrier(0);
                }
                mx = fmaxf(mx, __shfl_xor(mx, 16)); mx = fmaxf(mx, __shfl_xor(mx, 32)); mx = fmaxf(mx, sink);
                float sum = 0.f;
#pragma unroll
                for (int j = 0; j < 10; ++j)
#pragma unroll
                    for (int e = 0; e < 4; ++e) { const float pv = __expf(sacc[j][e] - mx); sacc[j][e] = pv; sum += pv; }
                sum += __shfl_xor(sum, 16); sum += __shfl_xor(sum, 32); sum += __expf(sink - mx);
                const float inv = 1.f / sum;
                f32x4 o[4];
#pragma unroll
                for (int dt = 0; dt < 4; ++dt) o[dt] = (f32x4){0.f, 0.f, 0.f, 0.f};
#pragma unroll
                for (int s2 = 0; s2 < 5; ++s2) {
                    const bf16x4 p0 = pack4(sacc[2 * s2]), p1 = pack4(sacc[2 * s2 + 1]);
                    const bf16x8 pb = {p0[0], p0[1], p0[2], p0[3], p1[0], p1[1], p1[2], p1[3]};
#pragma unroll
                    for (int dt = 0; dt < 4; ++dt) {
                        const bf16_t* vp = Vt + (16 * dt + r) * LDV + 32 * sb + 32 * s2 + 4 * q;
                        const bf16x4 v0 = *(const bf16x4*)vp, v1 = *(const bf16x4*)(vp + 16);
                        const bf16x8 va = {v0[0], v0[1], v0[2], v0[3], v1[0], v1[1], v1[2], v1[3]};
                        o[dt] = __builtin_amdgcn_mfma_f32_16x16x32_bf16(va, pb, o[dt], 0, 0, 0);
                    }
                    __builtin_amdgcn_sched_barrier(0);
                }
                bf16_t* yo = Y + (rowb + t0 + ql) * D + 256 + hq * 64 + 4 * q;
#pragma unroll
                for (int dt = 0; dt < 4; ++dt) { f32x4 ov = o[dt] * inv; *(bf16x4*)(yo + 16 * dt) = pack4(ov); }
            }
        }
        __syncthreads();
    }
}

__device__ __forceinline__ void mconv_unit(const Params& p, size_t z, int l, int n, int c, int g, int tid) {
    const bf16_t* P = (const bf16_t*)(p.ws + z + WS_P);
    bf16_t* XB = (bf16_t*)(p.ws + z + WS_XBCC);
    const float* cw = PIN(I_CONVW) + (size_t)l * 4 * 1024; const float* cb = PIN(I_CONVB) + (size_t)l * 1024;
#pragma unroll 1
    for (int i = tid; i < 1024; i += NTHREADS) {
        const int ch = i & 63, c0 = ch < 32 ? g * 256 + ch * 8 : (ch < 48 ? 512 + g * 128 + (ch - 32) * 8 : 768 + g * 128 + (ch - 48) * 8);
        const int row = n * T + c * 128 + (i >> 6) * 8, t = row & (T - 1);
        bf16x8 u[11];
#pragma unroll
        for (int k = 0; k < 11; ++k) { const bf16x8 zz = {0, 0, 0, 0, 0, 0, 0, 0}; u[k] = (t - 3 + k >= 0) ? *(const bf16x8*)(P + (size_t)(row - 3 + k) * PCOLS + OFF_XBC + c0) : zz; }
        float w[4][8], b[8];
#pragma unroll
        for (int e = 0; e < 8; ++e) { b[e] = cb[c0 + e];
#pragma unroll
            for (int j = 0; j < 4; ++j) w[j][e] = cw[j * 1024 + c0 + e]; }
#pragma unroll
        for (int r = 0; r < 8; ++r) { bf16x8 o;
#pragma unroll
            for (int e = 0; e < 8; ++e) { float acc = b[e];
#pragma unroll
                for (int j = 0; j < 4; ++j) acc += w[j][e] * bf2f((bf16_t)u[r + j][e]);
                o[e] = (short)f2bf(silu_f(acc)); }
            *(bf16x8*)(XB + (size_t)(row + r) * 1024 + c0) = o;
            if (t + r >= T - 3) { float* op = (p.out + z) + O_PCONV + (((size_t)l * NP + n) * 3 + (t + r - (T - 3))) * 1024 + c0;
#pragma unroll
                for (int e = 0; e < 8; ++e) op[e] = bf2f((bf16_t)u[3 + r][e]); }
        }
    }
}

__device__ __forceinline__ void stage_mconv(const Params& p, int l) {
    const Ctx cx = mkctx(p); const size_t z = cx.z;
    const unsigned gt = (unsigned)cx.bid * NTHREADS + cx.tid, GT = (unsigned)cx.nb * NTHREADS;
    const bf16_t* P = (const bf16_t*)(p.ws + z + WS_P);
    bf16_t* XB = (bf16_t*)(p.ws + z + WS_XBCC); float* DT = (float*)(p.ws + z + WS_DT);
    const float* cw = PIN(I_CONVW) + (size_t)l * 4 * 1024; const float* cb = PIN(I_CONVB) + (size_t)l * 1024;
    for (unsigned i = (unsigned)MP * 1024 + gt; i < (unsigned)R * 1024; i += GT) {
        const int c = (int)(i & 1023), row = (int)(i >> 10), n = row - MP;
        const float* st = PIN(I_SCONV) + ((size_t)l * NS + n) * 3 * 1024 + c;
        const float raw = bf2f(P[(size_t)row * PCOLS + OFF_XBC + c]);
        const float acc = cb[c] + cw[c] * st[0] + cw[1024 + c] * st[1024] + cw[2048 + c] * st[2048] + cw[3072 + c] * raw;
        XB[i] = f2bf(silu_f(acc));
        float* o = (p.out + z) + O_SCONV + ((size_t)l * NS + n) * 3 * 1024 + c;
        o[0] = st[1024]; o[1024] = st[2048]; o[2048] = raw;
    }
    float* DT2 = (float*)(p.ws + z + WS_DT2);
    for (unsigned i = (unsigned)MP * 8 + gt; i < (unsigned)R * 8; i += GT) DT2[i] = softplus_f(DT[i] + PIN(I_DTB)[(size_t)l * 8 + (i & 7)]);
}

__device__ __forceinline__ void stage_mscan(const Params& p, int l, float* lds, int first = 0) {
    const Ctx cx = mkctx(p, first); const size_t z = cx.z;
    const int lane = cx.tid & 63, wave = cx.tid >> 6;
    const bf16_t* XB = (const bf16_t*)(p.ws + z + WS_XBCC); const float* DT = (const float*)(p.ws + z + WS_DT2);
    float* YT = (float*)(p.ws + z + WS_YTMP);
    float* wl = lds + wave * 512;
    const int dh = lane & 1, pl = lane >> 1;
    for (int u = NP * 16 + cx.bid + cx.nb * wave; u < NSEQ * 16; u += cx.nb * NWAVES) {
        const int s = u >> 4, h = (u >> 1) & 7, ph = u & 1, g = h >> 2; const bool samp = s >= NP; const int n = samp ? s - NP : s;
        const int row0 = samp ? MP + n : n * T, nt = samp ? 1 : T, pp = ph * 32 + pl;
        float hs[64];
        if (samp) { const float* st = PIN(I_SSM) + ((((size_t)l * NS + n) * 8 + h) * 64 + pp) * 128 + dh * 64;
#pragma unroll
            for (int d = 0; d < 64; d += 4) { const f32x4 v4 = *(const f32x4*)(st + d); hs[d] = v4[0]; hs[d + 1] = v4[1]; hs[d + 2] = v4[2]; hs[d + 3] = v4[3]; } }
        else {
#pragma unroll
            for (int d = 0; d < 64; ++d) hs[d] = 0.f; }
        const float A = -__expf(PIN(I_ALOG)[(size_t)l * 8 + h]), Dh = PIN(I_SSMD)[(size_t)l * 8 + h];
        for (int t = 0; t < nt; ++t) {
            const size_t row = (size_t)row0 + t;
            const float dtv = DT[row * 8 + h], dA = __expf(dtv * A);
            const float x = bf2f(XB[row * 1024 + h * 64 + pp]), xdt = x * dtv;
            const bf16_t* b = XB + row * 1024 + 512 + g * 128; const bf16_t* c = XB + row * 1024 + 768 + g * 128;
            WAVE_LDS_SYNC();
            wl[lane] = bf2f(b[lane]); wl[64 + lane] = bf2f(b[64 + lane]); wl[128 + lane] = bf2f(c[lane]); wl[192 + lane] = bf2f(c[64 + lane]);
            WAVE_LDS_SYNC();
            float y = 0.f;
#pragma unroll
            for (int d = 0; d < 64; ++d) { hs[d] = hs[d] * dA + xdt * wl[dh * 64 + d]; y += hs[d] * wl[128 + dh * 64 + d]; }
            y += __shfl_xor(y, 1);
            if (dh == 0) YT[row * 512 + h * 64 + pp] = y + Dh * x;
        }
        float* so = (p.out + z) + (samp ? O_SSSM + ((((size_t)l * NS + n) * 8 + h) * 64 + pp) * 128 : O_PSSM + ((((size_t)l * NP + n) * 8 + h) * 64 + pp) * 128) + dh * 64;
#pragma unroll
        for (int d = 0; d < 64; d += 4) *(f32x4*)(so + d) = (f32x4){hs[d], hs[d + 1], hs[d + 2], hs[d + 3]};
    }
}

__device__ __forceinline__ void mgate_rows(const Params& p, size_t z, int l, int row_lo, int row_hi, int gw, int GW, int lane) {
    const bf16_t* P = (const bf16_t*)(p.ws + z + WS_P); const float* YT = (const float*)(p.ws + z + WS_YTMP);
    bf16_t* Y = (bf16_t*)(p.ws + z + WS_YCAT);
    const f32x4 g0 = *(const f32x4*)(PIN(I_SSMNG) + (size_t)l * 512 + lane * 8), g1 = *(const f32x4*)(PIN(I_SSMNG) + (size_t)l * 512 + lane * 8 + 4);
    for (int row = row_lo + 2 * gw; row < row_hi; row += 2 * GW) {
        f32x4 ya[2][2]; bf16x8 zz[2];
#pragma unroll
        for (int k = 0; k < 2; ++k) { ya[k][0] = *(const f32x4*)(YT + (size_t)(row + k) * 512 + lane * 8); ya[k][1] = *(const f32x4*)(YT + (size_t)(row + k) * 512 + lane * 8 + 4);
            zz[k] = *(const bf16x8*)(P + (size_t)(row + k) * PCOLS + OFF_Z + lane * 8); }
#pragma unroll
        for (int k = 0; k < 2; ++k) {
            float v[8]; float ss = 0.f;
#pragma unroll
            for (int e = 0; e < 8; ++e) { v[e] = ya[k][e >> 2][e & 3] * silu_f(bf2f((bf16_t)zz[k][e])); ss += v[e] * v[e]; }
            const float rstd = rsqrtf(wave_sum(ss) * (1.f / 512.f) + NORM_EPS);
            bf16x8 o;
#pragma unroll
            for (int e = 0; e < 8; ++e) o[e] = (short)f2bf(v[e] * rstd * (e < 4 ? g0[e & 3] : g1[e & 3]));
            *(bf16x8*)(Y + (size_t)(row + k) * D + 512 + lane * 8) = o;
        }
    }
}
constexpr int SL = 128, SNC = T / SL;
__device__ __forceinline__ f32x4 mma16(const bf16_t* A, const bf16_t* Bt, int nsteps, f32x4 acc, int r, int q) {
#pragma unroll
    for (int s = 0; s < 4; ++s) if (s < nsteps) {
        const bf16x8 a = *(const bf16x8*)(A + r * LD2 + 32 * s + 8 * q), b = *(const bf16x8*)(Bt + r * LD2 + 32 * s + 8 * q);
        acc = __builtin_amdgcn_mfma_f32_16x16x32_bf16(a, b, acc, 0, 0, 0);
    }
    return acc;
}
constexpr int SSD_OFF_AUX = 104448;
template <bool FROM_RAW>
__device__ __forceinline__ void ssd_aux(const Params& p, size_t z, int l, int g, int row0, float* aux, int tid) {
    float* DT2 = (float*)(p.ws + z + WS_DT2);
    const int t = tid & 127, e = tid >> 7, h = g * 4 + e;
    float dtv;
    if (FROM_RAW) { dtv = softplus_f(((const float*)(p.ws + z + WS_DT))[(size_t)(row0 + t) * 8 + h] + PIN(I_DTB)[(size_t)l * 8 + h]); DT2[(size_t)(row0 + t) * 8 + h] = dtv; }
    else dtv = DT2[(size_t)(row0 + t) * 8 + h];
    const float A = -__expf(PIN(I_ALOG)[(size_t)l * 8 + h]);
    aux[e * 128 + t] = dtv; aux[512 + e * 128 + t] = dtv * A;
    __syncthreads();
    float acc = 0.f;
    for (int i = 0; i <= t; ++i) acc += aux[512 + e * 128 + i];
    aux[1024 + e * 128 + t] = acc;
    __syncthreads();
}
__device__ __forceinline__ void stage_ssd1(const Params& p, int l, unsigned char* lds) {
    const Ctx cx = mkctx(p); const size_t z = cx.z;
    const int tid = cx.tid, lane = tid & 63, wave = __builtin_amdgcn_readfirstlane(tid >> 6), r = lane & 15, q = lane >> 4;
    bf16_t* BT = (bf16_t*)lds;
    bf16_t* XW = (bf16_t*)(lds + 34816);
    float* aux = (float*)(lds + SSD_OFF_AUX);
    const bf16_t* XB = (const bf16_t*)(p.ws + z + WS_XBCC);
    float* ST = (float*)(p.ws + z + WS_SST); float* CD = (float*)(p.ws + z + WS_SCD);
    for (int unit = cx.bid; unit < NP * SNC * 2; unit += cx.nb) {
        const int g = unit & 1, c = (unit >> 1) & (SNC - 1), n = unit >> 7, row0 = n * T + c * SL;
        mconv_unit(p, z, l, n, c, g, tid);
        asm volatile("s_waitcnt vmcnt(0)" ::: "memory"); __syncthreads();
        const int d = tid & 127, mg = tid >> 7, pp = tid & 63, mgp = tid >> 6;
        bf16x8 bv[4], xv[4][2];
#pragma unroll
        for (int it = 0; it < 4; ++it) { const int m0 = mg * 32 + it * 8;
#pragma unroll
            for (int j = 0; j < 8; ++j) bv[it][j] = (short)XB[(size_t)(row0 + m0 + j) * 1024 + 512 + g * 128 + d]; }
#pragma unroll
        for (int e = 0; e < 4; ++e)
#pragma unroll
            for (int it = 0; it < 2; ++it) { const int m0 = mgp * 16 + it * 8;
#pragma unroll
                for (int j = 0; j < 8; ++j) xv[e][it][j] = (short)XB[(size_t)(row0 + m0 + j) * 1024 + (g * 4 + e) * 64 + pp]; }
        ssd_aux<true>(p, z, l, g, row0, aux, tid);
        {
#pragma unroll
            for (int it = 0; it < 4; ++it) *(bf16x8*)(BT + d * LD2 + mg * 32 + it * 8) = bv[it];
#pragma unroll
            for (int e = 0; e < 4; ++e) { const float alast = aux[1024 + e * 128 + 127];
#pragma unroll
                for (int it = 0; it < 2; ++it) { const int m0 = mgp * 16 + it * 8; bf16x8 v;
#pragma unroll
                    for (int j = 0; j < 8; ++j) { const int m = m0 + j; v[j] = (short)f2bf(bf2f((bf16_t)xv[e][it][j]) * aux[e * 128 + m] * __expf(alast - aux[1024 + e * 128 + m])); }
                    *(bf16x8*)(XW + e * 64 * LD2 + pp * LD2 + m0) = v; } }
        }
        __syncthreads();
#pragma unroll
        for (int e = 0; e < 4; ++e) {
            float* st = ST + ((size_t)(n * SNC + c) * 8 + g * 4 + e) * 8192;
#pragma unroll
            for (int nt = 0; nt < 4; ++nt) {
                f32x4 acc = {0.f, 0.f, 0.f, 0.f};
                acc = mma16(BT + 16 * wave * LD2, XW + e * 64 * LD2 + 16 * nt * LD2, 4, acc, r, q);
                *(f32x4*)(st + (16 * nt + r) * 128 + 16 * wave + 4 * q) = acc;
            }
        }
        if (tid < 4) CD[(size_t)(n * SNC + c) * 8 + g * 4 + tid] = __expf(aux[1024 + tid * 128 + 127]);
        __syncthreads();
    }
}
__device__ __forceinline__ void stage_ssd2(const Params& p, int l) {
    const Ctx cx = mkctx(p); const size_t z = cx.z;
    const int first = cx.nb > 32 ? RW2_WGS : 0;
    if (cx.bid >= first) {
        typedef float f32x2 __attribute__((ext_vector_type(2)));
        const float* ST = (const float*)(p.ws + z + WS_SST); const float* CD = (const float*)(p.ws + z + WS_SCD);
        unsigned* HPV = (unsigned*)(p.ws + z + WS_HPREV);
        for (int idx = (cx.bid - first) * NTHREADS + cx.tid; idx < NP * 8 * 4096; idx += (cx.nb - first) * NTHREADS) {
            const int n = idx >> 15, h = (idx >> 12) & 7, pd = (idx & 4095) * 2;
            const float* base = ST + ((size_t)(n * SNC) * 8 + h) * 8192 + pd; const float* cd = CD + (size_t)(n * SNC) * 8 + h;
            unsigned* hb = HPV + (((size_t)(n * SNC) * 8 + h) * 8192 + pd) / 2;
            f32x2 hc = {0.f, 0.f};
#pragma unroll 1
            for (int c0 = 0; c0 < SNC; c0 += 16) {
                f32x2 v[16]; float dcy[16];
#pragma unroll
                for (int k = 0; k < 16; ++k) { v[k] = *(const f32x2*)(base + (size_t)(c0 + k) * 65536); dcy[k] = cd[(c0 + k) * 8]; }
#pragma unroll
                for (int k = 0; k < 16; ++k) { hb[(size_t)(c0 + k) * 32768] = cvtpk(hc[0], hc[1]); hc = hc * dcy[k] + v[k]; }
            }
            *(f32x2*)((p.out + z) + O_PSSM + ((size_t)(l * NP + n) * 8 + h) * 8192 + pd) = hc;
        }
    }
}
__device__ __forceinline__ void stage_ssd3(const Params& p, int l, unsigned char* lds, int first = 0, int count = 0) {
    const Ctx cx = mkctx(p, first, count); const size_t z = cx.z;
    const int tid = cx.tid, lane = tid & 63, wave = __builtin_amdgcn_readfirstlane(tid >> 6), r = lane & 15, q = lane >> 4;
    bf16_t* CM = (bf16_t*)lds;
    bf16_t* BG = (bf16_t*)(lds + 34816);
    bf16_t* XT = (bf16_t*)(lds + 69632);
    bf16_t* HP = (bf16_t*)(lds + 87040);
    float* aux = (float*)(lds + SSD_OFF_AUX);
    const bf16_t* XB = (const bf16_t*)(p.ws + z + WS_XBCC);
    const bf16_t* HPV = (const bf16_t*)(p.ws + z + WS_HPREV);
    float* YT = (float*)(p.ws + z + WS_YTMP);
    for (int u2 = cx.bid; u2 < NP * SNC; u2 += cx.nb)
    for (int g = 0; g < 2; ++g) {
        const int c = u2 & (SNC - 1), n = u2 >> 6, row0 = n * T + c * SL;
        bf16x8 cc[4], bb[4];
        {
            const int d0 = (tid & 15) * 8;
#pragma unroll
            for (int it = 0; it < 4; ++it) { const int row = (tid >> 4) + 32 * it;
                cc[it] = *(const bf16x8*)(XB + (size_t)(row0 + row) * 1024 + 768 + g * 128 + d0); bb[it] = *(const bf16x8*)(XB + (size_t)(row0 + row) * 1024 + 512 + g * 128 + d0); }
        }
        ssd_aux<false>(p, z, l, g, row0, aux, tid);
        {
            const int d0 = (tid & 15) * 8;
#pragma unroll
            for (int it = 0; it < 4; ++it) { const int row = (tid >> 4) + 32 * it; *(bf16x8*)(CM + row * LD2 + d0) = cc[it]; *(bf16x8*)(BG + row * LD2 + d0) = bb[it]; }
        }
        __syncthreads();
        f32x4 cb[8];
#pragma unroll
        for (int nt = 0; nt < 8; ++nt) { cb[nt] = (f32x4){0.f, 0.f, 0.f, 0.f}; if (nt <= wave) cb[nt] = mma16(CM + 16 * wave * LD2, BG + 16 * nt * LD2, 4, cb[nt], r, q); }
        __syncthreads();
        const int xpp = tid & 63, xmg = tid >> 6, hpp = tid >> 3, hd0 = (tid & 7) * 16;
        bf16_t xr[16]; bf16x8 hv[2];
#define SSD3_FETCH(ee) do { const int hh_ = g * 4 + (ee); \
            _Pragma("unroll") for (int j_ = 0; j_ < 16; ++j_) xr[j_] = XB[(size_t)(row0 + xmg * 16 + j_) * 1024 + hh_ * 64 + xpp]; \
            const bf16_t* src_ = HPV + ((size_t)(n * SNC + c) * 8 + hh_) * 8192 + hpp * 128 + hd0; \
            hv[0] = *(const bf16x8*)src_; hv[1] = *(const bf16x8*)(src_ + 8); } while (0)
        SSD3_FETCH(0);
#pragma unroll 1
        for (int e = 0; e < 4; ++e) {
            const int h = g * 4 + e;
            {
#pragma unroll
                for (int nt = 0; nt < 8; ++nt) { const int m = 16 * nt + r; const float am = aux[1024 + e * 128 + m];
#pragma unroll
                    for (int e2 = 0; e2 < 4; ++e2) { const int li = 16 * wave + 4 * q + e2; const float v = (m <= li) ? cb[nt][e2] * __expf(aux[1024 + e * 128 + li] - am) : 0.f; BG[li * LD2 + m] = f2bf(v); } }
#pragma unroll
                for (int it = 0; it < 2; ++it) { const int m0 = xmg * 16 + it * 8; bf16x8 v;
#pragma unroll
                    for (int j = 0; j < 8; ++j) v[j] = (short)f2bf(bf2f(xr[it * 8 + j]) * aux[e * 128 + m0 + j]);
                    *(bf16x8*)(XT + xpp * LD2 + m0) = v; }
                *(bf16x8*)(HP + hpp * LD2 + hd0) = hv[0]; *(bf16x8*)(HP + hpp * LD2 + hd0 + 8) = hv[1];
                if (e + 1 < 4) SSD3_FETCH(e + 1);
            }
            __syncthreads();
            {
                const int li = 16 * wave + r; const size_t row = (size_t)row0 + li;
                const float sc = __expf(aux[1024 + e * 128 + li]), Dh = PIN(I_SSMD)[(size_t)l * 8 + h];
                bf16x4 xq[4];
#pragma unroll
                for (int mt = 0; mt < 4; ++mt) xq[mt] = *(const bf16x4*)(XB + row * 1024 + h * 64 + 16 * mt + 4 * q);
#pragma unroll
                for (int mt = 0; mt < 4; ++mt) {
                    f32x4 ad = {0.f, 0.f, 0.f, 0.f}, ao = {0.f, 0.f, 0.f, 0.f};
                    ad = mma16(XT + 16 * mt * LD2, BG + 16 * wave * LD2, (wave >> 1) + 1, ad, r, q);
                    ao = mma16(HP + 16 * mt * LD2, CM + 16 * wave * LD2, 4, ao, r, q);
                    const bf16x4 xv = xq[mt];
                    f32x4 y;
#pragma unroll
                    for (int e2 = 0; e2 < 4; ++e2) y[e2] = ad[e2] + sc * ao[e2] + Dh * bf2f((bf16_t)xv[e2]);
                    *(f32x4*)(YT + row * 512 + h * 64 + 16 * mt + 4 * q) = y;
                }
            }
            __syncthreads();
        }
        if (g == 1) { asm volatile("s_waitcnt vmcnt(0)" ::: "memory"); __syncthreads(); mgate_rows(p, z, l, row0, row0 + SL, wave, NWAVES, lane); }
#undef SSD3_FETCH
    }
}

__device__ __forceinline__ void stage_mgate_sample(const Params& p, int l, int first) {
    const Ctx cx = mkctx(p, first); const size_t z = cx.z;
    mgate_rows(p, z, l, MP, R, cx.bid * NWAVES + (cx.tid >> 6), cx.nb * NWAVES, cx.tid & 63);
}

__device__ __forceinline__ void stage_glu(const Params& p, int l) {
    const Ctx cx = mkctx(p); const size_t z = cx.z;
    const unsigned gt = (unsigned)cx.bid * NTHREADS + cx.tid, GT = (unsigned)cx.nb * NTHREADS;
    const bf16_t* GV = (const bf16_t*)(p.ws + z + WS_GV); bf16_t* U = (bf16_t*)(p.ws + z + WS_U);
    const float* cw = PIN(I_FCW) + (size_t)l * 3 * DFF; const float* cb = PIN(I_FCB) + (size_t)l * DFF;
    for (unsigned i = gt; i < (unsigned)(MP / 32) * (DFF / 8); i += GT) {
        const int hr = (int)(i / (unsigned)(DFF / 8)), c0 = (int)(i - (unsigned)hr * (DFF / 8)) * 8, row = (hr >> 1) * 64 + (hr & 1), t = row & (T - 1);
        const int cg = 256 * (c0 >> 7) + (c0 & 127);
        bf16x8 u[3];
#pragma unroll
        for (int k = 0; k < 3; ++k) { const bf16x8 zz = {0, 0, 0, 0, 0, 0, 0, 0}; u[k] = (t - 2 + k >= 0) ? *(const bf16x8*)(GV + (size_t)(row - 2 + k) * 5632 + cg) : zz; }
        const bf16x8 vv = *(const bf16x8*)(GV + (size_t)row * 5632 + cg + 128);
        bf16x8 o;
#pragma unroll
        for (int e = 0; e < 8; ++e) { const float acc = cb[c0 + e] + cw[c0 + e] * bf2f((bf16_t)u[0][e]) + cw[DFF + c0 + e] * bf2f((bf16_t)u[1][e]) + cw[2 * DFF + c0 + e] * bf2f((bf16_t)u[2][e]);
            o[e] = (short)f2bf(silu_f(acc) * bf2f((bf16_t)vv[e])); }
        *(bf16x8*)(U + (size_t)row * DFF + c0) = o;
    }
    for (unsigned i = gt; i < (unsigned)NP * 2 * DFF; i += GT) {
        const int c = (int)(i % (unsigned)DFF), j = (int)(i / (unsigned)DFF) & 1, n = (int)(i / (unsigned)(2 * DFF));
        (p.out + z)[O_PFFN + (((size_t)l * NP + n) * 2 + j) * DFF + c] = bf2f(GV[(size_t)(n * T + T - 2 + j) * 5632 + 256 * (c >> 7) + (c & 127)]);
    }
    for (unsigned i = (unsigned)MP * (DFF / 8) + gt; i < (unsigned)R * (DFF / 8); i += GT) {
        const int row = (int)(i / (unsigned)(DFF / 8)), c0 = (int)(i - (unsigned)row * (DFF / 8)) * 8;
        const int cg = 256 * (c0 >> 7) + (c0 & 127);
        const bool samp = row >= MP; const int n = samp ? row - MP : row >> 13, t = samp ? 0 : (row & (T - 1));
        float acc[8], raw[8];
#pragma unroll
        for (int e = 0; e < 8; ++e) acc[e] = cb[c0 + e];
#pragma unroll
        for (int j = 0; j < 3; ++j) {
            const int tau = t - 2 + j; float u[8];
            if (tau >= 0) { const bf16x8 v = *(const bf16x8*)(GV + (size_t)(row - 2 + j) * 5632 + cg);
#pragma unroll
                for (int e = 0; e < 8; ++e) u[e] = bf2f((bf16_t)v[e]); }
            else {
#pragma unroll
                for (int e = 0; e < 8; ++e) u[e] = samp ? PIN(I_FCONV)[(((size_t)l * NS + n) * 2 + (2 + tau)) * DFF + c0 + e] : 0.f; }
#pragma unroll
            for (int e = 0; e < 8; ++e) { acc[e] += cw[j * DFF + c0 + e] * u[e]; if (j == 2) raw[e] = u[e]; }
        }
        const bf16x8 vv = *(const bf16x8*)(GV + (size_t)row * 5632 + cg + 128);
        bf16x8 o;
#pragma unroll
        for (int e = 0; e < 8; ++e) o[e] = (short)f2bf(silu_f(acc[e]) * bf2f((bf16_t)vv[e]));
        *(bf16x8*)(U + (size_t)row * DFF + c0) = o;
        if (samp) { float* op = (p.out + z) + O_SFFN + ((size_t)l * NS + n) * 2 * DFF + c0;
#pragma unroll
            for (int e = 0; e < 8; ++e) { op[e] = PIN(I_FCONV)[(((size_t)l * NS + n) * 2 + 1) * DFF + c0 + e]; op[DFF + e] = raw[e]; } }
        else if (t >= T - 2) { float* op = (p.out + z) + O_PFFN + (((size_t)l * NP + n) * 2 + (t - (T - 2))) * DFF + c0;
#pragma unroll
            for (int e = 0; e < 8; ++e) op[e] = raw[e]; }
    }
}

__device__ __forceinline__ void stage_final(const Params& p) {
    const Ctx cx = mkctx(p); const size_t z = cx.z;
    const size_t gt = (size_t)cx.bid * NTHREADS + cx.tid, GT = (size_t)cx.nb * NTHREADS;
    const float* X = (const float*)(p.out + z);
    for (size_t i = gt; i < (size_t)R * D; i += GT) (p.out + z)[i] = X[i];
}

#define LAS __attribute__((address_space(3)))
typedef unsigned v4u __attribute__((ext_vector_type(4)));
__device__ __forceinline__ unsigned pk2(float lo, float hi) { return cvtpk(lo, hi); }
template <bool GV_PERM = false>
__device__ __forceinline__ void p0_transpose_item(const float* W, int ldw, int K, int nblk, bf16_t* WT, LAS float* scr, int item, int lane) {
    const int kb = item / nblk, nb = item % nblk, k0 = 64 * kb, n0 = 32 * nb;
    int nd = n0;
    if (GV_PERM) { const int bj = n0 >= DFF ? 1 : 0, rem = n0 - bj * DFF; nd = 256 * (rem >> 7) + 128 * bj + (rem & 127); }
#pragma unroll 8
    for (int i = 0; i < 32; ++i) { const int kk = 2 * i + (lane >> 5); scr[kk * 33 + (lane & 31)] = W[(size_t)(k0 + kk) * ldw + n0 + (lane & 31)]; }
    asm volatile("s_waitcnt lgkmcnt(0)" ::: "memory");
    const int c = lane & 7;
#pragma unroll
    for (int j = 0; j < 4; ++j) { const int n = (lane >> 3) + 8 * j; const LAS float* s = scr + (8 * c) * 33 + n;
        v4u o; o.x = pk2(s[0 * 33], s[1 * 33]); o.y = pk2(s[2 * 33], s[3 * 33]); o.z = pk2(s[4 * 33], s[5 * 33]); o.w = pk2(s[6 * 33], s[7 * 33]);
        *(v4u*)(WT + (size_t)(nd + n) * K + k0 + 8 * c) = o; }
    asm volatile("s_waitcnt lgkmcnt(0)" ::: "memory");
}
__device__ __forceinline__ void stage_wconv(const Params& p, unsigned char* lds, int l_lo, int l_hi, int first = 0) {
    const Ctx cx = mkctx(p, first); const size_t z = cx.z;
    if (l_lo == 0) {
        bf16_t* LT = (bf16_t*)(p.ws + z + WS_LORA);
        for (unsigned i = (unsigned)cx.bid * NTHREADS + cx.tid; i < (unsigned)L * 65536; i += (unsigned)cx.nb * NTHREADS) {
            const int l = i >> 16, e = i & 65535, j = e & 255, ii = e >> 8;
            float v; bf16_t* dst;
            if (ii < 64) { v = PIN(I_W2)[(size_t)l * 16384 + ii * 256 + j]; dst = LT + (size_t)l * 65536 + j * 64 + ii; }
            else if (ii < 128) { v = PIN(I_A2)[(size_t)l * 16384 + (ii - 64) * 256 + j]; dst = LT + (size_t)l * 65536 + 16384 + j * 64 + (ii - 64); }
            else { v = PIN(I_G2)[(size_t)l * 32768 + (ii - 128) * 256 + j]; dst = LT + (size_t)l * 65536 + 32768 + j * 128 + (ii - 128); }
            *dst = f2bf(v);
        }
        bf16_t* WD = (bf16_t*)(p.ws + z + WS_WDTT);
        for (unsigned i = (unsigned)cx.bid * NTHREADS + cx.tid; i < (unsigned)L * 16384; i += (unsigned)cx.nb * NTHREADS) {
            const int l = i >> 14, j = (i >> 10) & 15, k = i & 1023;
            WD[i] = j < 8 ? f2bf(PIN(I_WIN)[(size_t)l * D * PROJ + (size_t)k * PROJ + PCOLS + j]) : (bf16_t)0;
        }
    }
    const int lane = cx.tid & 63, wave = cx.tid >> 6;
    LAS float* scr = (LAS float*)(lds + wave * 16384);
    const int gw = cx.bid * NWAVES + wave, NGW = cx.nb * NWAVES;
    constexpr int I_IN = 16 * 96, I_OUT = 16 * 32, I_UP = 16 * 176, I_DN = 44 * 32, PER_L = I_IN + I_OUT + I_UP + I_DN;
    for (int it = gw; it < (l_hi - l_lo) * PER_L; it += NGW) {
        const int l = l_lo + it / PER_L; int r = it % PER_L;
        if (r < I_IN) { p0_transpose_item(PIN(I_WIN) + (size_t)l * D * PROJ, PROJ, D, 96, (bf16_t*)(p.ws + z + WS_WIN) + (size_t)l * PCOLS * D, scr, r, lane); continue; } r -= I_IN;
        if (r < I_OUT) { p0_transpose_item(PIN(I_WOUT) + (size_t)l * D * D, D, D, 32, (bf16_t*)(p.ws + z + WS_WOUT) + (size_t)l * D * D, scr, r, lane); continue; } r -= I_OUT;
        if (r < I_UP) { p0_transpose_item<true>(PIN(I_WUP) + (size_t)l * D * 5632, 5632, D, 176, (bf16_t*)(p.ws + z + WS_WUP) + (size_t)l * 5632 * D, scr, r, lane); continue; } r -= I_UP;
        p0_transpose_item(PIN(I_WDOWN) + (size_t)l * DFF * D, D, DFF, 32, (bf16_t*)(p.ws + z + WS_WDN) + (size_t)l * D * DFF, scr, r, lane);
    }
}

template <int NT, class F>
__device__ __forceinline__ void gemm_small(const Params& p, const bf16_t* A, int lda, const bf16_t* Bt, int N, int K, int ksplit, const F& epi) {
    const Ctx cx = mkctx(p); A += cx.z; Bt += cx.z;
    const int lane = cx.tid & 63, wave = __builtin_amdgcn_readfirstlane(cx.tid >> 6), r = lane & 15, q = lane >> 4;
    const int ntile = N / (16 * NT), kc = K / ksplit;
    for (int task = cx.nb - 1 - cx.bid; task < ntile * ksplit; task += cx.nb) {
        const int tn = task % ntile, ks = task / ntile, n0 = tn * 16 * NT, k0 = ks * kc;
        const bf16_t* ap = A + (size_t)(16 * wave + r) * lda + k0 + 8 * q;
        const bf16_t* bp = Bt + (size_t)(n0 + r) * K + k0 + 8 * q;
        f32x4 acc[NT];
#pragma unroll
        for (int nt = 0; nt < NT; ++nt) acc[nt] = (f32x4){0.f, 0.f, 0.f, 0.f};
#pragma unroll 8
        for (int s2 = 0; s2 < kc / 32; ++s2) {
            const bf16x8 fa = *(const bf16x8*)(ap + 32 * s2);
#pragma unroll
            for (int nt = 0; nt < NT; ++nt) { const bf16x8 fb = *(const bf16x8*)(bp + (size_t)nt * 16 * K + 32 * s2); acc[nt] = __builtin_amdgcn_mfma_f32_16x16x32_bf16(fb, fa, acc[nt], 0, 0, 0); }
        }
#pragma unroll
        for (int nt = 0; nt < NT; ++nt) epi(16 * wave + r, n0 + 16 * nt + 4 * q, acc[nt]);
    }
}
struct SmallBf { bf16_t* O; int ldc; __device__ __forceinline__ void operator()(int row, int col, f32x4 v) const { *(bf16x4*)(O + (size_t)(MP + row) * ldc + col) = pack4(v); } };
struct SmallRes { float* X; const float* gate;   __device__ __forceinline__ void operator()(int row, int col, f32x4 v) const {
    const f32x4 g = *(const f32x4*)(gate + (size_t)(NP + row) * 6144 + col); float* x = X + (size_t)(MP + row) * D + col;
#pragma unroll
    for (int e = 0; e < 4; ++e) unsafeAtomicAdd(x + e, g[e] * v[e]); } };

__device__ __forceinline__ void stage_dtgemm(const Params& p, int l) {
    const Ctx cx = mkctx(p); const size_t z = cx.z;
    const int lane = cx.tid & 63, wave = __builtin_amdgcn_readfirstlane(cx.tid >> 6), r = lane & 15, q = lane >> 4;
    const bf16_t* H = (const bf16_t*)(p.ws + z + WS_H); const bf16_t* WD = (const bf16_t*)(p.ws + z + WS_WDTT) + (size_t)l * 16384;
    float* DT = (float*)(p.ws + z + WS_DT);
    for (int task = cx.nb - 1 - cx.bid; task < R / 128; task += cx.nb) {
        const int row = task * 128 + 16 * wave + r;
        const bf16_t* hp = H + (size_t)row * D + 8 * q; const bf16_t* wp = WD + r * 1024 + 8 * q;
        f32x4 acc = {0.f, 0.f, 0.f, 0.f};
#pragma unroll 8
        for (int s2 = 0; s2 < 32; ++s2) { const bf16x8 fa = *(const bf16x8*)(hp + 32 * s2), fb = *(const bf16x8*)(wp + 32 * s2); acc = __builtin_amdgcn_mfma_f32_16x16x32_bf16(fb, fa, acc, 0, 0, 0); }
        if (q < 2) *(f32x4*)(DT + (size_t)row * 8 + 4 * q) = acc;
    }
}

#define RLX_AGENT __ATOMIC_RELAXED, __HIP_MEMORY_SCOPE_AGENT
#define XB_TMO      128
#define XB_XCNT(j)  (256  + 64 * (j))
#define XB_XSUB(j)  (1280 + 64 * (j))
#define XB_XGEN(j)  (2304 + 64 * (j))
#define XB_TOP      3328
#define XB_TOPGEN   3392
#define XCD_BAR_WORDS 3456
#define XB_SPIN_CAP (1u << 18)

__device__ __forceinline__ unsigned xb_ld(unsigned* p)              { return __hip_atomic_load(p, __ATOMIC_RELAXED, __HIP_MEMORY_SCOPE_AGENT); }
__device__ __forceinline__ unsigned xb_add(unsigned* p, unsigned v) { return __hip_atomic_fetch_add(p, v, __ATOMIC_RELAXED, __HIP_MEMORY_SCOPE_AGENT); }
__device__ __forceinline__ unsigned xb_xcc_id() { return (unsigned)__builtin_amdgcn_s_getreg((3 << 11) | 20) & 0xFu; }
#define XB_SPIN(cond, bar) do { unsigned _sp = 0; while (cond) { __builtin_amdgcn_s_sleep(1); \
    if ((++_sp & 255u) == 0u) { if (xb_ld(&(bar)[XB_TMO])) break; if (_sp > XB_SPIN_CAP) { atomicAdd(&(bar)[XB_TMO], 1u); break; } } } } while (0)

struct XcdBarrier {
    unsigned* bar; unsigned x; int wave;
    volatile LAS unsigned* st;
};

__device__ __forceinline__ XcdBarrier xcd_barrier_post(unsigned* bar, volatile LAS unsigned* st, int wave) {
    XcdBarrier b; b.bar = bar; b.x = xb_xcc_id(); b.st = st; b.wave = wave;
    if (wave == 0 && lane_id() == 0) (void)xb_add(&bar[XB_XCNT(b.x)], 1u);
    return b;
}
__device__ __forceinline__ void xcd_barrier_complete(unsigned* bar, unsigned x, unsigned& nloc, unsigned& nx) {
    const unsigned G = gridDim.x * gridDim.y * gridDim.z;
    unsigned sum, cnt, mine, sp = 0u;
    for (;;) {
        sum = 0u; cnt = 0u; mine = 0u;
#pragma unroll
        for (unsigned j = 0; j < 16; ++j) { const unsigned c = xb_ld(&bar[XB_XCNT(j)]); sum += c; cnt += (c > 0u) ? 1u : 0u; mine = (j == x) ? c : mine; }
        if (sum == G) break;
        __builtin_amdgcn_s_sleep(1);
        if ((++sp & 255u) == 0u) { if (xb_ld(&bar[XB_TMO])) break; if (sp > XB_SPIN_CAP) { atomicAdd(&bar[XB_TMO], 1u); break; } }
    }
    nloc = mine > 0u ? mine : 1u; nx = cnt > 0u ? cnt : 1u;
}

__device__ __forceinline__ void xcd_barrier(const XcdBarrier& b) {
    asm volatile("s_waitcnt vmcnt(0)" ::: "memory");
    __syncthreads();
    if (b.wave == 0 && lane_id() == 0) {
        unsigned* bar = b.bar;
        __builtin_amdgcn_s_waitcnt(0);
        unsigned nloc = b.st[0], nx = b.st[1];
        if (nloc == 0u) { xcd_barrier_complete(bar, b.x, nloc, nx); b.st[0] = nloc; b.st[1] = nx; }
        const unsigned old = xb_add(&bar[XB_XSUB(b.x)], 1u);
        const unsigned gen = old / nloc;
        if (old + 1u == (gen + 1u) * nloc) {
            __builtin_amdgcn_fence(__ATOMIC_RELEASE, "agent");
            asm volatile("s_waitcnt vmcnt(0)" ::: "memory");
            const unsigned og = xb_add(&bar[XB_TOP], 1u);
            const unsigned tg = og / nx;
            if (og + 1u == (tg + 1u) * nx) xb_add(&bar[XB_TOPGEN], 1u);
            else XB_SPIN(xb_ld(&bar[XB_TOPGEN]) == tg, bar);
            __builtin_amdgcn_fence(__ATOMIC_ACQUIRE, "agent");
            xb_add(&bar[XB_XGEN(b.x)], 1u);
            asm volatile("s_waitcnt vmcnt(0)" ::: "memory");
        } else {
            XB_SPIN(xb_ld(&bar[XB_XGEN(b.x)]) == gen, bar);
            __builtin_amdgcn_fence(__ATOMIC_ACQUIRE, "agent");
            asm volatile("s_waitcnt vmcnt(0)" ::: "memory");
        }
    }
    __syncthreads();
}

namespace cg = cooperative_groups;
constexpr int LDS_BYTES = 153600;
__global__ void __launch_bounds__(NTHREADS, 2) fwd_mega(Params p_in) {
    Params p = p_in; p.wave = __builtin_amdgcn_readfirstlane((int)(threadIdx.x >> 6));
    extern __shared__ __attribute__((aligned(16))) unsigned char lds[];
    cg::grid_group grid = cg::this_grid();
    float* ldsf = (float*)lds;
    volatile LAS unsigned* MISC = (volatile LAS unsigned*)((LAS unsigned char*)lds + LDS_BYTES - 64);
    if (p.wave == 0 && lane_id() < 16) MISC[lane_id()] = 0u;
    __syncthreads();
    const XcdBarrier bar = xcd_barrier_post((unsigned*)(p.ws + WS_CTL), MISC, p.wave);
#define GSYNC() xcd_barrier(bar)
    stage_init(p); stage_wconv(p, lds, 0, 1); __syncthreads(); stage_mod(p, lds, 0, L); grid.sync();
    for (int l = 0; l < L; ++l) {
        const float* MODl = (const float*)(p.ws + WS_MOD) + (size_t)l * NSEQ * 6144;
        if (l > 0) stage_norm_b(p, l, 0);
        stage_norm(p, l, 0, ldsf, l == 0); GSYNC();
        { pg8::Gemm g{(const bf16_t*)(p.ws + WS_H), (const bf16_t*)(p.ws + WS_WIN) + (size_t)l * PCOLS * D, MP, PCOLS, D}; pg8::StaticOrder S; S.init(MP, PCOLS, (int)gridDim.x, (int)blockIdx.x);
          pg8::EpiBf16<0> E{(bf16_t*)(p.ws + WS_P), PCOLS, nullptr, 0, 0, 1.f};
          pg8::gemm_phase<pg8::EpiBf16<0>, pg8::StaticOrder, true, true>((LAS unsigned char*)lds, g, S, E, (p.wave << 6) | lane_id()); }
        gemm_small<1>(p, (const bf16_t*)(p.ws + WS_H) + (size_t)MP * D, D, (const bf16_t*)(p.ws + WS_WIN) + (size_t)l * PCOLS * D, PCOLS, D, 1, SmallBf{(bf16_t*)(p.ws + WS_P), PCOLS});
        stage_dtgemm(p, l);
        GSYNC();
        stage_rwprep(p, l, ldsf); __syncthreads(); stage_rwprep2(p, l, lds); asm volatile("s_waitcnt vmcnt(0)" ::: "memory"); __syncthreads();
        stage_rw1(p, l, lds); stage_mconv(p, l); stage_qkn(p, l); stage_ssd1(p, l, lds); GSYNC();
        stage_rw2(p, l, lds); stage_ssd2(p, l); stage_att(p, l, RW2_WGS); stage_rwscan(p, l, ldsf, RW2_WGS); stage_mscan(p, l, ldsf, RW2_WGS);
        if (l + 1 < L) { __syncthreads(); stage_wconv(p, lds, l + 1, l + 2, RW2_WGS); }
        GSYNC();
        stage_ssd3(p, l, lds, 0, 128); stage_rw3(p, l, 128); stage_attn(p, l, lds, 128); stage_mgate_sample(p, l, 128); GSYNC();
        { pg8::Gemm g{(const bf16_t*)(p.ws + WS_YCAT), (const bf16_t*)(p.ws + WS_WOUT) + (size_t)l * D * D, MP, D, D}; pg8::StaticOrder S; S.init(MP, D, (int)gridDim.x, (int)blockIdx.x);
          pg8::EpiResGate E{p.out, p.in[I_XP], (bf16_t*)(p.ws + WS_XB), MODl + 2048, l == 0, 0, 13, 6144};
          pg8::gemm_phase<pg8::EpiResGate, pg8::StaticOrder, true, true>((LAS unsigned char*)lds, g, S, E, (p.wave << 6) | lane_id()); }
        gemm_small<1>(p, (const bf16_t*)(p.ws + WS_YCAT) + (size_t)MP * D, D, (const bf16_t*)(p.ws + WS_WOUT) + (size_t)l * D * D, D, D, 4, SmallRes{p.out, MODl + 2048});
        GSYNC();
        stage_norm_b(p, l, 1); stage_norm(p, l, 1, ldsf, false); GSYNC();
        { pg8::Gemm g{(const bf16_t*)(p.ws + WS_H), (const bf16_t*)(p.ws + WS_WUP) + (size_t)l * 5632 * D, MP, 5632, D}; pg8::StaticOrder S; S.init(MP, 5632, (int)gridDim.x, (int)blockIdx.x);
          pg8::EpiGlu E{(bf16_t*)(p.ws + WS_GV), (bf16_t*)(p.ws + WS_U), p.in[I_FCW] + (size_t)l * 3 * DFF, p.in[I_FCB] + (size_t)l * DFF};
          pg8::gemm_phase<pg8::EpiGlu, pg8::StaticOrder, true, true>((LAS unsigned char*)lds, g, S, E, (p.wave << 6) | lane_id()); }
        gemm_small<1>(p, (const bf16_t*)(p.ws + WS_H) + (size_t)MP * D, D, (const bf16_t*)(p.ws + WS_WUP) + (size_t)l * 5632 * D, 5632, D, 1, SmallBf{(bf16_t*)(p.ws + WS_GV), 5632});
        stage_cachecopy(p, l, 128);
        GSYNC();
        stage_glu(p, l); GSYNC();
        { pg8::Gemm g{(const bf16_t*)(p.ws + WS_U), (const bf16_t*)(p.ws + WS_WDN) + (size_t)l * D * DFF, MP, D, DFF}; pg8::StaticOrder S; S.init(MP, D, (int)gridDim.x, (int)blockIdx.x);
          pg8::EpiResGate E{p.out, p.in[I_XP], (bf16_t*)(p.ws + WS_XB), MODl + 5120, 0, l == L - 1, 13, 6144};
          pg8::gemm_phase<pg8::EpiResGate, pg8::StaticOrder, true, true>((LAS unsigned char*)lds, g, S, E, (p.wave << 6) | lane_id()); }
        gemm_small<1>(p, (const bf16_t*)(p.ws + WS_U) + (size_t)MP * DFF, DFF, (const bf16_t*)(p.ws + WS_WDN) + (size_t)l * D * DFF, D, DFF, 11, SmallRes{p.out, MODl + 5120});
        GSYNC();
    }
}

extern "C" void kernel_launch(void* const* d_in, const int* in_sizes, int n_in, void* d_out, int out_size, void* d_ws, size_t ws_size, hipStream_t stream) {
    static int grid = 0;
    if (grid == 0) {
        if (n_in != N_IN || (size_t)out_size != O_END || ws_size < WS_END) { fprintf(stderr, "kernel_launch: unexpected sizes n_in %d out %d ws %zu\n", n_in, out_size, ws_size); grid = -1; return; }
        int dev = 0, cus = 0, per_cu = 0;
        hipGetDevice(&dev); hipDeviceGetAttribute(&cus, hipDeviceAttributeMultiprocessorCount, dev);
        if (hipFuncSetAttribute((const void*)fwd_mega, hipFuncAttributeMaxDynamicSharedMemorySize, LDS_BYTES) != hipSuccess) { fprintf(stderr, "hipFuncSetAttribute failed\n"); grid = -1; return; }
        hipOccupancyMaxActiveBlocksPerMultiprocessor(&per_cu, (const void*)fwd_mega, NTHREADS, LDS_BYTES);
        if (per_cu < 1) { fprintf(stderr, "occupancy query says %d blocks per CU\n", per_cu); grid = -1; return; }
        grid = cus;
    }
    if (grid < 0) return;
    Params p{};
    for (int i = 0; i < N_IN; ++i) p.in[i] = (const float*)d_in[i];
    p.out = (float*)d_out; p.ws = (unsigned char*)d_ws;
    if (hipMemsetAsync((char*)d_ws + WS_CTL, 0, 16384, stream) != hipSuccess) { fprintf(stderr, "memset of the barrier words failed\n"); return; }
    void* args[] = {&p};
    hipError_t e = hipLaunchCooperativeKernel((void*)fwd_mega, dim3(grid), dim3(NTHREADS), args, LDS_BYTES, stream);
    if (e != hipSuccess) fprintf(stderr, "cooperative launch failed: %s\n", hipGetErrorString(e));
}
```

```cpp
#include <hip/hip_runtime.h>
#include <hip/hip_cooperative_groups.h>
#include <cstdint>
#include <cstdio>

typedef unsigned short bf16_t;
__device__ __forceinline__ float bf2f(bf16_t v) { return __uint_as_float(((unsigned)v) << 16); }
typedef float f32x2_t __attribute__((ext_vector_type(2)));
typedef __bf16 bf16x2_t __attribute__((ext_vector_type(2)));
__device__ __forceinline__ unsigned cvtpk(float lo, float hi) { const f32x2_t v = {lo, hi}; const bf16x2_t b = __builtin_convertvector(v, bf16x2_t); return __builtin_bit_cast(unsigned, b); }
__device__ __forceinline__ bf16_t f2bf(float f) { return (bf16_t)cvtpk(f, 0.f); }

constexpr int D = 1024, NP = 2, T = 8192, MP = NP * T, NS = 128, R = MP + NS, NSEQ = NP + NS, L = 4;
constexpr int PROJ = 3080, PCOLS = 3072, DFF = 2816;
constexpr int OFF_B = 1024, OFF_Z = 1536, OFF_XBC = 2048;
constexpr float NORM_EPS = 1e-6f, GN_EPS = 64e-5f;
constexpr int NTHREADS = 512, NWAVES = 8;
typedef short bf16x8 __attribute__((ext_vector_type(8)));
typedef short bf16x4 __attribute__((ext_vector_type(4)));
typedef float f32x4 __attribute__((ext_vector_type(4)));
__device__ __forceinline__ bf16x4 pack4(f32x4 v) { typedef unsigned u32x2_t __attribute__((ext_vector_type(2))); const u32x2_t w = {cvtpk(v[0], v[1]), cvtpk(v[2], v[3])}; return __builtin_bit_cast(bf16x4, w); }
constexpr int LD = 72, MSZ = 64 * LD;
constexpr int LD2 = 136;

enum { I_XP = 0, I_XS, I_CP, I_CS, I_SHIFT, I_WKV, I_CK, I_CV, I_SCONV, I_SSM, I_FCONV, I_ADAW, I_ADAB, I_NMIXG, I_NFFNG, I_WIN, I_WOUT,
       I_MU, I_W0, I_W2, I_A0, I_A2, I_G2, I_KK, I_KA, I_RK, I_LNG, I_LNB, I_QNG, I_KNG, I_SINK, I_CONVW, I_CONVB, I_DTB, I_ALOG, I_SSMD, I_SSMNG,
       I_WUP, I_FCW, I_FCB, I_WDOWN, N_IN };

constexpr size_t O_YP = 0;
constexpr size_t O_YS = O_YP + (size_t)MP * D;
constexpr size_t O_PSHIFT = O_YS + (size_t)NS * D;
constexpr size_t O_PWKV = O_PSHIFT + (size_t)L * NP * 1024;
constexpr size_t O_PK = O_PWKV + (size_t)L * NP * 4 * 64 * 64;
constexpr size_t O_PV = O_PK + (size_t)L * NP * 128 * 128;
constexpr size_t O_PCONV = O_PV + (size_t)L * NP * 128 * 128;
constexpr size_t O_PSSM = O_PCONV + (size_t)L * NP * 3 * 1024;
constexpr size_t O_PFFN = O_PSSM + (size_t)L * NP * 8 * 64 * 128;
constexpr size_t O_SSHIFT = O_PFFN + (size_t)L * NP * 2 * DFF;
constexpr size_t O_SWKV = O_SSHIFT + (size_t)L * NS * 1024;
constexpr size_t O_SK = O_SWKV + (size_t)L * NS * 4 * 64 * 64;
constexpr size_t O_SV = O_SK + (size_t)L * NS * 128 * 128;
constexpr size_t O_SCONV = O_SV + (size_t)L * NS * 128 * 128;
constexpr size_t O_SSSM = O_SCONV + (size_t)L * NS * 3 * 1024;
constexpr size_t O_SFFN = O_SSSM + (size_t)L * NS * 8 * 64 * 128;
constexpr size_t O_END = O_SFFN + (size_t)L * NS * 2 * DFF;

constexpr size_t MiB = 1u << 20;
constexpr int MPAD = 16640;
constexpr size_t WS_XB = 0;
constexpr size_t WS_X = 0;
constexpr size_t WS_H = 65 * MiB;
constexpr size_t WS_YCAT = WS_H;
constexpr size_t WS_MOD = 98 * MiB;
constexpr size_t WS_P = 111 * MiB;
constexpr size_t WS_DT = 209 * MiB;
constexpr size_t WS_GV = 210 * MiB;
constexpr size_t WS_U = 389 * MiB;
constexpr size_t WS_WIN = 479 * MiB;
constexpr size_t WS_WOUT = 503 * MiB;
constexpr size_t WS_WUP = 511 * MiB;
constexpr size_t WS_WDN = 555 * MiB;
constexpr size_t WS_RWC_Y0 = 578 * MiB;
constexpr size_t WS_CTL = 595 * MiB;
constexpr size_t WS_LORA = 596 * MiB;
constexpr size_t WS_WDTT = WS_LORA + 512 * 1024;
constexpr size_t WS_DT2 = 597 * MiB;
constexpr size_t WS_END = 598 * MiB;
constexpr size_t WS_RWC_RP = WS_U + 65 * MiB;
constexpr size_t WS_RWC_MC = WS_RWC_RP + 8 * MiB;
constexpr size_t WS_RWC_NCT = WS_RWC_MC + 8 * MiB;
static_assert(WS_RWC_NCT + 8 * MiB <= WS_WIN, "rwkv chunk buffers fit the U region tail");
constexpr size_t WS_RW = WS_GV;
constexpr size_t WS_RWD = WS_RW + 49 * MiB;
constexpr size_t WS_HPREV = WS_RW + 70 * MiB;
constexpr size_t WS_QN = WS_RW + 113 * MiB;
constexpr size_t WS_KN = WS_QN + 17 * MiB;
constexpr size_t WS_YTMP = WS_KN + 9 * MiB;
static_assert(WS_YTMP + (size_t)R * 512 * 4 <= WS_U, "mixer temporaries fit the GV region");
constexpr size_t WS_XBCC = WS_U;
constexpr size_t WS_SST = WS_U + 33 * MiB;
static_assert(WS_XBCC + (size_t)R * 1024 * 2 <= WS_SST && WS_SST + 32 * MiB <= WS_RWC_RP, "xbc / ssd states fit the U region");
constexpr size_t WS_SCD = WS_RWC_Y0 + 16 * MiB;

struct Params {
    const float* in[N_IN];
    float* out;
    unsigned char* ws;
    int wave, pad;
};

__device__ __forceinline__ int seq_of_row(int row) { return row < MP ? (row >> 13) : (NP + row - MP); }
__device__ __forceinline__ float wave_sum(float v) {
#pragma unroll
    for (int o = 1; o < 64; o <<= 1) v += __shfl_xor(v, o);
    return v;
}
__device__ __forceinline__ float wave_max(float v) {
#pragma unroll
    for (int o = 1; o < 64; o <<= 1) v = fmaxf(v, __shfl_xor(v, o));
    return v;
}
__device__ __forceinline__ float silu_f(float x) { return x * __builtin_amdgcn_rcpf(1.f + __expf(-x)); }
__device__ __forceinline__ float sigmoid_f(float x) { return __builtin_amdgcn_rcpf(1.f + __expf(-x)); }
__device__ __forceinline__ float tanh_fast(float x) { return 1.f - 2.f * __builtin_amdgcn_rcpf(1.f + __expf(2.f * x)); }
__device__ __forceinline__ float softplus_fast(float x) { return fmaxf(x, 0.f) + __logf(1.f + __expf(-fabsf(x))); }
__device__ __forceinline__ float softplus_f(float x) { return fmaxf(x, 0.f) + log1pf(__expf(-fabsf(x))); }

namespace pg8 {
#define PG8_LAS __attribute__((address_space(3)))
typedef unsigned short bf16_t;
typedef short bf16x8 __attribute__((ext_vector_type(8)));
typedef float f32x4 __attribute__((ext_vector_type(4)));
typedef unsigned u32x4 __attribute__((ext_vector_type(4)));
constexpr int BM = 256, BK = 64, HALF = 128, HTB = HALF * BK * 2  , STAGE_BYTES = 8 * HTB, NXCD = 8, WGM = 8;

__host__ __device__ __forceinline__ int lds_byte(int r, int c) { const int st = (r >> 4) * 2 + (c >> 5), rr = r & 15, cc = c & 31, ob = rr * 64 + cc * 2; return st * 1024 + (ob ^ (((ob >> 9) & 1) << 5)); }
__host__ __device__ __forceinline__ void stage_rc(int b, int& R, int& C) { const int st = b / 1024, sb = b % 1024, swz = sb ^ (((sb >> 9) & 1) << 5); R = (st >> 1) * 16 + swz / 64; C = (st & 1) * 32 + (swz % 64) / 2; }
__host__ __device__ __forceinline__ int perm32(int rho) { const int n = rho >> 4, i = rho & 15; return 8 * (i >> 2) + 4 * n + (i & 3); }

struct Unit { int pm, pn; };
struct Gemm { const bf16_t* A; const bf16_t* Bt; int M, N, K; };

struct StaticOrder {
    int nM, nN, nwg, G, c;
    __host__ __device__ void init(int M, int N, int G_, int c_) { nM = M / BM; nN = N / BM; nwg = nM * nN; G = G_; c = c_; }
    __host__ __device__ bool next(int i, Unit& u) const {
        const long L = (long)i * G + c; if (L >= nwg) return false;
        int wgid = (int)L; { const int q = nwg / NXCD, r = nwg % NXCD, xcd = wgid % NXCD, off = wgid / NXCD; wgid = (xcd < r ? xcd * (q + 1) : r * (q + 1) + (xcd - r) * q) + off; }
        const int nig = WGM * nN, gid = wgid / nig, fm = gid * WGM, gsz = (nM - fm) < WGM ? (nM - fm) : WGM;
        u.pm = fm + ((wgid % nig) % gsz); u.pn = (wgid % nig) / gsz; return true;
    }
    __device__ __forceinline__ void a_ready(const Unit&) const {}
    __device__ __forceinline__ void done(const Unit&) const {}
};

__device__ __forceinline__ unsigned cvt_pk_bf16(float lo, float hi) { unsigned r; asm volatile("v_cvt_pk_bf16_f32 %0, %1, %2" : "=v"(r) : "v"(lo), "v"(hi)); return r; }
typedef float f32x2 __attribute__((ext_vector_type(2)));
__device__ __forceinline__ f32x2 gelu_pk(f32x2 v) {
    const f32x2 av = __builtin_elementwise_abs(v), d = av * 0.2316418882f + 1.0f;
    f32x2 t; t.x = __builtin_amdgcn_rcpf(d.x); t.y = __builtin_amdgcn_rcpf(d.y);
    f32x2 q = t * 0.5307027145f + (-0.7265760135f); q = q * t + 0.7107068705f; q = q * t + (-0.142248368f); q = q * t + 0.127414796f; q = q * t;
    const f32x2 s = (v * v) * (-0.72134752044f);
    f32x2 e; e.x = __builtin_amdgcn_exp2f(s.x); e.y = __builtin_amdgcn_exp2f(s.y);
    const f32x2 m = v * (q * e), r = v - m;
    f32x2 o; o.x = v.x < 0.f ? m.x : r.x; o.y = v.y < 0.f ? m.y : r.y; return o;
}

template <int ACT  > struct EpiBf16 {
    static constexpr bool PERM = true, AFTER_DRAIN = false; static_assert(ACT == 0 || ACT == 1, "EpiBf16: ACT is 0 (none) or 1 (gelu_pk)");
    bf16_t* O; int ldc; const float* bias; int split_cols; size_t split_stride; float scale0;
    __device__ __forceinline__ void operator()(const f32x4 (&acc)[2][2][4][2], const Unit& u, int wr, int wc, int fr, int fq) const {
        const int row0 = u.pm * BM + wr * 64 + fr; int colt = u.pn * BM; bf16_t* base = O;
        float sc = 1.f; if (split_cols) { const int t = colt / split_cols; base += (size_t)t * split_stride; colt -= t * split_cols; if (t == 0) sc = scale0; }
        const int col0 = colt + wc * 32 + 8 * fq, bcol0 = u.pn * BM + wc * 32 + 8 * fq;
        f32x4 bv[2][2];
#pragma unroll
        for (int bj = 0; bj < 2; ++bj)
#pragma unroll
            for (int n = 0; n < 2; ++n) bv[bj][n] = bias ? *(const f32x4*)(bias + bcol0 + bj * HALF + 4 * n) : (f32x4){0.f, 0.f, 0.f, 0.f};
#pragma unroll
        for (int ai = 0; ai < 2; ++ai)
#pragma unroll
            for (int m = 0; m < 4; ++m) { bf16_t* rowp = base + (size_t)(row0 + ai * HALF + m * 16) * ldc + col0;
#pragma unroll
                for (int bj = 0; bj < 2; ++bj) { f32x4 v0 = acc[ai][bj][m][0] + bv[bj][0], v1 = acc[ai][bj][m][1] + bv[bj][1];
                    if (ACT == 1) { f32x2 a = gelu_pk((f32x2){v0[0], v0[1]}), b = gelu_pk((f32x2){v0[2], v0[3]}), c = gelu_pk((f32x2){v1[0], v1[1]}), d = gelu_pk((f32x2){v1[2], v1[3]});
                        v0 = (f32x4){a.x, a.y, b.x, b.y}; v1 = (f32x4){c.x, c.y, d.x, d.y}; }
                    v0 = v0 * sc; v1 = v1 * sc; u32x4 w; w.x = cvt_pk_bf16(v0[0], v0[1]); w.y = cvt_pk_bf16(v0[2], v0[3]); w.z = cvt_pk_bf16(v1[0], v1[1]); w.w = cvt_pk_bf16(v1[2], v1[3]);
                    *(u32x4*)(rowp + bj * HALF) = w; } }
    }
};

__device__ __forceinline__ float dpp_shr(float cur, float prevblk, int n  ) {
    const int c = __builtin_bit_cast(int, cur), pb = __builtin_bit_cast(int, prevblk);
    int t;
    if (n == 1) { t = __builtin_amdgcn_update_dpp(0, pb, 0x121, 0xf, 0xf, false); t = __builtin_amdgcn_update_dpp(t, c, 0x111, 0xf, 0xf, false); }
    else        { t = __builtin_amdgcn_update_dpp(0, pb, 0x122, 0xf, 0xf, false); t = __builtin_amdgcn_update_dpp(t, c, 0x112, 0xf, 0xf, false); }
    return __builtin_bit_cast(float, t);
}
struct EpiGlu {
    static constexpr bool PERM = true, AFTER_DRAIN = false;
    bf16_t* GV; bf16_t* U; const float* cw; const float* cb;
    __device__ __forceinline__ void operator()(const f32x4 (&acc)[2][2][4][2], const Unit& u, int wr, int wc, int fr, int fq) const {
        const int row0 = u.pm * BM + wr * 64 + fr, x0 = wc * 32 + 8 * fq, ch0 = u.pn * HALF + x0;
        f32x4 w0[2], w1[2], w2[2], bb[2];
#pragma unroll
        for (int n = 0; n < 2; ++n) { w0[n] = *(const f32x4*)(cw + ch0 + 4 * n); w1[n] = *(const f32x4*)(cw + 2816 + ch0 + 4 * n); w2[n] = *(const f32x4*)(cw + 5632 + ch0 + 4 * n); bb[n] = *(const f32x4*)(cb + ch0 + 4 * n); }
#pragma unroll
        for (int ai = 0; ai < 2; ++ai)
#pragma unroll
            for (int m = 0; m < 4; ++m) {
                const int row = row0 + ai * HALF + m * 16;
                bf16_t* gp = GV + (size_t)row * 5632 + u.pn * BM + x0;
                u32x4 wu;
#pragma unroll
                for (int n = 0; n < 2; ++n) {
                    const f32x4 g = acc[ai][0][m][n], v = acc[ai][1][m][n], pv = acc[ai][0][m > 0 ? m - 1 : 0][n];
                    float o[4];
#pragma unroll
                    for (int e = 0; e < 4; ++e) {
                        const float g1 = dpp_shr(g[e], pv[e], 1), g2 = dpp_shr(g[e], pv[e], 2);
                        const float a = bb[n][e] + w0[n][e] * g2 + w1[n][e] * g1 + w2[n][e] * g[e];
                        o[e] = a * __builtin_amdgcn_rcpf(1.f + __expf(-a)) * v[e];
                    }
                    if (n == 0) { wu.x = cvt_pk_bf16(o[0], o[1]); wu.y = cvt_pk_bf16(o[2], o[3]); } else { wu.z = cvt_pk_bf16(o[0], o[1]); wu.w = cvt_pk_bf16(o[2], o[3]); }
                }
                if (m > 0 || fr >= 2) *(u32x4*)(U + (size_t)row * 2816 + ch0) = wu;
                u32x4 wg, wv;
                wg.x = cvt_pk_bf16(acc[ai][0][m][0][0], acc[ai][0][m][0][1]); wg.y = cvt_pk_bf16(acc[ai][0][m][0][2], acc[ai][0][m][0][3]); wg.z = cvt_pk_bf16(acc[ai][0][m][1][0], acc[ai][0][m][1][1]); wg.w = cvt_pk_bf16(acc[ai][0][m][1][2], acc[ai][0][m][1][3]);
                wv.x = cvt_pk_bf16(acc[ai][1][m][0][0], acc[ai][1][m][0][1]); wv.y = cvt_pk_bf16(acc[ai][1][m][0][2], acc[ai][1][m][0][3]); wv.z = cvt_pk_bf16(acc[ai][1][m][1][0], acc[ai][1][m][1][1]); wv.w = cvt_pk_bf16(acc[ai][1][m][1][2], acc[ai][1][m][1][3]);
                if ((m == 0 && fr < 2) || (m == 3 && fr >= 14)) { *(u32x4*)gp = wg; *(u32x4*)(gp + HALF) = wv; }
            }
    }
};

struct EpiResGate {
    static constexpr bool PERM = true, AFTER_DRAIN = false;
    float* Xf; const float* Xinf; bf16_t* Xb; const float* gate; int src_f32, dst_f32, seq_shift, gate_ld;
    __device__ __forceinline__ void operator()(const f32x4 (&acc)[2][2][4][2], const Unit& u, int wr, int wc, int fr, int fq) const {
        const int col0 = u.pn * BM + wc * 32 + 8 * fq;
#pragma unroll
        for (int ai = 0; ai < 2; ++ai)
#pragma unroll
            for (int m = 0; m < 4; ++m) {
                const int row = u.pm * BM + ai * HALF + wr * 64 + m * 16 + fr;
                const float* gp = gate + (size_t)(row >> seq_shift) * gate_ld + col0; const size_t off = (size_t)row * 1024 + col0;
#pragma unroll
                for (int bj = 0; bj < 2; ++bj) {
                    const f32x4 g0 = *(const f32x4*)(gp + bj * HALF), g1 = *(const f32x4*)(gp + bj * HALF + 4);
                    f32x4 x0, x1;
                    if (src_f32) { x0 = *(const f32x4*)(Xinf + off + bj * HALF); x1 = *(const f32x4*)(Xinf + off + bj * HALF + 4); }
                    else { const u32x4 w = *(const u32x4*)(Xb + off + bj * HALF);
                        x0 = (f32x4){__builtin_bit_cast(float, w.x << 16), __builtin_bit_cast(float, w.x & 0xffff0000u), __builtin_bit_cast(float, w.y << 16), __builtin_bit_cast(float, w.y & 0xffff0000u)};
                        x1 = (f32x4){__builtin_bit_cast(float, w.z << 16), __builtin_bit_cast(float, w.z & 0xffff0000u), __builtin_bit_cast(float, w.w << 16), __builtin_bit_cast(float, w.w & 0xffff0000u)}; }
                    x0 = x0 + g0 * acc[ai][bj][m][0]; x1 = x1 + g1 * acc[ai][bj][m][1];
                    if (dst_f32) { *(f32x4*)(Xf + off + bj * HALF) = x0; *(f32x4*)(Xf + off + bj * HALF + 4) = x1; }
                    else { u32x4 w; w.x = cvt_pk_bf16(x0[0], x0[1]); w.y = cvt_pk_bf16(x0[2], x0[3]); w.z = cvt_pk_bf16(x1[0], x1[1]); w.w = cvt_pk_bf16(x1[2], x1[3]); *(u32x4*)(Xb + off + bj * HALF) = w; }
                }
            }
    }
};
template <class Epi, class Sched, bool ALIGN_EPI = false, bool SP2 = false>
__device__ __forceinline__ void gemm_phase(PG8_LAS unsigned char* lds, const Gemm g, const Sched& S, const Epi& E, int tid_in) {
    int tid_ = tid_in; asm volatile("" : "+v"(tid_));
    const int tid = tid_, wid = __builtin_amdgcn_readfirstlane(tid >> 6), lane = tid & 63, wr = wid >> 2, wc = wid & 3, fr = lane & 15, fq = lane >> 4;
    const int K = g.K, nt = K / BK;
    unsigned voffA[2], voffB[2];
#pragma unroll
    for (int i = 0; i < 2; ++i) { int R, C; stage_rc(tid * 16 + i * 8192, R, C); const int Rb = Epi::PERM ? ((R & ~31) + perm32(R & 31)) : R;
        voffA[i] = (unsigned)(R * K + C) * 2u; voffB[i] = (unsigned)(Rb * K + C) * 2u; }
    const size_t kstep = (size_t)(BK * 2);
    const size_t hstep = (size_t)HALF * K * 2;
    const size_t tstep = 2 * hstep;
    const unsigned ldsw = (unsigned)wid * 1024u;
    const int aoff = lds_byte(wr * 64 + fr, fq * 8), boff = lds_byte(wc * 32 + fr, fq * 8);
#define PG8_SA(b, h) (((b) * 2 + (h)) * HTB)
#define PG8_SB(b, h) ((4 + (b) * 2 + (h)) * HTB)
#define PG8_STAGE(bufoff, gbase, voff) do { _Pragma("unroll") for (int _i = 0; _i < 2; ++_i) \
        __builtin_amdgcn_global_load_lds((const unsigned*)((const char*)(gbase) + (voff)[_i]), (PG8_LAS unsigned*)(lds + (bufoff) + ldsw + _i * 8192), 16, 0, 0); } while (0)
#define PG8_LDA(dst, b, h) do { _Pragma("unroll") for (int m = 0; m < 4; ++m) _Pragma("unroll") for (int k = 0; k < 2; ++k) dst[m][k] = *(const PG8_LAS bf16x8*)(lds + PG8_SA(b, h) + aoff + m * 2048 + k * 1024); } while (0)
#define PG8_LDB(dst, b, h) do { _Pragma("unroll") for (int n = 0; n < 2; ++n) _Pragma("unroll") for (int k = 0; k < 2; ++k) dst[n][k] = *(const PG8_LAS bf16x8*)(lds + PG8_SB(b, h) + boff + n * 2048 + k * 1024); } while (0)
#define PG8_MMA(ai, bj, At, Bt) do { __builtin_amdgcn_s_setprio(1); _Pragma("unroll") for (int m = 0; m < 4; ++m) _Pragma("unroll") for (int n = 0; n < 2; ++n) _Pragma("unroll") for (int k = 0; k < 2; ++k) \
        acc[ai][bj][m][n] = __builtin_amdgcn_mfma_f32_16x16x32_bf16(Bt[n][k], At[m][k], acc[ai][bj][m][n], 0, 0, 0); __builtin_amdgcn_s_setprio(0); } while (0)
#define PG8_WAIT_V(n) asm volatile("s_waitcnt vmcnt(" #n ")" ::: "memory")
#define PG8_WAIT_L(n) asm volatile("s_waitcnt lgkmcnt(" #n ")" ::: "memory")
#define PG8_BAR __builtin_amdgcn_s_barrier()
#define PG8_SCHED __builtin_amdgcn_sched_barrier(0)
    Unit cur, nxt; int ui = 0;
    if (!S.next(0, cur)) return;
    f32x4 acc[2][2][4][2];
#pragma unroll
    for (int a = 0; a < 2; ++a)
#pragma unroll
        for (int b = 0; b < 2; ++b)
#pragma unroll
            for (int m = 0; m < 4; ++m)
#pragma unroll
                for (int n = 0; n < 2; ++n) acc[a][b][m][n] = (f32x4){0.f, 0.f, 0.f, 0.f};
    bf16x8 At[4][2], B0[2][2], B1[2][2];
    const char* cA = (const char*)g.A + (size_t)cur.pm * tstep; const char* cB = (const char*)g.Bt + (size_t)cur.pn * tstep;
    S.a_ready(cur);
    if constexpr (SP2) {
        PG8_STAGE(PG8_SB(0, 0), cB, voffB); PG8_STAGE(PG8_SB(0, 1), cB + hstep, voffB); PG8_STAGE(PG8_SA(0, 0), cA, voffA); PG8_STAGE(PG8_SA(0, 1), cA + hstep, voffA);
        if (wr == 1) PG8_BAR;
        PG8_WAIT_V(2); PG8_BAR;
        PG8_STAGE(PG8_SB(1, 0), cB + kstep, voffB); PG8_STAGE(PG8_SA(1, 0), cA + kstep, voffA); PG8_STAGE(PG8_SB(1, 1), cB + hstep + kstep, voffB);
        PG8_WAIT_V(6); PG8_BAR;
    } else {
        PG8_STAGE(PG8_SB(0, 0), cB, voffB); PG8_STAGE(PG8_SA(0, 0), cA, voffA); PG8_STAGE(PG8_SB(0, 1), cB + hstep, voffB); PG8_STAGE(PG8_SA(0, 1), cA + hstep, voffA);
        if (wr == 1) PG8_BAR;
        PG8_WAIT_V(4); PG8_BAR;
        PG8_STAGE(PG8_SB(1, 0), cB + kstep, voffB); PG8_STAGE(PG8_SA(1, 0), cA + kstep, voffA); PG8_STAGE(PG8_SB(1, 1), cB + hstep + kstep, voffB);
        PG8_WAIT_V(6); PG8_BAR;
    }
    for (;;) {
        const bool has_next = S.next(ui + 1, nxt);
        const char* nA = has_next ? (const char*)g.A + (size_t)nxt.pm * tstep : cA; const char* nB = has_next ? (const char*)g.Bt + (size_t)nxt.pn * tstep : cB;
        for (int t = 0; t < nt; t += 2) {
            const bool last = (t == nt - 2);
            const char* a1 = cA + (size_t)(t + 1) * kstep;
            const char* a2 = last ? nA : cA + (size_t)(t + 2) * kstep; const char* b2 = last ? nB : cB + (size_t)(t + 2) * kstep;
            const char* a3 = a2 + kstep; const char* b3 = b2 + kstep;
            if (last && has_next) S.a_ready(nxt);
            if constexpr (SP2) {
            PG8_LDB(B0, 0, 0); PG8_LDB(B1, 0, 1); PG8_SCHED; PG8_LDA(At, 0, 0); PG8_STAGE(PG8_SA(1, 1), a1 + hstep, voffA);
            PG8_WAIT_V(8); PG8_WAIT_L(0); PG8_BAR; PG8_MMA(0, 0, At, B0); PG8_MMA(0, 1, At, B1); PG8_BAR; PG8_SCHED;
            PG8_LDA(At, 0, 1); PG8_STAGE(PG8_SB(0, 0), b2, voffB); PG8_STAGE(PG8_SB(0, 1), b2 + hstep, voffB); PG8_STAGE(PG8_SA(0, 0), a2, voffA);
            PG8_WAIT_V(8); PG8_WAIT_L(0); PG8_BAR; PG8_MMA(1, 0, At, B0); PG8_MMA(1, 1, At, B1); PG8_BAR; PG8_SCHED;
            PG8_LDB(B0, 1, 0); PG8_LDB(B1, 1, 1); PG8_SCHED; PG8_LDA(At, 1, 0); PG8_STAGE(PG8_SA(0, 1), a2 + hstep, voffA);
            PG8_WAIT_V(8); PG8_WAIT_L(0); PG8_BAR; PG8_MMA(0, 0, At, B0); PG8_MMA(0, 1, At, B1); PG8_BAR; PG8_SCHED;
            PG8_LDA(At, 1, 1); PG8_STAGE(PG8_SB(1, 0), b3, voffB); PG8_STAGE(PG8_SB(1, 1), b3 + hstep, voffB); PG8_STAGE(PG8_SA(1, 0), a3, voffA);
            PG8_WAIT_V(8); PG8_WAIT_L(0); PG8_BAR; PG8_MMA(1, 0, At, B0); PG8_MMA(1, 1, At, B1); PG8_BAR; PG8_SCHED;
            } else {
            PG8_LDB(B0, 0, 0); PG8_SCHED; PG8_LDA(At, 0, 0); PG8_STAGE(PG8_SA(1, 1), a1 + hstep, voffA);
            PG8_WAIT_L(8); PG8_BAR; PG8_WAIT_L(0); PG8_MMA(0, 0, At, B0); PG8_BAR; PG8_SCHED;
            PG8_LDB(B1, 0, 1); PG8_STAGE(PG8_SB(0, 0), b2, voffB);
            PG8_BAR; PG8_WAIT_L(0); PG8_MMA(0, 1, At, B1); PG8_BAR;
            PG8_LDA(At, 0, 1); PG8_STAGE(PG8_SA(0, 0), a2, voffA);
            PG8_BAR; PG8_WAIT_L(0); PG8_MMA(1, 0, At, B0); PG8_BAR; PG8_SCHED;
            PG8_STAGE(PG8_SB(0, 1), b2 + hstep, voffB);
            PG8_WAIT_V(6); PG8_BAR; PG8_MMA(1, 1, At, B1); PG8_BAR;
            PG8_LDB(B0, 1, 0); PG8_SCHED; PG8_LDA(At, 1, 0); PG8_STAGE(PG8_SA(0, 1), a2 + hstep, voffA);
            PG8_WAIT_L(8); PG8_BAR; PG8_WAIT_L(0); PG8_MMA(0, 0, At, B0); PG8_BAR; PG8_SCHED;
            PG8_LDB(B1, 1, 1); PG8_STAGE(PG8_SB(1, 0), b3, voffB);
            PG8_BAR; PG8_WAIT_L(0); PG8_MMA(0, 1, At, B1); PG8_BAR;
            PG8_LDA(At, 1, 1); PG8_STAGE(PG8_SA(1, 0), a3, voffA);
            PG8_BAR; PG8_WAIT_L(0); PG8_MMA(1, 0, At, B0); PG8_BAR; PG8_SCHED;
            PG8_STAGE(PG8_SB(1, 1), b3 + hstep, voffB);
            PG8_WAIT_V(6); PG8_BAR; PG8_MMA(1, 1, At, B1); PG8_BAR;
            }
        }
        if constexpr (ALIGN_EPI) { if (wr == 0) PG8_BAR; }
        if constexpr (!Epi::AFTER_DRAIN) { E(acc, cur, wr, wc, fr, fq); S.done(cur); }
        if (!has_next) break;
#pragma unroll
        for (int a = 0; a < 2; ++a)
#pragma unroll
            for (int b = 0; b < 2; ++b)
#pragma unroll
                for (int m = 0; m < 4; ++m)
#pragma unroll
                    for (int n = 0; n < 2; ++n) acc[a][b][m][n] = (f32x4){0.f, 0.f, 0.f, 0.f};
        cur = nxt; cA = nA; cB = nB; ++ui;
        if constexpr (ALIGN_EPI) { if (wr == 1) PG8_BAR; }
    }
    PG8_WAIT_V(0);
    if constexpr (!ALIGN_EPI) { if (wr == 0) PG8_BAR; }
    PG8_BAR;
    if constexpr (Epi::AFTER_DRAIN) { E.fused(acc, cur, wr, wc, fr, fq, lds, wid, lane); S.done(cur); }
#undef PG8_SA
#undef PG8_SB
#undef PG8_STAGE
#undef PG8_LDA
#undef PG8_LDB
#undef PG8_MMA
#undef PG8_WAIT_V
#undef PG8_WAIT_L
#undef PG8_BAR
#undef PG8_SCHED
}
}

struct Ctx { int tid, bid, nb; size_t z; };
__device__ __forceinline__ int lane_id() { return (int)__builtin_amdgcn_mbcnt_hi(~0u, __builtin_amdgcn_mbcnt_lo(~0u, 0u)); }
__device__ __forceinline__ Ctx mkctx(const Params& p, int first = 0, int count = 0) { Ctx c; c.tid = (p.wave << 6) | lane_id(); c.bid = blockIdx.x; c.nb = gridDim.x; c.z = 0; asm volatile("" : "+v"(c.tid), "+s"(c.bid), "+s"(c.nb), "+s"(c.z));
    if (first > 0 || count > 0) { const int hi = count > 0 ? first + count : c.nb; c.bid = (c.bid >= first && c.bid < hi) ? c.bid - first : (1 << 20); c.nb = hi - first; } return c; }
__device__ __forceinline__ int flip_bid(const Ctx& c) { return c.bid < c.nb ? c.nb - 1 - c.bid : (1 << 20); }
#define PIN(i) (p.in[i] + z)
__device__ __forceinline__ void stage_init(const Params& p) {
    const Ctx cx = mkctx(p); const size_t z = cx.z;
    const unsigned gt = (unsigned)cx.bid * NTHREADS + cx.tid, GT = (unsigned)cx.nb * NTHREADS;
    typedef float f4 __attribute__((ext_vector_type(4)));
    f4* X = (f4*)(p.out + z); const f4* xp = (const f4*)PIN(I_XP); const f4* xs = (const f4*)PIN(I_XS);
    (void)xp;
    for (unsigned i = gt; i < (unsigned)NS * (D / 4); i += GT) X[(unsigned)MP * (D / 4) + i] = xs[i];
}
__device__ __forceinline__ void stage_mod(const Params& p, unsigned char* lds, int l_lo, int l_hi, int first = 0) {
    const Ctx cx = mkctx(p, first); const size_t z = cx.z;
    float* MOD = (float*)(p.ws + z + WS_MOD);
    bf16_t* SCs = (bf16_t*)lds;
    bf16_t* WTs = (bf16_t*)(lds + 39168);
    const int lane = cx.tid & 63, wave = __builtin_amdgcn_readfirstlane(cx.tid >> 6), r = lane & 15, q = lane >> 4;
    const int lk = cx.tid >> 4, lj = (cx.tid & 15) * 8;
    for (int item = cx.bid; item < (l_hi - l_lo) * 48; item += cx.nb) {
        const int l = l_lo + item / 48, j0 = (item % 48) * 128;
        const float* w = PIN(I_ADAW) + (size_t)l * D * 6144 + j0 + lj;
        f32x4 acc[9];
#pragma unroll
        for (int i = 0; i < 9; ++i) acc[i] = (f32x4){0.f, 0.f, 0.f, 0.f};
        f32x4 n0 = *(const f32x4*)(w + (size_t)lk * 6144), n1 = *(const f32x4*)(w + (size_t)lk * 6144 + 4);
        __syncthreads();
#pragma unroll
        for (int e = 0; e < 4; ++e) { WTs[(lj + e) * 40 + lk] = f2bf(n0[e]); WTs[(lj + 4 + e) * 40 + lk] = f2bf(n1[e]); }
#pragma unroll 1
        for (int t = 0; t < 32; ++t) {
            if ((t & 3) == 0) {
                __syncthreads();
                for (int i = cx.tid; i < 144 * 16; i += NTHREADS) { const int sidx = i >> 4, k8 = (i & 15) * 8; bf16x8 o;
                    if (sidx < NSEQ) { const float* c = (sidx < NP ? PIN(I_CP) + (size_t)sidx * D : PIN(I_CS) + (size_t)(sidx - NP) * D) + (t >> 2) * 128 + k8;
                        const f32x4 c0 = *(const f32x4*)c, c1 = *(const f32x4*)(c + 4);
#pragma unroll
                        for (int e = 0; e < 4; ++e) { o[e] = (short)f2bf(silu_f(c0[e])); o[4 + e] = (short)f2bf(silu_f(c1[e])); } }
                    else o = (bf16x8){0, 0, 0, 0, 0, 0, 0, 0};
                    *(bf16x8*)(SCs + sidx * LD2 + k8) = o; }
            }
            const int tn = t + 1 < 32 ? t + 1 : 31;
            n0 = *(const f32x4*)(w + (size_t)(tn * 32 + lk) * 6144); n1 = *(const f32x4*)(w + (size_t)(tn * 32 + lk) * 6144 + 4);
            __syncthreads();
            {
                const bf16x8 a = *(const bf16x8*)(WTs + (t & 1) * 5120 + (16 * wave + r) * 40 + 8 * q);
#pragma unroll
                for (int st = 0; st < 9; ++st) {
                    const bf16x8 b = *(const bf16x8*)(SCs + (16 * st + r) * LD2 + 32 * (t & 3) + 8 * q);
                    acc[st] = __builtin_amdgcn_mfma_f32_16x16x32_bf16(a, b, acc[st], 0, 0, 0);
                }
            }
            bf16_t* wn = WTs + ((t + 1) & 1) * 5120;
#pragma unroll
            for (int e = 0; e < 4; ++e) { wn[(lj + e) * 40 + lk] = f2bf(n0[e]); wn[(lj + 4 + e) * 40 + lk] = f2bf(n1[e]); }
        }
        const int j = j0 + 16 * wave + 4 * q;
        const f32x4 b0 = *(const f32x4*)(PIN(I_ADAB) + (size_t)l * 6144 + j);
#pragma unroll
        for (int st = 0; st < 9; ++st) { const int sidx = 16 * st + r; if (sidx < NSEQ) *(f32x4*)(MOD + ((size_t)l * NSEQ + sidx) * 6144 + j) = acc[st] + b0; }
    }
}

__device__ __forceinline__ void stage_norm(const Params& p, int l, int which, float* wl, bool prompt_f32) {
    const Ctx cx = mkctx(p); const size_t z = cx.z;
    const int lane = cx.tid & 63, gw = cx.bid * NWAVES + (cx.tid >> 6), GW = cx.nb * NWAVES;
    const float* X = (l == 0 && which == 0) ? PIN(I_XP) : (const float*)(p.out + z);
    const float* XS = (const float*)(p.out + z);
    bf16_t* H = (bf16_t*)(p.ws + z + WS_H);
    const float* MOD = (const float*)(p.ws + z + WS_MOD);
    const float* g = PIN(which ? I_NFFNG : I_NMIXG) + (size_t)l * D;
    f32x4 gg[4];
#pragma unroll
    for (int j = 0; j < 4; ++j) gg[j] = *(const f32x4*)(g + 4 * lane + 256 * j);
    f32x4 v[2][4], nv[2][4];
    const int rbeg = (prompt_f32 ? 0 : MP) + 2 * gw;
    if (rbeg < R) {
#pragma unroll
        for (int k = 0; k < 2; ++k)
#pragma unroll
            for (int j = 0; j < 4; ++j) v[k][j] = *(const f32x4*)((rbeg + k < MP ? X : XS) + (size_t)(rbeg + k) * D + 4 * lane + 256 * j);
    }
    for (int row0 = rbeg; row0 < R; row0 += 2 * GW) {
        const int rnext = row0 + 2 * GW < R ? row0 + 2 * GW : row0;
#pragma unroll
        for (int k = 0; k < 2; ++k)
#pragma unroll
            for (int j = 0; j < 4; ++j) nv[k][j] = *(const f32x4*)((rnext + k < MP ? X : XS) + (size_t)(rnext + k) * D + 4 * lane + 256 * j);
#pragma unroll
        for (int k = 0; k < 2; ++k) {
            const int row = row0 + k;
            const float* md = MOD + ((size_t)l * NSEQ + seq_of_row(row)) * 6144 + which * 3072 + 4 * lane;
            f32x4 sh[4], sc[4];
#pragma unroll
            for (int j = 0; j < 4; ++j) { sh[j] = *(const f32x4*)(md + 256 * j); sc[j] = *(const f32x4*)(md + 1024 + 256 * j); }
            float ss = 0.f;
#pragma unroll
            for (int j = 0; j < 4; ++j) ss += (v[k][j][0] * v[k][j][0] + v[k][j][1] * v[k][j][1]) + (v[k][j][2] * v[k][j][2] + v[k][j][3] * v[k][j][3]);
            ss = wave_sum(ss);
            const float rstd = rsqrtf(ss * (1.f / D) + NORM_EPS);
#pragma unroll
            for (int j = 0; j < 4; ++j) { v[k][j] = v[k][j] * rstd * gg[j] * (1.f + sc[j]) + sh[j];
                *(bf16x4*)(H + (size_t)row * D + 4 * lane + 256 * j) = (bf16x4){(short)f2bf(v[k][j][0]), (short)f2bf(v[k][j][1]), (short)f2bf(v[k][j][2]), (short)f2bf(v[k][j][3])}; }
        }
#pragma unroll
        for (int k = 0; k < 2; ++k)
#pragma unroll
            for (int j = 0; j < 4; ++j) v[k][j] = nv[k][j];
    }
}

__device__ __forceinline__ void stage_norm_b(const Params& p, int l, int which) {
    const Ctx cx = mkctx(p); const size_t z = cx.z;
    const int lane = cx.tid & 63, gw = cx.bid * NWAVES + (cx.tid >> 6), GW = cx.nb * NWAVES;
    const bf16_t* XB = (const bf16_t*)(p.ws + z + WS_XB);
    bf16_t* H = (bf16_t*)(p.ws + z + WS_H);
    const float* MOD = (const float*)(p.ws + z + WS_MOD);
    const float* g = PIN(which ? I_NFFNG : I_NMIXG) + (size_t)l * D;
    f32x4 gg[2][2];
#pragma unroll
    for (int j = 0; j < 2; ++j) { gg[j][0] = *(const f32x4*)(g + 8 * lane + 512 * j); gg[j][1] = *(const f32x4*)(g + 8 * lane + 512 * j + 4); }
    typedef pg8::u32x4 u32x4;
    u32x4 v[4][2], nv[4][2];
    if (4 * gw < MP) {
#pragma unroll
        for (int k = 0; k < 4; ++k)
#pragma unroll
            for (int j = 0; j < 2; ++j) v[k][j] = *(const u32x4*)(XB + (size_t)(4 * gw + k) * D + 8 * lane + 512 * j);
    }
    for (int row0 = 4 * gw; row0 < MP; row0 += 4 * GW) {
        const int rnext = row0 + 4 * GW < MP ? row0 + 4 * GW : row0;
#pragma unroll
        for (int k = 0; k < 4; ++k)
#pragma unroll
            for (int j = 0; j < 2; ++j) nv[k][j] = *(const u32x4*)(XB + (size_t)(rnext + k) * D + 8 * lane + 512 * j);
        const float* md = MOD + ((size_t)l * NSEQ + (row0 >> 13)) * 6144 + which * 3072 + 8 * lane;
        f32x4 sh[2][2], sc[2][2];
#pragma unroll
        for (int j = 0; j < 2; ++j)
#pragma unroll
            for (int h = 0; h < 2; ++h) { sh[j][h] = *(const f32x4*)(md + 512 * j + 4 * h); sc[j][h] = *(const f32x4*)(md + 1024 + 512 * j + 4 * h) + 1.f; sc[j][h] = sc[j][h] * gg[j][h]; }
#pragma unroll
        for (int k = 0; k < 4; ++k) {
            const int row = row0 + k;
            f32x4 x[2][2]; float ss = 0.f;
#pragma unroll
            for (int j = 0; j < 2; ++j) { const u32x4 w = v[k][j];
                x[j][0] = (f32x4){__builtin_bit_cast(float, w.x << 16), __builtin_bit_cast(float, w.x & 0xffff0000u), __builtin_bit_cast(float, w.y << 16), __builtin_bit_cast(float, w.y & 0xffff0000u)};
                x[j][1] = (f32x4){__builtin_bit_cast(float, w.z << 16), __builtin_bit_cast(float, w.z & 0xffff0000u), __builtin_bit_cast(float, w.w << 16), __builtin_bit_cast(float, w.w & 0xffff0000u)};
#pragma unroll
                for (int h = 0; h < 2; ++h) ss += (x[j][h][0] * x[j][h][0] + x[j][h][1] * x[j][h][1]) + (x[j][h][2] * x[j][h][2] + x[j][h][3] * x[j][h][3]); }
            ss = wave_sum(ss);
            const float rstd = rsqrtf(ss * (1.f / D) + NORM_EPS);
#pragma unroll
            for (int j = 0; j < 2; ++j) { const f32x4 o0 = x[j][0] * rstd * sc[j][0] + sh[j][0], o1 = x[j][1] * rstd * sc[j][1] + sh[j][1];
                u32x4 w; w.x = cvtpk(o0[0], o0[1]); w.y = cvtpk(o0[2], o0[3]); w.z = cvtpk(o1[0], o1[1]); w.w = cvtpk(o1[2], o1[3]);
                *(u32x4*)(H + (size_t)row * D + 8 * lane + 512 * j) = w; }
        }
#pragma unroll
        for (int k = 0; k < 4; ++k)
#pragma unroll
            for (int j = 0; j < 2; ++j) v[k][j] = nv[k][j];
    }
}

__device__ __forceinline__ f32x4 ld4bf(const bf16_t* p) { const bf16x4 v = *(const bf16x4*)p; return (f32x4){bf2f((bf16_t)v[0]), bf2f((bf16_t)v[1]), bf2f((bf16_t)v[2]), bf2f((bf16_t)v[3])}; }
__device__ __forceinline__ void stage_rwprep(const Params& p, int l, float* lds) {
    const Ctx cx = mkctx(p); const size_t z = cx.z;
    const bf16_t* P = (const bf16_t*)(p.ws + z + WS_P);
    bf16_t* RWH = (bf16_t*)(p.ws + z + WS_RW); float* RWD = (float*)(p.ws + z + WS_RWD);
    float* xs = lds; float* kk = lds + 1024;
    const int tid = cx.tid;
    const float* mu = PIN(I_MU) + (size_t)l * 1024;
    for (int row = MP + cx.bid; row < R; row += cx.nb) {
        const bool samp = row >= MP; const int n = samp ? row - MP : row >> 13, t = samp ? 0 : (row & (T - 1));
        __syncthreads();
        for (int c = tid; c < 1024; c += NTHREADS) {
            const float pa = bf2f(P[(size_t)row * PCOLS + c]);
            float prev;
            if (t > 0) prev = bf2f(P[(size_t)(row - 1) * PCOLS + c]);
            else prev = samp ? PIN(I_SHIFT)[((size_t)l * NS + n) * 1024 + c] : 0.f;
            float v = pa + (prev - pa) * mu[c];
            if (c >= 768 && c < 832) v = tanh_fast(v);
            if (c >= 896) v = sigmoid_f(v);
            xs[c] = v;
            if (samp) (p.out + z)[O_SSHIFT + ((size_t)l * NS + n) * 1024 + c] = pa;
            else if (t == T - 1) (p.out + z)[O_PSHIFT + ((size_t)l * NP + n) * 1024 + c] = pa;
        }
        __syncthreads();
        float av = 0.f, gv = 0.f, dec = 0.f, kraw = 0.f;
        if (tid < 256) {
            const int j = tid;
            float wl = PIN(I_W0)[(size_t)l * 256 + j], al = PIN(I_A0)[(size_t)l * 256 + j]; gv = 0.f;
            const bf16_t* W2T = (const bf16_t*)(p.ws + z + WS_LORA) + (size_t)l * 65536;
            bf16x8 fw[8], fa[8], fg[16];
#pragma unroll
            for (int c8 = 0; c8 < 8; ++c8) { fw[c8] = *(const bf16x8*)(W2T + j * 64 + c8 * 8); fa[c8] = *(const bf16x8*)(W2T + 16384 + j * 64 + c8 * 8); }
#pragma unroll
            for (int c8 = 0; c8 < 16; ++c8) fg[c8] = *(const bf16x8*)(W2T + 32768 + j * 128 + c8 * 8);
#pragma unroll
            for (int c8 = 0; c8 < 8; ++c8)
#pragma unroll
                for (int e = 0; e < 8; ++e) { wl += xs[768 + c8 * 8 + e] * bf2f((bf16_t)fw[c8][e]); al += xs[832 + c8 * 8 + e] * bf2f((bf16_t)fa[c8][e]); }
#pragma unroll
            for (int c8 = 0; c8 < 16; ++c8)
#pragma unroll
                for (int e = 0; e < 8; ++e) gv += xs[896 + c8 * 8 + e] * bf2f((bf16_t)fg[c8][e]);
            const float w_log = -softplus_fast(-wl) - 0.5f;
            dec = -__expf(w_log);
            av = sigmoid_f(al);
            kraw = xs[256 + j];
            kk[j] = kraw * PIN(I_KK)[(size_t)l * 256 + j];
        }
        __syncthreads();
        if (tid < 256) {
            const int j = tid, h0 = j & ~63;
            float s = 0.f;
#pragma unroll 4
            for (int i = 0; i < 64; ++i) s += kk[h0 + i] * kk[h0 + i];
            const float kkn = kk[j] / fmaxf(sqrtf(s), 1e-12f);
            const float kmod = kraw * (1.f + (av - 1.f) * PIN(I_KA)[(size_t)l * 256 + j]);
            bf16_t* rw = RWH + (size_t)row * 1536 + j;
            rw[0] = f2bf(xs[j]); rw[256] = f2bf(kmod); rw[512] = f2bf(xs[512 + j]); rw[768] = f2bf(-kkn); rw[1024] = f2bf(kkn * av); rw[1280] = f2bf(gv); RWD[(size_t)row * 256 + j] = dec;
        }
    }
}

__device__ __forceinline__ void stage_rwprep2(const Params& p, int l, unsigned char* lds) {
    const Ctx cx = mkctx(p); const size_t z = cx.z;
    const int tid = cx.tid, lane = tid & 63, wave = __builtin_amdgcn_readfirstlane(tid >> 6), r = lane & 15, q = lane >> 4;
    bf16_t* ACW = (bf16_t*)lds;
    bf16_t* ACA = (bf16_t*)(lds + 9216);
    bf16_t* ACG = (bf16_t*)(lds + 18432);
    const bf16_t* P = (const bf16_t*)(p.ws + z + WS_P);
    bf16_t* RWH = (bf16_t*)(p.ws + z + WS_RW); float* RWD = (float*)(p.ws + z + WS_RWD);
    const bf16_t* W2T = (const bf16_t*)(p.ws + z + WS_LORA) + (size_t)l * 65536; const bf16_t* A2T = W2T + 16384; const bf16_t* G2T = W2T + 32768;
    const float* mu = PIN(I_MU) + (size_t)l * 1024;
    for (int tile = cx.bid; tile < MP / 64; tile += cx.nb) {
        const int row0 = tile * 64;
#pragma unroll
        for (int it = 0; it < 4; ++it) {
            const int task = it * NTHREADS + tid, tok = task >> 5, ch = task & 31, c = 768 + ch * 8, row = row0 + tok;
            const bf16x8 pa = *(const bf16x8*)(P + (size_t)row * PCOLS + c);
            bf16x8 pv = {0, 0, 0, 0, 0, 0, 0, 0};
            if ((row & (T - 1)) != 0) pv = *(const bf16x8*)(P + (size_t)(row - 1) * PCOLS + c);
            bf16x8 o;
#pragma unroll
            for (int e = 0; e < 8; ++e) { const float a = bf2f((bf16_t)pa[e]), b = bf2f((bf16_t)pv[e]); float x = a + (b - a) * mu[c + e];
                x = ch < 8 ? tanh_fast(x) : (ch >= 16 ? sigmoid_f(x) : x); o[e] = (short)f2bf(x); }
            if (ch < 8) *(bf16x8*)(ACW + tok * LD + ch * 8) = o;
            else if (ch < 16) *(bf16x8*)(ACA + tok * LD + (ch - 8) * 8) = o;
            else *(bf16x8*)(ACG + tok * LD2 + (ch - 16) * 8) = o;
        }
        if ((row0 & (T - 1)) == T - 64) {
            const int n = row0 >> 13;
            for (int c = tid; c < 1024; c += NTHREADS) (p.out + z)[O_PSHIFT + ((size_t)l * NP + n) * 1024 + c] = bf2f(P[(size_t)(row0 + 63) * PCOLS + c]);
        }
        __syncthreads();
        {
            const int h = wave >> 1, th = wave & 1;
#pragma unroll 1
            for (int nt = 0; nt < 2; ++nt) {
                const int tb = 32 * th + 16 * nt, row = row0 + tb + r; const bool first = (row & (T - 1)) == 0;
                float kkv[4][4], avv[4][4]; float ssq = 0.f;
                bf16x4 pc[4][3], pp_[4][3];
#pragma unroll
                for (int mt = 0; mt < 4; ++mt) { const int j = h * 64 + 16 * mt + 4 * q; const bf16x4 zero4 = {0, 0, 0, 0};
#pragma unroll
                    for (int f = 0; f < 3; ++f) { pc[mt][f] = *(const bf16x4*)(P + (size_t)row * PCOLS + 256 * f + j); pp_[mt][f] = first ? zero4 : *(const bf16x4*)(P + (size_t)(row - 1) * PCOLS + 256 * f + j); } }
#pragma unroll
                for (int mt = 0; mt < 4; ++mt) {
                    const int j0 = h * 64 + 16 * mt, j = j0 + 4 * q;
                    f32x4 aw = {0.f, 0.f, 0.f, 0.f}, aa = {0.f, 0.f, 0.f, 0.f}, ag = {0.f, 0.f, 0.f, 0.f};
#pragma unroll
                    for (int s2 = 0; s2 < 2; ++s2) {
                        const bf16x8 fw = *(const bf16x8*)(W2T + (j0 + r) * 64 + 32 * s2 + 8 * q), fa = *(const bf16x8*)(A2T + (j0 + r) * 64 + 32 * s2 + 8 * q);
                        const bf16x8 bw = *(const bf16x8*)(ACW + (tb + r) * LD + 32 * s2 + 8 * q), ba = *(const bf16x8*)(ACA + (tb + r) * LD + 32 * s2 + 8 * q);
                        aw = __builtin_amdgcn_mfma_f32_16x16x32_bf16(fw, bw, aw, 0, 0, 0);
                        aa = __builtin_amdgcn_mfma_f32_16x16x32_bf16(fa, ba, aa, 0, 0, 0);
                    }
#pragma unroll
                    for (int s2 = 0; s2 < 4; ++s2) {
                        const bf16x8 fg = *(const bf16x8*)(G2T + (j0 + r) * 128 + 32 * s2 + 8 * q), bg = *(const bf16x8*)(ACG + (tb + r) * LD2 + 32 * s2 + 8 * q);
                        ag = __builtin_amdgcn_mfma_f32_16x16x32_bf16(fg, bg, ag, 0, 0, 0);
                    }
                    const bf16x4 par = pc[mt][0], pak = pc[mt][1], pav = pc[mt][2], pvr = pp_[mt][0], pvk = pp_[mt][1], pvv = pp_[mt][2];
                    const f32x4 mur = *(const f32x4*)(mu + j), muk = *(const f32x4*)(mu + 256 + j), muv = *(const f32x4*)(mu + 512 + j);
                    const f32x4 w0 = *(const f32x4*)(PIN(I_W0) + (size_t)l * 256 + j), a0 = *(const f32x4*)(PIN(I_A0) + (size_t)l * 256 + j);
                    const f32x4 kkw = *(const f32x4*)(PIN(I_KK) + (size_t)l * 256 + j), kaw = *(const f32x4*)(PIN(I_KA) + (size_t)l * 256 + j);
                    f32x4 fr_, fk_, fv_, fd_;
#pragma unroll
                    for (int e = 0; e < 4; ++e) {
                        const float ar = bf2f((bf16_t)par[e]), ak = bf2f((bf16_t)pak[e]), av_ = bf2f((bf16_t)pav[e]);
                        const float xr = ar + (bf2f((bf16_t)pvr[e]) - ar) * mur[e], xk = ak + (bf2f((bf16_t)pvk[e]) - ak) * muk[e], xv = av_ + (bf2f((bf16_t)pvv[e]) - av_) * muv[e];
                        const float w_log = -softplus_fast(-(w0[e] + aw[e])) - 0.5f;
                        const float av = sigmoid_f(a0[e] + aa[e]);
                        fd_[e] = -__expf(w_log);
                        fr_[e] = xr; fv_[e] = xv;
                        fk_[e] = xk * (1.f + (av - 1.f) * kaw[e]);
                        const float kv = xk * kkw[e]; kkv[mt][e] = kv; avv[mt][e] = av; ssq += kv * kv;
                    }
                    bf16_t* rw = RWH + (size_t)row * 1536 + j;
                    *(bf16x4*)rw = pack4(fr_); *(bf16x4*)(rw + 256) = pack4(fk_); *(bf16x4*)(rw + 512) = pack4(fv_); *(bf16x4*)(rw + 1280) = pack4(ag); *(f32x4*)(RWD + (size_t)row * 256 + j) = fd_;
                }
                ssq += __shfl_xor(ssq, 16); ssq += __shfl_xor(ssq, 32);
                const float rn = 1.f / fmaxf(sqrtf(ssq), 1e-12f);
#pragma unroll
                for (int mt = 0; mt < 4; ++mt) {
                    bf16_t* rw = RWH + (size_t)row * 1536 + h * 64 + 16 * mt + 4 * q;
                    f32x4 fa_, fb_;
#pragma unroll
                    for (int e = 0; e < 4; ++e) { const float kn = kkv[mt][e] * rn; fa_[e] = -kn; fb_[e] = kn * avv[mt][e]; }
                    *(bf16x4*)(rw + 768) = pack4(fa_); *(bf16x4*)(rw + 1024) = pack4(fb_);
                }
            }
        }
        __syncthreads();
    }
}

#define WAVE_LDS_SYNC() do { asm volatile("s_waitcnt lgkmcnt(0)" ::: "memory"); __builtin_amdgcn_wave_barrier(); } while (0)
__device__ __forceinline__ void stage_rwscan(const Params& p, int l, float* lds, int first = 0) {
    const Ctx cx = mkctx(p, first); const size_t z = cx.z;
    const int lane = cx.tid & 63, wave = cx.tid >> 6;
    const bf16_t* RWH = (const bf16_t*)(p.ws + z + WS_RW); const float* RWD = (const float*)(p.ws + z + WS_RWD);
    bf16_t* Y = (bf16_t*)(p.ws + z + WS_YCAT);
    float* wl = lds + wave * 512;
    for (int u = NP * 4 + cx.bid + cx.nb * wave; u < NSEQ * 4; u += cx.nb * NWAVES) {
        const int s = u >> 2, h = u & 3; const bool samp = s >= NP; const int n = samp ? s - NP : s;
        const int row0 = samp ? MP + n : n * T, nt = samp ? 1 : T;
        float S[64];
        if (samp) { const float* st = PIN(I_WKV) + ((((size_t)l * NS + n) * 4 + h) * 64 + lane) * 64;
#pragma unroll
            for (int k = 0; k < 64; k += 4) { const f32x4 v4 = *(const f32x4*)(st + k); S[k] = v4[0]; S[k + 1] = v4[1]; S[k + 2] = v4[2]; S[k + 3] = v4[3]; } }
        else {
#pragma unroll
            for (int k = 0; k < 64; ++k) S[k] = 0.f; }
        const float lng = PIN(I_LNG)[(size_t)l * 256 + h * 64 + lane], lnb = PIN(I_LNB)[(size_t)l * 256 + h * 64 + lane];
        const float rkl = PIN(I_RK)[(size_t)l * 256 + h * 64 + lane];
        for (int t = 0; t < nt; ++t) {
            const bf16_t* rw = RWH + (size_t)(row0 + t) * 1536 + h * 64 + lane;
            const float rl = bf2f(rw[0]), kl = bf2f(rw[256]), vl = bf2f(rw[512]), gl = bf2f(rw[1280]);
            WAVE_LDS_SYNC();
            wl[lane] = rl; wl[64 + lane] = kl; wl[128 + lane] = __expf(RWD[(size_t)(row0 + t) * 256 + h * 64 + lane]); wl[192 + lane] = bf2f(rw[768]); wl[256 + lane] = bf2f(rw[1024]);
            WAVE_LDS_SYNC();
            const float bd = wave_sum(rl * kl * rkl);
            float sa = 0.f;
#pragma unroll
            for (int k = 0; k < 64; ++k) sa += S[k] * wl[192 + k];
            float y = 0.f;
#pragma unroll
            for (int k = 0; k < 64; ++k) {
                S[k] = S[k] * wl[128 + k] + sa * wl[256 + k] + vl * wl[64 + k];
                y += S[k] * wl[k];
            }
            const float mean = wave_sum(y) * (1.f / 64.f), dl = y - mean;
            const float var = wave_sum(dl * dl) * (1.f / 64.f);
            const float yn = dl * rsqrtf(var + GN_EPS) * lng + lnb;
            Y[(size_t)(row0 + t) * D + h * 64 + lane] = f2bf((yn + bd * vl) * gl);
        }
        float* so = (p.out + z) + (samp ? O_SWKV + ((((size_t)l * NS + n) * 4 + h) * 64 + lane) * 64 : O_PWKV + ((((size_t)l * NP + n) * 4 + h) * 64 + lane) * 64);
#pragma unroll
        for (int k = 0; k < 64; k += 4) *(f32x4*)(so + k) = (f32x4){S[k], S[k + 1], S[k + 2], S[k + 3]};
    }
}

constexpr int RWL = 64, NCH = T / RWL, RW_UNITS = NP * 4 * NCH;
__device__ __forceinline__ f32x4 mma16_k64(const bf16_t* A, const bf16_t* Bt, f32x4 acc, int r, int q) {
    const bf16x8 a0 = *(const bf16x8*)(A + r * LD + 8 * q), a1 = *(const bf16x8*)(A + r * LD + 32 + 8 * q);
    const bf16x8 b0 = *(const bf16x8*)(Bt + r * LD + 8 * q), b1 = *(const bf16x8*)(Bt + r * LD + 32 + 8 * q);
    acc = __builtin_amdgcn_mfma_f32_16x16x32_bf16(a0, b0, acc, 0, 0, 0);
    acc = __builtin_amdgcn_mfma_f32_16x16x32_bf16(a1, b1, acc, 0, 0, 0);
    return acc;
}

__device__ __forceinline__ void stage_rw1(const Params& p, int l, unsigned char* lds) {
    const Ctx cx = mkctx(p); const size_t z = cx.z;
    const int tid = cx.tid, lane0 = tid & 63, wave = __builtin_amdgcn_readfirstlane(tid >> 6);
#define RELANE() int lane_ = lane0; asm volatile("" : "+v"(lane_)); const int lane = lane_, r = lane & 15, q = lane >> 4; (void)r; (void)q;
    bf16_t* M = (bf16_t*)lds;
    float* AT = (float*)(lds + 12 * MSZ * 2);
    float* psum = AT + 64 * 68;
    float* PLs = psum + 512;
    bf16_t* TA10 = (bf16_t*)(PLs + 64);
    bf16_t* TT00 = TA10 + 32 * LD; bf16_t* TYT = TT00 + 32 * LD;
    unsigned char* const wsz = p.ws + z;
    for (int uu = cx.bid; uu < RW_UNITS; uu += cx.nb) {
        const int tile = uu & 255, h = uu >> 8, n = tile >> 7, c = tile & (NCH - 1), unit = (n * 4 + h) * NCH + c;
        const int row0 = n * T + c * RWL;
        {
            RELANE();
            const int k = lane, tg = wave;
            const bf16_t* rw = (const bf16_t*)(wsz + WS_RW) + (size_t)(row0 + tg * 8) * 1536 + h * 64 + k; const float* rwd = (const float*)(wsz + WS_RWD) + (size_t)(row0 + tg * 8) * 256 + h * 64 + k;
            float ld[8], f_r[8], f_k[8], f_v[8], f_a[8], f_b[8]; float cs = 0.f;
#pragma unroll
            for (int j = 0; j < 8; ++j) { ld[j] = rwd[j * 256]; f_r[j] = bf2f(rw[j * 1536]); f_k[j] = bf2f(rw[j * 1536 + 256]); f_v[j] = bf2f(rw[j * 1536 + 512]); f_a[j] = bf2f(rw[j * 1536 + 768]); f_b[j] = bf2f(rw[j * 1536 + 1024]); }
#pragma unroll
            for (int j = 0; j < 8; ++j) { cs += ld[j]; ld[j] = cs; }
            psum[tg * 64 + k] = cs;
            __syncthreads();
            float off = 0.f, tot = 0.f;
#pragma unroll
            for (int g = 0; g < 8; ++g) { const float v_ = psum[g * 64 + k]; tot += v_; off += g < tg ? v_ : 0.f; }
            if (tg == 0) PLs[k] = __expf(tot);
            bf16x8 atT, bcT, kcT, vT;
#pragma unroll
            for (int j = 0; j < 8; ++j) {
                const float lp = off + ld[j], lpm1 = j ? off + ld[j - 1] : off;
                const float Pt = __expf(lp), Pinv = __expf(-lp), Pm1 = __expf(lpm1), E = __expf(tot - lp);
                const float rr = f_r[j], km = f_k[j], vv = f_v[j], av = f_a[j], bv = f_b[j];
                const int t = tg * 8 + j;
                const bf16_t at = f2bf(av * Pm1);
                M[0 * MSZ + t * LD + k] = at; atT[j] = (short)at;
                M[3 * MSZ + t * LD + k] = f2bf(rr * Pt);
                M[1 * MSZ + t * LD + k] = f2bf(bv * Pinv);
                M[2 * MSZ + t * LD + k] = f2bf(km * Pinv);
                bcT[j] = (short)f2bf(bv * E); kcT[j] = (short)f2bf(km * E); vT[j] = (short)f2bf(vv);
            }
            *(bf16x8*)(M + 4 * MSZ + k * LD + tg * 8) = atT;
            *(bf16x8*)(M + 5 * MSZ + k * LD + tg * 8) = bcT;
            *(bf16x8*)(M + 6 * MSZ + k * LD + tg * 8) = kcT;
            *(bf16x8*)(M + 7 * MSZ + k * LD + tg * 8) = vT;
        }
        __syncthreads();
        {
            RELANE();
            const int mm = wave >> 1, hh = wave & 1;
            const bf16_t* Asrc = M + (mm < 2 ? 0 : 3) * MSZ; const bf16_t* Bsrc = M + ((mm & 1) ? 2 : 1) * MSZ;
#pragma unroll
            for (int m2 = 0; m2 < 2; ++m2) {
                const int mt = hh * 2 + m2;
#pragma unroll
                for (int nt = 0; nt < 4; ++nt) {
                    float zf = 0.f; asm volatile("" : "+v"(zf));
                    f32x4 acc = {zf, zf, zf, zf};
                    if (nt <= mt) acc = mma16_k64(Asrc + mt * 16 * LD, Bsrc + nt * 16 * LD, acc, r, q);
                    const int i = 16 * nt + r;
#pragma unroll
                    for (int e = 0; e < 4; ++e) { const int t = 16 * mt + 4 * q + e; const bool keep = mm < 2 ? (i < t) : (i <= t); acc[e] = keep ? acc[e] : 0.f; }
                    if (mm == 0) { *(f32x4*)(AT + i * 68 + 16 * mt + 4 * q) = acc;
                        if (mt >= 2 && nt < 2) {
#pragma unroll
                            for (int e = 0; e < 4; ++e) TA10[(16 * (mt - 2) + 4 * q + e) * LD + i] = f2bf(acc[e]); } }
                    else {
                        bf16_t* dst = M + (7 + mm) * MSZ;
#pragma unroll
                        for (int e = 0; e < 4; ++e) dst[(16 * mt + 4 * q + e) * LD + i] = f2bf(acc[e]);
                    }
                }
            }
        }
        __syncthreads();
        if (wave == 0) {
            RELANE();
            const int blk = lane >> 5, jl = lane & 31;
            const float* ATl = AT + blk * (32 * 68 + 32);
            float tc[32];
#pragma unroll
            for (int t = 0; t < 32; ++t) tc[t] = (t == jl) ? 1.f : 0.f;
            int aoff = 0;
            float cur[31], nxt[31];
#pragma unroll
            for (int t = 1; t < 32; ++t) cur[t - 1] = ATl[t];
#pragma unroll
            for (int i = 0; i < 31; ++i) {
                asm volatile("" : "+v"(aoff), "+v"(tc[i]));
                if (i + 1 < 31) {
#pragma unroll
                    for (int t = i + 2; t < 32; ++t) nxt[t - i - 2] = ATl[aoff + (i + 1) * 68 + t];
                }
                const float ti = tc[i];
#pragma unroll
                for (int t = i + 1; t < 32; ++t) tc[t] += cur[t - i - 1] * ti;
#pragma unroll
                for (int t = 0; t < 30; ++t) cur[t] = nxt[t];
            }
            bf16_t* T11 = M + 11 * MSZ;
#pragma unroll
            for (int t = 0; t < 32; ++t) { T11[(blk * 32 + t) * LD + lane] = f2bf(tc[t]); if (blk) T11[t * LD + lane] = 0; }
            if (blk == 0) {
#pragma unroll
                for (int c8 = 0; c8 < 4; ++c8) { bf16x8 o;
#pragma unroll
                    for (int e = 0; e < 8; ++e) o[e] = (short)f2bf(tc[c8 * 8 + e]);
                    *(bf16x8*)(TT00 + jl * LD + c8 * 8) = o; }
            }
        } else if (wave >= 4) {
            RELANE();
            const int mt = wave - 4;
#pragma unroll
            for (int nt = 0; nt < 4; ++nt) {
                f32x4 acc = {0.f, 0.f, 0.f, 0.f};
                acc = mma16_k64(M + 7 * MSZ + mt * 16 * LD, M + 8 * MSZ + nt * 16 * LD, acc, r, q);
#pragma unroll
                for (int e = 0; e < 4; ++e) M[1 * MSZ + (16 * mt + 4 * q + e) * LD + 16 * nt + r] = f2bf(acc[e]);
            }
        }
        __syncthreads();
        if (wave < 4) {
            RELANE();
            const int mt = wave >> 1, nt = wave & 1;
            const bf16x8 a = *(const bf16x8*)(TA10 + (16 * mt + r) * LD + 8 * q), b = *(const bf16x8*)(TT00 + (16 * nt + r) * LD + 8 * q);
            f32x4 acc = {0.f, 0.f, 0.f, 0.f};
            acc = __builtin_amdgcn_mfma_f32_16x16x32_bf16(a, b, acc, 0, 0, 0);
#pragma unroll
            for (int e = 0; e < 4; ++e) TYT[(16 * nt + r) * LD + 16 * mt + 4 * q + e] = f2bf(acc[e]);
        }
        __syncthreads();
        if (wave < 4) {
            RELANE();
            const int mt = wave >> 1, nt = wave & 1;
            const bf16x8 a = *(const bf16x8*)(M + 11 * MSZ + (32 + 16 * mt + r) * LD + 32 + 8 * q), b = *(const bf16x8*)(TYT + (16 * nt + r) * LD + 8 * q);
            f32x4 acc = {0.f, 0.f, 0.f, 0.f};
            acc = __builtin_amdgcn_mfma_f32_16x16x32_bf16(a, b, acc, 0, 0, 0);
#pragma unroll
            for (int e = 0; e < 4; ++e) M[11 * MSZ + (32 + 16 * mt + 4 * q + e) * LD + 16 * nt + r] = f2bf(acc[e]);
        }
        __syncthreads();
        {
            RELANE();
            const int mt = wave & 3; const bf16_t* Asrc = M + (wave < 4 ? 4 : 1) * MSZ; bf16_t* dst = M + (wave < 4 ? 0 : 2) * MSZ;
#pragma unroll
            for (int nt = 0; nt < 4; ++nt) {
                f32x4 acc = {0.f, 0.f, 0.f, 0.f};
                acc = mma16_k64(Asrc + mt * 16 * LD, M + 11 * MSZ + nt * 16 * LD, acc, r, q);
#pragma unroll
                for (int e = 0; e < 4; ++e) dst[(16 * mt + 4 * q + e) * LD + 16 * nt + r] = f2bf(acc[e]);
            }
        }
        __syncthreads();
        {
            RELANE();
            const int job = wave >> 1;
            bf16_t* RPg = (bf16_t*)(wsz + WS_RWC_RP); bf16_t* MCg = (bf16_t*)(wsz + WS_RWC_MC); bf16_t* NCTg = (bf16_t*)(wsz + WS_RWC_NCT); float* Y0g = (float*)(wsz + WS_RWC_Y0);
#pragma unroll
            for (int m2 = 0; m2 < 2; ++m2) {
                const int mt = (wave & 1) * 2 + m2;
#pragma unroll
                for (int nt = 0; nt < 4; ++nt) {
                    const size_t ub = (size_t)unit * 4096;
                    if (job == 0) {
                        const bf16x4 in = *(const bf16x4*)(M + 3 * MSZ + (16 * nt + r) * LD + 16 * mt + 4 * q);
                        f32x4 acc = {bf2f((bf16_t)in[0]), bf2f((bf16_t)in[1]), bf2f((bf16_t)in[2]), bf2f((bf16_t)in[3])};
                        acc = mma16_k64(M + 0 * MSZ + mt * 16 * LD, M + 9 * MSZ + nt * 16 * LD, acc, r, q);
                        *(bf16x4*)(RPg + ub + (16 * nt + r) * 64 + 16 * mt + 4 * q) = pack4(acc);
                    } else if (job == 1) {
                        f32x4 acc = {0.f, 0.f, 0.f, 0.f};
                        acc = mma16_k64(M + 0 * MSZ + mt * 16 * LD, M + 5 * MSZ + nt * 16 * LD, acc, r, q);
                        const int k1 = 16 * nt + r; const float pl = PLs[k1];
#pragma unroll
                        for (int e = 0; e < 4; ++e) acc[e] += (16 * mt + 4 * q + e == k1) ? pl : 0.f;
                        *(bf16x4*)(MCg + ub + k1 * 64 + 32 * (mt >> 1) + 8 * q + 4 * (mt & 1)) = pack4(acc);
                    } else if (job == 2) {
                        f32x4 acc = {0.f, 0.f, 0.f, 0.f};
                        acc = mma16_k64(M + 2 * MSZ + mt * 16 * LD, M + 9 * MSZ + nt * 16 * LD, acc, r, q);
                        acc = mma16_k64(M + 7 * MSZ + mt * 16 * LD, M + 10 * MSZ + nt * 16 * LD, acc, r, q);
                        *(f32x4*)(Y0g + ub + (16 * nt + r) * 64 + 16 * mt + 4 * q) = acc;
                    } else {
                        f32x4 acc = {0.f, 0.f, 0.f, 0.f};
                        acc = mma16_k64(M + 5 * MSZ + mt * 16 * LD, M + 2 * MSZ + nt * 16 * LD, acc, r, q);
                        acc = mma16_k64(M + 6 * MSZ + mt * 16 * LD, M + 7 * MSZ + nt * 16 * LD, acc, r, q);
                        *(bf16x4*)(NCTg + ub + (16 * nt + r) * 64 + 16 * mt + 4 * q) = pack4(acc);
                    }
                }
            }
        }
        __syncthreads();
    }
}
#undef RELANE

constexpr int RW2_WGS = NP * 4 * 2;
constexpr int RW2_D = 8, RW2_SLOT = 2 * MSZ;
struct RwRegs { bf16x8 m0, m1, n0, n1; };
__device__ __forceinline__ void rw2_fetch(RwRegs& R, const bf16_t* mc, const bf16_t* nct, int c, int lt) {
    const int cc = c & (NCH - 1);
    R.m0 = *(const bf16x8*)(mc + (size_t)cc * 4096 + lt * 8); R.m1 = *(const bf16x8*)(mc + (size_t)cc * 4096 + 2048 + lt * 8);
    R.n0 = *(const bf16x8*)(nct + (size_t)cc * 4096 + lt * 8); R.n1 = *(const bf16x8*)(nct + (size_t)cc * 4096 + 2048 + lt * 8);
}
__device__ __forceinline__ void rw2_put(const RwRegs& R, bf16_t* slot, int lt) {
    const int row = lt >> 3, pc = lt & 7;
    *(bf16x8*)(slot + row * LD + pc * 8) = R.m0; *(bf16x8*)(slot + (row + 32) * LD + pc * 8) = R.m1;
    *(bf16x8*)(slot + MSZ + row * LD + pc * 8) = R.n0; *(bf16x8*)(slot + MSZ + (row + 32) * LD + pc * 8) = R.n1;
}
__device__ __forceinline__ void rw2_consume(f32x4 (&acc)[4], const bf16_t* slot, bf16_t* s0, int c, int r, int q, int v) {
    bf16x4 pk[4];
#pragma unroll
    for (int mt = 0; mt < 4; ++mt) { pk[mt] = pack4(acc[mt]); *(bf16x4*)(s0 + (size_t)c * 4096 + v * 64 + 16 * mt + 4 * q) = pk[mt]; }
    const bf16x8 b0 = {pk[0][0], pk[0][1], pk[0][2], pk[0][3], pk[1][0], pk[1][1], pk[1][2], pk[1][3]};
    const bf16x8 b1 = {pk[2][0], pk[2][1], pk[2][2], pk[2][3], pk[3][0], pk[3][1], pk[3][2], pk[3][3]};
#pragma unroll
    for (int mt = 0; mt < 4; ++mt) {
        const bf16x8 a0 = *(const bf16x8*)(slot + (16 * mt + r) * LD + 8 * q), a1 = *(const bf16x8*)(slot + (16 * mt + r) * LD + 32 + 8 * q);
        const bf16x4 nc = *(const bf16x4*)(slot + MSZ + v * LD + 16 * mt + 4 * q);
        f32x4 ci = {bf2f((bf16_t)nc[0]), bf2f((bf16_t)nc[1]), bf2f((bf16_t)nc[2]), bf2f((bf16_t)nc[3])};
        ci = __builtin_amdgcn_mfma_f32_16x16x32_bf16(a0, b0, ci, 0, 0, 0);
        acc[mt] = __builtin_amdgcn_mfma_f32_16x16x32_bf16(a1, b1, ci, 0, 0, 0);
    }
}
__device__ __forceinline__ void stage_rw2(const Params& p, int l, unsigned char* lds) {
    const Ctx cx = mkctx(p); const size_t z = cx.z;
    const int tid = cx.tid, lane = tid & 63, wave = __builtin_amdgcn_readfirstlane(tid >> 6), r = lane & 15, q = lane >> 4;
    if (cx.bid < RW2_WGS) {
        const int nh = cx.bid & (NP * 4 - 1), vh = cx.bid >> 3, v = 32 * vh + 16 * (wave & 1) + r;
        const bf16_t* mc = (const bf16_t*)(p.ws + z + WS_RWC_MC) + (size_t)nh * NCH * 4096;
        bf16_t* nct = (bf16_t*)(p.ws + z + WS_RWC_NCT) + (size_t)nh * NCH * 4096;
        bf16_t* L0 = (bf16_t*)lds; bf16_t* L1 = L0 + RW2_SLOT;
        f32x4 acc[4];
#pragma unroll
        for (int mt = 0; mt < 4; ++mt) acc[mt] = (f32x4){0.f, 0.f, 0.f, 0.f};
        const int lt = tid - 128;
        const bool b_is_m = lt < 128;
        const int pb = b_is_m ? lt + 384 : lt - 128;
        const bf16_t* srcA = mc + lt * 8;
        const bf16_t* srcB = b_is_m ? mc + pb * 8 : nct + (32 * vh) * 64 + pb * 8;
        const int dstA = (lt >> 3) * LD + (lt & 7) * 8;
        const int dstB = b_is_m ? (pb >> 3) * LD + (pb & 7) * 8 : MSZ + (32 * vh + (pb >> 3)) * LD + (pb & 7) * 8;
        struct RwHalf { bf16x8 a, b; };
        RwHalf H0, H1, H2, H3, H4, H5, H6, H7, H8, H9, H10, H11, H12, H13, H14, H15;
#define RW2_FETCH(HH, c) do { HH.a = *(const bf16x8*)(srcA + (size_t)(c) * 4096); HH.b = *(const bf16x8*)(srcB + (size_t)(c) * 4096); } while (0)
#define RW2_PUT(HH, slot) do { *(bf16x8*)((slot) + dstA) = HH.a; *(bf16x8*)((slot) + dstB) = HH.b; } while (0)
        if (wave >= 2) {
            { RwHalf F; RW2_FETCH(F, 0); RW2_PUT(F, L0); }
            RW2_FETCH(H0, 1); RW2_FETCH(H1, 2); RW2_FETCH(H2, 3); RW2_FETCH(H3, 4); RW2_FETCH(H4, 5); RW2_FETCH(H5, 6); RW2_FETCH(H6, 7); RW2_FETCH(H7, 8);
            RW2_FETCH(H8, 9); RW2_FETCH(H9, 10); RW2_FETCH(H10, 11); RW2_FETCH(H11, 12); RW2_FETCH(H12, 13); RW2_FETCH(H13, 14); RW2_FETCH(H14, 15); RW2_FETCH(H15, 16);
        }
        __syncthreads();
        if (wave >= 2) {
#define RW2_LSTEP(HH, c) do { RW2_PUT(HH, ((c) & 1) ? L0 : L1); RW2_FETCH(HH, (c) + 17); __syncthreads(); } while (0)
#pragma unroll 1
            for (int c = 0; c < NCH; c += 16) {
                RW2_LSTEP(H0, c); RW2_LSTEP(H1, c + 1); RW2_LSTEP(H2, c + 2); RW2_LSTEP(H3, c + 3); RW2_LSTEP(H4, c + 4); RW2_LSTEP(H5, c + 5); RW2_LSTEP(H6, c + 6); RW2_LSTEP(H7, c + 7);
                RW2_LSTEP(H8, c + 8); RW2_LSTEP(H9, c + 9); RW2_LSTEP(H10, c + 10); RW2_LSTEP(H11, c + 11); RW2_LSTEP(H12, c + 12); RW2_LSTEP(H13, c + 13); RW2_LSTEP(H14, c + 14); RW2_LSTEP(H15, c + 15);
            }
#undef RW2_LSTEP
        } else {
#pragma unroll 1
            for (int c = 0; c < NCH; c += 2) {
                rw2_consume(acc, L0, nct, c, r, q, v); __syncthreads();
                rw2_consume(acc, L1, nct, c + 1, r, q, v); __syncthreads();
            }
        }
#undef RW2_FETCH
#undef RW2_PUT
        if (wave < 2) {
            float* so = (p.out + z) + O_PWKV + ((size_t)l * NP * 4 + nh) * 4096 + v * 64 + 4 * q;
#pragma unroll
            for (int mt = 0; mt < 4; ++mt) *(f32x4*)(so + 16 * mt) = acc[mt];
        }
    }
}

__device__ __forceinline__ void stage_rw3(const Params& p, int l, int first = 0) {
    const Ctx cx = mkctx(p, first); const size_t z = cx.z;
    const int tid = cx.tid, lane = tid & 63, wave = tid >> 6, r = lane & 15, q = lane >> 4;
    const bf16_t* RWH = (const bf16_t*)(p.ws + z + WS_RW);
    const bf16_t* RPg = (const bf16_t*)(p.ws + z + WS_RWC_RP); const bf16_t* S0g = (const bf16_t*)(p.ws + z + WS_RWC_NCT);
    const float* Y0g = (const float*)(p.ws + z + WS_RWC_Y0);
    bf16_t* Y = (bf16_t*)(p.ws + z + WS_YCAT);
    for (int it = cx.bid; it < RW_UNITS / 2; it += cx.nb) {
        const int c = (it & 63) * 2 + (wave >> 2), nh = it >> 6, n = nh >> 2, h = nh & 3, unit = nh * NCH + c, nt = wave & 3;
        const int t = 16 * nt + r, row = n * T + c * RWL + t;
        const size_t ub = (size_t)unit * 4096;
        const bf16x8 rp0 = *(const bf16x8*)(RPg + ub + t * 64 + 8 * q), rp1 = *(const bf16x8*)(RPg + ub + t * 64 + 32 + 8 * q);
        const bf16_t* rw = RWH + (size_t)row * 1536 + h * 64;
        f32x4 y[4]; float sum = 0.f, bd = 0.f;
#pragma unroll
        for (int mt = 0; mt < 4; ++mt) {
            const bf16x8 s0 = *(const bf16x8*)(S0g + ub + (16 * mt + r) * 64 + 8 * q), s1 = *(const bf16x8*)(S0g + ub + (16 * mt + r) * 64 + 32 + 8 * q);
            f32x4 acc = *(const f32x4*)(Y0g + ub + t * 64 + 16 * mt + 4 * q);
            acc = __builtin_amdgcn_mfma_f32_16x16x32_bf16(s0, rp0, acc, 0, 0, 0);
            acc = __builtin_amdgcn_mfma_f32_16x16x32_bf16(s1, rp1, acc, 0, 0, 0);
            y[mt] = acc; sum += (acc[0] + acc[1]) + (acc[2] + acc[3]);
            const f32x4 rr = ld4bf(rw + 16 * mt + 4 * q), km = ld4bf(rw + 256 + 16 * mt + 4 * q), rk = *(const f32x4*)(PIN(I_RK) + (size_t)l * 256 + h * 64 + 16 * mt + 4 * q);
            bd += (rr[0] * km[0] * rk[0] + rr[1] * km[1] * rk[1]) + (rr[2] * km[2] * rk[2] + rr[3] * km[3] * rk[3]);
        }
        sum += __shfl_xor(sum, 16); sum += __shfl_xor(sum, 32);
        bd += __shfl_xor(bd, 16); bd += __shfl_xor(bd, 32);
        const float mean = sum * (1.f / 64.f); float vs = 0.f;
#pragma unroll
        for (int mt = 0; mt < 4; ++mt)
#pragma unroll
            for (int e = 0; e < 4; ++e) { const float d_ = y[mt][e] - mean; vs += d_ * d_; }
        vs += __shfl_xor(vs, 16); vs += __shfl_xor(vs, 32);
        const float rstd = rsqrtf(vs * (1.f / 64.f) + GN_EPS);
#pragma unroll
        for (int mt = 0; mt < 4; ++mt) {
            const int vi = 16 * mt + 4 * q;
            const f32x4 vv = ld4bf(rw + 512 + vi), gg = ld4bf(rw + 1280 + vi);
            const f32x4 lg = *(const f32x4*)(PIN(I_LNG) + (size_t)l * 256 + h * 64 + vi), lb = *(const f32x4*)(PIN(I_LNB) + (size_t)l * 256 + h * 64 + vi);
            f32x4 o;
#pragma unroll
            for (int e = 0; e < 4; ++e) o[e] = ((y[mt][e] - mean) * rstd * lg[e] + lb[e] + bd * vv[e]) * gg[e];
            *(bf16x4*)(Y + (size_t)row * D + h * 64 + vi) = pack4(o);
        }
    }
}

__device__ __forceinline__ void stage_qkn(const Params& p, int l) {
    const Ctx cx = mkctx(p); const size_t z = cx.z;
    const int lane = cx.tid & 63, gw = cx.bid * NWAVES + (cx.tid >> 6), GW = cx.nb * NWAVES;
    const bf16_t* P = (const bf16_t*)(p.ws + z + WS_P);
    float* QN = (float*)(p.ws + z + WS_QN); float* KN = (float*)(p.ws + z + WS_KN);
    for (int it = MP * 6 + gw; it < R * 6; it += GW) {
        const int row = it / 6, unit = it % 6;
        const bool samp = row >= MP; const int n = samp ? row - MP : row >> 13, t = samp ? 0 : (row & (T - 1));
        const float x = bf2f(P[(size_t)row * PCOLS + OFF_B + unit * 64 + lane]);
        const float ss = wave_sum(x * x) * (1.f / 64.f);
        const float g = unit < 4 ? PIN(I_QNG)[(size_t)l * 64 + lane] : PIN(I_KNG)[(size_t)l * 64 + lane];
        const float y = x * rsqrtf(ss + NORM_EPS) * g;
        if (unit < 4) QN[(size_t)row * 256 + unit * 64 + lane] = y;
        else {
            const int kvh = unit - 4;
            KN[(size_t)row * 128 + kvh * 64 + lane] = y;
            const float v = bf2f(P[(size_t)row * PCOLS + OFF_B + 384 + kvh * 64 + lane]);
            if (samp) { const size_t o = (((size_t)l * NS + n) * 128 + 127) * 128 + kvh * 64 + lane; (p.out + z)[O_SK + o] = y; (p.out + z)[O_SV + o] = v; }
            else if (t >= T - 128) { const size_t o = (((size_t)l * NP + n) * 128 + (t - (T - 128))) * 128 + kvh * 64 + lane; (p.out + z)[O_PK + o] = y; (p.out + z)[O_PV + o] = v; }
        }
    }
}

__device__ __forceinline__ void stage_cachecopy(const Params& p, int l, int first = 0) {
    const Ctx cx = mkctx(p, first); const size_t z = cx.z;
    {
        typedef float f4 __attribute__((ext_vector_type(4)));
        const unsigned gt4 = (unsigned)cx.bid * NTHREADS + cx.tid, GT4 = (unsigned)cx.nb * NTHREADS;
        for (unsigned i = gt4; i < (unsigned)NS * 4064; i += GT4) {
            const unsigned n = i / 4064u, o4 = i - n * 4064u;
            const size_t src = (((size_t)l * NS + n) * 128 + 1) * 128 + (size_t)o4 * 4, dst = ((size_t)l * NS + n) * 128 * 128 + (size_t)o4 * 4;
            *(f4*)((p.out + z) + O_SK + dst) = *(const f4*)(PIN(I_CK) + src); *(f4*)((p.out + z) + O_SV + dst) = *(const f4*)(PIN(I_CV) + src);
        }
    }
}

__device__ __forceinline__ void stage_att(const Params& p, int l, int first = 0) {
    const Ctx cx = mkctx(p, first); const size_t z = cx.z;
    const int lane = cx.tid & 63, gw = flip_bid(cx) * NWAVES + (cx.tid >> 6), GW = cx.nb * NWAVES;
    const bf16_t* P = (const bf16_t*)(p.ws + z + WS_P);
    const float* QN = (const float*)(p.ws + z + WS_QN); const float* KN = (const float*)(p.ws + z + WS_KN);
    bf16_t* Y = (bf16_t*)(p.ws + z + WS_YCAT);
    for (int it = MP * 4 + gw; it < R * 4; it += GW) {
        const int row = it >> 2, hq = it & 3, kvh = hq >> 1;
        const bool samp = row >= MP; const int n = samp ? row - MP : row >> 13, t = samp ? 0 : (row & (T - 1));
        const int rowbase = row - t;
        const float* q = QN + (size_t)row * 256 + hq * 64;
        const float sink = PIN(I_SINK)[(size_t)l * 4 + hq];
        f32x4 qreg[16];
#pragma unroll
        for (int d4 = 0; d4 < 16; ++d4) qreg[d4] = *(const f32x4*)(q + 4 * d4);
        float sc[3]; float mx = -INFINITY;
#pragma unroll
        for (int j = 0; j < 3; ++j) {
            const int i = lane + 64 * j; sc[j] = -INFINITY;
            if (i <= 128) {
                const int pos = t - 128 + i;
                const float* kp = nullptr;
                if (pos >= 0) kp = KN + (size_t)(rowbase + pos) * 128 + kvh * 64;
                else if (samp) kp = PIN(I_CK) + (((size_t)l * NS + n) * 128 + i) * 128 + kvh * 64;
                if (kp) { float s = 0.f;
#pragma unroll
                    for (int hf = 0; hf < 2; ++hf) {
                        f32x4 kv[8];
#pragma unroll
                        for (int d4 = 0; d4 < 8; ++d4) kv[d4] = *(const f32x4*)(kp + 32 * hf + 4 * d4);
#pragma unroll
                        for (int d4 = 0; d4 < 8; ++d4) { const f32x4 qv = qreg[8 * hf + d4]; s += (qv[0] * kv[d4][0] + qv[1] * kv[d4][1]) + (qv[2] * kv[d4][2] + qv[3] * kv[d4][3]); }
                        __builtin_amdgcn_sched_barrier(0);
                    }
                    sc[j] = s * 0.125f; }
            }
            mx = fmaxf(mx, sc[j]);
            __builtin_amdgcn_sched_barrier(0);
        }
        mx = fmaxf(wave_max(mx), sink);
        float pr[3]; float sum = 0.f;
#pragma unroll
        for (int j = 0; j < 3; ++j) { pr[j] = sc[j] == -INFINITY ? 0.f : __expf(sc[j] - mx); sum += pr[j]; }
        sum = wave_sum(sum) + __expf(sink - mx);
        float o = 0.f;
        for (int i = 0; i <= 128; ++i) {
            const float prs = i < 64 ? pr[0] : (i < 128 ? pr[1] : pr[2]);
            const float pi = __shfl(prs, i & 63);
            const int pos = t - 128 + i;
            float v = 0.f;
            if (pos >= 0) v = bf2f(P[(size_t)(rowbase + pos) * PCOLS + OFF_B + 384 + kvh * 64 + lane]);
            else if (samp) v = PIN(I_CV)[(((size_t)l * NS + n) * 128 + i) * 128 + kvh * 64 + lane];
            o += pi * v;
        }
        Y[(size_t)row * D + 256 + hq * 64 + lane] = f2bf(o / sum);
    }
}

constexpr int LDV = 264;
__device__ __forceinline__ void stage_attn(const Params& p, int l, unsigned char* lds, int first = 0) {
    const Ctx cx = mkctx(p, first); const size_t z = cx.z;
    const int tid = cx.tid, lane = tid & 63, wave = __builtin_amdgcn_readfirstlane(tid >> 6), r = lane & 15, q = lane >> 4;
    bf16_t* Ks = (bf16_t*)lds;
    bf16_t* Qs = (bf16_t*)(lds + 36864);
    bf16_t* Vt = (bf16_t*)(lds + 73728);
    const bf16_t* P = (const bf16_t*)(p.ws + z + WS_P);
    bf16_t* Y = (bf16_t*)(p.ws + z + WS_YCAT);
    for (int unit = cx.bid; unit < NP * 2 * (T / 128); unit += cx.nb) {
        const int b = unit & 63, kvh = (unit >> 6) & 1, n = unit >> 7, t0 = b * 128;
        const size_t rowb = (size_t)n * T;
        float gk[8], gq[8];
#pragma unroll
        for (int j = 0; j < 8; ++j) { gk[j] = PIN(I_KNG)[(size_t)l * 64 + (tid & 7) * 8 + j]; gq[j] = PIN(I_QNG)[(size_t)l * 64 + (tid & 7) * 8 + j]; }
        bf16x8 kraw[4], qraw[4], vraw[4];
#pragma unroll
        for (int it = 0; it < 4; ++it) {
            const int task = it * NTHREADS + tid, c8 = task & 7, kk = task >> 3, kp = t0 - 128 + kk, g = kk >> 7, tl = kk & 127;
            const bf16x8 zz = {0, 0, 0, 0, 0, 0, 0, 0};
            kraw[it] = kp >= 0 ? *(const bf16x8*)(P + (rowb + kp) * PCOLS + OFF_B + 256 + kvh * 64 + c8 * 8) : zz;
            qraw[it] = *(const bf16x8*)(P + (rowb + t0 + tl) * PCOLS + OFF_B + (kvh * 2 + g) * 64 + c8 * 8);
            const int d = task & 63, m0 = (task >> 6) * 8;
#pragma unroll
            for (int j = 0; j < 8; ++j) { const int vp = t0 - 128 + m0 + j; vraw[it][j] = vp >= 0 ? (short)P[(rowb + vp) * PCOLS + OFF_B + 384 + kvh * 64 + d] : (short)0; }
        }
#pragma unroll
        for (int it = 0; it < 4; ++it) {
            const int task = it * NTHREADS + tid, c8 = task & 7;
            {
                const int kk = task >> 3;
                float x[8]; float ss = 0.f;
#pragma unroll
                for (int j = 0; j < 8; ++j) { x[j] = bf2f((bf16_t)kraw[it][j]); ss += x[j] * x[j]; }
                ss += __shfl_xor(ss, 1); ss += __shfl_xor(ss, 2); ss += __shfl_xor(ss, 4);
                const float rstd = rsqrtf(ss * (1.f / 64.f) + NORM_EPS);
                bf16x8 o;
#pragma unroll
                for (int j = 0; j < 8; ++j) { x[j] = x[j] * rstd * gk[j]; o[j] = (short)f2bf(x[j]); }
                *(bf16x8*)(Ks + kk * LD + c8 * 8) = o;
                if (b == 63 && kk >= 128) { float* ko = (p.out + z) + O_PK + (((size_t)l * NP + n) * 128 + (kk - 128)) * 128 + kvh * 64 + c8 * 8;
#pragma unroll
                    for (int j = 0; j < 8; ++j) ko[j] = x[j]; }
            }
            {
                const int qr = task >> 3;
                float x[8]; float ss = 0.f;
#pragma unroll
                for (int j = 0; j < 8; ++j) { x[j] = bf2f((bf16_t)qraw[it][j]); ss += x[j] * x[j]; }
                ss += __shfl_xor(ss, 1); ss += __shfl_xor(ss, 2); ss += __shfl_xor(ss, 4);
                const float rstd = rsqrtf(ss * (1.f / 64.f) + NORM_EPS) * 0.125f;
                bf16x8 o;
#pragma unroll
                for (int j = 0; j < 8; ++j) o[j] = (short)f2bf(x[j] * rstd * gq[j]);
                *(bf16x8*)(Qs + qr * LD + c8 * 8) = o;
            }
            {
                const int d = task & 63, m0 = (task >> 6) * 8;
                *(bf16x8*)(Vt + d * LDV + m0) = vraw[it];
                if (b == 63 && m0 >= 128) { float* vo = (p.out + z) + O_PV + (((size_t)l * NP + n) * 128 + (m0 - 128)) * 128 + kvh * 64 + d;
#pragma unroll
                    for (int j = 0; j < 8; ++j) vo[j * 128] = bf2f((bf16_t)vraw[it][j]); }
            }
        }
        __syncthreads();
        {
            const int g = wave >> 2, sb = wave & 3, hq = kvh * 2 + g;
            const float sink = PIN(I_SINK)[(size_t)l * 4 + hq];
#pragma unroll 1
            for (int mt = 0; mt < 2; ++mt) {
                const int ql = 32 * sb + 16 * mt + r;
                const bf16_t* Qb = Qs + (g * 128 + 32 * sb + 16 * mt) * LD;
                f32x4 sacc[10]; float mx = -INFINITY;
#pragma unroll
                for (int j = 0; j < 10; ++j) {
                    f32x4 a = {0.f, 0.f, 0.f, 0.f};
                    a = mma16_k64(Ks + (32 * sb + 16 * j) * LD, Qb, a, r, q);
#pragma unroll
                    for (int e = 0; e < 4; ++e) { const int kk = 32 * sb + 16 * j + 4 * q + e, rel = ql + 128 - kk;
                        const bool ok = rel >= 0 && rel <= 128 && (t0 - 128 + kk) >= 0;
                        a[e] = ok ? a[e] : -INFINITY; mx = fmaxf(mx, a[e]); }
                    sacc[j] = a;
                    __builtin_amdgcn_sched_barrier(0);
                }
                mx = fmaxf(mx, __shfl_xor(mx, 16)); mx = fmaxf(mx, __shfl_xor(mx, 32)); mx = fmaxf(mx, sink);
                float sum = 0.f;
#pragma unroll
                for (int j = 0; j < 10; ++j)
#pragma unroll
                    for (int e = 0; e < 4; ++e) { const float pv = __expf(sacc[j][e] - mx); sacc[j][e] = pv; sum += pv; }
                sum += __shfl_xor(sum, 16); sum += __shfl_xor(sum, 32); sum += __expf(sink - mx);
                const float inv = 1.f / sum;
                f32x4 o[4];
#pragma unroll
                for (int dt = 0; dt < 4; ++dt) o[dt] = (f32x4){0.f, 0.f, 0.f, 0.f};
#pragma unroll
                for (int s2 = 0; s2 < 5; ++s2) {
                    const bf16x4 p0 = pack4(sacc[2 * s2]), p1 = pack4(sacc[2 * s2 + 1]);
                    const bf16x8 pb = {p0[0], p0[1], p0[2], p0[3], p1[0], p1[1], p1[2], p1[3]};
#pragma unroll
                    for (int dt = 0; dt < 4; ++dt) {
                        const bf16_t* vp = Vt + (16 * dt + r) * LDV + 32 * sb + 32 * s2 + 4 * q;
                        const bf16x4 v0 = *(const bf16x4*)vp, v1 = *(const bf16x4*)(vp + 16);
                        const bf16x8 va = {v0[0], v0[1], v0[2], v0[3], v1[0], v1[1], v1[2], v1[3]};
                        o[dt] = __builtin_amdgcn_mfma_f32_16x16x32_bf16(va, pb, o[dt], 0, 0, 0);
                    }
                    __builtin_amdgcn_sched_barrier(0);
                }
                bf16_t* yo = Y + (rowb + t0 + ql) * D + 256 + hq * 64 + 4 * q;
#pragma unroll
                for (int dt = 0; dt < 4; ++dt) { f32x4 ov = o[dt] * inv; *(bf16x4*)(yo + 16 * dt) = pack4(ov); }
            }
        }
        __syncthreads();
    }
}

__device__ __forceinline__ void mconv_unit(const Params& p, size_t z, int l, int n, int c, int g, int tid) {
    const bf16_t* P = (const bf16_t*)(p.ws + z + WS_P);
    bf16_t* XB = (bf16_t*)(p.ws + z + WS_XBCC);
    const float* cw = PIN(I_CONVW) + (size_t)l * 4 * 1024; const float* cb = PIN(I_CONVB) + (size_t)l * 1024;
#pragma unroll 1
    for (int i = tid; i < 1024; i += NTHREADS) {
        const int ch = i & 63, c0 = ch < 32 ? g * 256 + ch * 8 : (ch < 48 ? 512 + g * 128 + (ch - 32) * 8 : 768 + g * 128 + (ch - 48) * 8);
        const int row = n * T + c * 128 + (i >> 6) * 8, t = row & (T - 1);
        bf16x8 u[11];
#pragma unroll
        for (int k = 0; k < 11; ++k) { const bf16x8 zz = {0, 0, 0, 0, 0, 0, 0, 0}; u[k] = (t - 3 + k >= 0) ? *(const bf16x8*)(P + (size_t)(row - 3 + k) * PCOLS + OFF_XBC + c0) : zz; }
        float w[4][8], b[8];
#pragma unroll
        for (int e = 0; e < 8; ++e) { b[e] = cb[c0 + e];
#pragma unroll
            for (int j = 0; j < 4; ++j) w[j][e] = cw[j * 1024 + c0 + e]; }
#pragma unroll
        for (int r = 0; r < 8; ++r) { bf16x8 o;
#pragma unroll
            for (int e = 0; e < 8; ++e) { float acc = b[e];
#pragma unroll
                for (int j = 0; j < 4; ++j) acc += w[j][e] * bf2f((bf16_t)u[r + j][e]);
                o[e] = (short)f2bf(silu_f(acc)); }
            *(bf16x8*)(XB + (size_t)(row + r) * 1024 + c0) = o;
            if (t + r >= T - 3) { float* op = (p.out + z) + O_PCONV + (((size_t)l * NP + n) * 3 + (t + r - (T - 3))) * 1024 + c0;
#pragma unroll
                for (int e = 0; e < 8; ++e) op[e] = bf2f((bf16_t)u[3 + r][e]); }
        }
    }
}

__device__ __forceinline__ void stage_mconv(const Params& p, int l) {
    const Ctx cx = mkctx(p); const size_t z = cx.z;
    const unsigned gt = (unsigned)cx.bid * NTHREADS + cx.tid, GT = (unsigned)cx.nb * NTHREADS;
    const bf16_t* P = (const bf16_t*)(p.ws + z + WS_P);
    bf16_t* XB = (bf16_t*)(p.ws + z + WS_XBCC); float* DT = (float*)(p.ws + z + WS_DT);
    const float* cw = PIN(I_CONVW) + (size_t)l * 4 * 1024; const float* cb = PIN(I_CONVB) + (size_t)l * 1024;
    for (unsigned i = (unsigned)MP * 1024 + gt; i < (unsigned)R * 1024; i += GT) {
        const int c = (int)(i & 1023), row = (int)(i >> 10), n = row - MP;
        const float* st = PIN(I_SCONV) + ((size_t)l * NS + n) * 3 * 1024 + c;
        const float raw = bf2f(P[(size_t)row * PCOLS + OFF_XBC + c]);
        const float acc = cb[c] + cw[c] * st[0] + cw[1024 + c] * st[1024] + cw[2048 + c] * st[2048] + cw[3072 + c] * raw;
        XB[i] = f2bf(silu_f(acc));
        float* o = (p.out + z) + O_SCONV + ((size_t)l * NS + n) * 3 * 1024 + c;
        o[0] = st[1024]; o[1024] = st[2048]; o[2048] = raw;
    }
    float* DT2 = (float*)(p.ws + z + WS_DT2);
    for (unsigned i = (unsigned)MP * 8 + gt; i < (unsigned)R * 8; i += GT) DT2[i] = softplus_f(DT[i] + PIN(I_DTB)[(size_t)l * 8 + (i & 7)]);
}

__device__ __forceinline__ void stage_mscan(const Params& p, int l, float* lds, int first = 0) {
    const Ctx cx = mkctx(p, first); const size_t z = cx.z;
    const int lane = cx.tid & 63, wave = cx.tid >> 6;
    const bf16_t* XB = (const bf16_t*)(p.ws + z + WS_XBCC); const float* DT = (const float*)(p.ws + z + WS_DT2);
    float* YT = (float*)(p.ws + z + WS_YTMP);
    float* wl = lds + wave * 512;
    const int dh = lane & 1, pl = lane >> 1;
    for (int u = NP * 16 + flip_bid(cx) + cx.nb * wave; u < NSEQ * 16; u += cx.nb * NWAVES) {
        const int s = u >> 4, h = (u >> 1) & 7, ph = u & 1, g = h >> 2; const bool samp = s >= NP; const int n = samp ? s - NP : s;
        const int row0 = samp ? MP + n : n * T, nt = samp ? 1 : T, pp = ph * 32 + pl;
        float hs[64];
        if (samp) { const float* st = PIN(I_SSM) + ((((size_t)l * NS + n) * 8 + h) * 64 + pp) * 128 + dh * 64;
#pragma unroll
            for (int d = 0; d < 64; d += 4) { const f32x4 v4 = *(const f32x4*)(st + d); hs[d] = v4[0]; hs[d + 1] = v4[1]; hs[d + 2] = v4[2]; hs[d + 3] = v4[3]; } }
        else {
#pragma unroll
            for (int d = 0; d < 64; ++d) hs[d] = 0.f; }
        const float A = -__expf(PIN(I_ALOG)[(size_t)l * 8 + h]), Dh = PIN(I_SSMD)[(size_t)l * 8 + h];
        for (int t = 0; t < nt; ++t) {
            const size_t row = (size_t)row0 + t;
            const float dtv = DT[row * 8 + h], dA = __expf(dtv * A);
            const float x = bf2f(XB[row * 1024 + h * 64 + pp]), xdt = x * dtv;
            const bf16_t* b = XB + row * 1024 + 512 + g * 128; const bf16_t* c = XB + row * 1024 + 768 + g * 128;
            WAVE_LDS_SYNC();
            wl[lane] = bf2f(b[lane]); wl[64 + lane] = bf2f(b[64 + lane]); wl[128 + lane] = bf2f(c[lane]); wl[192 + lane] = bf2f(c[64 + lane]);
            WAVE_LDS_SYNC();
            float y = 0.f;
#pragma unroll
            for (int d = 0; d < 64; ++d) { hs[d] = hs[d] * dA + xdt * wl[dh * 64 + d]; y += hs[d] * wl[128 + dh * 64 + d]; }
            y += __shfl_xor(y, 1);
            if (dh == 0) YT[row * 512 + h * 64 + pp] = y + Dh * x;
        }
        float* so = (p.out + z) + (samp ? O_SSSM + ((((size_t)l * NS + n) * 8 + h) * 64 + pp) * 128 : O_PSSM + ((((size_t)l * NP + n) * 8 + h) * 64 + pp) * 128) + dh * 64;
#pragma unroll
        for (int d = 0; d < 64; d += 4) *(f32x4*)(so + d) = (f32x4){hs[d], hs[d + 1], hs[d + 2], hs[d + 3]};
    }
}

__device__ __forceinline__ void mgate_rows(const Params& p, size_t z, int l, int row_lo, int row_hi, int gw, int GW, int lane) {
    const bf16_t* P = (const bf16_t*)(p.ws + z + WS_P); const float* YT = (const float*)(p.ws + z + WS_YTMP);
    bf16_t* Y = (bf16_t*)(p.ws + z + WS_YCAT);
    const f32x4 g0 = *(const f32x4*)(PIN(I_SSMNG) + (size_t)l * 512 + lane * 8), g1 = *(const f32x4*)(PIN(I_SSMNG) + (size_t)l * 512 + lane * 8 + 4);
    for (int row = row_lo + 2 * gw; row < row_hi; row += 2 * GW) {
        f32x4 ya[2][2]; bf16x8 zz[2];
#pragma unroll
        for (int k = 0; k < 2; ++k) { ya[k][0] = *(const f32x4*)(YT + (size_t)(row + k) * 512 + lane * 8); ya[k][1] = *(const f32x4*)(YT + (size_t)(row + k) * 512 + lane * 8 + 4);
            zz[k] = *(const bf16x8*)(P + (size_t)(row + k) * PCOLS + OFF_Z + lane * 8); }
#pragma unroll
        for (int k = 0; k < 2; ++k) {
            float v[8]; float ss = 0.f;
#pragma unroll
            for (int e = 0; e < 8; ++e) { v[e] = ya[k][e >> 2][e & 3] * silu_f(bf2f((bf16_t)zz[k][e])); ss += v[e] * v[e]; }
            const float rstd = rsqrtf(wave_sum(ss) * (1.f / 512.f) + NORM_EPS);
            bf16x8 o;
#pragma unroll
            for (int e = 0; e < 8; ++e) o[e] = (short)f2bf(v[e] * rstd * (e < 4 ? g0[e & 3] : g1[e & 3]));
            *(bf16x8*)(Y + (size_t)(row + k) * D + 512 + lane * 8) = o;
        }
    }
}
constexpr int SL = 128, SNC = T / SL;
__device__ __forceinline__ f32x4 mma16(const bf16_t* A, const bf16_t* Bt, int nsteps, f32x4 acc, int r, int q) {
#pragma unroll
    for (int s = 0; s < 4; ++s) if (s < nsteps) {
        const bf16x8 a = *(const bf16x8*)(A + r * LD2 + 32 * s + 8 * q), b = *(const bf16x8*)(Bt + r * LD2 + 32 * s + 8 * q);
        acc = __builtin_amdgcn_mfma_f32_16x16x32_bf16(a, b, acc, 0, 0, 0);
    }
    return acc;
}
constexpr int SSD_OFF_AUX = 104448;
template <bool FROM_RAW>
__device__ __forceinline__ void ssd_aux(const Params& p, size_t z, int l, int g, int row0, float* aux, int tid) {
    float* DT2 = (float*)(p.ws + z + WS_DT2);
    const int t = tid & 127, e = tid >> 7, h = g * 4 + e;
    float dtv;
    if (FROM_RAW) { dtv = softplus_f(((const float*)(p.ws + z + WS_DT))[(size_t)(row0 + t) * 8 + h] + PIN(I_DTB)[(size_t)l * 8 + h]); DT2[(size_t)(row0 + t) * 8 + h] = dtv; }
    else dtv = DT2[(size_t)(row0 + t) * 8 + h];
    const float A = -__expf(PIN(I_ALOG)[(size_t)l * 8 + h]);
    aux[e * 128 + t] = dtv; aux[512 + e * 128 + t] = dtv * A;
    __syncthreads();
    float acc = 0.f;
    for (int i = 0; i <= t; ++i) acc += aux[512 + e * 128 + i];
    aux[1024 + e * 128 + t] = acc;
    __syncthreads();
}
__device__ __forceinline__ void stage_ssd1(const Params& p, int l, unsigned char* lds) {
    const Ctx cx = mkctx(p); const size_t z = cx.z;
    const int tid = cx.tid, lane = tid & 63, wave = __builtin_amdgcn_readfirstlane(tid >> 6), r = lane & 15, q = lane >> 4;
    bf16_t* BT = (bf16_t*)lds;
    bf16_t* XW = (bf16_t*)(lds + 34816);
    float* aux = (float*)(lds + SSD_OFF_AUX);
    const bf16_t* XB = (const bf16_t*)(p.ws + z + WS_XBCC);
    float* ST = (float*)(p.ws + z + WS_SST); float* CD = (float*)(p.ws + z + WS_SCD);
    for (int unit = cx.bid; unit < NP * SNC * 2; unit += cx.nb) {
        const int g = unit & 1, c = (unit >> 1) & (SNC - 1), n = unit >> 7, row0 = n * T + c * SL;
        mconv_unit(p, z, l, n, c, g, tid);
        asm volatile("s_waitcnt vmcnt(0)" ::: "memory"); __syncthreads();
        const int d = tid & 127, mg = tid >> 7, pp = tid & 63, mgp = tid >> 6;
        bf16x8 bv[4], xv[4][2];
#pragma unroll
        for (int it = 0; it < 4; ++it) { const int m0 = mg * 32 + it * 8;
#pragma unroll
            for (int j = 0; j < 8; ++j) bv[it][j] = (short)XB[(size_t)(row0 + m0 + j) * 1024 + 512 + g * 128 + d]; }
#pragma unroll
        for (int e = 0; e < 4; ++e)
#pragma unroll
            for (int it = 0; it < 2; ++it) { const int m0 = mgp * 16 + it * 8;
#pragma unroll
                for (int j = 0; j < 8; ++j) xv[e][it][j] = (short)XB[(size_t)(row0 + m0 + j) * 1024 + (g * 4 + e) * 64 + pp]; }
        ssd_aux<true>(p, z, l, g, row0, aux, tid);
        {
#pragma unroll
            for (int it = 0; it < 4; ++it) *(bf16x8*)(BT + d * LD2 + mg * 32 + it * 8) = bv[it];
#pragma unroll
            for (int e = 0; e < 4; ++e) { const float alast = aux[1024 + e * 128 + 127];
#pragma unroll
                for (int it = 0; it < 2; ++it) { const int m0 = mgp * 16 + it * 8; bf16x8 v;
#pragma unroll
                    for (int j = 0; j < 8; ++j) { const int m = m0 + j; v[j] = (short)f2bf(bf2f((bf16_t)xv[e][it][j]) * aux[e * 128 + m] * __expf(alast - aux[1024 + e * 128 + m])); }
                    *(bf16x8*)(XW + e * 64 * LD2 + pp * LD2 + m0) = v; } }
        }
        __syncthreads();
#pragma unroll
        for (int e = 0; e < 4; ++e) {
            float* st = ST + ((size_t)(n * SNC + c) * 8 + g * 4 + e) * 8192;
#pragma unroll
            for (int nt = 0; nt < 4; ++nt) {
                f32x4 acc = {0.f, 0.f, 0.f, 0.f};
                acc = mma16(BT + 16 * wave * LD2, XW + e * 64 * LD2 + 16 * nt * LD2, 4, acc, r, q);
                *(f32x4*)(st + (16 * nt + r) * 128 + 16 * wave + 4 * q) = acc;
            }
        }
        if (tid < 4) CD[(size_t)(n * SNC + c) * 8 + g * 4 + tid] = __expf(aux[1024 + tid * 128 + 127]);
        __syncthreads();
    }
}
__device__ __forceinline__ void stage_ssd2(const Params& p, int l) {
    const Ctx cx = mkctx(p); const size_t z = cx.z;
    const int first = cx.nb > 32 ? RW2_WGS : 0;
    if (cx.bid >= first) {
        typedef float f32x2 __attribute__((ext_vector_type(2)));
        const float* ST = (const float*)(p.ws + z + WS_SST); const float* CD = (const float*)(p.ws + z + WS_SCD);
        unsigned* HPV = (unsigned*)(p.ws + z + WS_HPREV);
        for (int idx = (cx.bid - first) * NTHREADS + cx.tid; idx < NP * 8 * 4096; idx += (cx.nb - first) * NTHREADS) {
            const int n = idx >> 15, h = (idx >> 12) & 7, pd = (idx & 4095) * 2;
            const float* base = ST + ((size_t)(n * SNC) * 8 + h) * 8192 + pd; const float* cd = CD + (size_t)(n * SNC) * 8 + h;
            unsigned* hb = HPV + (((size_t)(n * SNC) * 8 + h) * 8192 + pd) / 2;
            f32x2 hc = {0.f, 0.f};
#pragma unroll 1
            for (int c0 = 0; c0 < SNC; c0 += 16) {
                f32x2 v[16]; float dcy[16];
#pragma unroll
                for (int k = 0; k < 16; ++k) { v[k] = *(const f32x2*)(base + (size_t)(c0 + k) * 65536); dcy[k] = cd[(c0 + k) * 8]; }
#pragma unroll
                for (int k = 0; k < 16; ++k) { hb[(size_t)(c0 + k) * 32768] = cvtpk(hc[0], hc[1]); hc = hc * dcy[k] + v[k]; }
            }
            *(f32x2*)((p.out + z) + O_PSSM + ((size_t)(l * NP + n) * 8 + h) * 8192 + pd) = hc;
        }
    }
}
__device__ __forceinline__ void stage_ssd3(const Params& p, int l, unsigned char* lds, int first = 0, int count = 0) {
    const Ctx cx = mkctx(p, first, count); const size_t z = cx.z;
    const int tid = cx.tid, lane = tid & 63, wave = __builtin_amdgcn_readfirstlane(tid >> 6), r = lane & 15, q = lane >> 4;
    bf16_t* CM = (bf16_t*)lds;
    bf16_t* BG = (bf16_t*)(lds + 34816);
    bf16_t* XT = (bf16_t*)(lds + 69632);
    bf16_t* HP = (bf16_t*)(lds + 87040);
    float* aux = (float*)(lds + SSD_OFF_AUX);
    const bf16_t* XB = (const bf16_t*)(p.ws + z + WS_XBCC);
    const bf16_t* HPV = (const bf16_t*)(p.ws + z + WS_HPREV);
    float* YT = (float*)(p.ws + z + WS_YTMP);
    for (int u2 = cx.bid; u2 < NP * SNC; u2 += cx.nb)
    for (int g = 0; g < 2; ++g) {
        const int c = u2 & (SNC - 1), n = u2 >> 6, row0 = n * T + c * SL;
        bf16x8 cc[4], bb[4];
        {
            const int d0 = (tid & 15) * 8;
#pragma unroll
            for (int it = 0; it < 4; ++it) { const int row = (tid >> 4) + 32 * it;
                cc[it] = *(const bf16x8*)(XB + (size_t)(row0 + row) * 1024 + 768 + g * 128 + d0); bb[it] = *(const bf16x8*)(XB + (size_t)(row0 + row) * 1024 + 512 + g * 128 + d0); }
        }
        ssd_aux<false>(p, z, l, g, row0, aux, tid);
        {
            const int d0 = (tid & 15) * 8;
#pragma unroll
            for (int it = 0; it < 4; ++it) { const int row = (tid >> 4) + 32 * it; *(bf16x8*)(CM + row * LD2 + d0) = cc[it]; *(bf16x8*)(BG + row * LD2 + d0) = bb[it]; }
        }
        __syncthreads();
        f32x4 cb[8];
#pragma unroll
        for (int nt = 0; nt < 8; ++nt) { cb[nt] = (f32x4){0.f, 0.f, 0.f, 0.f}; if (nt <= wave) cb[nt] = mma16(CM + 16 * wave * LD2, BG + 16 * nt * LD2, 4, cb[nt], r, q); }
        __syncthreads();
        const int xpp = tid & 63, xmg = tid >> 6, hpp = tid >> 3, hd0 = (tid & 7) * 16;
        bf16_t xr[16]; bf16x8 hv[2];
#define SSD3_FETCH(ee) do { const int hh_ = g * 4 + (ee); \
            _Pragma("unroll") for (int j_ = 0; j_ < 16; ++j_) xr[j_] = XB[(size_t)(row0 + xmg * 16 + j_) * 1024 + hh_ * 64 + xpp]; \
            const bf16_t* src_ = HPV + ((size_t)(n * SNC + c) * 8 + hh_) * 8192 + hpp * 128 + hd0; \
            hv[0] = *(const bf16x8*)src_; hv[1] = *(const bf16x8*)(src_ + 8); } while (0)
        SSD3_FETCH(0);
#pragma unroll 1
        for (int e = 0; e < 4; ++e) {
            const int h = g * 4 + e;
            {
#pragma unroll
                for (int nt = 0; nt < 8; ++nt) { const int m = 16 * nt + r; const float am = aux[1024 + e * 128 + m];
#pragma unroll
                    for (int e2 = 0; e2 < 4; ++e2) { const int li = 16 * wave + 4 * q + e2; const float v = (m <= li) ? cb[nt][e2] * __expf(aux[1024 + e * 128 + li] - am) : 0.f; BG[li * LD2 + m] = f2bf(v); } }
#pragma unroll
                for (int it = 0; it < 2; ++it) { const int m0 = xmg * 16 + it * 8; bf16x8 v;
#pragma unroll
                    for (int j = 0; j < 8; ++j) v[j] = (short)f2bf(bf2f(xr[it * 8 + j]) * aux[e * 128 + m0 + j]);
                    *(bf16x8*)(XT + xpp * LD2 + m0) = v; }
                *(bf16x8*)(HP + hpp * LD2 + hd0) = hv[0]; *(bf16x8*)(HP + hpp * LD2 + hd0 + 8) = hv[1];
                if (e + 1 < 4) SSD3_FETCH(e + 1);
            }
            __syncthreads();
            {
                const int li = 16 * wave + r; const size_t row = (size_t)row0 + li;
                const float sc = __expf(aux[1024 + e * 128 + li]), Dh = PIN(I_SSMD)[(size_t)l * 8 + h];
                bf16x4 xq[4];
#pragma unroll
                for (int mt = 0; mt < 4; ++mt) xq[mt] = *(const bf16x4*)(XB + row * 1024 + h * 64 + 16 * mt + 4 * q);
#pragma unroll
                for (int mt = 0; mt < 4; ++mt) {
                    f32x4 ad = {0.f, 0.f, 0.f, 0.f}, ao = {0.f, 0.f, 0.f, 0.f};
                    ad = mma16(XT + 16 * mt * LD2, BG + 16 * wave * LD2, (wave >> 1) + 1, ad, r, q);
                    ao = mma16(HP + 16 * mt * LD2, CM + 16 * wave * LD2, 4, ao, r, q);
                    const bf16x4 xv = xq[mt];
                    f32x4 y;
#pragma unroll
                    for (int e2 = 0; e2 < 4; ++e2) y[e2] = ad[e2] + sc * ao[e2] + Dh * bf2f((bf16_t)xv[e2]);
                    *(f32x4*)(YT + row * 512 + h * 64 + 16 * mt + 4 * q) = y;
                }
            }
            __syncthreads();
        }
        if (g == 1) { asm volatile("s_waitcnt vmcnt(0)" ::: "memory"); __syncthreads(); mgate_rows(p, z, l, row0, row0 + SL, wave, NWAVES, lane); }
#undef SSD3_FETCH
    }
}

__device__ __forceinline__ void stage_mgate_sample(const Params& p, int l, int first) {
    const Ctx cx = mkctx(p, first); const size_t z = cx.z;
    mgate_rows(p, z, l, MP, R, cx.bid * NWAVES + (cx.tid >> 6), cx.nb * NWAVES, cx.tid & 63);
}

__device__ __forceinline__ void stage_glu(const Params& p, int l) {
    const Ctx cx = mkctx(p); const size_t z = cx.z;
    const unsigned gt = (unsigned)cx.bid * NTHREADS + cx.tid, GT = (unsigned)cx.nb * NTHREADS;
    const bf16_t* GV = (const bf16_t*)(p.ws + z + WS_GV); bf16_t* U = (bf16_t*)(p.ws + z + WS_U);
    const float* cw = PIN(I_FCW) + (size_t)l * 3 * DFF; const float* cb = PIN(I_FCB) + (size_t)l * DFF;
    for (unsigned i = gt; i < (unsigned)(MP / 32) * (DFF / 8); i += GT) {
        const int hr = (int)(i / (unsigned)(DFF / 8)), c0 = (int)(i - (unsigned)hr * (DFF / 8)) * 8, row = (hr >> 1) * 64 + (hr & 1), t = row & (T - 1);
        const int cg = 256 * (c0 >> 7) + (c0 & 127);
        bf16x8 u[3];
#pragma unroll
        for (int k = 0; k < 3; ++k) { const bf16x8 zz = {0, 0, 0, 0, 0, 0, 0, 0}; u[k] = (t - 2 + k >= 0) ? *(const bf16x8*)(GV + (size_t)(row - 2 + k) * 5632 + cg) : zz; }
        const bf16x8 vv = *(const bf16x8*)(GV + (size_t)row * 5632 + cg + 128);
        bf16x8 o;
#pragma unroll
        for (int e = 0; e < 8; ++e) { const float acc = cb[c0 + e] + cw[c0 + e] * bf2f((bf16_t)u[0][e]) + cw[DFF + c0 + e] * bf2f((bf16_t)u[1][e]) + cw[2 * DFF + c0 + e] * bf2f((bf16_t)u[2][e]);
            o[e] = (short)f2bf(silu_f(acc) * bf2f((bf16_t)vv[e])); }
        *(bf16x8*)(U + (size_t)row * DFF + c0) = o;
    }
    for (unsigned i = gt; i < (unsigned)NP * 2 * DFF; i += GT) {
        const int c = (int)(i % (unsigned)DFF), j = (int)(i / (unsigned)DFF) & 1, n = (int)(i / (unsigned)(2 * DFF));
        (p.out + z)[O_PFFN + (((size_t)l * NP + n) * 2 + j) * DFF + c] = bf2f(GV[(size_t)(n * T + T - 2 + j) * 5632 + 256 * (c >> 7) + (c & 127)]);
    }
    for (unsigned i = (unsigned)MP * (DFF / 8) + gt; i < (unsigned)R * (DFF / 8); i += GT) {
        const int row = (int)(i / (unsigned)(DFF / 8)), c0 = (int)(i - (unsigned)row * (DFF / 8)) * 8;
        const int cg = 256 * (c0 >> 7) + (c0 & 127);
        const bool samp = row >= MP; const int n = samp ? row - MP : row >> 13, t = samp ? 0 : (row & (T - 1));
        float acc[8], raw[8];
#pragma unroll
        for (int e = 0; e < 8; ++e) acc[e] = cb[c0 + e];
#pragma unroll
        for (int j = 0; j < 3; ++j) {
            const int tau = t - 2 + j; float u[8];
            if (tau >= 0) { const bf16x8 v = *(const bf16x8*)(GV + (size_t)(row - 2 + j) * 5632 + cg);
#pragma unroll
                for (int e = 0; e < 8; ++e) u[e] = bf2f((bf16_t)v[e]); }
            else {
#pragma unroll
                for (int e = 0; e < 8; ++e) u[e] = samp ? PIN(I_FCONV)[(((size_t)l * NS + n) * 2 + (2 + tau)) * DFF + c0 + e] : 0.f; }
#pragma unroll
            for (int e = 0; e < 8; ++e) { acc[e] += cw[j * DFF + c0 + e] * u[e]; if (j == 2) raw[e] = u[e]; }
        }
        const bf16x8 vv = *(const bf16x8*)(GV + (size_t)row * 5632 + cg + 128);
        bf16x8 o;
#pragma unroll
        for (int e = 0; e < 8; ++e) o[e] = (short)f2bf(silu_f(acc[e]) * bf2f((bf16_t)vv[e]));
        *(bf16x8*)(U + (size_t)row * DFF + c0) = o;
        if (samp) { float* op = (p.out + z) + O_SFFN + ((size_t)l * NS + n) * 2 * DFF + c0;
#pragma unroll
            for (int e = 0; e < 8; ++e) { op[e] = PIN(I_FCONV)[(((size_t)l * NS + n) * 2 + 1) * DFF + c0 + e]; op[DFF + e] = raw[e]; } }
        else if (t >= T - 2) { float* op = (p.out + z) + O_PFFN + (((size_t)l * NP + n) * 2 + (t - (T - 2))) * DFF + c0;
#pragma unroll
            for (int e = 0; e < 8; ++e) op[e] = raw[e]; }
    }
}

__device__ __forceinline__ void stage_final(const Params& p) {
    const Ctx cx = mkctx(p); const size_t z = cx.z;
    const size_t gt = (size_t)cx.bid * NTHREADS + cx.tid, GT = (size_t)cx.nb * NTHREADS;
    const float* X = (const float*)(p.out + z);
    for (size_t i = gt; i < (size_t)R * D; i += GT) (p.out + z)[i] = X[i];
}

#define LAS __attribute__((address_space(3)))
typedef unsigned v4u __attribute__((ext_vector_type(4)));
__device__ __forceinline__ unsigned pk2(float lo, float hi) { return cvtpk(lo, hi); }
template <bool GV_PERM = false>
__device__ __forceinline__ void p0_transpose_item(const float* W, int ldw, int K, int nblk, bf16_t* WT, LAS float* scr, int item, int lane) {
    const int kb = item / nblk, nb = item % nblk, k0 = 64 * kb, n0 = 32 * nb;
    int nd = n0;
    if (GV_PERM) { const int bj = n0 >= DFF ? 1 : 0, rem = n0 - bj * DFF; nd = 256 * (rem >> 7) + 128 * bj + (rem & 127); }
    {
        f32x4 t[8];
#pragma unroll
        for (int i = 0; i < 8; ++i) t[i] = *(const f32x4*)(W + (size_t)(k0 + 8 * i + (lane >> 3)) * ldw + n0 + 4 * (lane & 7));
#pragma unroll
        for (int i = 0; i < 8; ++i) { LAS float* d = scr + (8 * i + (lane >> 3)) * 33 + 4 * (lane & 7); d[0] = t[i][0]; d[1] = t[i][1]; d[2] = t[i][2]; d[3] = t[i][3]; }
    }
    asm volatile("s_waitcnt lgkmcnt(0)" ::: "memory");
    const int c = lane & 7;
#pragma unroll
    for (int j = 0; j < 4; ++j) { const int n = (lane >> 3) + 8 * j; const LAS float* s = scr + (8 * c) * 33 + n;
        v4u o; o.x = pk2(s[0 * 33], s[1 * 33]); o.y = pk2(s[2 * 33], s[3 * 33]); o.z = pk2(s[4 * 33], s[5 * 33]); o.w = pk2(s[6 * 33], s[7 * 33]);
        *(v4u*)(WT + (size_t)(nd + n) * K + k0 + 8 * c) = o; }
    asm volatile("s_waitcnt lgkmcnt(0)" ::: "memory");
}
__device__ __forceinline__ void stage_wconv(const Params& p, unsigned char* lds, int l_lo, int l_hi, int first = 0) {
    const Ctx cx = mkctx(p, first); const size_t z = cx.z;
    if (l_lo == 0) {
        bf16_t* LT = (bf16_t*)(p.ws + z + WS_LORA);
        for (unsigned i = (unsigned)cx.bid * NTHREADS + cx.tid; i < (unsigned)L * 65536; i += (unsigned)cx.nb * NTHREADS) {
            const int l = i >> 16, e = i & 65535, j = e & 255, ii = e >> 8;
            float v; bf16_t* dst;
            if (ii < 64) { v = PIN(I_W2)[(size_t)l * 16384 + ii * 256 + j]; dst = LT + (size_t)l * 65536 + j * 64 + ii; }
            else if (ii < 128) { v = PIN(I_A2)[(size_t)l * 16384 + (ii - 64) * 256 + j]; dst = LT + (size_t)l * 65536 + 16384 + j * 64 + (ii - 64); }
            else { v = PIN(I_G2)[(size_t)l * 32768 + (ii - 128) * 256 + j]; dst = LT + (size_t)l * 65536 + 32768 + j * 128 + (ii - 128); }
            *dst = f2bf(v);
        }
        bf16_t* WD = (bf16_t*)(p.ws + z + WS_WDTT);
        for (unsigned i = (unsigned)cx.bid * NTHREADS + cx.tid; i < (unsigned)L * 16384; i += (unsigned)cx.nb * NTHREADS) {
            const int l = i >> 14, j = (i >> 10) & 15, k = i & 1023;
            WD[i] = j < 8 ? f2bf(PIN(I_WIN)[(size_t)l * D * PROJ + (size_t)k * PROJ + PCOLS + j]) : (bf16_t)0;
        }
    }
    const int lane = cx.tid & 63, wave = cx.tid >> 6;
    LAS float* scr = (LAS float*)(lds + wave * 16384);
    const int gw = flip_bid(cx) * NWAVES + wave, NGW = cx.nb * NWAVES;
    constexpr int I_IN = 16 * 96, I_OUT = 16 * 32, I_UP = 16 * 176, I_DN = 44 * 32, PER_L = I_IN + I_OUT + I_UP + I_DN;
    for (int it = gw; it < (l_hi - l_lo) * PER_L; it += NGW) {
        const int l = l_lo + it / PER_L; int r = it % PER_L;
        if (r < I_IN) { p0_transpose_item(PIN(I_WIN) + (size_t)l * D * PROJ, PROJ, D, 96, (bf16_t*)(p.ws + z + WS_WIN) + (size_t)l * PCOLS * D, scr, r, lane); continue; } r -= I_IN;
        if (r < I_OUT) { p0_transpose_item(PIN(I_WOUT) + (size_t)l * D * D, D, D, 32, (bf16_t*)(p.ws + z + WS_WOUT) + (size_t)l * D * D, scr, r, lane); continue; } r -= I_OUT;
        if (r < I_UP) { p0_transpose_item<true>(PIN(I_WUP) + (size_t)l * D * 5632, 5632, D, 176, (bf16_t*)(p.ws + z + WS_WUP) + (size_t)l * 5632 * D, scr, r, lane); continue; } r -= I_UP;
        p0_transpose_item(PIN(I_WDOWN) + (size_t)l * DFF * D, D, DFF, 32, (bf16_t*)(p.ws + z + WS_WDN) + (size_t)l * D * DFF, scr, r, lane);
    }
}

template <int NT, class F>
__device__ __forceinline__ void gemm_small(const Params& p, const bf16_t* A, int lda, const bf16_t* Bt, int N, int K, int ksplit, const F& epi) {
    const Ctx cx = mkctx(p); A += cx.z; Bt += cx.z;
    const int lane = cx.tid & 63, wave = __builtin_amdgcn_readfirstlane(cx.tid >> 6), r = lane & 15, q = lane >> 4;
    const int ntile = N / (16 * NT), kc = K / ksplit;
    for (int task = cx.nb - 1 - cx.bid; task < ntile * ksplit; task += cx.nb) {
        const int tn = task % ntile, ks = task / ntile, n0 = tn * 16 * NT, k0 = ks * kc;
        const bf16_t* ap = A + (size_t)(16 * wave + r) * lda + k0 + 8 * q;
        const bf16_t* bp = Bt + (size_t)(n0 + r) * K + k0 + 8 * q;
        f32x4 acc[NT];
#pragma unroll
        for (int nt = 0; nt < NT; ++nt) acc[nt] = (f32x4){0.f, 0.f, 0.f, 0.f};
#pragma unroll 8
        for (int s2 = 0; s2 < kc / 32; ++s2) {
            const bf16x8 fa = *(const bf16x8*)(ap + 32 * s2);
#pragma unroll
            for (int nt = 0; nt < NT; ++nt) { const bf16x8 fb = *(const bf16x8*)(bp + (size_t)nt * 16 * K + 32 * s2); acc[nt] = __builtin_amdgcn_mfma_f32_16x16x32_bf16(fb, fa, acc[nt], 0, 0, 0); }
        }
#pragma unroll
        for (int nt = 0; nt < NT; ++nt) epi(16 * wave + r, n0 + 16 * nt + 4 * q, acc[nt]);
    }
}
struct SmallBf { bf16_t* O; int ldc; __device__ __forceinline__ void operator()(int row, int col, f32x4 v) const { *(bf16x4*)(O + (size_t)(MP + row) * ldc + col) = pack4(v); } };
struct SmallRes { float* X; const float* gate;   __device__ __forceinline__ void operator()(int row, int col, f32x4 v) const {
    const f32x4 g = *(const f32x4*)(gate + (size_t)(NP + row) * 6144 + col); float* x = X + (size_t)(MP + row) * D + col;
#pragma unroll
    for (int e = 0; e < 4; ++e) unsafeAtomicAdd(x + e, g[e] * v[e]); } };

__device__ __forceinline__ void stage_dtgemm(const Params& p, int l) {
    const Ctx cx = mkctx(p); const size_t z = cx.z;
    const int lane = cx.tid & 63, wave = __builtin_amdgcn_readfirstlane(cx.tid >> 6), r = lane & 15, q = lane >> 4;
    const bf16_t* H = (const bf16_t*)(p.ws + z + WS_H); const bf16_t* WD = (const bf16_t*)(p.ws + z + WS_WDTT) + (size_t)l * 16384;
    float* DT = (float*)(p.ws + z + WS_DT);
    for (int task = cx.nb - 1 - cx.bid; task < R / 128; task += cx.nb) {
        const int row = task * 128 + 16 * wave + r;
        const bf16_t* hp = H + (size_t)row * D + 8 * q; const bf16_t* wp = WD + r * 1024 + 8 * q;
        f32x4 acc = {0.f, 0.f, 0.f, 0.f};
#pragma unroll 8
        for (int s2 = 0; s2 < 32; ++s2) { const bf16x8 fa = *(const bf16x8*)(hp + 32 * s2), fb = *(const bf16x8*)(wp + 32 * s2); acc = __builtin_amdgcn_mfma_f32_16x16x32_bf16(fb, fa, acc, 0, 0, 0); }
        if (q < 2) *(f32x4*)(DT + (size_t)row * 8 + 4 * q) = acc;
    }
}

#define RLX_AGENT __ATOMIC_RELAXED, __HIP_MEMORY_SCOPE_AGENT
#define XB_TMO      128
#define XB_XCNT(j)  (256  + 64 * (j))
#define XB_XSUB(j)  (1280 + 64 * (j))
#define XB_XGEN(j)  (2304 + 64 * (j))
#define XB_TOP      3328
#define XB_TOPGEN   3392
#define XCD_BAR_WORDS 3456
#define XB_SPIN_CAP (1u << 18)

__device__ __forceinline__ unsigned xb_ld(unsigned* p)              { return __hip_atomic_load(p, __ATOMIC_RELAXED, __HIP_MEMORY_SCOPE_AGENT); }
__device__ __forceinline__ unsigned xb_add(unsigned* p, unsigned v) { return __hip_atomic_fetch_add(p, v, __ATOMIC_RELAXED, __HIP_MEMORY_SCOPE_AGENT); }
__device__ __forceinline__ unsigned xb_xcc_id() { return (unsigned)__builtin_amdgcn_s_getreg((3 << 11) | 20) & 0xFu; }
#define XB_SPIN(cond, bar) do { unsigned _sp = 0; while (cond) { __builtin_amdgcn_s_sleep(1); \
    if ((++_sp & 255u) == 0u) { if (xb_ld(&(bar)[XB_TMO])) break; if (_sp > XB_SPIN_CAP) { atomicAdd(&(bar)[XB_TMO], 1u); break; } } } } while (0)

struct XcdBarrier {
    unsigned* bar; unsigned x; int wave;
    volatile LAS unsigned* st;
};

__device__ __forceinline__ XcdBarrier xcd_barrier_post(unsigned* bar, volatile LAS unsigned* st, int wave) {
    XcdBarrier b; b.bar = bar; b.x = xb_xcc_id(); b.st = st; b.wave = wave;
    if (wave == 0 && lane_id() == 0) (void)xb_add(&bar[XB_XCNT(b.x)], 1u);
    return b;
}
__device__ __forceinline__ void xcd_barrier_complete(unsigned* bar, unsigned x, unsigned& nloc, unsigned& nx) {
    const unsigned G = gridDim.x * gridDim.y * gridDim.z;
    unsigned sum, cnt, mine, sp = 0u;
    for (;;) {
        sum = 0u; cnt = 0u; mine = 0u;
#pragma unroll
        for (unsigned j = 0; j < 16; ++j) { const unsigned c = xb_ld(&bar[XB_XCNT(j)]); sum += c; cnt += (c > 0u) ? 1u : 0u; mine = (j == x) ? c : mine; }
        if (sum == G) break;
        __builtin_amdgcn_s_sleep(1);
        if ((++sp & 255u) == 0u) { if (xb_ld(&bar[XB_TMO])) break; if (sp > XB_SPIN_CAP) { atomicAdd(&bar[XB_TMO], 1u); break; } }
    }
    nloc = mine > 0u ? mine : 1u; nx = cnt > 0u ? cnt : 1u;
}

__device__ __forceinline__ void xcd_barrier(const XcdBarrier& b) {
    asm volatile("s_waitcnt vmcnt(0)" ::: "memory");
    __syncthreads();
    if (b.wave == 0 && lane_id() == 0) {
        unsigned* bar = b.bar;
        __builtin_amdgcn_s_waitcnt(0);
        unsigned nloc = b.st[0], nx = b.st[1];
        if (nloc == 0u) { xcd_barrier_complete(bar, b.x, nloc, nx); b.st[0] = nloc; b.st[1] = nx; }
        const unsigned old = xb_add(&bar[XB_XSUB(b.x)], 1u);
        const unsigned gen = old / nloc;
        if (old + 1u == (gen + 1u) * nloc) {
            __builtin_amdgcn_fence(__ATOMIC_RELEASE, "agent");
            asm volatile("s_waitcnt vmcnt(0)" ::: "memory");
            const unsigned og = xb_add(&bar[XB_TOP], 1u);
            const unsigned tg = og / nx;
            if (og + 1u == (tg + 1u) * nx) xb_add(&bar[XB_TOPGEN], 1u);
            else XB_SPIN(xb_ld(&bar[XB_TOPGEN]) == tg, bar);
            __builtin_amdgcn_fence(__ATOMIC_ACQUIRE, "agent");
            xb_add(&bar[XB_XGEN(b.x)], 1u);
            asm volatile("s_waitcnt vmcnt(0)" ::: "memory");
        } else {
            XB_SPIN(xb_ld(&bar[XB_XGEN(b.x)]) == gen, bar);
            __builtin_amdgcn_fence(__ATOMIC_ACQUIRE, "agent");
            asm volatile("s_waitcnt vmcnt(0)" ::: "memory");
        }
    }
    __syncthreads();
}

namespace cg = cooperative_groups;
constexpr int LDS_BYTES = 153600;
__global__ void __launch_bounds__(NTHREADS, 2) fwd_mega(Params p_in) {
    Params p = p_in; p.wave = __builtin_amdgcn_readfirstlane((int)(threadIdx.x >> 6));
    extern __shared__ __attribute__((aligned(16))) unsigned char lds[];
    cg::grid_group grid = cg::this_grid();
    float* ldsf = (float*)lds;
    volatile LAS unsigned* MISC = (volatile LAS unsigned*)((LAS unsigned char*)lds + LDS_BYTES - 64);
    if (p.wave == 0 && lane_id() < 16) MISC[lane_id()] = 0u;
    __syncthreads();
    const XcdBarrier bar = xcd_barrier_post((unsigned*)(p.ws + WS_CTL), MISC, p.wave);
#define GSYNC() xcd_barrier(bar)
    stage_init(p); stage_wconv(p, lds, 0, 1); __syncthreads(); stage_mod(p, lds, 0, L); grid.sync();
    for (int l = 0; l < L; ++l) {
        const float* MODl = (const float*)(p.ws + WS_MOD) + (size_t)l * NSEQ * 6144;
        if (l > 0) stage_norm_b(p, l, 0);
        stage_norm(p, l, 0, ldsf, l == 0); GSYNC();
        { pg8::Gemm g{(const bf16_t*)(p.ws + WS_H), (const bf16_t*)(p.ws + WS_WIN) + (size_t)l * PCOLS * D, MP, PCOLS, D}; pg8::StaticOrder S; S.init(MP, PCOLS, (int)gridDim.x, (int)blockIdx.x);
          pg8::EpiBf16<0> E{(bf16_t*)(p.ws + WS_P), PCOLS, nullptr, 0, 0, 1.f};
          pg8::gemm_phase<pg8::EpiBf16<0>, pg8::StaticOrder, true, true>((LAS unsigned char*)lds, g, S, E, (p.wave << 6) | lane_id()); }
        gemm_small<1>(p, (const bf16_t*)(p.ws + WS_H) + (size_t)MP * D, D, (const bf16_t*)(p.ws + WS_WIN) + (size_t)l * PCOLS * D, PCOLS, D, 1, SmallBf{(bf16_t*)(p.ws + WS_P), PCOLS});
        stage_dtgemm(p, l);
        GSYNC();
        stage_rwprep(p, l, ldsf); __syncthreads(); stage_rwprep2(p, l, lds); asm volatile("s_waitcnt vmcnt(0)" ::: "memory"); __syncthreads();
        stage_rw1(p, l, lds); stage_mconv(p, l); stage_qkn(p, l); stage_ssd1(p, l, lds); GSYNC();
        stage_rw2(p, l, lds); stage_ssd2(p, l); stage_att(p, l, RW2_WGS); stage_rwscan(p, l, ldsf, RW2_WGS); stage_mscan(p, l, ldsf, RW2_WGS);
        if (l + 1 < L) { __syncthreads(); stage_wconv(p, lds, l + 1, l + 2, RW2_WGS); }
        GSYNC();
        stage_ssd3(p, l, lds, 0, 128); stage_rw3(p, l, 128); stage_attn(p, l, lds, 128); stage_mgate_sample(p, l, 128); GSYNC();
        { pg8::Gemm g{(const bf16_t*)(p.ws + WS_YCAT), (const bf16_t*)(p.ws + WS_WOUT) + (size_t)l * D * D, MP, D, D}; pg8::StaticOrder S; S.init(MP, D, (int)gridDim.x, (int)blockIdx.x);
          pg8::EpiResGate E{p.out, p.in[I_XP], (bf16_t*)(p.ws + WS_XB), MODl + 2048, l == 0, 0, 13, 6144};
          pg8::gemm_phase<pg8::EpiResGate, pg8::StaticOrder, true, true>((LAS unsigned char*)lds, g, S, E, (p.wave << 6) | lane_id()); }
        gemm_small<1>(p, (const bf16_t*)(p.ws + WS_YCAT) + (size_t)MP * D, D, (const bf16_t*)(p.ws + WS_WOUT) + (size_t)l * D * D, D, D, 4, SmallRes{p.out, MODl + 2048});
        GSYNC();
        stage_norm_b(p, l, 1); stage_norm(p, l, 1, ldsf, false); GSYNC();
        { pg8::Gemm g{(const bf16_t*)(p.ws + WS_H), (const bf16_t*)(p.ws + WS_WUP) + (size_t)l * 5632 * D, MP, 5632, D}; pg8::StaticOrder S; S.init(MP, 5632, (int)gridDim.x, (int)blockIdx.x);
          pg8::EpiGlu E{(bf16_t*)(p.ws + WS_GV), (bf16_t*)(p.ws + WS_U), p.in[I_FCW] + (size_t)l * 3 * DFF, p.in[I_FCB] + (size_t)l * DFF};
          pg8::gemm_phase<pg8::EpiGlu, pg8::StaticOrder, true, true>((LAS unsigned char*)lds, g, S, E, (p.wave << 6) | lane_id()); }
        gemm_small<1>(p, (const bf16_t*)(p.ws + WS_H) + (size_t)MP * D, D, (const bf16_t*)(p.ws + WS_WUP) + (size_t)l * 5632 * D, 5632, D, 1, SmallBf{(bf16_t*)(p.ws + WS_GV), 5632});
        stage_cachecopy(p, l, 128);
        GSYNC();
        stage_glu(p, l); GSYNC();
        { pg8::Gemm g{(const bf16_t*)(p.ws + WS_U), (const bf16_t*)(p.ws + WS_WDN) + (size_t)l * D * DFF, MP, D, DFF}; pg8::StaticOrder S; S.init(MP, D, (int)gridDim.x, (int)blockIdx.x);
          pg8::EpiResGate E{p.out, p.in[I_XP], (bf16_t*)(p.ws + WS_XB), MODl + 5120, 0, l == L - 1, 13, 6144};
          pg8::gemm_phase<pg8::EpiResGate, pg8::StaticOrder, true, true>((LAS unsigned char*)lds, g, S, E, (p.wave << 6) | lane_id()); }
        gemm_small<1>(p, (const bf16_t*)(p.ws + WS_U) + (size_t)MP * DFF, DFF, (const bf16_t*)(p.ws + WS_WDN) + (size_t)l * D * DFF, D, DFF, 4, SmallRes{p.out, MODl + 5120});
        GSYNC();
    }
}

extern "C" void kernel_launch(void* const* d_in, const int* in_sizes, int n_in, void* d_out, int out_size, void* d_ws, size_t ws_size, hipStream_t stream) {
    static int grid = 0;
    if (grid == 0) {
        if (n_in != N_IN || (size_t)out_size != O_END || ws_size < WS_END) { fprintf(stderr, "kernel_launch: unexpected sizes n_in %d out %d ws %zu\n", n_in, out_size, ws_size); grid = -1; return; }
        int dev = 0, cus = 0, per_cu = 0;
        hipGetDevice(&dev); hipDeviceGetAttribute(&cus, hipDeviceAttributeMultiprocessorCount, dev);
        if (hipFuncSetAttribute((const void*)fwd_mega, hipFuncAttributeMaxDynamicSharedMemorySize, LDS_BYTES) != hipSuccess) { fprintf(stderr, "hipFuncSetAttribute failed\n"); grid = -1; return; }
        hipOccupancyMaxActiveBlocksPerMultiprocessor(&per_cu, (const void*)fwd_mega, NTHREADS, LDS_BYTES);
        if (per_cu < 1) { fprintf(stderr, "occupancy query says %d blocks per CU\n", per_cu); grid = -1; return; }
        grid = cus;
    }
    if (grid < 0) return;
    Params p{};
    for (int i = 0; i < N_IN; ++i) p.in[i] = (const float*)d_in[i];
    p.out = (float*)d_out; p.ws = (unsigned char*)d_ws;
    if (hipMemsetAsync((char*)d_ws + WS_CTL, 0, 16384, stream) != hipSuccess) { fprintf(stderr, "memset of the barrier words failed\n"); return; }
    void* args[] = {&p};
    hipError_t e = hipLaunchCooperativeKernel((void*)fwd_mega, dim3(grid), dim3(NTHREADS), args, LDS_BYTES, stream);
    if (e != hipSuccess) fprintf(stderr, "cooperative launch failed: %s\n", hipGetErrorString(e));
}
```

```cpp
#include <hip/hip_runtime.h>
#include <hip/hip_cooperative_groups.h>
#include <cstdint>
#include <cstdio>

typedef unsigned short bf16_t;
__device__ __forceinline__ float bf2f(bf16_t v) { return __uint_as_float(((unsigned)v) << 16); }
typedef float f32x2_t __attribute__((ext_vector_type(2)));
typedef __bf16 bf16x2_t __attribute__((ext_vector_type(2)));
__device__ __forceinline__ unsigned cvtpk(float lo, float hi) { const f32x2_t v = {lo, hi}; const bf16x2_t b = __builtin_convertvector(v, bf16x2_t); return __builtin_bit_cast(unsigned, b); }
__device__ __forceinline__ bf16_t f2bf(float f) { return (bf16_t)cvtpk(f, 0.f); }

constexpr int D = 1024, NP = 2, T = 8192, MP = NP * T, NS = 128, R = MP + NS, NSEQ = NP + NS, L = 4;
constexpr int PROJ = 3080, PCOLS = 3072, DFF = 2816;
constexpr int OFF_B = 1024, OFF_Z = 1536, OFF_XBC = 2048;
constexpr float NORM_EPS = 1e-6f, GN_EPS = 64e-5f;
constexpr int NTHREADS = 512, NWAVES = 8;
typedef short bf16x8 __attribute__((ext_vector_type(8)));
typedef short bf16x4 __attribute__((ext_vector_type(4)));
typedef float f32x4 __attribute__((ext_vector_type(4)));
__device__ __forceinline__ bf16x4 pack4(f32x4 v) { typedef unsigned u32x2_t __attribute__((ext_vector_type(2))); const u32x2_t w = {cvtpk(v[0], v[1]), cvtpk(v[2], v[3])}; return __builtin_bit_cast(bf16x4, w); }
constexpr int LD = 72, MSZ = 64 * LD;
constexpr int LD2 = 136;

enum { I_XP = 0, I_XS, I_CP, I_CS, I_SHIFT, I_WKV, I_CK, I_CV, I_SCONV, I_SSM, I_FCONV, I_ADAW, I_ADAB, I_NMIXG, I_NFFNG, I_WIN, I_WOUT,
       I_MU, I_W0, I_W2, I_A0, I_A2, I_G2, I_KK, I_KA, I_RK, I_LNG, I_LNB, I_QNG, I_KNG, I_SINK, I_CONVW, I_CONVB, I_DTB, I_ALOG, I_SSMD, I_SSMNG,
       I_WUP, I_FCW, I_FCB, I_WDOWN, N_IN };

constexpr size_t O_YP = 0;
constexpr size_t O_YS = O_YP + (size_t)MP * D;
constexpr size_t O_PSHIFT = O_YS + (size_t)NS * D;
constexpr size_t O_PWKV = O_PSHIFT + (size_t)L * NP * 1024;
constexpr size_t O_PK = O_PWKV + (size_t)L * NP * 4 * 64 * 64;
constexpr size_t O_PV = O_PK + (size_t)L * NP * 128 * 128;
constexpr size_t O_PCONV = O_PV + (size_t)L * NP * 128 * 128;
constexpr size_t O_PSSM = O_PCONV + (size_t)L * NP * 3 * 1024;
constexpr size_t O_PFFN = O_PSSM + (size_t)L * NP * 8 * 64 * 128;
constexpr size_t O_SSHIFT = O_PFFN + (size_t)L * NP * 2 * DFF;
constexpr size_t O_SWKV = O_SSHIFT + (size_t)L * NS * 1024;
constexpr size_t O_SK = O_SWKV + (size_t)L * NS * 4 * 64 * 64;
constexpr size_t O_SV = O_SK + (size_t)L * NS * 128 * 128;
constexpr size_t O_SCONV = O_SV + (size_t)L * NS * 128 * 128;
constexpr size_t O_SSSM = O_SCONV + (size_t)L * NS * 3 * 1024;
constexpr size_t O_SFFN = O_SSSM + (size_t)L * NS * 8 * 64 * 128;
constexpr size_t O_END = O_SFFN + (size_t)L * NS * 2 * DFF;

constexpr size_t MiB = 1u << 20;
constexpr int MPAD = 16640;
constexpr size_t WS_XB = 0;
constexpr size_t WS_X = 0;
constexpr size_t WS_H = 65 * MiB;
constexpr size_t WS_YCAT = WS_H;
constexpr size_t WS_MOD = 98 * MiB;
constexpr size_t WS_P = 111 * MiB;
constexpr size_t WS_DT = 209 * MiB;
constexpr size_t WS_GV = 210 * MiB;
constexpr size_t WS_U = 389 * MiB;
constexpr size_t WS_WIN = 479 * MiB;
constexpr size_t WS_WOUT = 503 * MiB;
constexpr size_t WS_WUP = 511 * MiB;
constexpr size_t WS_WDN = 555 * MiB;
constexpr size_t WS_RWC_Y0 = 578 * MiB;
constexpr size_t WS_CTL = 595 * MiB;
constexpr size_t WS_LORA = 596 * MiB;
constexpr size_t WS_WDTT = WS_LORA + 512 * 1024;
constexpr size_t WS_DT2 = 597 * MiB;
constexpr size_t WS_END = 598 * MiB;
constexpr size_t WS_RWC_RP = WS_U + 65 * MiB;
constexpr size_t WS_RWC_MC = WS_RWC_RP + 8 * MiB;
constexpr size_t WS_RWC_NCT = WS_RWC_MC + 8 * MiB;
static_assert(WS_RWC_NCT + 8 * MiB <= WS_WIN, "rwkv chunk buffers fit the U region tail");
constexpr size_t WS_RW = WS_GV;
constexpr size_t WS_RWD = WS_RW + 49 * MiB;
constexpr size_t WS_HPREV = WS_RW + 70 * MiB;
constexpr size_t WS_QN = WS_RW + 113 * MiB;
constexpr size_t WS_KN = WS_QN + 17 * MiB;
constexpr size_t WS_YTMP = WS_KN + 9 * MiB;
static_assert(WS_YTMP + (size_t)R * 512 * 4 <= WS_U, "mixer temporaries fit the GV region");
constexpr size_t WS_XBCC = WS_U;
constexpr size_t WS_SST = WS_U + 33 * MiB;
static_assert(WS_XBCC + (size_t)R * 1024 * 2 <= WS_SST && WS_SST + 32 * MiB <= WS_RWC_RP, "xbc / ssd states fit the U region");
constexpr size_t WS_SCD = WS_RWC_Y0 + 16 * MiB;

struct Params {
    const float* in[N_IN];
    float* out;
    unsigned char* ws;
    int wave, pad;
};

__device__ __forceinline__ int seq_of_row(int row) { return row < MP ? (row >> 13) : (NP + row - MP); }
__device__ __forceinline__ float wave_sum(float v) {
#pragma unroll
    for (int o = 1; o < 64; o <<= 1) v += __shfl_xor(v, o);
    return v;
}
__device__ __forceinline__ float wave_max(float v) {
#pragma unroll
    for (int o = 1; o < 64; o <<= 1) v = fmaxf(v, __shfl_xor(v, o));
    return v;
}
__device__ __forceinline__ float silu_f(float x) { return x * __builtin_amdgcn_rcpf(1.f + __expf(-x)); }
__device__ __forceinline__ float sigmoid_f(float x) { return __builtin_amdgcn_rcpf(1.f + __expf(-x)); }
__device__ __forceinline__ float tanh_fast(float x) { return 1.f - 2.f * __builtin_amdgcn_rcpf(1.f + __expf(2.f * x)); }
__device__ __forceinline__ float softplus_fast(float x) { return fmaxf(x, 0.f) + __logf(1.f + __expf(-fabsf(x))); }
__device__ __forceinline__ float softplus_f(float x) { return fmaxf(x, 0.f) + log1pf(__expf(-fabsf(x))); }

namespace pg8 {
#define PG8_LAS __attribute__((address_space(3)))
typedef unsigned short bf16_t;
typedef short bf16x8 __attribute__((ext_vector_type(8)));
typedef float f32x4 __attribute__((ext_vector_type(4)));
typedef unsigned u32x4 __attribute__((ext_vector_type(4)));
constexpr int BM = 256, BK = 64, HALF = 128, HTB = HALF * BK * 2  , STAGE_BYTES = 8 * HTB, NXCD = 8, WGM = 8;

__host__ __device__ __forceinline__ int lds_byte(int r, int c) { const int st = (r >> 4) * 2 + (c >> 5), rr = r & 15, cc = c & 31, ob = rr * 64 + cc * 2; return st * 1024 + (ob ^ (((ob >> 9) & 1) << 5)); }
__host__ __device__ __forceinline__ void stage_rc(int b, int& R, int& C) { const int st = b / 1024, sb = b % 1024, swz = sb ^ (((sb >> 9) & 1) << 5); R = (st >> 1) * 16 + swz / 64; C = (st & 1) * 32 + (swz % 64) / 2; }
__host__ __device__ __forceinline__ int perm32(int rho) { const int n = rho >> 4, i = rho & 15; return 8 * (i >> 2) + 4 * n + (i & 3); }

struct Unit { int pm, pn; };
struct Gemm { const bf16_t* A; const bf16_t* Bt; int M, N, K; };

struct StaticOrder {
    int nM, nN, nwg, G, c;
    __host__ __device__ void init(int M, int N, int G_, int c_) { nM = M / BM; nN = N / BM; nwg = nM * nN; G = G_; c = c_; }
    __host__ __device__ bool next(int i, Unit& u) const {
        const long L = (long)i * G + c; if (L >= nwg) return false;
        int wgid = (int)L; { const int q = nwg / NXCD, r = nwg % NXCD, xcd = wgid % NXCD, off = wgid / NXCD; wgid = (xcd < r ? xcd * (q + 1) : r * (q + 1) + (xcd - r) * q) + off; }
        const int nig = WGM * nN, gid = wgid / nig, fm = gid * WGM, gsz = (nM - fm) < WGM ? (nM - fm) : WGM;
        u.pm = fm + ((wgid % nig) % gsz); u.pn = (wgid % nig) / gsz; return true;
    }
    __device__ __forceinline__ void a_ready(const Unit&) const {}
    __device__ __forceinline__ void done(const Unit&) const {}
};

__device__ __forceinline__ unsigned cvt_pk_bf16(float lo, float hi) { unsigned r; asm volatile("v_cvt_pk_bf16_f32 %0, %1, %2" : "=v"(r) : "v"(lo), "v"(hi)); return r; }
typedef float f32x2 __attribute__((ext_vector_type(2)));
__device__ __forceinline__ f32x2 gelu_pk(f32x2 v) {
    const f32x2 av = __builtin_elementwise_abs(v), d = av * 0.2316418882f + 1.0f;
    f32x2 t; t.x = __builtin_amdgcn_rcpf(d.x); t.y = __builtin_amdgcn_rcpf(d.y);
    f32x2 q = t * 0.5307027145f + (-0.7265760135f); q = q * t + 0.7107068705f; q = q * t + (-0.142248368f); q = q * t + 0.127414796f; q = q * t;
    const f32x2 s = (v * v) * (-0.72134752044f);
    f32x2 e; e.x = __builtin_amdgcn_exp2f(s.x); e.y = __builtin_amdgcn_exp2f(s.y);
    const f32x2 m = v * (q * e), r = v - m;
    f32x2 o; o.x = v.x < 0.f ? m.x : r.x; o.y = v.y < 0.f ? m.y : r.y; return o;
}

template <int ACT  > struct EpiBf16 {
    static constexpr bool PERM = true, AFTER_DRAIN = false; static_assert(ACT == 0 || ACT == 1, "EpiBf16: ACT is 0 (none) or 1 (gelu_pk)");
    bf16_t* O; int ldc; const float* bias; int split_cols; size_t split_stride; float scale0;
    __device__ __forceinline__ void operator()(const f32x4 (&acc)[2][2][4][2], const Unit& u, int wr, int wc, int fr, int fq) const {
        const int row0 = u.pm * BM + wr * 64 + fr; int colt = u.pn * BM; bf16_t* base = O;
        float sc = 1.f; if (split_cols) { const int t = colt / split_cols; base += (size_t)t * split_stride; colt -= t * split_cols; if (t == 0) sc = scale0; }
        const int col0 = colt + wc * 32 + 8 * fq, bcol0 = u.pn * BM + wc * 32 + 8 * fq;
        f32x4 bv[2][2];
#pragma unroll
        for (int bj = 0; bj < 2; ++bj)
#pragma unroll
            for (int n = 0; n < 2; ++n) bv[bj][n] = bias ? *(const f32x4*)(bias + bcol0 + bj * HALF + 4 * n) : (f32x4){0.f, 0.f, 0.f, 0.f};
#pragma unroll
        for (int ai = 0; ai < 2; ++ai)
#pragma unroll
            for (int m = 0; m < 4; ++m) { bf16_t* rowp = base + (size_t)(row0 + ai * HALF + m * 16) * ldc + col0;
#pragma unroll
                for (int bj = 0; bj < 2; ++bj) { f32x4 v0 = acc[ai][bj][m][0] + bv[bj][0], v1 = acc[ai][bj][m][1] + bv[bj][1];
                    if (ACT == 1) { f32x2 a = gelu_pk((f32x2){v0[0], v0[1]}), b = gelu_pk((f32x2){v0[2], v0[3]}), c = gelu_pk((f32x2){v1[0], v1[1]}), d = gelu_pk((f32x2){v1[2], v1[3]});
                        v0 = (f32x4){a.x, a.y, b.x, b.y}; v1 = (f32x4){c.x, c.y, d.x, d.y}; }
                    v0 = v0 * sc; v1 = v1 * sc; u32x4 w; w.x = cvt_pk_bf16(v0[0], v0[1]); w.y = cvt_pk_bf16(v0[2], v0[3]); w.z = cvt_pk_bf16(v1[0], v1[1]); w.w = cvt_pk_bf16(v1[2], v1[3]);
                    *(u32x4*)(rowp + bj * HALF) = w; } }
    }
};

__device__ __forceinline__ float dpp_shr(float cur, float prevblk, int n  ) {
    const int c = __builtin_bit_cast(int, cur), pb = __builtin_bit_cast(int, prevblk);
    int t;
    if (n == 1) { t = __builtin_amdgcn_update_dpp(0, pb, 0x121, 0xf, 0xf, false); t = __builtin_amdgcn_update_dpp(t, c, 0x111, 0xf, 0xf, false); }
    else        { t = __builtin_amdgcn_update_dpp(0, pb, 0x122, 0xf, 0xf, false); t = __builtin_amdgcn_update_dpp(t, c, 0x112, 0xf, 0xf, false); }
    return __builtin_bit_cast(float, t);
}
struct EpiGlu {
    static constexpr bool PERM = true, AFTER_DRAIN = false;
    bf16_t* GV; bf16_t* U; const float* cw; const float* cb;
    __device__ __forceinline__ void operator()(const f32x4 (&acc)[2][2][4][2], const Unit& u, int wr, int wc, int fr, int fq) const {
        const int row0 = u.pm * BM + wr * 64 + fr, x0 = wc * 32 + 8 * fq, ch0 = u.pn * HALF + x0;
        if (u.pm * BM >= MP) {
#pragma unroll
            for (int m = 0; m < 4; ++m) {
                bf16_t* gp = GV + (size_t)(row0 + m * 16) * 5632 + u.pn * BM + x0;
                u32x4 wg, wv;
                wg.x = cvt_pk_bf16(acc[0][0][m][0][0], acc[0][0][m][0][1]); wg.y = cvt_pk_bf16(acc[0][0][m][0][2], acc[0][0][m][0][3]); wg.z = cvt_pk_bf16(acc[0][0][m][1][0], acc[0][0][m][1][1]); wg.w = cvt_pk_bf16(acc[0][0][m][1][2], acc[0][0][m][1][3]);
                wv.x = cvt_pk_bf16(acc[0][1][m][0][0], acc[0][1][m][0][1]); wv.y = cvt_pk_bf16(acc[0][1][m][0][2], acc[0][1][m][0][3]); wv.z = cvt_pk_bf16(acc[0][1][m][1][0], acc[0][1][m][1][1]); wv.w = cvt_pk_bf16(acc[0][1][m][1][2], acc[0][1][m][1][3]);
                *(u32x4*)gp = wg; *(u32x4*)(gp + HALF) = wv;
            }
            return;
        }
        f32x4 w0[2], w1[2], w2[2], bb[2];
#pragma unroll
        for (int n = 0; n < 2; ++n) { w0[n] = *(const f32x4*)(cw + ch0 + 4 * n); w1[n] = *(const f32x4*)(cw + 2816 + ch0 + 4 * n); w2[n] = *(const f32x4*)(cw + 5632 + ch0 + 4 * n); bb[n] = *(const f32x4*)(cb + ch0 + 4 * n); }
#pragma unroll
        for (int ai = 0; ai < 2; ++ai)
#pragma unroll
            for (int m = 0; m < 4; ++m) {
                const int row = row0 + ai * HALF + m * 16;
                bf16_t* gp = GV + (size_t)row * 5632 + u.pn * BM + x0;
                u32x4 wu;
#pragma unroll
                for (int n = 0; n < 2; ++n) {
                    const f32x4 g = acc[ai][0][m][n], v = acc[ai][1][m][n], pv = acc[ai][0][m > 0 ? m - 1 : 0][n];
                    float o[4];
#pragma unroll
                    for (int e = 0; e < 4; ++e) {
                        const float g1 = dpp_shr(g[e], pv[e], 1), g2 = dpp_shr(g[e], pv[e], 2);
                        const float a = bb[n][e] + w0[n][e] * g2 + w1[n][e] * g1 + w2[n][e] * g[e];
                        o[e] = a * __builtin_amdgcn_rcpf(1.f + __expf(-a)) * v[e];
                    }
                    if (n == 0) { wu.x = cvt_pk_bf16(o[0], o[1]); wu.y = cvt_pk_bf16(o[2], o[3]); } else { wu.z = cvt_pk_bf16(o[0], o[1]); wu.w = cvt_pk_bf16(o[2], o[3]); }
                }
                if (m > 0 || fr >= 2) *(u32x4*)(U + (size_t)row * 2816 + ch0) = wu;
                u32x4 wg, wv;
                wg.x = cvt_pk_bf16(acc[ai][0][m][0][0], acc[ai][0][m][0][1]); wg.y = cvt_pk_bf16(acc[ai][0][m][0][2], acc[ai][0][m][0][3]); wg.z = cvt_pk_bf16(acc[ai][0][m][1][0], acc[ai][0][m][1][1]); wg.w = cvt_pk_bf16(acc[ai][0][m][1][2], acc[ai][0][m][1][3]);
                wv.x = cvt_pk_bf16(acc[ai][1][m][0][0], acc[ai][1][m][0][1]); wv.y = cvt_pk_bf16(acc[ai][1][m][0][2], acc[ai][1][m][0][3]); wv.z = cvt_pk_bf16(acc[ai][1][m][1][0], acc[ai][1][m][1][1]); wv.w = cvt_pk_bf16(acc[ai][1][m][1][2], acc[ai][1][m][1][3]);
                if ((m == 0 && fr < 2) || (m == 3 && fr >= 14)) { *(u32x4*)gp = wg; *(u32x4*)(gp + HALF) = wv; }
            }
    }
};

struct EpiResGate {
    static constexpr bool PERM = true, AFTER_DRAIN = false;
    float* Xf; const float* Xinf; bf16_t* Xb; const float* gate; int src_f32, dst_f32, seq_shift, gate_ld;
    __device__ __forceinline__ void operator()(const f32x4 (&acc)[2][2][4][2], const Unit& u, int wr, int wc, int fr, int fq) const {
        const int col0 = u.pn * BM + wc * 32 + 8 * fq;
#pragma unroll
        for (int ai = 0; ai < 2; ++ai)
#pragma unroll
            for (int m = 0; m < 4; ++m) {
                const int row = u.pm * BM + ai * HALF + wr * 64 + m * 16 + fr;
                const float* gp = gate + (size_t)(row >> seq_shift) * gate_ld + col0; const size_t off = (size_t)row * 1024 + col0;
#pragma unroll
                for (int bj = 0; bj < 2; ++bj) {
                    const f32x4 g0 = *(const f32x4*)(gp + bj * HALF), g1 = *(const f32x4*)(gp + bj * HALF + 4);
                    f32x4 x0, x1;
                    if (src_f32) { x0 = *(const f32x4*)(Xinf + off + bj * HALF); x1 = *(const f32x4*)(Xinf + off + bj * HALF + 4); }
                    else { const u32x4 w = *(const u32x4*)(Xb + off + bj * HALF);
                        x0 = (f32x4){__builtin_bit_cast(float, w.x << 16), __builtin_bit_cast(float, w.x & 0xffff0000u), __builtin_bit_cast(float, w.y << 16), __builtin_bit_cast(float, w.y & 0xffff0000u)};
                        x1 = (f32x4){__builtin_bit_cast(float, w.z << 16), __builtin_bit_cast(float, w.z & 0xffff0000u), __builtin_bit_cast(float, w.w << 16), __builtin_bit_cast(float, w.w & 0xffff0000u)}; }
                    x0 = x0 + g0 * acc[ai][bj][m][0]; x1 = x1 + g1 * acc[ai][bj][m][1];
                    if (dst_f32) { *(f32x4*)(Xf + off + bj * HALF) = x0; *(f32x4*)(Xf + off + bj * HALF + 4) = x1; }
                    else { u32x4 w; w.x = cvt_pk_bf16(x0[0], x0[1]); w.y = cvt_pk_bf16(x0[2], x0[3]); w.z = cvt_pk_bf16(x1[0], x1[1]); w.w = cvt_pk_bf16(x1[2], x1[3]); *(u32x4*)(Xb + off + bj * HALF) = w; }
                }
            }
    }
};
template <class Epi, class Sched, bool ALIGN_EPI = false, bool SP2 = false>
__device__ __forceinline__ void gemm_phase(PG8_LAS unsigned char* lds, const Gemm g, const Sched& S, const Epi& E, int tid_in) {
    int tid_ = tid_in; asm volatile("" : "+v"(tid_));
    const int tid = tid_, wid = __builtin_amdgcn_readfirstlane(tid >> 6), lane = tid & 63, wr = wid >> 2, wc = wid & 3, fr = lane & 15, fq = lane >> 4;
    const int K = g.K, nt = K / BK;
    unsigned voffA[2], voffB[2];
#pragma unroll
    for (int i = 0; i < 2; ++i) { int R, C; stage_rc(tid * 16 + i * 8192, R, C); const int Rb = Epi::PERM ? ((R & ~31) + perm32(R & 31)) : R;
        voffA[i] = (unsigned)(R * K + C) * 2u; voffB[i] = (unsigned)(Rb * K + C) * 2u; }
    const size_t kstep = (size_t)(BK * 2);
    const size_t hstep = (size_t)HALF * K * 2;
    const size_t tstep = 2 * hstep;
    const unsigned ldsw = (unsigned)wid * 1024u;
    const int aoff = lds_byte(wr * 64 + fr, fq * 8), boff = lds_byte(wc * 32 + fr, fq * 8);
#define PG8_SA(b, h) (((b) * 2 + (h)) * HTB)
#define PG8_SB(b, h) ((4 + (b) * 2 + (h)) * HTB)
#define PG8_STAGE(bufoff, gbase, voff) do { _Pragma("unroll") for (int _i = 0; _i < 2; ++_i) \
        __builtin_amdgcn_global_load_lds((const unsigned*)((const char*)(gbase) + (voff)[_i]), (PG8_LAS unsigned*)(lds + (bufoff) + ldsw + _i * 8192), 16, 0, 0); } while (0)
#define PG8_LDA(dst, b, h) do { _Pragma("unroll") for (int m = 0; m < 4; ++m) _Pragma("unroll") for (int k = 0; k < 2; ++k) dst[m][k] = *(const PG8_LAS bf16x8*)(lds + PG8_SA(b, h) + aoff + m * 2048 + k * 1024); } while (0)
#define PG8_LDB(dst, b, h) do { _Pragma("unroll") for (int n = 0; n < 2; ++n) _Pragma("unroll") for (int k = 0; k < 2; ++k) dst[n][k] = *(const PG8_LAS bf16x8*)(lds + PG8_SB(b, h) + boff + n * 2048 + k * 1024); } while (0)
#define PG8_MMA(ai, bj, At, Bt) do { __builtin_amdgcn_s_setprio(1); _Pragma("unroll") for (int m = 0; m < 4; ++m) _Pragma("unroll") for (int n = 0; n < 2; ++n) _Pragma("unroll") for (int k = 0; k < 2; ++k) \
        acc[ai][bj][m][n] = __builtin_amdgcn_mfma_f32_16x16x32_bf16(Bt[n][k], At[m][k], acc[ai][bj][m][n], 0, 0, 0); __builtin_amdgcn_s_setprio(0); } while (0)
#define PG8_WAIT_V(n) asm volatile("s_waitcnt vmcnt(" #n ")" ::: "memory")
#define PG8_WAIT_L(n) asm volatile("s_waitcnt lgkmcnt(" #n ")" ::: "memory")
#define PG8_BAR __builtin_amdgcn_s_barrier()
#define PG8_SCHED __builtin_amdgcn_sched_barrier(0)
    Unit cur, nxt; int ui = 0;
    if (!S.next(0, cur)) return;
    f32x4 acc[2][2][4][2];
#pragma unroll
    for (int a = 0; a < 2; ++a)
#pragma unroll
        for (int b = 0; b < 2; ++b)
#pragma unroll
            for (int m = 0; m < 4; ++m)
#pragma unroll
                for (int n = 0; n < 2; ++n) acc[a][b][m][n] = (f32x4){0.f, 0.f, 0.f, 0.f};
    bf16x8 At[4][2], B0[2][2], B1[2][2];
    const char* cA = (const char*)g.A + (size_t)cur.pm * tstep; const char* cB = (const char*)g.Bt + (size_t)cur.pn * tstep;
    S.a_ready(cur);
    if constexpr (SP2) {
        PG8_STAGE(PG8_SB(0, 0), cB, voffB); PG8_STAGE(PG8_SB(0, 1), cB + hstep, voffB); PG8_STAGE(PG8_SA(0, 0), cA, voffA); PG8_STAGE(PG8_SA(0, 1), cA + hstep, voffA);
        if (wr == 1) PG8_BAR;
        PG8_WAIT_V(2); PG8_BAR;
        PG8_STAGE(PG8_SB(1, 0), cB + kstep, voffB); PG8_STAGE(PG8_SA(1, 0), cA + kstep, voffA); PG8_STAGE(PG8_SB(1, 1), cB + hstep + kstep, voffB);
        PG8_WAIT_V(6); PG8_BAR;
    } else {
        PG8_STAGE(PG8_SB(0, 0), cB, voffB); PG8_STAGE(PG8_SA(0, 0), cA, voffA); PG8_STAGE(PG8_SB(0, 1), cB + hstep, voffB); PG8_STAGE(PG8_SA(0, 1), cA + hstep, voffA);
        if (wr == 1) PG8_BAR;
        PG8_WAIT_V(4); PG8_BAR;
        PG8_STAGE(PG8_SB(1, 0), cB + kstep, voffB); PG8_STAGE(PG8_SA(1, 0), cA + kstep, voffA); PG8_STAGE(PG8_SB(1, 1), cB + hstep + kstep, voffB);
        PG8_WAIT_V(6); PG8_BAR;
    }
    for (;;) {
        const bool has_next = S.next(ui + 1, nxt);
        const char* nA = has_next ? (const char*)g.A + (size_t)nxt.pm * tstep : cA; const char* nB = has_next ? (const char*)g.Bt + (size_t)nxt.pn * tstep : cB;
        for (int t = 0; t < nt; t += 2) {
            const bool last = (t == nt - 2);
            const char* a1 = cA + (size_t)(t + 1) * kstep;
            const char* a2 = last ? nA : cA + (size_t)(t + 2) * kstep; const char* b2 = last ? nB : cB + (size_t)(t + 2) * kstep;
            const char* a3 = a2 + kstep; const char* b3 = b2 + kstep;
            if (last && has_next) S.a_ready(nxt);
            if constexpr (SP2) {
            PG8_LDB(B0, 0, 0); PG8_LDB(B1, 0, 1); PG8_SCHED; PG8_LDA(At, 0, 0); PG8_STAGE(PG8_SA(1, 1), a1 + hstep, voffA);
            PG8_WAIT_V(8); PG8_WAIT_L(0); PG8_BAR; PG8_MMA(0, 0, At, B0); PG8_MMA(0, 1, At, B1); PG8_BAR; PG8_SCHED;
            PG8_LDA(At, 0, 1); PG8_STAGE(PG8_SB(0, 0), b2, voffB); PG8_STAGE(PG8_SB(0, 1), b2 + hstep, voffB); PG8_STAGE(PG8_SA(0, 0), a2, voffA);
            PG8_WAIT_V(8); PG8_WAIT_L(0); PG8_BAR; PG8_MMA(1, 0, At, B0); PG8_MMA(1, 1, At, B1); PG8_BAR; PG8_SCHED;
            PG8_LDB(B0, 1, 0); PG8_LDB(B1, 1, 1); PG8_SCHED; PG8_LDA(At, 1, 0); PG8_STAGE(PG8_SA(0, 1), a2 + hstep, voffA);
            PG8_WAIT_V(8); PG8_WAIT_L(0); PG8_BAR; PG8_MMA(0, 0, At, B0); PG8_MMA(0, 1, At, B1); PG8_BAR; PG8_SCHED;
            PG8_LDA(At, 1, 1); PG8_STAGE(PG8_SB(1, 0), b3, voffB); PG8_STAGE(PG8_SB(1, 1), b3 + hstep, voffB); PG8_STAGE(PG8_SA(1, 0), a3, voffA);
            PG8_WAIT_V(8); PG8_WAIT_L(0); PG8_BAR; PG8_MMA(1, 0, At, B0); PG8_MMA(1, 1, At, B1); PG8_BAR; PG8_SCHED;
            } else {
            PG8_LDB(B0, 0, 0); PG8_SCHED; PG8_LDA(At, 0, 0); PG8_STAGE(PG8_SA(1, 1), a1 + hstep, voffA);
            PG8_WAIT_L(8); PG8_BAR; PG8_WAIT_L(0); PG8_MMA(0, 0, At, B0); PG8_BAR; PG8_SCHED;
            PG8_LDB(B1, 0, 1); PG8_STAGE(PG8_SB(0, 0), b2, voffB);
            PG8_BAR; PG8_WAIT_L(0); PG8_MMA(0, 1, At, B1); PG8_BAR;
            PG8_LDA(At, 0, 1); PG8_STAGE(PG8_SA(0, 0), a2, voffA);
            PG8_BAR; PG8_WAIT_L(0); PG8_MMA(1, 0, At, B0); PG8_BAR; PG8_SCHED;
            PG8_STAGE(PG8_SB(0, 1), b2 + hstep, voffB);
            PG8_WAIT_V(6); PG8_BAR; PG8_MMA(1, 1, At, B1); PG8_BAR;
            PG8_LDB(B0, 1, 0); PG8_SCHED; PG8_LDA(At, 1, 0); PG8_STAGE(PG8_SA(0, 1), a2 + hstep, voffA);
            PG8_WAIT_L(8); PG8_BAR; PG8_WAIT_L(0); PG8_MMA(0, 0, At, B0); PG8_BAR; PG8_SCHED;
            PG8_LDB(B1, 1, 1); PG8_STAGE(PG8_SB(1, 0), b3, voffB);
            PG8_BAR; PG8_WAIT_L(0); PG8_MMA(0, 1, At, B1); PG8_BAR;
            PG8_LDA(At, 1, 1); PG8_STAGE(PG8_SA(1, 0), a3, voffA);
            PG8_BAR; PG8_WAIT_L(0); PG8_MMA(1, 0, At, B0); PG8_BAR; PG8_SCHED;
            PG8_STAGE(PG8_SB(1, 1), b3 + hstep, voffB);
            PG8_WAIT_V(6); PG8_BAR; PG8_MMA(1, 1, At, B1); PG8_BAR;
            }
        }
        if constexpr (ALIGN_EPI) { if (wr == 0) PG8_BAR; }
        if constexpr (!Epi::AFTER_DRAIN) { E(acc, cur, wr, wc, fr, fq); S.done(cur); }
        if (!has_next) break;
#pragma unroll
        for (int a = 0; a < 2; ++a)
#pragma unroll
            for (int b = 0; b < 2; ++b)
#pragma unroll
                for (int m = 0; m < 4; ++m)
#pragma unroll
                    for (int n = 0; n < 2; ++n) acc[a][b][m][n] = (f32x4){0.f, 0.f, 0.f, 0.f};
        cur = nxt; cA = nA; cB = nB; ++ui;
        if constexpr (ALIGN_EPI) { if (wr == 1) PG8_BAR; }
    }
    PG8_WAIT_V(0);
    if constexpr (!ALIGN_EPI) { if (wr == 0) PG8_BAR; }
    PG8_BAR;
    if constexpr (Epi::AFTER_DRAIN) { E.fused(acc, cur, wr, wc, fr, fq, lds, wid, lane); S.done(cur); }
#undef PG8_SA
#undef PG8_SB
#undef PG8_STAGE
#undef PG8_LDA
#undef PG8_LDB
#undef PG8_MMA
#undef PG8_WAIT_V
#undef PG8_WAIT_L
#undef PG8_BAR
#undef PG8_SCHED
}
}

struct Ctx { int tid, bid, nb; size_t z; };
__device__ __forceinline__ int lane_id() { return (int)__builtin_amdgcn_mbcnt_hi(~0u, __builtin_amdgcn_mbcnt_lo(~0u, 0u)); }
__device__ __forceinline__ Ctx mkctx(const Params& p, int first = 0, int count = 0) { Ctx c; c.tid = (p.wave << 6) | lane_id(); c.bid = blockIdx.x; c.nb = gridDim.x; c.z = 0; asm volatile("" : "+v"(c.tid), "+s"(c.bid), "+s"(c.nb), "+s"(c.z));
    if (first > 0 || count > 0) { const int hi = count > 0 ? first + count : c.nb; c.bid = (c.bid >= first && c.bid < hi) ? c.bid - first : (1 << 20); c.nb = hi - first; } return c; }
__device__ __forceinline__ int flip_bid(const Ctx& c) { return c.bid < c.nb ? c.nb - 1 - c.bid : (1 << 20); }
#define PIN(i) (p.in[i] + z)
__device__ __forceinline__ void stage_init(const Params& p) {
    const Ctx cx = mkctx(p); const size_t z = cx.z;
    const unsigned gt = (unsigned)cx.bid * NTHREADS + cx.tid, GT = (unsigned)cx.nb * NTHREADS;
    typedef float f4 __attribute__((ext_vector_type(4)));
    f4* X = (f4*)(p.out + z); const f4* xp = (const f4*)PIN(I_XP); const f4* xs = (const f4*)PIN(I_XS);
    (void)xp;
    for (unsigned i = gt; i < (unsigned)NS * (D / 4); i += GT) X[(unsigned)MP * (D / 4) + i] = xs[i];
}
__device__ __forceinline__ void stage_mod(const Params& p, unsigned char* lds, int l_lo, int l_hi, int first = 0) {
    const Ctx cx = mkctx(p, first); const size_t z = cx.z;
    float* MOD = (float*)(p.ws + z + WS_MOD);
    bf16_t* SCs = (bf16_t*)lds;
    bf16_t* WTs = (bf16_t*)(lds + 39168);
    const int lane = cx.tid & 63, wave = __builtin_amdgcn_readfirstlane(cx.tid >> 6), r = lane & 15, q = lane >> 4;
    const int lk = cx.tid >> 4, lj = (cx.tid & 15) * 8;
    for (int item = cx.bid; item < (l_hi - l_lo) * 48; item += cx.nb) {
        const int l = l_lo + item / 48, j0 = (item % 48) * 128;
        const float* w = PIN(I_ADAW) + (size_t)l * D * 6144 + j0 + lj;
        f32x4 acc[9];
#pragma unroll
        for (int i = 0; i < 9; ++i) acc[i] = (f32x4){0.f, 0.f, 0.f, 0.f};
        f32x4 n0 = *(const f32x4*)(w + (size_t)lk * 6144), n1 = *(const f32x4*)(w + (size_t)lk * 6144 + 4);
        __syncthreads();
#pragma unroll
        for (int e = 0; e < 4; ++e) { WTs[(lj + e) * 40 + lk] = f2bf(n0[e]); WTs[(lj + 4 + e) * 40 + lk] = f2bf(n1[e]); }
#pragma unroll 1
        for (int t = 0; t < 32; ++t) {
            if ((t & 3) == 0) {
                __syncthreads();
                for (int i = cx.tid; i < 144 * 16; i += NTHREADS) { const int sidx = i >> 4, k8 = (i & 15) * 8; bf16x8 o;
                    if (sidx < NSEQ) { const float* c = (sidx < NP ? PIN(I_CP) + (size_t)sidx * D : PIN(I_CS) + (size_t)(sidx - NP) * D) + (t >> 2) * 128 + k8;
                        const f32x4 c0 = *(const f32x4*)c, c1 = *(const f32x4*)(c + 4);
#pragma unroll
                        for (int e = 0; e < 4; ++e) { o[e] = (short)f2bf(silu_f(c0[e])); o[4 + e] = (short)f2bf(silu_f(c1[e])); } }
                    else o = (bf16x8){0, 0, 0, 0, 0, 0, 0, 0};
                    *(bf16x8*)(SCs + sidx * LD2 + k8) = o; }
            }
            const int tn = t + 1 < 32 ? t + 1 : 31;
            n0 = *(const f32x4*)(w + (size_t)(tn * 32 + lk) * 6144); n1 = *(const f32x4*)(w + (size_t)(tn * 32 + lk) * 6144 + 4);
            __syncthreads();
            {
                const bf16x8 a = *(const bf16x8*)(WTs + (t & 1) * 5120 + (16 * wave + r) * 40 + 8 * q);
#pragma unroll
                for (int st = 0; st < 9; ++st) {
                    const bf16x8 b = *(const bf16x8*)(SCs + (16 * st + r) * LD2 + 32 * (t & 3) + 8 * q);
                    acc[st] = __builtin_amdgcn_mfma_f32_16x16x32_bf16(a, b, acc[st], 0, 0, 0);
                }
            }
            bf16_t* wn = WTs + ((t + 1) & 1) * 5120;
#pragma unroll
            for (int e = 0; e < 4; ++e) { wn[(lj + e) * 40 + lk] = f2bf(n0[e]); wn[(lj + 4 + e) * 40 + lk] = f2bf(n1[e]); }
        }
        const int j = j0 + 16 * wave + 4 * q;
        const f32x4 b0 = *(const f32x4*)(PIN(I_ADAB) + (size_t)l * 6144 + j);
#pragma unroll
        for (int st = 0; st < 9; ++st) { const int sidx = 16 * st + r; if (sidx < NSEQ) *(f32x4*)(MOD + ((size_t)l * NSEQ + sidx) * 6144 + j) = acc[st] + b0; }
    }
}

__device__ __forceinline__ void stage_norm(const Params& p, int l, int which, float* wl, bool prompt_f32) {
    const Ctx cx = mkctx(p); const size_t z = cx.z;
    const int lane = cx.tid & 63, gw = cx.bid * NWAVES + (cx.tid >> 6), GW = cx.nb * NWAVES;
    const float* X = (l == 0 && which == 0) ? PIN(I_XP) : (const float*)(p.out + z);
    const float* XS = (const float*)(p.out + z);
    bf16_t* H = (bf16_t*)(p.ws + z + WS_H);
    const float* MOD = (const float*)(p.ws + z + WS_MOD);
    const float* g = PIN(which ? I_NFFNG : I_NMIXG) + (size_t)l * D;
    f32x4 gg[4];
#pragma unroll
    for (int j = 0; j < 4; ++j) gg[j] = *(const f32x4*)(g + 4 * lane + 256 * j);
    f32x4 v[2][4], nv[2][4];
    const int rbeg = (prompt_f32 ? 0 : MP) + 2 * gw;
    if (rbeg < R) {
#pragma unroll
        for (int k = 0; k < 2; ++k)
#pragma unroll
            for (int j = 0; j < 4; ++j) v[k][j] = *(const f32x4*)((rbeg + k < MP ? X : XS) + (size_t)(rbeg + k) * D + 4 * lane + 256 * j);
    }
    for (int row0 = rbeg; row0 < R; row0 += 2 * GW) {
        const int rnext = row0 + 2 * GW < R ? row0 + 2 * GW : row0;
#pragma unroll
        for (int k = 0; k < 2; ++k)
#pragma unroll
            for (int j = 0; j < 4; ++j) nv[k][j] = *(const f32x4*)((rnext + k < MP ? X : XS) + (size_t)(rnext + k) * D + 4 * lane + 256 * j);
#pragma unroll
        for (int k = 0; k < 2; ++k) {
            const int row = row0 + k;
            const float* md = MOD + ((size_t)l * NSEQ + seq_of_row(row)) * 6144 + which * 3072 + 4 * lane;
            f32x4 sh[4], sc[4];
#pragma unroll
            for (int j = 0; j < 4; ++j) { sh[j] = *(const f32x4*)(md + 256 * j); sc[j] = *(const f32x4*)(md + 1024 + 256 * j); }
            float ss = 0.f;
#pragma unroll
            for (int j = 0; j < 4; ++j) ss += (v[k][j][0] * v[k][j][0] + v[k][j][1] * v[k][j][1]) + (v[k][j][2] * v[k][j][2] + v[k][j][3] * v[k][j][3]);
            ss = wave_sum(ss);
            const float rstd = rsqrtf(ss * (1.f / D) + NORM_EPS);
#pragma unroll
            for (int j = 0; j < 4; ++j) { v[k][j] = v[k][j] * rstd * gg[j] * (1.f + sc[j]) + sh[j];
                *(bf16x4*)(H + (size_t)row * D + 4 * lane + 256 * j) = (bf16x4){(short)f2bf(v[k][j][0]), (short)f2bf(v[k][j][1]), (short)f2bf(v[k][j][2]), (short)f2bf(v[k][j][3])}; }
        }
#pragma unroll
        for (int k = 0; k < 2; ++k)
#pragma unroll
            for (int j = 0; j < 4; ++j) v[k][j] = nv[k][j];
    }
}

__device__ __forceinline__ void stage_norm_b(const Params& p, int l, int which) {
    const Ctx cx = mkctx(p); const size_t z = cx.z;
    const int lane = cx.tid & 63, gw = cx.bid * NWAVES + (cx.tid >> 6), GW = cx.nb * NWAVES;
    const bf16_t* XB = (const bf16_t*)(p.ws + z + WS_XB);
    bf16_t* H = (bf16_t*)(p.ws + z + WS_H);
    const float* MOD = (const float*)(p.ws + z + WS_MOD);
    const float* g = PIN(which ? I_NFFNG : I_NMIXG) + (size_t)l * D;
    f32x4 gg[2][2];
#pragma unroll
    for (int j = 0; j < 2; ++j) { gg[j][0] = *(const f32x4*)(g + 8 * lane + 512 * j); gg[j][1] = *(const f32x4*)(g + 8 * lane + 512 * j + 4); }
    typedef pg8::u32x4 u32x4;
    u32x4 v[4][2], nv[4][2];
    if (4 * gw < MP) {
#pragma unroll
        for (int k = 0; k < 4; ++k)
#pragma unroll
            for (int j = 0; j < 2; ++j) v[k][j] = *(const u32x4*)(XB + (size_t)(4 * gw + k) * D + 8 * lane + 512 * j);
    }
    for (int row0 = 4 * gw; row0 < MP; row0 += 4 * GW) {
        const int rnext = row0 + 4 * GW < MP ? row0 + 4 * GW : row0;
#pragma unroll
        for (int k = 0; k < 4; ++k)
#pragma unroll
            for (int j = 0; j < 2; ++j) nv[k][j] = *(const u32x4*)(XB + (size_t)(rnext + k) * D + 8 * lane + 512 * j);
        const float* md = MOD + ((size_t)l * NSEQ + (row0 >> 13)) * 6144 + which * 3072 + 8 * lane;
        f32x4 sh[2][2], sc[2][2];
#pragma unroll
        for (int j = 0; j < 2; ++j)
#pragma unroll
            for (int h = 0; h < 2; ++h) { sh[j][h] = *(const f32x4*)(md + 512 * j + 4 * h); sc[j][h] = *(const f32x4*)(md + 1024 + 512 * j + 4 * h) + 1.f; sc[j][h] = sc[j][h] * gg[j][h]; }
#pragma unroll
        for (int k = 0; k < 4; ++k) {
            const int row = row0 + k;
            f32x4 x[2][2]; float ss = 0.f;
#pragma unroll
            for (int j = 0; j < 2; ++j) { const u32x4 w = v[k][j];
                x[j][0] = (f32x4){__builtin_bit_cast(float, w.x << 16), __builtin_bit_cast(float, w.x & 0xffff0000u), __builtin_bit_cast(float, w.y << 16), __builtin_bit_cast(float, w.y & 0xffff0000u)};
                x[j][1] = (f32x4){__builtin_bit_cast(float, w.z << 16), __builtin_bit_cast(float, w.z & 0xffff0000u), __builtin_bit_cast(float, w.w << 16), __builtin_bit_cast(float, w.w & 0xffff0000u)};
#pragma unroll
                for (int h = 0; h < 2; ++h) ss += (x[j][h][0] * x[j][h][0] + x[j][h][1] * x[j][h][1]) + (x[j][h][2] * x[j][h][2] + x[j][h][3] * x[j][h][3]); }
            ss = wave_sum(ss);
            const float rstd = rsqrtf(ss * (1.f / D) + NORM_EPS);
#pragma unroll
            for (int j = 0; j < 2; ++j) { const f32x4 o0 = x[j][0] * rstd * sc[j][0] + sh[j][0], o1 = x[j][1] * rstd * sc[j][1] + sh[j][1];
                u32x4 w; w.x = cvtpk(o0[0], o0[1]); w.y = cvtpk(o0[2], o0[3]); w.z = cvtpk(o1[0], o1[1]); w.w = cvtpk(o1[2], o1[3]);
                *(u32x4*)(H + (size_t)row * D + 8 * lane + 512 * j) = w; }
        }
#pragma unroll
        for (int k = 0; k < 4; ++k)
#pragma unroll
            for (int j = 0; j < 2; ++j) v[k][j] = nv[k][j];
    }
}

__device__ __forceinline__ f32x4 ld4bf(const bf16_t* p) { const bf16x4 v = *(const bf16x4*)p; return (f32x4){bf2f((bf16_t)v[0]), bf2f((bf16_t)v[1]), bf2f((bf16_t)v[2]), bf2f((bf16_t)v[3])}; }
__device__ __forceinline__ void stage_rwprep(const Params& p, int l, float* lds) {
    const Ctx cx = mkctx(p); const size_t z = cx.z;
    const bf16_t* P = (const bf16_t*)(p.ws + z + WS_P);
    bf16_t* RWH = (bf16_t*)(p.ws + z + WS_RW); float* RWD = (float*)(p.ws + z + WS_RWD);
    float* xs = lds; float* kk = lds + 1024;
    const int tid = cx.tid;
    const float* mu = PIN(I_MU) + (size_t)l * 1024;
    for (int row = MP + cx.bid; row < R; row += cx.nb) {
        const bool samp = row >= MP; const int n = samp ? row - MP : row >> 13, t = samp ? 0 : (row & (T - 1));
        __syncthreads();
        for (int c = tid; c < 1024; c += NTHREADS) {
            const float pa = bf2f(P[(size_t)row * PCOLS + c]);
            float prev;
            if (t > 0) prev = bf2f(P[(size_t)(row - 1) * PCOLS + c]);
            else prev = samp ? PIN(I_SHIFT)[((size_t)l * NS + n) * 1024 + c] : 0.f;
            float v = pa + (prev - pa) * mu[c];
            if (c >= 768 && c < 832) v = tanh_fast(v);
            if (c >= 896) v = sigmoid_f(v);
            xs[c] = v;
            if (samp) (p.out + z)[O_SSHIFT + ((size_t)l * NS + n) * 1024 + c] = pa;
            else if (t == T - 1) (p.out + z)[O_PSHIFT + ((size_t)l * NP + n) * 1024 + c] = pa;
        }
        __syncthreads();
        float av = 0.f, gv = 0.f, dec = 0.f, kraw = 0.f;
        if (tid < 256) {
            const int j = tid;
            float wl = PIN(I_W0)[(size_t)l * 256 + j], al = PIN(I_A0)[(size_t)l * 256 + j]; gv = 0.f;
            const bf16_t* W2T = (const bf16_t*)(p.ws + z + WS_LORA) + (size_t)l * 65536;
            bf16x8 fw[8], fa[8], fg[16];
#pragma unroll
            for (int c8 = 0; c8 < 8; ++c8) { fw[c8] = *(const bf16x8*)(W2T + j * 64 + c8 * 8); fa[c8] = *(const bf16x8*)(W2T + 16384 + j * 64 + c8 * 8); }
#pragma unroll
            for (int c8 = 0; c8 < 16; ++c8) fg[c8] = *(const bf16x8*)(W2T + 32768 + j * 128 + c8 * 8);
#pragma unroll
            for (int c8 = 0; c8 < 8; ++c8)
#pragma unroll
                for (int e = 0; e < 8; ++e) { wl += xs[768 + c8 * 8 + e] * bf2f((bf16_t)fw[c8][e]); al += xs[832 + c8 * 8 + e] * bf2f((bf16_t)fa[c8][e]); }
#pragma unroll
            for (int c8 = 0; c8 < 16; ++c8)
#pragma unroll
                for (int e = 0; e < 8; ++e) gv += xs[896 + c8 * 8 + e] * bf2f((bf16_t)fg[c8][e]);
            const float w_log = -softplus_fast(-wl) - 0.5f;
            dec = -__expf(w_log);
            av = sigmoid_f(al);
            kraw = xs[256 + j];
            kk[j] = kraw * PIN(I_KK)[(size_t)l * 256 + j];
        }
        __syncthreads();
        if (tid < 256) {
            const int j = tid, h0 = j & ~63;
            float s = 0.f;
#pragma unroll 4
            for (int i = 0; i < 64; ++i) s += kk[h0 + i] * kk[h0 + i];
            const float kkn = kk[j] / fmaxf(sqrtf(s), 1e-12f);
            const float kmod = kraw * (1.f + (av - 1.f) * PIN(I_KA)[(size_t)l * 256 + j]);
            bf16_t* rw = RWH + (size_t)row * 1536 + j;
            rw[0] = f2bf(xs[j]); rw[256] = f2bf(kmod); rw[512] = f2bf(xs[512 + j]); rw[768] = f2bf(-kkn); rw[1024] = f2bf(kkn * av); rw[1280] = f2bf(gv); RWD[(size_t)row * 256 + j] = dec;
        }
    }
}

__device__ __forceinline__ void stage_rwprep2(const Params& p, int l, unsigned char* lds) {
    const Ctx cx = mkctx(p); const size_t z = cx.z;
    const int tid = cx.tid, lane = tid & 63, wave = __builtin_amdgcn_readfirstlane(tid >> 6), r = lane & 15, q = lane >> 4;
    bf16_t* ACW = (bf16_t*)lds;
    bf16_t* ACA = (bf16_t*)(lds + 9216);
    bf16_t* ACG = (bf16_t*)(lds + 18432);
    const bf16_t* P = (const bf16_t*)(p.ws + z + WS_P);
    bf16_t* RWH = (bf16_t*)(p.ws + z + WS_RW); float* RWD = (float*)(p.ws + z + WS_RWD);
    const bf16_t* W2T = (const bf16_t*)(p.ws + z + WS_LORA) + (size_t)l * 65536; const bf16_t* A2T = W2T + 16384; const bf16_t* G2T = W2T + 32768;
    const float* mu = PIN(I_MU) + (size_t)l * 1024;
    for (int tile = cx.bid; tile < MP / 64; tile += cx.nb) {
        const int row0 = tile * 64;
#pragma unroll
        for (int it = 0; it < 4; ++it) {
            const int task = it * NTHREADS + tid, tok = task >> 5, ch = task & 31, c = 768 + ch * 8, row = row0 + tok;
            const bf16x8 pa = *(const bf16x8*)(P + (size_t)row * PCOLS + c);
            bf16x8 pv = {0, 0, 0, 0, 0, 0, 0, 0};
            if ((row & (T - 1)) != 0) pv = *(const bf16x8*)(P + (size_t)(row - 1) * PCOLS + c);
            bf16x8 o;
#pragma unroll
            for (int e = 0; e < 8; ++e) { const float a = bf2f((bf16_t)pa[e]), b = bf2f((bf16_t)pv[e]); float x = a + (b - a) * mu[c + e];
                x = ch < 8 ? tanh_fast(x) : (ch >= 16 ? sigmoid_f(x) : x); o[e] = (short)f2bf(x); }
            if (ch < 8) *(bf16x8*)(ACW + tok * LD + ch * 8) = o;
            else if (ch < 16) *(bf16x8*)(ACA + tok * LD + (ch - 8) * 8) = o;
            else *(bf16x8*)(ACG + tok * LD2 + (ch - 16) * 8) = o;
        }
        if ((row0 & (T - 1)) == T - 64) {
            const int n = row0 >> 13;
            for (int c = tid; c < 1024; c += NTHREADS) (p.out + z)[O_PSHIFT + ((size_t)l * NP + n) * 1024 + c] = bf2f(P[(size_t)(row0 + 63) * PCOLS + c]);
        }
        __syncthreads();
        {
            const int h = wave >> 1, th = wave & 1;
#pragma unroll 1
            for (int nt = 0; nt < 2; ++nt) {
                const int tb = 32 * th + 16 * nt, row = row0 + tb + r; const bool first = (row & (T - 1)) == 0;
                float kkv[4][4], avv[4][4]; float ssq = 0.f;
                bf16x4 pc[4][3], pp_[4][3];
#pragma unroll
                for (int mt = 0; mt < 4; ++mt) { const int j = h * 64 + 16 * mt + 4 * q; const bf16x4 zero4 = {0, 0, 0, 0};
#pragma unroll
                    for (int f = 0; f < 3; ++f) { pc[mt][f] = *(const bf16x4*)(P + (size_t)row * PCOLS + 256 * f + j); pp_[mt][f] = first ? zero4 : *(const bf16x4*)(P + (size_t)(row - 1) * PCOLS + 256 * f + j); } }
#pragma unroll
                for (int mt = 0; mt < 4; ++mt) {
                    const int j0 = h * 64 + 16 * mt, j = j0 + 4 * q;
                    f32x4 aw = {0.f, 0.f, 0.f, 0.f}, aa = {0.f, 0.f, 0.f, 0.f}, ag = {0.f, 0.f, 0.f, 0.f};
#pragma unroll
                    for (int s2 = 0; s2 < 2; ++s2) {
                        const bf16x8 fw = *(const bf16x8*)(W2T + (j0 + r) * 64 + 32 * s2 + 8 * q), fa = *(const bf16x8*)(A2T + (j0 + r) * 64 + 32 * s2 + 8 * q);
                        const bf16x8 bw = *(const bf16x8*)(ACW + (tb + r) * LD + 32 * s2 + 8 * q), ba = *(const bf16x8*)(ACA + (tb + r) * LD + 32 * s2 + 8 * q);
                        aw = __builtin_amdgcn_mfma_f32_16x16x32_bf16(fw, bw, aw, 0, 0, 0);
                        aa = __builtin_amdgcn_mfma_f32_16x16x32_bf16(fa, ba, aa, 0, 0, 0);
                    }
#pragma unroll
                    for (int s2 = 0; s2 < 4; ++s2) {
                        const bf16x8 fg = *(const bf16x8*)(G2T + (j0 + r) * 128 + 32 * s2 + 8 * q), bg = *(const bf16x8*)(ACG + (tb + r) * LD2 + 32 * s2 + 8 * q);
                        ag = __builtin_amdgcn_mfma_f32_16x16x32_bf16(fg, bg, ag, 0, 0, 0);
                    }
                    const bf16x4 par = pc[mt][0], pak = pc[mt][1], pav = pc[mt][2], pvr = pp_[mt][0], pvk = pp_[mt][1], pvv = pp_[mt][2];
                    const f32x4 mur = *(const f32x4*)(mu + j), muk = *(const f32x4*)(mu + 256 + j), muv = *(const f32x4*)(mu + 512 + j);
                    const f32x4 w0 = *(const f32x4*)(PIN(I_W0) + (size_t)l * 256 + j), a0 = *(const f32x4*)(PIN(I_A0) + (size_t)l * 256 + j);
                    const f32x4 kkw = *(const f32x4*)(PIN(I_KK) + (size_t)l * 256 + j), kaw = *(const f32x4*)(PIN(I_KA) + (size_t)l * 256 + j);
                    f32x4 fr_, fk_, fv_, fd_;
#pragma unroll
                    for (int e = 0; e < 4; ++e) {
                        const float ar = bf2f((bf16_t)par[e]), ak = bf2f((bf16_t)pak[e]), av_ = bf2f((bf16_t)pav[e]);
                        const float xr = ar + (bf2f((bf16_t)pvr[e]) - ar) * mur[e], xk = ak + (bf2f((bf16_t)pvk[e]) - ak) * muk[e], xv = av_ + (bf2f((bf16_t)pvv[e]) - av_) * muv[e];
                        const float w_log = -softplus_fast(-(w0[e] + aw[e])) - 0.5f;
                        const float av = sigmoid_f(a0[e] + aa[e]);
                        fd_[e] = -__expf(w_log);
                        fr_[e] = xr; fv_[e] = xv;
                        fk_[e] = xk * (1.f + (av - 1.f) * kaw[e]);
                        const float kv = xk * kkw[e]; kkv[mt][e] = kv; avv[mt][e] = av; ssq += kv * kv;
                    }
                    bf16_t* rw = RWH + (size_t)row * 1536 + j;
                    *(bf16x4*)rw = pack4(fr_); *(bf16x4*)(rw + 256) = pack4(fk_); *(bf16x4*)(rw + 512) = pack4(fv_); *(bf16x4*)(rw + 1280) = pack4(ag); *(f32x4*)(RWD + (size_t)row * 256 + j) = fd_;
                }
                ssq += __shfl_xor(ssq, 16); ssq += __shfl_xor(ssq, 32);
                const float rn = 1.f / fmaxf(sqrtf(ssq), 1e-12f);
#pragma unroll
                for (int mt = 0; mt < 4; ++mt) {
                    bf16_t* rw = RWH + (size_t)row * 1536 + h * 64 + 16 * mt + 4 * q;
                    f32x4 fa_, fb_;
#pragma unroll
                    for (int e = 0; e < 4; ++e) { const float kn = kkv[mt][e] * rn; fa_[e] = -kn; fb_[e] = kn * avv[mt][e]; }
                    *(bf16x4*)(rw + 768) = pack4(fa_); *(bf16x4*)(rw + 1024) = pack4(fb_);
                }
            }
        }
        __syncthreads();
    }
}

#define WAVE_LDS_SYNC() do { asm volatile("s_waitcnt lgkmcnt(0)" ::: "memory"); __builtin_amdgcn_wave_barrier(); } while (0)
__device__ __forceinline__ void stage_rwscan(const Params& p, int l, float* lds, int first = 0) {
    const Ctx cx = mkctx(p, first); const size_t z = cx.z;
    const int lane = cx.tid & 63, wave = cx.tid >> 6;
    const bf16_t* RWH = (const bf16_t*)(p.ws + z + WS_RW); const float* RWD = (const float*)(p.ws + z + WS_RWD);
    bf16_t* Y = (bf16_t*)(p.ws + z + WS_YCAT);
    float* wl = lds + wave * 512;
    for (int u = NP * 4 + cx.bid + cx.nb * wave; u < NSEQ * 4; u += cx.nb * NWAVES) {
        const int s = u >> 2, h = u & 3; const bool samp = s >= NP; const int n = samp ? s - NP : s;
        const int row0 = samp ? MP + n : n * T, nt = samp ? 1 : T;
        float S[64];
        if (samp) { const float* st = PIN(I_WKV) + ((((size_t)l * NS + n) * 4 + h) * 64 + lane) * 64;
#pragma unroll
            for (int k = 0; k < 64; k += 4) { const f32x4 v4 = *(const f32x4*)(st + k); S[k] = v4[0]; S[k + 1] = v4[1]; S[k + 2] = v4[2]; S[k + 3] = v4[3]; } }
        else {
#pragma unroll
            for (int k = 0; k < 64; ++k) S[k] = 0.f; }
        const float lng = PIN(I_LNG)[(size_t)l * 256 + h * 64 + lane], lnb = PIN(I_LNB)[(size_t)l * 256 + h * 64 + lane];
        const float rkl = PIN(I_RK)[(size_t)l * 256 + h * 64 + lane];
        for (int t = 0; t < nt; ++t) {
            const bf16_t* rw = RWH + (size_t)(row0 + t) * 1536 + h * 64 + lane;
            const float rl = bf2f(rw[0]), kl = bf2f(rw[256]), vl = bf2f(rw[512]), gl = bf2f(rw[1280]);
            WAVE_LDS_SYNC();
            wl[lane] = rl; wl[64 + lane] = kl; wl[128 + lane] = __expf(RWD[(size_t)(row0 + t) * 256 + h * 64 + lane]); wl[192 + lane] = bf2f(rw[768]); wl[256 + lane] = bf2f(rw[1024]);
            WAVE_LDS_SYNC();
            const float bd = wave_sum(rl * kl * rkl);
            float sa = 0.f;
#pragma unroll
            for (int k = 0; k < 64; ++k) sa += S[k] * wl[192 + k];
            float y = 0.f;
#pragma unroll
            for (int k = 0; k < 64; ++k) {
                S[k] = S[k] * wl[128 + k] + sa * wl[256 + k] + vl * wl[64 + k];
                y += S[k] * wl[k];
            }
            const float mean = wave_sum(y) * (1.f / 64.f), dl = y - mean;
            const float var = wave_sum(dl * dl) * (1.f / 64.f);
            const float yn = dl * rsqrtf(var + GN_EPS) * lng + lnb;
            Y[(size_t)(row0 + t) * D + h * 64 + lane] = f2bf((yn + bd * vl) * gl);
        }
        float* so = (p.out + z) + (samp ? O_SWKV + ((((size_t)l * NS + n) * 4 + h) * 64 + lane) * 64 : O_PWKV + ((((size_t)l * NP + n) * 4 + h) * 64 + lane) * 64);
#pragma unroll
        for (int k = 0; k < 64; k += 4) *(f32x4*)(so + k) = (f32x4){S[k], S[k + 1], S[k + 2], S[k + 3]};
    }
}

constexpr int RWL = 64, NCH = T / RWL, RW_UNITS = NP * 4 * NCH;
__device__ __forceinline__ f32x4 mma16_k64(const bf16_t* A, const bf16_t* Bt, f32x4 acc, int r, int q) {
    const bf16x8 a0 = *(const bf16x8*)(A + r * LD + 8 * q), a1 = *(const bf16x8*)(A + r * LD + 32 + 8 * q);
    const bf16x8 b0 = *(const bf16x8*)(Bt + r * LD + 8 * q), b1 = *(const bf16x8*)(Bt + r * LD + 32 + 8 * q);
    acc = __builtin_amdgcn_mfma_f32_16x16x32_bf16(a0, b0, acc, 0, 0, 0);
    acc = __builtin_amdgcn_mfma_f32_16x16x32_bf16(a1, b1, acc, 0, 0, 0);
    return acc;
}

__device__ __forceinline__ void stage_rw1(const Params& p, int l, unsigned char* lds) {
    const Ctx cx = mkctx(p); const size_t z = cx.z;
    const int tid = cx.tid, lane0 = tid & 63, wave = __builtin_amdgcn_readfirstlane(tid >> 6);
#define RELANE() int lane_ = lane0; asm volatile("" : "+v"(lane_)); const int lane = lane_, r = lane & 15, q = lane >> 4; (void)r; (void)q;
    bf16_t* M = (bf16_t*)lds;
    float* AT = (float*)(lds + 12 * MSZ * 2);
    float* psum = AT + 64 * 68;
    float* PLs = psum + 512;
    bf16_t* TA10 = (bf16_t*)(PLs + 64);
    bf16_t* TT00 = TA10 + 32 * LD; bf16_t* TYT = TT00 + 32 * LD;
    unsigned char* const wsz = p.ws + z;
    for (int uu = cx.bid; uu < RW_UNITS; uu += cx.nb) {
        const int tile = uu & 255, h = uu >> 8, n = tile >> 7, c = tile & (NCH - 1), unit = (n * 4 + h) * NCH + c;
        const int row0 = n * T + c * RWL;
        {
            RELANE();
            const int k = lane, tg = wave;
            const bf16_t* rw = (const bf16_t*)(wsz + WS_RW) + (size_t)(row0 + tg * 8) * 1536 + h * 64 + k; const float* rwd = (const float*)(wsz + WS_RWD) + (size_t)(row0 + tg * 8) * 256 + h * 64 + k;
            float ld[8], f_r[8], f_k[8], f_v[8], f_a[8], f_b[8]; float cs = 0.f;
#pragma unroll
            for (int j = 0; j < 8; ++j) { ld[j] = rwd[j * 256]; f_r[j] = bf2f(rw[j * 1536]); f_k[j] = bf2f(rw[j * 1536 + 256]); f_v[j] = bf2f(rw[j * 1536 + 512]); f_a[j] = bf2f(rw[j * 1536 + 768]); f_b[j] = bf2f(rw[j * 1536 + 1024]); }
#pragma unroll
            for (int j = 0; j < 8; ++j) { cs += ld[j]; ld[j] = cs; }
            psum[tg * 64 + k] = cs;
            __syncthreads();
            float off = 0.f, tot = 0.f;
#pragma unroll
            for (int g = 0; g < 8; ++g) { const float v_ = psum[g * 64 + k]; tot += v_; off += g < tg ? v_ : 0.f; }
            if (tg == 0) PLs[k] = __expf(tot);
            bf16x8 atT, bcT, kcT, vT;
#pragma unroll
            for (int j = 0; j < 8; ++j) {
                const float lp = off + ld[j], lpm1 = j ? off + ld[j - 1] : off;
                const float Pt = __expf(lp), Pinv = __expf(-lp), Pm1 = __expf(lpm1), E = __expf(tot - lp);
                const float rr = f_r[j], km = f_k[j], vv = f_v[j], av = f_a[j], bv = f_b[j];
                const int t = tg * 8 + j;
                const bf16_t at = f2bf(av * Pm1);
                M[0 * MSZ + t * LD + k] = at; atT[j] = (short)at;
                M[3 * MSZ + t * LD + k] = f2bf(rr * Pt);
                M[1 * MSZ + t * LD + k] = f2bf(bv * Pinv);
                M[2 * MSZ + t * LD + k] = f2bf(km * Pinv);
                bcT[j] = (short)f2bf(bv * E); kcT[j] = (short)f2bf(km * E); vT[j] = (short)f2bf(vv);
            }
            *(bf16x8*)(M + 4 * MSZ + k * LD + tg * 8) = atT;
            *(bf16x8*)(M + 5 * MSZ + k * LD + tg * 8) = bcT;
            *(bf16x8*)(M + 6 * MSZ + k * LD + tg * 8) = kcT;
            *(bf16x8*)(M + 7 * MSZ + k * LD + tg * 8) = vT;
        }
        __syncthreads();
        {
            RELANE();
            const int mm = wave >> 1, hh = wave & 1;
            const bf16_t* Asrc = M + (mm < 2 ? 0 : 3) * MSZ; const bf16_t* Bsrc = M + ((mm & 1) ? 2 : 1) * MSZ;
#pragma unroll
            for (int m2 = 0; m2 < 2; ++m2) {
                const int mt = hh * 2 + m2;
#pragma unroll
                for (int nt = 0; nt < 4; ++nt) {
                    float zf = 0.f; asm volatile("" : "+v"(zf));
                    f32x4 acc = {zf, zf, zf, zf};
                    if (nt <= mt) acc = mma16_k64(Asrc + mt * 16 * LD, Bsrc + nt * 16 * LD, acc, r, q);
                    const int i = 16 * nt + r;
#pragma unroll
                    for (int e = 0; e < 4; ++e) { const int t = 16 * mt + 4 * q + e; const bool keep = mm < 2 ? (i < t) : (i <= t); acc[e] = keep ? acc[e] : 0.f; }
                    if (mm == 0) { *(f32x4*)(AT + i * 68 + 16 * mt + 4 * q) = acc;
                        if (mt >= 2 && nt < 2) {
#pragma unroll
                            for (int e = 0; e < 4; ++e) TA10[(16 * (mt - 2) + 4 * q + e) * LD + i] = f2bf(acc[e]); } }
                    else {
                        bf16_t* dst = M + (7 + mm) * MSZ;
#pragma unroll
                        for (int e = 0; e < 4; ++e) dst[(16 * mt + 4 * q + e) * LD + i] = f2bf(acc[e]);
                    }
                }
            }
        }
        __syncthreads();
        if (wave == 0) {
            RELANE();
            const int blk = lane >> 5, jl = lane & 31;
            const float* ATl = AT + blk * (32 * 68 + 32);
            float tc[32];
#pragma unroll
            for (int t = 0; t < 32; ++t) tc[t] = (t == jl) ? 1.f : 0.f;
            int aoff = 0;
            float cur[31], nxt[31];
#pragma unroll
            for (int t = 1; t < 32; ++t) cur[t - 1] = ATl[t];
#pragma unroll
            for (int i = 0; i < 31; ++i) {
                asm volatile("" : "+v"(aoff), "+v"(tc[i]));
                if (i + 1 < 31) {
#pragma unroll
                    for (int t = i + 2; t < 32; ++t) nxt[t - i - 2] = ATl[aoff + (i + 1) * 68 + t];
                }
                const float ti = tc[i];
#pragma unroll
                for (int t = i + 1; t < 32; ++t) tc[t] += cur[t - i - 1] * ti;
#pragma unroll
                for (int t = 0; t < 30; ++t) cur[t] = nxt[t];
            }
            bf16_t* T11 = M + 11 * MSZ;
#pragma unroll
            for (int t = 0; t < 32; ++t) { T11[(blk * 32 + t) * LD + lane] = f2bf(tc[t]); if (blk) T11[t * LD + lane] = 0; }
            if (blk == 0) {
#pragma unroll
                for (int c8 = 0; c8 < 4; ++c8) { bf16x8 o;
#pragma unroll
                    for (int e = 0; e < 8; ++e) o[e] = (short)f2bf(tc[c8 * 8 + e]);
                    *(bf16x8*)(TT00 + jl * LD + c8 * 8) = o; }
            }
        } else if (wave >= 4) {
            RELANE();
            const int mt = wave - 4;
#pragma unroll
            for (int nt = 0; nt < 4; ++nt) {
                f32x4 acc = {0.f, 0.f, 0.f, 0.f};
                acc = mma16_k64(M + 7 * MSZ + mt * 16 * LD, M + 8 * MSZ + nt * 16 * LD, acc, r, q);
#pragma unroll
                for (int e = 0; e < 4; ++e) M[1 * MSZ + (16 * mt + 4 * q + e) * LD + 16 * nt + r] = f2bf(acc[e]);
            }
        }
        __syncthreads();
        if (wave < 4) {
            RELANE();
            const int mt = wave >> 1, nt = wave & 1;
            const bf16x8 a = *(const bf16x8*)(TA10 + (16 * mt + r) * LD + 8 * q), b = *(const bf16x8*)(TT00 + (16 * nt + r) * LD + 8 * q);
            f32x4 acc = {0.f, 0.f, 0.f, 0.f};
            acc = __builtin_amdgcn_mfma_f32_16x16x32_bf16(a, b, acc, 0, 0, 0);
#pragma unroll
            for (int e = 0; e < 4; ++e) TYT[(16 * nt + r) * LD + 16 * mt + 4 * q + e] = f2bf(acc[e]);
        }
        __syncthreads();
        if (wave < 4) {
            RELANE();
            const int mt = wave >> 1, nt = wave & 1;
            const bf16x8 a = *(const bf16x8*)(M + 11 * MSZ + (32 + 16 * mt + r) * LD + 32 + 8 * q), b = *(const bf16x8*)(TYT + (16 * nt + r) * LD + 8 * q);
            f32x4 acc = {0.f, 0.f, 0.f, 0.f};
            acc = __builtin_amdgcn_mfma_f32_16x16x32_bf16(a, b, acc, 0, 0, 0);
#pragma unroll
            for (int e = 0; e < 4; ++e) M[11 * MSZ + (32 + 16 * mt + 4 * q + e) * LD + 16 * nt + r] = f2bf(acc[e]);
        }
        __syncthreads();
        {
            RELANE();
            const int mt = wave & 3; const bf16_t* Asrc = M + (wave < 4 ? 4 : 1) * MSZ; bf16_t* dst = M + (wave < 4 ? 0 : 2) * MSZ;
#pragma unroll
            for (int nt = 0; nt < 4; ++nt) {
                f32x4 acc = {0.f, 0.f, 0.f, 0.f};
                acc = mma16_k64(Asrc + mt * 16 * LD, M + 11 * MSZ + nt * 16 * LD, acc, r, q);
#pragma unroll
                for (int e = 0; e < 4; ++e) dst[(16 * mt + 4 * q + e) * LD + 16 * nt + r] = f2bf(acc[e]);
            }
        }
        __syncthreads();
        {
            RELANE();
            const int job = wave >> 1;
            bf16_t* RPg = (bf16_t*)(wsz + WS_RWC_RP); bf16_t* MCg = (bf16_t*)(wsz + WS_RWC_MC); bf16_t* NCTg = (bf16_t*)(wsz + WS_RWC_NCT); float* Y0g = (float*)(wsz + WS_RWC_Y0);
#pragma unroll
            for (int m2 = 0; m2 < 2; ++m2) {
                const int mt = (wave & 1) * 2 + m2;
#pragma unroll
                for (int nt = 0; nt < 4; ++nt) {
                    const size_t ub = (size_t)unit * 4096;
                    if (job == 0) {
                        const bf16x4 in = *(const bf16x4*)(M + 3 * MSZ + (16 * nt + r) * LD + 16 * mt + 4 * q);
                        f32x4 acc = {bf2f((bf16_t)in[0]), bf2f((bf16_t)in[1]), bf2f((bf16_t)in[2]), bf2f((bf16_t)in[3])};
                        acc = mma16_k64(M + 0 * MSZ + mt * 16 * LD, M + 9 * MSZ + nt * 16 * LD, acc, r, q);
                        *(bf16x4*)(RPg + ub + (16 * nt + r) * 64 + 16 * mt + 4 * q) = pack4(acc);
                    } else if (job == 1) {
                        f32x4 acc = {0.f, 0.f, 0.f, 0.f};
                        acc = mma16_k64(M + 0 * MSZ + mt * 16 * LD, M + 5 * MSZ + nt * 16 * LD, acc, r, q);
                        const int k1 = 16 * nt + r; const float pl = PLs[k1];
#pragma unroll
                        for (int e = 0; e < 4; ++e) acc[e] += (16 * mt + 4 * q + e == k1) ? pl : 0.f;
                        *(bf16x4*)(MCg + ub + k1 * 64 + 32 * (mt >> 1) + 8 * q + 4 * (mt & 1)) = pack4(acc);
                    } else if (job == 2) {
                        f32x4 acc = {0.f, 0.f, 0.f, 0.f};
                        acc = mma16_k64(M + 2 * MSZ + mt * 16 * LD, M + 9 * MSZ + nt * 16 * LD, acc, r, q);
                        acc = mma16_k64(M + 7 * MSZ + mt * 16 * LD, M + 10 * MSZ + nt * 16 * LD, acc, r, q);
                        *(f32x4*)(Y0g + ub + (16 * nt + r) * 64 + 16 * mt + 4 * q) = acc;
                    } else {
                        f32x4 acc = {0.f, 0.f, 0.f, 0.f};
                        acc = mma16_k64(M + 5 * MSZ + mt * 16 * LD, M + 2 * MSZ + nt * 16 * LD, acc, r, q);
                        acc = mma16_k64(M + 6 * MSZ + mt * 16 * LD, M + 7 * MSZ + nt * 16 * LD, acc, r, q);
                        *(bf16x4*)(NCTg + ub + (16 * nt + r) * 64 + 16 * mt + 4 * q) = pack4(acc);
                    }
                }
            }
        }
        __syncthreads();
    }
}
#undef RELANE

constexpr int RW2_WGS = NP * 4 * 2;
constexpr int RW2_D = 8, RW2_SLOT = 2 * MSZ;
struct RwRegs { bf16x8 m0, m1, n0, n1; };
__device__ __forceinline__ void rw2_fetch(RwRegs& R, const bf16_t* mc, const bf16_t* nct, int c, int lt) {
    const int cc = c & (NCH - 1);
    R.m0 = *(const bf16x8*)(mc + (size_t)cc * 4096 + lt * 8); R.m1 = *(const bf16x8*)(mc + (size_t)cc * 4096 + 2048 + lt * 8);
    R.n0 = *(const bf16x8*)(nct + (size_t)cc * 4096 + lt * 8); R.n1 = *(const bf16x8*)(nct + (size_t)cc * 4096 + 2048 + lt * 8);
}
__device__ __forceinline__ void rw2_put(const RwRegs& R, bf16_t* slot, int lt) {
    const int row = lt >> 3, pc = lt & 7;
    *(bf16x8*)(slot + row * LD + pc * 8) = R.m0; *(bf16x8*)(slot + (row + 32) * LD + pc * 8) = R.m1;
    *(bf16x8*)(slot + MSZ + row * LD + pc * 8) = R.n0; *(bf16x8*)(slot + MSZ + (row + 32) * LD + pc * 8) = R.n1;
}
__device__ __forceinline__ void rw2_consume(f32x4 (&acc)[4], const bf16_t* slot, bf16_t* s0, int c, int r, int q, int v) {
    bf16x4 pk[4];
#pragma unroll
    for (int mt = 0; mt < 4; ++mt) { pk[mt] = pack4(acc[mt]); *(bf16x4*)(s0 + (size_t)c * 4096 + v * 64 + 16 * mt + 4 * q) = pk[mt]; }
    const bf16x8 b0 = {pk[0][0], pk[0][1], pk[0][2], pk[0][3], pk[1][0], pk[1][1], pk[1][2], pk[1][3]};
    const bf16x8 b1 = {pk[2][0], pk[2][1], pk[2][2], pk[2][3], pk[3][0], pk[3][1], pk[3][2], pk[3][3]};
#pragma unroll
    for (int mt = 0; mt < 4; ++mt) {
        const bf16x8 a0 = *(const bf16x8*)(slot + (16 * mt + r) * LD + 8 * q), a1 = *(const bf16x8*)(slot + (16 * mt + r) * LD + 32 + 8 * q);
        const bf16x4 nc = *(const bf16x4*)(slot + MSZ + v * LD + 16 * mt + 4 * q);
        f32x4 ci = {bf2f((bf16_t)nc[0]), bf2f((bf16_t)nc[1]), bf2f((bf16_t)nc[2]), bf2f((bf16_t)nc[3])};
        ci = __builtin_amdgcn_mfma_f32_16x16x32_bf16(a0, b0, ci, 0, 0, 0);
        acc[mt] = __builtin_amdgcn_mfma_f32_16x16x32_bf16(a1, b1, ci, 0, 0, 0);
    }
}
__device__ __forceinline__ void stage_rw2(const Params& p, int l, unsigned char* lds) {
    const Ctx cx = mkctx(p); const size_t z = cx.z;
    const int tid = cx.tid, lane = tid & 63, wave = __builtin_amdgcn_readfirstlane(tid >> 6), r = lane & 15, q = lane >> 4;
    if (cx.bid < RW2_WGS) {
        const int nh = cx.bid & (NP * 4 - 1), vh = cx.bid >> 3, v = 32 * vh + 16 * (wave & 1) + r;
        const bf16_t* mc = (const bf16_t*)(p.ws + z + WS_RWC_MC) + (size_t)nh * NCH * 4096;
        bf16_t* nct = (bf16_t*)(p.ws + z + WS_RWC_NCT) + (size_t)nh * NCH * 4096;
        bf16_t* L0 = (bf16_t*)lds; bf16_t* L1 = L0 + RW2_SLOT;
        f32x4 acc[4];
#pragma unroll
        for (int mt = 0; mt < 4; ++mt) acc[mt] = (f32x4){0.f, 0.f, 0.f, 0.f};
        const int lt = tid - 128;
        const bool b_is_m = lt < 128;
        const int pb = b_is_m ? lt + 384 : lt - 128;
        const bf16_t* srcA = mc + lt * 8;
        const bf16_t* srcB = b_is_m ? mc + pb * 8 : nct + (32 * vh) * 64 + pb * 8;
        const int dstA = (lt >> 3) * LD + (lt & 7) * 8;
        const int dstB = b_is_m ? (pb >> 3) * LD + (pb & 7) * 8 : MSZ + (32 * vh + (pb >> 3)) * LD + (pb & 7) * 8;
        struct RwHalf { bf16x8 a, b; };
        RwHalf H0, H1, H2, H3, H4, H5, H6, H7, H8, H9, H10, H11, H12, H13, H14, H15;
#define RW2_FETCH(HH, c) do { HH.a = *(const bf16x8*)(srcA + (size_t)(c) * 4096); HH.b = *(const bf16x8*)(srcB + (size_t)(c) * 4096); } while (0)
#define RW2_PUT(HH, slot) do { *(bf16x8*)((slot) + dstA) = HH.a; *(bf16x8*)((slot) + dstB) = HH.b; } while (0)
        if (wave >= 2) {
            { RwHalf F; RW2_FETCH(F, 0); RW2_PUT(F, L0); }
            RW2_FETCH(H0, 1); RW2_FETCH(H1, 2); RW2_FETCH(H2, 3); RW2_FETCH(H3, 4); RW2_FETCH(H4, 5); RW2_FETCH(H5, 6); RW2_FETCH(H6, 7); RW2_FETCH(H7, 8);
            RW2_FETCH(H8, 9); RW2_FETCH(H9, 10); RW2_FETCH(H10, 11); RW2_FETCH(H11, 12); RW2_FETCH(H12, 13); RW2_FETCH(H13, 14); RW2_FETCH(H14, 15); RW2_FETCH(H15, 16);
        }
        __syncthreads();
        if (wave >= 2) {
#define RW2_LSTEP(HH, c) do { RW2_PUT(HH, ((c) & 1) ? L0 : L1); RW2_FETCH(HH, (c) + 17); __syncthreads(); } while (0)
#pragma unroll 1
            for (int c = 0; c < NCH; c += 16) {
                RW2_LSTEP(H0, c); RW2_LSTEP(H1, c + 1); RW2_LSTEP(H2, c + 2); RW2_LSTEP(H3, c + 3); RW2_LSTEP(H4, c + 4); RW2_LSTEP(H5, c + 5); RW2_LSTEP(H6, c + 6); RW2_LSTEP(H7, c + 7);
                RW2_LSTEP(H8, c + 8); RW2_LSTEP(H9, c + 9); RW2_LSTEP(H10, c + 10); RW2_LSTEP(H11, c + 11); RW2_LSTEP(H12, c + 12); RW2_LSTEP(H13, c + 13); RW2_LSTEP(H14, c + 14); RW2_LSTEP(H15, c + 15);
            }
#undef RW2_LSTEP
        } else {
#pragma unroll 1
            for (int c = 0; c < NCH; c += 2) {
                rw2_consume(acc, L0, nct, c, r, q, v); __syncthreads();
                rw2_consume(acc, L1, nct, c + 1, r, q, v); __syncthreads();
            }
        }
#undef RW2_FETCH
#undef RW2_PUT
        if (wave < 2) {
            float* so = (p.out + z) + O_PWKV + ((size_t)l * NP * 4 + nh) * 4096 + v * 64 + 4 * q;
#pragma unroll
            for (int mt = 0; mt < 4; ++mt) *(f32x4*)(so + 16 * mt) = acc[mt];
        }
    }
}

__device__ __forceinline__ void stage_rw3(const Params& p, int l, int first = 0) {
    const Ctx cx = mkctx(p, first); const size_t z = cx.z;
    const int tid = cx.tid, lane = tid & 63, wave = tid >> 6, r = lane & 15, q = lane >> 4;
    const bf16_t* RWH = (const bf16_t*)(p.ws + z + WS_RW);
    const bf16_t* RPg = (const bf16_t*)(p.ws + z + WS_RWC_RP); const bf16_t* S0g = (const bf16_t*)(p.ws + z + WS_RWC_NCT);
    const float* Y0g = (const float*)(p.ws + z + WS_RWC_Y0);
    bf16_t* Y = (bf16_t*)(p.ws + z + WS_YCAT);
    for (int it = cx.bid; it < RW_UNITS / 2; it += cx.nb) {
        const int c = (it & 63) * 2 + (wave >> 2), nh = it >> 6, n = nh >> 2, h = nh & 3, unit = nh * NCH + c, nt = wave & 3;
        const int t = 16 * nt + r, row = n * T + c * RWL + t;
        const size_t ub = (size_t)unit * 4096;
        const bf16x8 rp0 = *(const bf16x8*)(RPg + ub + t * 64 + 8 * q), rp1 = *(const bf16x8*)(RPg + ub + t * 64 + 32 + 8 * q);
        const bf16_t* rw = RWH + (size_t)row * 1536 + h * 64;
        f32x4 y[4]; float sum = 0.f, bd = 0.f;
#pragma unroll
        for (int mt = 0; mt < 4; ++mt) {
            const bf16x8 s0 = *(const bf16x8*)(S0g + ub + (16 * mt + r) * 64 + 8 * q), s1 = *(const bf16x8*)(S0g + ub + (16 * mt + r) * 64 + 32 + 8 * q);
            f32x4 acc = *(const f32x4*)(Y0g + ub + t * 64 + 16 * mt + 4 * q);
            acc = __builtin_amdgcn_mfma_f32_16x16x32_bf16(s0, rp0, acc, 0, 0, 0);
            acc = __builtin_amdgcn_mfma_f32_16x16x32_bf16(s1, rp1, acc, 0, 0, 0);
            y[mt] = acc; sum += (acc[0] + acc[1]) + (acc[2] + acc[3]);
            const f32x4 rr = ld4bf(rw + 16 * mt + 4 * q), km = ld4bf(rw + 256 + 16 * mt + 4 * q), rk = *(const f32x4*)(PIN(I_RK) + (size_t)l * 256 + h * 64 + 16 * mt + 4 * q);
            bd += (rr[0] * km[0] * rk[0] + rr[1] * km[1] * rk[1]) + (rr[2] * km[2] * rk[2] + rr[3] * km[3] * rk[3]);
        }
        sum += __shfl_xor(sum, 16); sum += __shfl_xor(sum, 32);
        bd += __shfl_xor(bd, 16); bd += __shfl_xor(bd, 32);
        const float mean = sum * (1.f / 64.f); float vs = 0.f;
#pragma unroll
        for (int mt = 0; mt < 4; ++mt)
#pragma unroll
            for (int e = 0; e < 4; ++e) { const float d_ = y[mt][e] - mean; vs += d_ * d_; }
        vs += __shfl_xor(vs, 16); vs += __shfl_xor(vs, 32);
        const float rstd = rsqrtf(vs * (1.f / 64.f) + GN_EPS);
#pragma unroll
        for (int mt = 0; mt < 4; ++mt) {
            const int vi = 16 * mt + 4 * q;
            const f32x4 vv = ld4bf(rw + 512 + vi), gg = ld4bf(rw + 1280 + vi);
            const f32x4 lg = *(const f32x4*)(PIN(I_LNG) + (size_t)l * 256 + h * 64 + vi), lb = *(const f32x4*)(PIN(I_LNB) + (size_t)l * 256 + h * 64 + vi);
            f32x4 o;
#pragma unroll
            for (int e = 0; e < 4; ++e) o[e] = ((y[mt][e] - mean) * rstd * lg[e] + lb[e] + bd * vv[e]) * gg[e];
            *(bf16x4*)(Y + (size_t)row * D + h * 64 + vi) = pack4(o);
        }
    }
}

__device__ __forceinline__ void stage_qkn(const Params& p, int l) {
    const Ctx cx = mkctx(p); const size_t z = cx.z;
    const int lane = cx.tid & 63, gw = cx.bid * NWAVES + (cx.tid >> 6), GW = cx.nb * NWAVES;
    const bf16_t* P = (const bf16_t*)(p.ws + z + WS_P);
    float* QN = (float*)(p.ws + z + WS_QN); float* KN = (float*)(p.ws + z + WS_KN);
    for (int it = MP * 6 + gw; it < R * 6; it += GW) {
        const int row = it / 6, unit = it % 6;
        const bool samp = row >= MP; const int n = samp ? row - MP : row >> 13, t = samp ? 0 : (row & (T - 1));
        const float x = bf2f(P[(size_t)row * PCOLS + OFF_B + unit * 64 + lane]);
        const float ss = wave_sum(x * x) * (1.f / 64.f);
        const float g = unit < 4 ? PIN(I_QNG)[(size_t)l * 64 + lane] : PIN(I_KNG)[(size_t)l * 64 + lane];
        const float y = x * rsqrtf(ss + NORM_EPS) * g;
        if (unit < 4) QN[(size_t)row * 256 + unit * 64 + lane] = y;
        else {
            const int kvh = unit - 4;
            KN[(size_t)row * 128 + kvh * 64 + lane] = y;
            const float v = bf2f(P[(size_t)row * PCOLS + OFF_B + 384 + kvh * 64 + lane]);
            if (samp) { const size_t o = (((size_t)l * NS + n) * 128 + 127) * 128 + kvh * 64 + lane; (p.out + z)[O_SK + o] = y; (p.out + z)[O_SV + o] = v; }
            else if (t >= T - 128) { const size_t o = (((size_t)l * NP + n) * 128 + (t - (T - 128))) * 128 + kvh * 64 + lane; (p.out + z)[O_PK + o] = y; (p.out + z)[O_PV + o] = v; }
        }
    }
}

__device__ __forceinline__ void stage_cachecopy(const Params& p, int l, int first = 0) {
    const Ctx cx = mkctx(p, first); const size_t z = cx.z;
    {
        typedef float f4 __attribute__((ext_vector_type(4)));
        const unsigned gt4 = (unsigned)cx.bid * NTHREADS + cx.tid, GT4 = (unsigned)cx.nb * NTHREADS;
        for (unsigned i = gt4; i < (unsigned)NS * 4064; i += GT4) {
            const unsigned n = i / 4064u, o4 = i - n * 4064u;
            const size_t src = (((size_t)l * NS + n) * 128 + 1) * 128 + (size_t)o4 * 4, dst = ((size_t)l * NS + n) * 128 * 128 + (size_t)o4 * 4;
            *(f4*)((p.out + z) + O_SK + dst) = *(const f4*)(PIN(I_CK) + src); *(f4*)((p.out + z) + O_SV + dst) = *(const f4*)(PIN(I_CV) + src);
        }
    }
}

__device__ __forceinline__ void stage_att(const Params& p, int l, int first = 0) {
    const Ctx cx = mkctx(p, first); const size_t z = cx.z;
    const int lane = cx.tid & 63, gw = flip_bid(cx) * NWAVES + (cx.tid >> 6), GW = cx.nb * NWAVES;
    const bf16_t* P = (const bf16_t*)(p.ws + z + WS_P);
    const float* QN = (const float*)(p.ws + z + WS_QN); const float* KN = (const float*)(p.ws + z + WS_KN);
    bf16_t* Y = (bf16_t*)(p.ws + z + WS_YCAT);
    for (int it = MP * 4 + gw; it < R * 4; it += GW) {
        const int row = it >> 2, hq = it & 3, kvh = hq >> 1;
        const bool samp = row >= MP; const int n = samp ? row - MP : row >> 13, t = samp ? 0 : (row & (T - 1));
        const int rowbase = row - t;
        const float* q = QN + (size_t)row * 256 + hq * 64;
        const float sink = PIN(I_SINK)[(size_t)l * 4 + hq];
        f32x4 qreg[16];
#pragma unroll
        for (int d4 = 0; d4 < 16; ++d4) qreg[d4] = *(const f32x4*)(q + 4 * d4);
        float sc[3]; float mx = -INFINITY;
#pragma unroll
        for (int j = 0; j < 3; ++j) {
            const int i = lane + 64 * j; sc[j] = -INFINITY;
            if (i <= 128) {
                const int pos = t - 128 + i;
                const float* kp = nullptr;
                if (pos >= 0) kp = KN + (size_t)(rowbase + pos) * 128 + kvh * 64;
                else if (samp) kp = PIN(I_CK) + (((size_t)l * NS + n) * 128 + i) * 128 + kvh * 64;
                if (kp) { float s = 0.f;
#pragma unroll
                    for (int hf = 0; hf < 2; ++hf) {
                        f32x4 kv[8];
#pragma unroll
                        for (int d4 = 0; d4 < 8; ++d4) kv[d4] = *(const f32x4*)(kp + 32 * hf + 4 * d4);
#pragma unroll
                        for (int d4 = 0; d4 < 8; ++d4) { const f32x4 qv = qreg[8 * hf + d4]; s += (qv[0] * kv[d4][0] + qv[1] * kv[d4][1]) + (qv[2] * kv[d4][2] + qv[3] * kv[d4][3]); }
                        __builtin_amdgcn_sched_barrier(0);
                    }
                    sc[j] = s * 0.125f; }
            }
            mx = fmaxf(mx, sc[j]);
            __builtin_amdgcn_sched_barrier(0);
        }
        mx = fmaxf(wave_max(mx), sink);
        float pr[3]; float sum = 0.f;
#pragma unroll
        for (int j = 0; j < 3; ++j) { pr[j] = sc[j] == -INFINITY ? 0.f : __expf(sc[j] - mx); sum += pr[j]; }
        sum = wave_sum(sum) + __expf(sink - mx);
        float o = 0.f;
        for (int i = 0; i <= 128; ++i) {
            const float prs = i < 64 ? pr[0] : (i < 128 ? pr[1] : pr[2]);
            const float pi = __shfl(prs, i & 63);
            const int pos = t - 128 + i;
            float v = 0.f;
            if (pos >= 0) v = bf2f(P[(size_t)(rowbase + pos) * PCOLS + OFF_B + 384 + kvh * 64 + lane]);
            else if (samp) v = PIN(I_CV)[(((size_t)l * NS + n) * 128 + i) * 128 + kvh * 64 + lane];
            o += pi * v;
        }
        Y[(size_t)row * D + 256 + hq * 64 + lane] = f2bf(o / sum);
    }
}

constexpr int LDV = 264;
__device__ __forceinline__ void stage_attn(const Params& p, int l, unsigned char* lds, int first = 0) {
    const Ctx cx = mkctx(p, first); const size_t z = cx.z;
    const int tid = cx.tid, lane = tid & 63, wave = __builtin_amdgcn_readfirstlane(tid >> 6), r = lane & 15, q = lane >> 4;
    bf16_t* Ks = (bf16_t*)lds;
    bf16_t* Qs = (bf16_t*)(lds + 36864);
    bf16_t* Vt = (bf16_t*)(lds + 73728);
    const bf16_t* P = (const bf16_t*)(p.ws + z + WS_P);
    bf16_t* Y = (bf16_t*)(p.ws + z + WS_YCAT);
    for (int unit = cx.bid; unit < NP * 2 * (T / 128); unit += cx.nb) {
        const int b = unit & 63, kvh = (unit >> 6) & 1, n = unit >> 7, t0 = b * 128;
        const size_t rowb = (size_t)n * T;
        float gk[8], gq[8];
#pragma unroll
        for (int j = 0; j < 8; ++j) { gk[j] = PIN(I_KNG)[(size_t)l * 64 + (tid & 7) * 8 + j]; gq[j] = PIN(I_QNG)[(size_t)l * 64 + (tid & 7) * 8 + j]; }
        bf16x8 kraw[4], qraw[4], vraw[4];
#pragma unroll
        for (int it = 0; it < 4; ++it) {
            const int task = it * NTHREADS + tid, c8 = task & 7, kk = task >> 3, kp = t0 - 128 + kk, g = kk >> 7, tl = kk & 127;
            const bf16x8 zz = {0, 0, 0, 0, 0, 0, 0, 0};
            kraw[it] = kp >= 0 ? *(const bf16x8*)(P + (rowb + kp) * PCOLS + OFF_B + 256 + kvh * 64 + c8 * 8) : zz;
            qraw[it] = *(const bf16x8*)(P + (rowb + t0 + tl) * PCOLS + OFF_B + (kvh * 2 + g) * 64 + c8 * 8);
            const int d = task & 63, m0 = (task >> 6) * 8;
#pragma unroll
            for (int j = 0; j < 8; ++j) { const int vp = t0 - 128 + m0 + j; vraw[it][j] = vp >= 0 ? (short)P[(rowb + vp) * PCOLS + OFF_B + 384 + kvh * 64 + d] : (short)0; }
        }
#pragma unroll
        for (int it = 0; it < 4; ++it) {
            const int task = it * NTHREADS + tid, c8 = task & 7;
            {
                const int kk = task >> 3;
                float x[8]; float ss = 0.f;
#pragma unroll
                for (int j = 0; j < 8; ++j) { x[j] = bf2f((bf16_t)kraw[it][j]); ss += x[j] * x[j]; }
                ss += __shfl_xor(ss, 1); ss += __shfl_xor(ss, 2); ss += __shfl_xor(ss, 4);
                const float rstd = rsqrtf(ss * (1.f / 64.f) + NORM_EPS);
                bf16x8 o;
#pragma unroll
                for (int j = 0; j < 8; ++j) { x[j] = x[j] * rstd * gk[j]; o[j] = (short)f2bf(x[j]); }
                *(bf16x8*)(Ks + kk * LD + c8 * 8) = o;
                if (b == 63 && kk >= 128) { float* ko = (p.out + z) + O_PK + (((size_t)l * NP + n) * 128 + (kk - 128)) * 128 + kvh * 64 + c8 * 8;
#pragma unroll
                    for (int j = 0; j < 8; ++j) ko[j] = x[j]; }
            }
            {
                const int qr = task >> 3;
                float x[8]; float ss = 0.f;
#pragma unroll
                for (int j = 0; j < 8; ++j) { x[j] = bf2f((bf16_t)qraw[it][j]); ss += x[j] * x[j]; }
                ss += __shfl_xor(ss, 1); ss += __shfl_xor(ss, 2); ss += __shfl_xor(ss, 4);
                const float rstd = rsqrtf(ss * (1.f / 64.f) + NORM_EPS) * 0.125f;
                bf16x8 o;
#pragma unroll
                for (int j = 0; j < 8; ++j) o[j] = (short)f2bf(x[j] * rstd * gq[j]);
                *(bf16x8*)(Qs + qr * LD + c8 * 8) = o;
            }
            {
                const int d = task & 63, m0 = (task >> 6) * 8;
                *(bf16x8*)(Vt + d * LDV + m0) = vraw[it];
                if (b == 63 && m0 >= 128) { float* vo = (p.out + z) + O_PV + (((size_t)l * NP + n) * 128 + (m0 - 128)) * 128 + kvh * 64 + d;
#pragma unroll
                    for (int j = 0; j < 8; ++j) vo[j * 128] = bf2f((bf16_t)vraw[it][j]); }
            }
        }
        __syncthreads();
        {
            const int g = wave >> 2, sb = wave & 3, hq = kvh * 2 + g;
            const float sink = PIN(I_SINK)[(size_t)l * 4 + hq];
#pragma unroll 1
            for (int mt = 0; mt < 2; ++mt) {
                const int ql = 32 * sb + 16 * mt + r;
                const bf16_t* Qb = Qs + (g * 128 + 32 * sb + 16 * mt) * LD;
                f32x4 sacc[10]; float mx = -INFINITY;
#pragma unroll
                for (int j = 0; j < 10; ++j) {
                    f32x4 a = {0.f, 0.f, 0.f, 0.f};
                    a = mma16_k64(Ks + (32 * sb + 16 * j) * LD, Qb, a, r, q);
#pragma unroll
                    for (int e = 0; e < 4; ++e) { const int kk = 32 * sb + 16 * j + 4 * q + e, rel = ql + 128 - kk;
                        const bool ok = rel >= 0 && rel <= 128 && (t0 - 128 + kk) >= 0;
                        a[e] = ok ? a[e] : -INFINITY; mx = fmaxf(mx, a[e]); }
                    sacc[j] = a;
                    __builtin_amdgcn_sched_barrier(0);
                }
                mx = fmaxf(mx, __shfl_xor(mx, 16)); mx = fmaxf(mx, __shfl_xor(mx, 32)); mx = fmaxf(mx, sink);
                float sum = 0.f;
#pragma unroll
                for (int j = 0; j < 10; ++j)
#pragma unroll
                    for (int e = 0; e < 4; ++e) { const float pv = __expf(sacc[j][e] - mx); sacc[j][e] = pv; sum += pv; }
                sum += __shfl_xor(sum, 16); sum += __shfl_xor(sum, 32); sum += __expf(sink - mx);
                const float inv = 1.f / sum;
                f32x4 o[4];
#pragma unroll
                for (int dt = 0; dt < 4; ++dt) o[dt] = (f32x4){0.f, 0.f, 0.f, 0.f};
#pragma unroll
                for (int s2 = 0; s2 < 5; ++s2) {
                    const bf16x4 p0 = pack4(sacc[2 * s2]), p1 = pack4(sacc[2 * s2 + 1]);
                    const bf16x8 pb = {p0[0], p0[1], p0[2], p0[3], p1[0], p1[1], p1[2], p1[3]};
#pragma unroll
                    for (int dt = 0; dt < 4; ++dt) {
                        const bf16_t* vp = Vt + (16 * dt + r) * LDV + 32 * sb + 32 * s2 + 4 * q;
                        const bf16x4 v0 = *(const bf16x4*)vp, v1 = *(const bf16x4*)(vp + 16);
                        const bf16x8 va = {v0[0], v0[1], v0[2], v0[3], v1[0], v1[1], v1[2], v1[3]};
                        o[dt] = __builtin_amdgcn_mfma_f32_16x16x32_bf16(va, pb, o[dt], 0, 0, 0);
                    }
                    __builtin_amdgcn_sched_barrier(0);
                }
                bf16_t* yo = Y + (rowb + t0 + ql) * D + 256 + hq * 64 + 4 * q;
#pragma unroll
                for (int dt = 0; dt < 4; ++dt) { f32x4 ov = o[dt] * inv; *(bf16x4*)(yo + 16 * dt) = pack4(ov); }
            }
        }
        __syncthreads();
    }
}

__device__ __forceinline__ void mconv_unit(const Params& p, size_t z, int l, int n, int c, int g, int tid) {
    const bf16_t* P = (const bf16_t*)(p.ws + z + WS_P);
    bf16_t* XB = (bf16_t*)(p.ws + z + WS_XBCC);
    const float* cw = PIN(I_CONVW) + (size_t)l * 4 * 1024; const float* cb = PIN(I_CONVB) + (size_t)l * 1024;
#pragma unroll 1
    for (int i = tid; i < 1024; i += NTHREADS) {
        const int ch = i & 63, c0 = ch < 32 ? g * 256 + ch * 8 : (ch < 48 ? 512 + g * 128 + (ch - 32) * 8 : 768 + g * 128 + (ch - 48) * 8);
        const int row = n * T + c * 128 + (i >> 6) * 8, t = row & (T - 1);
        bf16x8 u[11];
#pragma unroll
        for (int k = 0; k < 11; ++k) { const bf16x8 zz = {0, 0, 0, 0, 0, 0, 0, 0}; u[k] = (t - 3 + k >= 0) ? *(const bf16x8*)(P + (size_t)(row - 3 + k) * PCOLS + OFF_XBC + c0) : zz; }
        float w[4][8], b[8];
#pragma unroll
        for (int e = 0; e < 8; ++e) { b[e] = cb[c0 + e];
#pragma unroll
            for (int j = 0; j < 4; ++j) w[j][e] = cw[j * 1024 + c0 + e]; }
#pragma unroll
        for (int r = 0; r < 8; ++r) { bf16x8 o;
#pragma unroll
            for (int e = 0; e < 8; ++e) { float acc = b[e];
#pragma unroll
                for (int j = 0; j < 4; ++j) acc += w[j][e] * bf2f((bf16_t)u[r + j][e]);
                o[e] = (short)f2bf(silu_f(acc)); }
            *(bf16x8*)(XB + (size_t)(row + r) * 1024 + c0) = o;
            if (t + r >= T - 3) { float* op = (p.out + z) + O_PCONV + (((size_t)l * NP + n) * 3 + (t + r - (T - 3))) * 1024 + c0;
#pragma unroll
                for (int e = 0; e < 8; ++e) op[e] = bf2f((bf16_t)u[3 + r][e]); }
        }
    }
}

__device__ __forceinline__ void stage_mconv(const Params& p, int l) {
    const Ctx cx = mkctx(p); const size_t z = cx.z;
    const unsigned gt = (unsigned)cx.bid * NTHREADS + cx.tid, GT = (unsigned)cx.nb * NTHREADS;
    const bf16_t* P = (const bf16_t*)(p.ws + z + WS_P);
    bf16_t* XB = (bf16_t*)(p.ws + z + WS_XBCC); float* DT = (float*)(p.ws + z + WS_DT);
    const float* cw = PIN(I_CONVW) + (size_t)l * 4 * 1024; const float* cb = PIN(I_CONVB) + (size_t)l * 1024;
    for (unsigned i = (unsigned)MP * 1024 + gt; i < (unsigned)R * 1024; i += GT) {
        const int c = (int)(i & 1023), row = (int)(i >> 10), n = row - MP;
        const float* st = PIN(I_SCONV) + ((size_t)l * NS + n) * 3 * 1024 + c;
        const float raw = bf2f(P[(size_t)row * PCOLS + OFF_XBC + c]);
        const float acc = cb[c] + cw[c] * st[0] + cw[1024 + c] * st[1024] + cw[2048 + c] * st[2048] + cw[3072 + c] * raw;
        XB[i] = f2bf(silu_f(acc));
        float* o = (p.out + z) + O_SCONV + ((size_t)l * NS + n) * 3 * 1024 + c;
        o[0] = st[1024]; o[1024] = st[2048]; o[2048] = raw;
    }
    float* DT2 = (float*)(p.ws + z + WS_DT2);
    for (unsigned i = (unsigned)MP * 8 + gt; i < (unsigned)R * 8; i += GT) DT2[i] = softplus_f(DT[i] + PIN(I_DTB)[(size_t)l * 8 + (i & 7)]);
}

__device__ __forceinline__ void stage_mscan(const Params& p, int l, float* lds, int first = 0) {
    const Ctx cx = mkctx(p, first); const size_t z = cx.z;
    const int lane = cx.tid & 63, wave = cx.tid >> 6;
    const bf16_t* XB = (const bf16_t*)(p.ws + z + WS_XBCC); const float* DT = (const float*)(p.ws + z + WS_DT2);
    float* YT = (float*)(p.ws + z + WS_YTMP);
    float* wl = lds + wave * 512;
    const int dh = lane & 1, pl = lane >> 1;
    for (int u = NP * 16 + flip_bid(cx) + cx.nb * wave; u < NSEQ * 16; u += cx.nb * NWAVES) {
        const int s = u >> 4, h = (u >> 1) & 7, ph = u & 1, g = h >> 2; const bool samp = s >= NP; const int n = samp ? s - NP : s;
        const int row0 = samp ? MP + n : n * T, nt = samp ? 1 : T, pp = ph * 32 + pl;
        float hs[64];
        if (samp) { const float* st = PIN(I_SSM) + ((((size_t)l * NS + n) * 8 + h) * 64 + pp) * 128 + dh * 64;
#pragma unroll
            for (int d = 0; d < 64; d += 4) { const f32x4 v4 = *(const f32x4*)(st + d); hs[d] = v4[0]; hs[d + 1] = v4[1]; hs[d + 2] = v4[2]; hs[d + 3] = v4[3]; } }
        else {
#pragma unroll
            for (int d = 0; d < 64; ++d) hs[d] = 0.f; }
        const float A = -__expf(PIN(I_ALOG)[(size_t)l * 8 + h]), Dh = PIN(I_SSMD)[(size_t)l * 8 + h];
        for (int t = 0; t < nt; ++t) {
            const size_t row = (size_t)row0 + t;
            const float dtv = DT[row * 8 + h], dA = __expf(dtv * A);
            const float x = bf2f(XB[row * 1024 + h * 64 + pp]), xdt = x * dtv;
            const bf16_t* b = XB + row * 1024 + 512 + g * 128; const bf16_t* c = XB + row * 1024 + 768 + g * 128;
            WAVE_LDS_SYNC();
            wl[lane] = bf2f(b[lane]); wl[64 + lane] = bf2f(b[64 + lane]); wl[128 + lane] = bf2f(c[lane]); wl[192 + lane] = bf2f(c[64 + lane]);
            WAVE_LDS_SYNC();
            float y = 0.f;
#pragma unroll
            for (int d = 0; d < 64; ++d) { hs[d] = hs[d] * dA + xdt * wl[dh * 64 + d]; y += hs[d] * wl[128 + dh * 64 + d]; }
            y += __shfl_xor(y, 1);
            if (dh == 0) YT[row * 512 + h * 64 + pp] = y + Dh * x;
        }
        float* so = (p.out + z) + (samp ? O_SSSM + ((((size_t)l * NS + n) * 8 + h) * 64 + pp) * 128 : O_PSSM + ((((size_t)l * NP + n) * 8 + h) * 64 + pp) * 128) + dh * 64;
#pragma unroll
        for (int d = 0; d < 64; d += 4) *(f32x4*)(so + d) = (f32x4){hs[d], hs[d + 1], hs[d + 2], hs[d + 3]};
    }
}

__device__ __forceinline__ void mgate_rows(const Params& p, size_t z, int l, int row_lo, int row_hi, int gw, int GW, int lane) {
    const bf16_t* P = (const bf16_t*)(p.ws + z + WS_P); const float* YT = (const float*)(p.ws + z + WS_YTMP);
    bf16_t* Y = (bf16_t*)(p.ws + z + WS_YCAT);
    const f32x4 g0 = *(const f32x4*)(PIN(I_SSMNG) + (size_t)l * 512 + lane * 8), g1 = *(const f32x4*)(PIN(I_SSMNG) + (size_t)l * 512 + lane * 8 + 4);
    for (int row = row_lo + 2 * gw; row < row_hi; row += 2 * GW) {
        f32x4 ya[2][2]; bf16x8 zz[2];
#pragma unroll
        for (int k = 0; k < 2; ++k) { ya[k][0] = *(const f32x4*)(YT + (size_t)(row + k) * 512 + lane * 8); ya[k][1] = *(const f32x4*)(YT + (size_t)(row + k) * 512 + lane * 8 + 4);
            zz[k] = *(const bf16x8*)(P + (size_t)(row + k) * PCOLS + OFF_Z + lane * 8); }
#pragma unroll
        for (int k = 0; k < 2; ++k) {
            float v[8]; float ss = 0.f;
#pragma unroll
            for (int e = 0; e < 8; ++e) { v[e] = ya[k][e >> 2][e & 3] * silu_f(bf2f((bf16_t)zz[k][e])); ss += v[e] * v[e]; }
            const float rstd = rsqrtf(wave_sum(ss) * (1.f / 512.f) + NORM_EPS);
            bf16x8 o;
#pragma unroll
            for (int e = 0; e < 8; ++e) o[e] = (short)f2bf(v[e] * rstd * (e < 4 ? g0[e & 3] : g1[e & 3]));
            *(bf16x8*)(Y + (size_t)(row + k) * D + 512 + lane * 8) = o;
        }
    }
}
constexpr int SL = 128, SNC = T / SL;
__device__ __forceinline__ f32x4 mma16(const bf16_t* A, const bf16_t* Bt, int nsteps, f32x4 acc, int r, int q) {
#pragma unroll
    for (int s = 0; s < 4; ++s) if (s < nsteps) {
        const bf16x8 a = *(const bf16x8*)(A + r * LD2 + 32 * s + 8 * q), b = *(const bf16x8*)(Bt + r * LD2 + 32 * s + 8 * q);
        acc = __builtin_amdgcn_mfma_f32_16x16x32_bf16(a, b, acc, 0, 0, 0);
    }
    return acc;
}
constexpr int SSD_OFF_AUX = 104448;
template <bool FROM_RAW>
__device__ __forceinline__ void ssd_aux(const Params& p, size_t z, int l, int g, int row0, float* aux, int tid) {
    float* DT2 = (float*)(p.ws + z + WS_DT2);
    const int t = tid & 127, e = tid >> 7, h = g * 4 + e;
    float dtv;
    if (FROM_RAW) { dtv = softplus_f(((const float*)(p.ws + z + WS_DT))[(size_t)(row0 + t) * 8 + h] + PIN(I_DTB)[(size_t)l * 8 + h]); DT2[(size_t)(row0 + t) * 8 + h] = dtv; }
    else dtv = DT2[(size_t)(row0 + t) * 8 + h];
    const float A = -__expf(PIN(I_ALOG)[(size_t)l * 8 + h]);
    aux[e * 128 + t] = dtv; aux[512 + e * 128 + t] = dtv * A;
    __syncthreads();
    float acc = 0.f;
    for (int i = 0; i <= t; ++i) acc += aux[512 + e * 128 + i];
    aux[1024 + e * 128 + t] = acc;
    __syncthreads();
}
__device__ __forceinline__ void stage_ssd1(const Params& p, int l, unsigned char* lds) {
    const Ctx cx = mkctx(p); const size_t z = cx.z;
    const int tid = cx.tid, lane = tid & 63, wave = __builtin_amdgcn_readfirstlane(tid >> 6), r = lane & 15, q = lane >> 4;
    bf16_t* BT = (bf16_t*)lds;
    bf16_t* XW = (bf16_t*)(lds + 34816);
    float* aux = (float*)(lds + SSD_OFF_AUX);
    const bf16_t* XB = (const bf16_t*)(p.ws + z + WS_XBCC);
    float* ST = (float*)(p.ws + z + WS_SST); float* CD = (float*)(p.ws + z + WS_SCD);
    for (int unit = cx.bid; unit < NP * SNC * 2; unit += cx.nb) {
        const int g = unit & 1, c = (unit >> 1) & (SNC - 1), n = unit >> 7, row0 = n * T + c * SL;
        mconv_unit(p, z, l, n, c, g, tid);
        asm volatile("s_waitcnt vmcnt(0)" ::: "memory"); __syncthreads();
        const int d = tid & 127, mg = tid >> 7, pp = tid & 63, mgp = tid >> 6;
        bf16x8 bv[4], xv[4][2];
#pragma unroll
        for (int it = 0; it < 4; ++it) { const int m0 = mg * 32 + it * 8;
#pragma unroll
            for (int j = 0; j < 8; ++j) bv[it][j] = (short)XB[(size_t)(row0 + m0 + j) * 1024 + 512 + g * 128 + d]; }
#pragma unroll
        for (int e = 0; e < 4; ++e)
#pragma unroll
            for (int it = 0; it < 2; ++it) { const int m0 = mgp * 16 + it * 8;
#pragma unroll
                for (int j = 0; j < 8; ++j) xv[e][it][j] = (short)XB[(size_t)(row0 + m0 + j) * 1024 + (g * 4 + e) * 64 + pp]; }
        ssd_aux<true>(p, z, l, g, row0, aux, tid);
        {
#pragma unroll
            for (int it = 0; it < 4; ++it) *(bf16x8*)(BT + d * LD2 + mg * 32 + it * 8) = bv[it];
#pragma unroll
            for (int e = 0; e < 4; ++e) { const float alast = aux[1024 + e * 128 + 127];
#pragma unroll
                for (int it = 0; it < 2; ++it) { const int m0 = mgp * 16 + it * 8; bf16x8 v;
#pragma unroll
                    for (int j = 0; j < 8; ++j) { const int m = m0 + j; v[j] = (short)f2bf(bf2f((bf16_t)xv[e][it][j]) * aux[e * 128 + m] * __expf(alast - aux[1024 + e * 128 + m])); }
                    *(bf16x8*)(XW + e * 64 * LD2 + pp * LD2 + m0) = v; } }
        }
        __syncthreads();
#pragma unroll
        for (int e = 0; e < 4; ++e) {
            float* st = ST + ((size_t)(n * SNC + c) * 8 + g * 4 + e) * 8192;
#pragma unroll
            for (int nt = 0; nt < 4; ++nt) {
                f32x4 acc = {0.f, 0.f, 0.f, 0.f};
                acc = mma16(BT + 16 * wave * LD2, XW + e * 64 * LD2 + 16 * nt * LD2, 4, acc, r, q);
                *(f32x4*)(st + (16 * nt + r) * 128 + 16 * wave + 4 * q) = acc;
            }
        }
        if (tid < 4) CD[(size_t)(n * SNC + c) * 8 + g * 4 + tid] = __expf(aux[1024 + tid * 128 + 127]);
        __syncthreads();
    }
}
__device__ __forceinline__ void stage_ssd2(const Params& p, int l) {
    const Ctx cx = mkctx(p); const size_t z = cx.z;
    const int first = cx.nb > 32 ? RW2_WGS : 0;
    if (cx.bid >= first) {
        typedef float f32x2 __attribute__((ext_vector_type(2)));
        const float* ST = (const float*)(p.ws + z + WS_SST); const float* CD = (const float*)(p.ws + z + WS_SCD);
        unsigned* HPV = (unsigned*)(p.ws + z + WS_HPREV);
        for (int idx = (cx.bid - first) * NTHREADS + cx.tid; idx < NP * 8 * 4096; idx += (cx.nb - first) * NTHREADS) {
            const int n = idx >> 15, h = (idx >> 12) & 7, pd = (idx & 4095) * 2;
            const float* base = ST + ((size_t)(n * SNC) * 8 + h) * 8192 + pd; const float* cd = CD + (size_t)(n * SNC) * 8 + h;
            unsigned* hb = HPV + (((size_t)(n * SNC) * 8 + h) * 8192 + pd) / 2;
            f32x2 hc = {0.f, 0.f};
#pragma unroll 1
            for (int c0 = 0; c0 < SNC; c0 += 16) {
                f32x2 v[16]; float dcy[16];
#pragma unroll
                for (int k = 0; k < 16; ++k) { v[k] = *(const f32x2*)(base + (size_t)(c0 + k) * 65536); dcy[k] = cd[(c0 + k) * 8]; }
#pragma unroll
                for (int k = 0; k < 16; ++k) { hb[(size_t)(c0 + k) * 32768] = cvtpk(hc[0], hc[1]); hc = hc * dcy[k] + v[k]; }
            }
            *(f32x2*)((p.out + z) + O_PSSM + ((size_t)(l * NP + n) * 8 + h) * 8192 + pd) = hc;
        }
    }
}
__device__ __forceinline__ void stage_ssd3(const Params& p, int l, unsigned char* lds, int first = 0, int count = 0) {
    const Ctx cx = mkctx(p, first, count); const size_t z = cx.z;
    const int tid = cx.tid, lane = tid & 63, wave = __builtin_amdgcn_readfirstlane(tid >> 6), r = lane & 15, q = lane >> 4;
    bf16_t* CM = (bf16_t*)lds;
    bf16_t* BG = (bf16_t*)(lds + 34816);
    bf16_t* XT = (bf16_t*)(lds + 69632);
    bf16_t* HP = (bf16_t*)(lds + 87040);
    float* aux = (float*)(lds + SSD_OFF_AUX);
    const bf16_t* XB = (const bf16_t*)(p.ws + z + WS_XBCC);
    const bf16_t* HPV = (const bf16_t*)(p.ws + z + WS_HPREV);
    float* YT = (float*)(p.ws + z + WS_YTMP);
    for (int u2 = cx.bid; u2 < NP * SNC; u2 += cx.nb)
    for (int g = 0; g < 2; ++g) {
        const int c = u2 & (SNC - 1), n = u2 >> 6, row0 = n * T + c * SL;
        bf16x8 cc[4], bb[4];
        {
            const int d0 = (tid & 15) * 8;
#pragma unroll
            for (int it = 0; it < 4; ++it) { const int row = (tid >> 4) + 32 * it;
                cc[it] = *(const bf16x8*)(XB + (size_t)(row0 + row) * 1024 + 768 + g * 128 + d0); bb[it] = *(const bf16x8*)(XB + (size_t)(row0 + row) * 1024 + 512 + g * 128 + d0); }
        }
        ssd_aux<false>(p, z, l, g, row0, aux, tid);
        {
            const int d0 = (tid & 15) * 8;
#pragma unroll
            for (int it = 0; it < 4; ++it) { const int row = (tid >> 4) + 32 * it; *(bf16x8*)(CM + row * LD2 + d0) = cc[it]; *(bf16x8*)(BG + row * LD2 + d0) = bb[it]; }
        }
        __syncthreads();
        f32x4 cb[8];
#pragma unroll
        for (int nt = 0; nt < 8; ++nt) { cb[nt] = (f32x4){0.f, 0.f, 0.f, 0.f}; if (nt <= wave) cb[nt] = mma16(CM + 16 * wave * LD2, BG + 16 * nt * LD2, 4, cb[nt], r, q); }
        __syncthreads();
        const int xpp = tid & 63, xmg = tid >> 6, hpp = tid >> 3, hd0 = (tid & 7) * 16;
        bf16_t xr[16]; bf16x8 hv[2];
#define SSD3_FETCH(ee) do { const int hh_ = g * 4 + (ee); \
            _Pragma("unroll") for (int j_ = 0; j_ < 16; ++j_) xr[j_] = XB[(size_t)(row0 + xmg * 16 + j_) * 1024 + hh_ * 64 + xpp]; \
            const bf16_t* src_ = HPV + ((size_t)(n * SNC + c) * 8 + hh_) * 8192 + hpp * 128 + hd0; \
            hv[0] = *(const bf16x8*)src_; hv[1] = *(const bf16x8*)(src_ + 8); } while (0)
        SSD3_FETCH(0);
#pragma unroll 1
        for (int e = 0; e < 4; ++e) {
            const int h = g * 4 + e;
            {
#pragma unroll
                for (int nt = 0; nt < 8; ++nt) { const int m = 16 * nt + r; const float am = aux[1024 + e * 128 + m];
#pragma unroll
                    for (int e2 = 0; e2 < 4; ++e2) { const int li = 16 * wave + 4 * q + e2; const float v = (m <= li) ? cb[nt][e2] * __expf(aux[1024 + e * 128 + li] - am) : 0.f; BG[li * LD2 + m] = f2bf(v); } }
#pragma unroll
                for (int it = 0; it < 2; ++it) { const int m0 = xmg * 16 + it * 8; bf16x8 v;
#pragma unroll
                    for (int j = 0; j < 8; ++j) v[j] = (short)f2bf(bf2f(xr[it * 8 + j]) * aux[e * 128 + m0 + j]);
                    *(bf16x8*)(XT + xpp * LD2 + m0) = v; }
                *(bf16x8*)(HP + hpp * LD2 + hd0) = hv[0]; *(bf16x8*)(HP + hpp * LD2 + hd0 + 8) = hv[1];
                if (e + 1 < 4) SSD3_FETCH(e + 1);
            }
            __syncthreads();
            {
                const int li = 16 * wave + r; const size_t row = (size_t)row0 + li;
                const float sc = __expf(aux[1024 + e * 128 + li]), Dh = PIN(I_SSMD)[(size_t)l * 8 + h];
                bf16x4 xq[4];
#pragma unroll
                for (int mt = 0; mt < 4; ++mt) xq[mt] = *(const bf16x4*)(XB + row * 1024 + h * 64 + 16 * mt + 4 * q);
#pragma unroll
                for (int mt = 0; mt < 4; ++mt) {
                    f32x4 ad = {0.f, 0.f, 0.f, 0.f}, ao = {0.f, 0.f, 0.f, 0.f};
                    ad = mma16(XT + 16 * mt * LD2, BG + 16 * wave * LD2, (wave >> 1) + 1, ad, r, q);
                    ao = mma16(HP + 16 * mt * LD2, CM + 16 * wave * LD2, 4, ao, r, q);
                    const bf16x4 xv = xq[mt];
                    f32x4 y;
#pragma unroll
                    for (int e2 = 0; e2 < 4; ++e2) y[e2] = ad[e2] + sc * ao[e2] + Dh * bf2f((bf16_t)xv[e2]);
                    *(f32x4*)(YT + row * 512 + h * 64 + 16 * mt + 4 * q) = y;
                }
            }
            __syncthreads();
        }
        if (g == 1) { asm volatile("s_waitcnt vmcnt(0)" ::: "memory"); __syncthreads(); mgate_rows(p, z, l, row0, row0 + SL, wave, NWAVES, lane); }
#undef SSD3_FETCH
    }
}

__device__ __forceinline__ void stage_mgate_sample(const Params& p, int l, int first) {
    const Ctx cx = mkctx(p, first); const size_t z = cx.z;
    mgate_rows(p, z, l, MP, R, cx.bid * NWAVES + (cx.tid >> 6), cx.nb * NWAVES, cx.tid & 63);
}

__device__ __forceinline__ void stage_glu(const Params& p, int l) {
    const Ctx cx = mkctx(p); const size_t z = cx.z;
    const unsigned gt = (unsigned)cx.bid * NTHREADS + cx.tid, GT = (unsigned)cx.nb * NTHREADS;
    const bf16_t* GV = (const bf16_t*)(p.ws + z + WS_GV); bf16_t* U = (bf16_t*)(p.ws + z + WS_U);
    const float* cw = PIN(I_FCW) + (size_t)l * 3 * DFF; const float* cb = PIN(I_FCB) + (size_t)l * DFF;
    for (unsigned i = gt; i < (unsigned)(MP / 32) * (DFF / 8); i += GT) {
        const int hr = (int)(i / (unsigned)(DFF / 8)), c0 = (int)(i - (unsigned)hr * (DFF / 8)) * 8, row = (hr >> 1) * 64 + (hr & 1), t = row & (T - 1);
        const int cg = 256 * (c0 >> 7) + (c0 & 127);
        bf16x8 u[3];
#pragma unroll
        for (int k = 0; k < 3; ++k) { const bf16x8 zz = {0, 0, 0, 0, 0, 0, 0, 0}; u[k] = (t - 2 + k >= 0) ? *(const bf16x8*)(GV + (size_t)(row - 2 + k) * 5632 + cg) : zz; }
        const bf16x8 vv = *(const bf16x8*)(GV + (size_t)row * 5632 + cg + 128);
        bf16x8 o;
#pragma unroll
        for (int e = 0; e < 8; ++e) { const float acc = cb[c0 + e] + cw[c0 + e] * bf2f((bf16_t)u[0][e]) + cw[DFF + c0 + e] * bf2f((bf16_t)u[1][e]) + cw[2 * DFF + c0 + e] * bf2f((bf16_t)u[2][e]);
            o[e] = (short)f2bf(silu_f(acc) * bf2f((bf16_t)vv[e])); }
        *(bf16x8*)(U + (size_t)row * DFF + c0) = o;
    }
    for (unsigned i = gt; i < (unsigned)NP * 2 * DFF; i += GT) {
        const int c = (int)(i % (unsigned)DFF), j = (int)(i / (unsigned)DFF) & 1, n = (int)(i / (unsigned)(2 * DFF));
        (p.out + z)[O_PFFN + (((size_t)l * NP + n) * 2 + j) * DFF + c] = bf2f(GV[(size_t)(n * T + T - 2 + j) * 5632 + 256 * (c >> 7) + (c & 127)]);
    }
    for (unsigned i = (unsigned)MP * (DFF / 8) + gt; i < (unsigned)R * (DFF / 8); i += GT) {
        const int row = (int)(i / (unsigned)(DFF / 8)), c0 = (int)(i - (unsigned)row * (DFF / 8)) * 8;
        const int cg = 256 * (c0 >> 7) + (c0 & 127);
        const bool samp = row >= MP; const int n = samp ? row - MP : row >> 13, t = samp ? 0 : (row & (T - 1));
        float acc[8], raw[8];
#pragma unroll
        for (int e = 0; e < 8; ++e) acc[e] = cb[c0 + e];
#pragma unroll
        for (int j = 0; j < 3; ++j) {
            const int tau = t - 2 + j; float u[8];
            if (tau >= 0) { const bf16x8 v = *(const bf16x8*)(GV + (size_t)(row - 2 + j) * 5632 + cg);
#pragma unroll
                for (int e = 0; e < 8; ++e) u[e] = bf2f((bf16_t)v[e]); }
            else {
#pragma unroll
                for (int e = 0; e < 8; ++e) u[e] = samp ? PIN(I_FCONV)[(((size_t)l * NS + n) * 2 + (2 + tau)) * DFF + c0 + e] : 0.f; }
#pragma unroll
            for (int e = 0; e < 8; ++e) { acc[e] += cw[j * DFF + c0 + e] * u[e]; if (j == 2) raw[e] = u[e]; }
        }
        const bf16x8 vv = *(const bf16x8*)(GV + (size_t)row * 5632 + cg + 128);
        bf16x8 o;
#pragma unroll
        for (int e = 0; e < 8; ++e) o[e] = (short)f2bf(silu_f(acc[e]) * bf2f((bf16_t)vv[e]));
        *(bf16x8*)(U + (size_t)row * DFF + c0) = o;
        if (samp) { float* op = (p.out + z) + O_SFFN + ((size_t)l * NS + n) * 2 * DFF + c0;
#pragma unroll
            for (int e = 0; e < 8; ++e) { op[e] = PIN(I_FCONV)[(((size_t)l * NS + n) * 2 + 1) * DFF + c0 + e]; op[DFF + e] = raw[e]; } }
        else if (t >= T - 2) { float* op = (p.out + z) + O_PFFN + (((size_t)l * NP + n) * 2 + (t - (T - 2))) * DFF + c0;
#pragma unroll
            for (int e = 0; e < 8; ++e) op[e] = raw[e]; }
    }
}

__device__ __forceinline__ void stage_final(const Params& p) {
    const Ctx cx = mkctx(p); const size_t z = cx.z;
    const size_t gt = (size_t)cx.bid * NTHREADS + cx.tid, GT = (size_t)cx.nb * NTHREADS;
    const float* X = (const float*)(p.out + z);
    for (size_t i = gt; i < (size_t)R * D; i += GT) (p.out + z)[i] = X[i];
}

#define LAS __attribute__((address_space(3)))
typedef unsigned v4u __attribute__((ext_vector_type(4)));
__device__ __forceinline__ unsigned pk2(float lo, float hi) { return cvtpk(lo, hi); }
template <bool GV_PERM = false>
__device__ __forceinline__ void p0_transpose_item(const float* W, int ldw, int K, int nblk, bf16_t* WT, LAS float* scr, int item, int lane) {
    const int kb = item / nblk, nb = item % nblk, k0 = 64 * kb, n0 = 32 * nb;
    int nd = n0;
    if (GV_PERM) { const int bj = n0 >= DFF ? 1 : 0, rem = n0 - bj * DFF; nd = 256 * (rem >> 7) + 128 * bj + (rem & 127); }
    {
        f32x4 t[8];
#pragma unroll
        for (int i = 0; i < 8; ++i) t[i] = *(const f32x4*)(W + (size_t)(k0 + 8 * i + (lane >> 3)) * ldw + n0 + 4 * (lane & 7));
#pragma unroll
        for (int i = 0; i < 8; ++i) { LAS float* d = scr + (8 * i + (lane >> 3)) * 33 + 4 * (lane & 7); d[0] = t[i][0]; d[1] = t[i][1]; d[2] = t[i][2]; d[3] = t[i][3]; }
    }
    asm volatile("s_waitcnt lgkmcnt(0)" ::: "memory");
    const int c = lane & 7;
#pragma unroll
    for (int j = 0; j < 4; ++j) { const int n = (lane >> 3) + 8 * j; const LAS float* s = scr + (8 * c) * 33 + n;
        v4u o; o.x = pk2(s[0 * 33], s[1 * 33]); o.y = pk2(s[2 * 33], s[3 * 33]); o.z = pk2(s[4 * 33], s[5 * 33]); o.w = pk2(s[6 * 33], s[7 * 33]);
        *(v4u*)(WT + (size_t)(nd + n) * K + k0 + 8 * c) = o; }
    asm volatile("s_waitcnt lgkmcnt(0)" ::: "memory");
}
__device__ __forceinline__ void stage_wconv(const Params& p, unsigned char* lds, int l_lo, int l_hi, int first = 0) {
    const Ctx cx = mkctx(p, first); const size_t z = cx.z;
    if (l_lo == 0) {
        bf16_t* LT = (bf16_t*)(p.ws + z + WS_LORA);
        for (unsigned i = (unsigned)cx.bid * NTHREADS + cx.tid; i < (unsigned)L * 65536; i += (unsigned)cx.nb * NTHREADS) {
            const int l = i >> 16, e = i & 65535, j = e & 255, ii = e >> 8;
            float v; bf16_t* dst;
            if (ii < 64) { v = PIN(I_W2)[(size_t)l * 16384 + ii * 256 + j]; dst = LT + (size_t)l * 65536 + j * 64 + ii; }
            else if (ii < 128) { v = PIN(I_A2)[(size_t)l * 16384 + (ii - 64) * 256 + j]; dst = LT + (size_t)l * 65536 + 16384 + j * 64 + (ii - 64); }
            else { v = PIN(I_G2)[(size_t)l * 32768 + (ii - 128) * 256 + j]; dst = LT + (size_t)l * 65536 + 32768 + j * 128 + (ii - 128); }
            *dst = f2bf(v);
        }
        bf16_t* WD = (bf16_t*)(p.ws + z + WS_WDTT);
        for (unsigned i = (unsigned)cx.bid * NTHREADS + cx.tid; i < (unsigned)L * 16384; i += (unsigned)cx.nb * NTHREADS) {
            const int l = i >> 14, j = (i >> 10) & 15, k = i & 1023;
            WD[i] = j < 8 ? f2bf(PIN(I_WIN)[(size_t)l * D * PROJ + (size_t)k * PROJ + PCOLS + j]) : (bf16_t)0;
        }
    }
    const int lane = cx.tid & 63, wave = cx.tid >> 6;
    LAS float* scr = (LAS float*)(lds + wave * 16384);
    const int gw = flip_bid(cx) * NWAVES + wave, NGW = cx.nb * NWAVES;
    constexpr int I_IN = 16 * 96, I_OUT = 16 * 32, I_UP = 16 * 176, I_DN = 44 * 32, PER_L = I_IN + I_OUT + I_UP + I_DN;
    for (int it = gw; it < (l_hi - l_lo) * PER_L; it += NGW) {
        const int l = l_lo + it / PER_L; int r = it % PER_L;
        if (r < I_IN) { p0_transpose_item(PIN(I_WIN) + (size_t)l * D * PROJ, PROJ, D, 96, (bf16_t*)(p.ws + z + WS_WIN) + (size_t)l * PCOLS * D, scr, r, lane); continue; } r -= I_IN;
        if (r < I_OUT) { p0_transpose_item(PIN(I_WOUT) + (size_t)l * D * D, D, D, 32, (bf16_t*)(p.ws + z + WS_WOUT) + (size_t)l * D * D, scr, r, lane); continue; } r -= I_OUT;
        if (r < I_UP) { p0_transpose_item<true>(PIN(I_WUP) + (size_t)l * D * 5632, 5632, D, 176, (bf16_t*)(p.ws + z + WS_WUP) + (size_t)l * 5632 * D, scr, r, lane); continue; } r -= I_UP;
        p0_transpose_item(PIN(I_WDOWN) + (size_t)l * DFF * D, D, DFF, 32, (bf16_t*)(p.ws + z + WS_WDN) + (size_t)l * D * DFF, scr, r, lane);
    }
}

template <int NT, class F>
__device__ __forceinline__ void gemm_small(const Params& p, const bf16_t* A, int lda, const bf16_t* Bt, int N, int K, int ksplit, const F& epi) {
    const Ctx cx = mkctx(p); A += cx.z; Bt += cx.z;
    const int lane = cx.tid & 63, wave = __builtin_amdgcn_readfirstlane(cx.tid >> 6), r = lane & 15, q = lane >> 4;
    const int ntile = N / (16 * NT), kc = K / ksplit;
    for (int task = cx.nb - 1 - cx.bid; task < ntile * ksplit; task += cx.nb) {
        const int tn = task % ntile, ks = task / ntile, n0 = tn * 16 * NT, k0 = ks * kc;
        const bf16_t* ap = A + (size_t)(16 * wave + r) * lda + k0 + 8 * q;
        const bf16_t* bp = Bt + (size_t)(n0 + r) * K + k0 + 8 * q;
        f32x4 acc[NT];
#pragma unroll
        for (int nt = 0; nt < NT; ++nt) acc[nt] = (f32x4){0.f, 0.f, 0.f, 0.f};
#pragma unroll 8
        for (int s2 = 0; s2 < kc / 32; ++s2) {
            const bf16x8 fa = *(const bf16x8*)(ap + 32 * s2);
#pragma unroll
            for (int nt = 0; nt < NT; ++nt) { const bf16x8 fb = *(const bf16x8*)(bp + (size_t)nt * 16 * K + 32 * s2); acc[nt] = __builtin_amdgcn_mfma_f32_16x16x32_bf16(fb, fa, acc[nt], 0, 0, 0); }
        }
#pragma unroll
        for (int nt = 0; nt < NT; ++nt) epi(16 * wave + r, n0 + 16 * nt + 4 * q, acc[nt]);
    }
}
struct SmallBf { bf16_t* O; int ldc; __device__ __forceinline__ void operator()(int row, int col, f32x4 v) const { *(bf16x4*)(O + (size_t)(MP + row) * ldc + col) = pack4(v); } };
struct SmallRes { float* X; const float* gate;   __device__ __forceinline__ void operator()(int row, int col, f32x4 v) const {
    const f32x4 g = *(const f32x4*)(gate + (size_t)(NP + row) * 6144 + col); float* x = X + (size_t)(MP + row) * D + col;
#pragma unroll
    for (int e = 0; e < 4; ++e) unsafeAtomicAdd(x + e, g[e] * v[e]); } };

__device__ __forceinline__ void stage_dtgemm(const Params& p, int l) {
    const Ctx cx = mkctx(p); const size_t z = cx.z;
    const int lane = cx.tid & 63, wave = __builtin_amdgcn_readfirstlane(cx.tid >> 6), r = lane & 15, q = lane >> 4;
    const bf16_t* H = (const bf16_t*)(p.ws + z + WS_H); const bf16_t* WD = (const bf16_t*)(p.ws + z + WS_WDTT) + (size_t)l * 16384;
    float* DT = (float*)(p.ws + z + WS_DT);
    for (int task = cx.nb - 1 - cx.bid; task < R / 128; task += cx.nb) {
        const int row = task * 128 + 16 * wave + r;
        const bf16_t* hp = H + (size_t)row * D + 8 * q; const bf16_t* wp = WD + r * 1024 + 8 * q;
        f32x4 acc = {0.f, 0.f, 0.f, 0.f};
#pragma unroll 8
        for (int s2 = 0; s2 < 32; ++s2) { const bf16x8 fa = *(const bf16x8*)(hp + 32 * s2), fb = *(const bf16x8*)(wp + 32 * s2); acc = __builtin_amdgcn_mfma_f32_16x16x32_bf16(fb, fa, acc, 0, 0, 0); }
        if (q < 2) *(f32x4*)(DT + (size_t)row * 8 + 4 * q) = acc;
    }
}

#define RLX_AGENT __ATOMIC_RELAXED, __HIP_MEMORY_SCOPE_AGENT
#define XB_TMO      128
#define XB_XCNT(j)  (256  + 64 * (j))
#define XB_XSUB(j)  (1280 + 64 * (j))
#define XB_XGEN(j)  (2304 + 64 * (j))
#define XB_TOP      3328
#define XB_TOPGEN   3392
#define XCD_BAR_WORDS 3456
#define XB_SPIN_CAP (1u << 18)

__device__ __forceinline__ unsigned xb_ld(unsigned* p)              { return __hip_atomic_load(p, __ATOMIC_RELAXED, __HIP_MEMORY_SCOPE_AGENT); }
__device__ __forceinline__ unsigned xb_add(unsigned* p, unsigned v) { return __hip_atomic_fetch_add(p, v, __ATOMIC_RELAXED, __HIP_MEMORY_SCOPE_AGENT); }
__device__ __forceinline__ unsigned xb_xcc_id() { return (unsigned)__builtin_amdgcn_s_getreg((3 << 11) | 20) & 0xFu; }
#define XB_SPIN(cond, bar) do { unsigned _sp = 0; while (cond) { __builtin_amdgcn_s_sleep(1); \
    if ((++_sp & 255u) == 0u) { if (xb_ld(&(bar)[XB_TMO])) break; if (_sp > XB_SPIN_CAP) { atomicAdd(&(bar)[XB_TMO], 1u); break; } } } } while (0)

struct XcdBarrier {
    unsigned* bar; unsigned x; int wave;
    volatile LAS unsigned* st;
};

__device__ __forceinline__ XcdBarrier xcd_barrier_post(unsigned* bar, volatile LAS unsigned* st, int wave) {
    XcdBarrier b; b.bar = bar; b.x = xb_xcc_id(); b.st = st; b.wave = wave;
    if (wave == 0 && lane_id() == 0) (void)xb_add(&bar[XB_XCNT(b.x)], 1u);
    return b;
}
__device__ __forceinline__ void xcd_barrier_complete(unsigned* bar, unsigned x, unsigned& nloc, unsigned& nx) {
    const unsigned G = gridDim.x * gridDim.y * gridDim.z;
    unsigned sum, cnt, mine, sp = 0u;
    for (;;) {
        sum = 0u; cnt = 0u; mine = 0u;
#pragma unroll
        for (unsigned j = 0; j < 16; ++j) { const unsigned c = xb_ld(&bar[XB_XCNT(j)]); sum += c; cnt += (c > 0u) ? 1u : 0u; mine = (j == x) ? c : mine; }
        if (sum == G) break;
        __builtin_amdgcn_s_sleep(1);
        if ((++sp & 255u) == 0u) { if (xb_ld(&bar[XB_TMO])) break; if (sp > XB_SPIN_CAP) { atomicAdd(&bar[XB_TMO], 1u); break; } }
    }
    nloc = mine > 0u ? mine : 1u; nx = cnt > 0u ? cnt : 1u;
}

__device__ __forceinline__ void xcd_barrier(const XcdBarrier& b) {
    asm volatile("s_waitcnt vmcnt(0)" ::: "memory");
    __syncthreads();
    if (b.wave == 0 && lane_id() == 0) {
        unsigned* bar = b.bar;
        __builtin_amdgcn_s_waitcnt(0);
        unsigned nloc = b.st[0], nx = b.st[1];
        if (nloc == 0u) { xcd_barrier_complete(bar, b.x, nloc, nx); b.st[0] = nloc; b.st[1] = nx; }
        const unsigned old = xb_add(&bar[XB_XSUB(b.x)], 1u);
        const unsigned gen = old / nloc;
        if (old + 1u == (gen + 1u) * nloc) {
            __builtin_amdgcn_fence(__ATOMIC_RELEASE, "agent");
            asm volatile("s_waitcnt vmcnt(0)" ::: "memory");
            const unsigned og = xb_add(&bar[XB_TOP], 1u);
            const unsigned tg = og / nx;
            if (og + 1u == (tg + 1u) * nx) xb_add(&bar[XB_TOPGEN], 1u);
            else XB_SPIN(xb_ld(&bar[XB_TOPGEN]) == tg, bar);
            __builtin_amdgcn_fence(__ATOMIC_ACQUIRE, "agent");
            xb_add(&bar[XB_XGEN(b.x)], 1u);
            asm volatile("s_waitcnt vmcnt(0)" ::: "memory");
        } else {
            XB_SPIN(xb_ld(&bar[XB_XGEN(b.x)]) == gen, bar);
            __builtin_amdgcn_fence(__ATOMIC_ACQUIRE, "agent");
            asm volatile("s_waitcnt vmcnt(0)" ::: "memory");
        }
    }
    __syncthreads();
}

namespace cg = cooperative_groups;
constexpr int LDS_BYTES = 153600;
__global__ void __launch_bounds__(NTHREADS, 2) fwd_mega(Params p_in) {
    Params p = p_in; p.wave = __builtin_amdgcn_readfirstlane((int)(threadIdx.x >> 6));
    extern __shared__ __attribute__((aligned(16))) unsigned char lds[];
    cg::grid_group grid = cg::this_grid();
    float* ldsf = (float*)lds;
    volatile LAS unsigned* MISC = (volatile LAS unsigned*)((LAS unsigned char*)lds + LDS_BYTES - 64);
    if (p.wave == 0 && lane_id() < 16) MISC[lane_id()] = 0u;
    __syncthreads();
    const XcdBarrier bar = xcd_barrier_post((unsigned*)(p.ws + WS_CTL), MISC, p.wave);
#define GSYNC() xcd_barrier(bar)
    stage_init(p); stage_wconv(p, lds, 0, 1); __syncthreads(); stage_mod(p, lds, 0, L); grid.sync();
    for (int l = 0; l < L; ++l) {
        const float* MODl = (const float*)(p.ws + WS_MOD) + (size_t)l * NSEQ * 6144;
        if (l > 0) stage_norm_b(p, l, 0);
        stage_norm(p, l, 0, ldsf, l == 0); GSYNC();
        { pg8::Gemm g{(const bf16_t*)(p.ws + WS_H), (const bf16_t*)(p.ws + WS_WIN) + (size_t)l * PCOLS * D, MP, PCOLS, D}; pg8::StaticOrder S; S.init(MP, PCOLS, (int)gridDim.x, (int)blockIdx.x);
          pg8::EpiBf16<0> E{(bf16_t*)(p.ws + WS_P), PCOLS, nullptr, 0, 0, 1.f};
          pg8::gemm_phase<pg8::EpiBf16<0>, pg8::StaticOrder, true, true>((LAS unsigned char*)lds, g, S, E, (p.wave << 6) | lane_id()); }
        gemm_small<1>(p, (const bf16_t*)(p.ws + WS_H) + (size_t)MP * D, D, (const bf16_t*)(p.ws + WS_WIN) + (size_t)l * PCOLS * D, PCOLS, D, 1, SmallBf{(bf16_t*)(p.ws + WS_P), PCOLS});
        stage_dtgemm(p, l);
        GSYNC();
        stage_rwprep(p, l, ldsf); __syncthreads(); stage_rwprep2(p, l, lds); asm volatile("s_waitcnt vmcnt(0)" ::: "memory"); __syncthreads();
        stage_rw1(p, l, lds); stage_mconv(p, l); stage_qkn(p, l); stage_ssd1(p, l, lds); GSYNC();
        stage_rw2(p, l, lds); stage_ssd2(p, l); stage_att(p, l, RW2_WGS); stage_rwscan(p, l, ldsf, RW2_WGS); stage_mscan(p, l, ldsf, RW2_WGS);
        if (l + 1 < L) { __syncthreads(); stage_wconv(p, lds, l + 1, l + 2, RW2_WGS); }
        GSYNC();
        stage_ssd3(p, l, lds, 0, 128); stage_rw3(p, l, 128); stage_attn(p, l, lds, 128); stage_mgate_sample(p, l, 128); GSYNC();
        { pg8::Gemm g{(const bf16_t*)(p.ws + WS_YCAT), (const bf16_t*)(p.ws + WS_WOUT) + (size_t)l * D * D, MP, D, D}; pg8::StaticOrder S; S.init(MP, D, (int)gridDim.x, (int)blockIdx.x);
          pg8::EpiResGate E{p.out, p.in[I_XP], (bf16_t*)(p.ws + WS_XB), MODl + 2048, l == 0, 0, 13, 6144};
          pg8::gemm_phase<pg8::EpiResGate, pg8::StaticOrder, true, true>((LAS unsigned char*)lds, g, S, E, (p.wave << 6) | lane_id()); }
        gemm_small<1>(p, (const bf16_t*)(p.ws + WS_YCAT) + (size_t)MP * D, D, (const bf16_t*)(p.ws + WS_WOUT) + (size_t)l * D * D, D, D, 4, SmallRes{p.out, MODl + 2048});
        GSYNC();
        stage_norm_b(p, l, 1); stage_norm(p, l, 1, ldsf, false); GSYNC();
        { pg8::Gemm g{(const bf16_t*)(p.ws + WS_H), (const bf16_t*)(p.ws + WS_WUP) + (size_t)l * 5632 * D, MPAD, 5632, D}; pg8::StaticOrder S; S.init(MPAD, 5632, (int)gridDim.x, (int)blockIdx.x);
          pg8::EpiGlu E{(bf16_t*)(p.ws + WS_GV), (bf16_t*)(p.ws + WS_U), p.in[I_FCW] + (size_t)l * 3 * DFF, p.in[I_FCB] + (size_t)l * DFF};
          pg8::gemm_phase<pg8::EpiGlu, pg8::StaticOrder, true, true>((LAS unsigned char*)lds, g, S, E, (p.wave << 6) | lane_id()); }
        stage_cachecopy(p, l, 150);
        GSYNC();
        stage_glu(p, l); GSYNC();
        { pg8::Gemm g{(const bf16_t*)(p.ws + WS_U), (const bf16_t*)(p.ws + WS_WDN) + (size_t)l * D * DFF, MP, D, DFF}; pg8::StaticOrder S; S.init(MP, D, (int)gridDim.x, (int)blockIdx.x);
          pg8::EpiResGate E{p.out, p.in[I_XP], (bf16_t*)(p.ws + WS_XB), MODl + 5120, 0, l == L - 1, 13, 6144};
          pg8::gemm_phase<pg8::EpiResGate, pg8::StaticOrder, true, true>((LAS unsigned char*)lds, g, S, E, (p.wave << 6) | lane_id()); }
        gemm_small<1>(p, (const bf16_t*)(p.ws + WS_U) + (size_t)MP * DFF, DFF, (const bf16_t*)(p.ws + WS_WDN) + (size_t)l * D * DFF, D, DFF, 4, SmallRes{p.out, MODl + 5120});
        GSYNC();
    }
}

extern "C" void kernel_launch(void* const* d_in, const int* in_sizes, int n_in, void* d_out, int out_size, void* d_ws, size_t ws_size, hipStream_t stream) {
    static int grid = 0;
    if (grid == 0) {
        if (n_in != N_IN || (size_t)out_size != O_END || ws_size < WS_END) { fprintf(stderr, "kernel_launch: unexpected sizes n_in %d out %d ws %zu\n", n_in, out_size, ws_size); grid = -1; return; }
        int dev = 0, cus = 0, per_cu = 0;
        hipGetDevice(&dev); hipDeviceGetAttribute(&cus, hipDeviceAttributeMultiprocessorCount, dev);
        if (hipFuncSetAttribute((const void*)fwd_mega, hipFuncAttributeMaxDynamicSharedMemorySize, LDS_BYTES) != hipSuccess) { fprintf(stderr, "hipFuncSetAttribute failed\n"); grid = -1; return; }
        hipOccupancyMaxActiveBlocksPerMultiprocessor(&per_cu, (const void*)fwd_mega, NTHREADS, LDS_BYTES);
        if (per_cu < 1) { fprintf(stderr, "occupancy query says %d blocks per CU\n", per_cu); grid = -1; return; }
        grid = cus;
    }
    if (grid < 0) return;
    Params p{};
    for (int i = 0; i < N_IN; ++i) p.in[i] = (const float*)d_in[i];
    p.out = (float*)d_out; p.ws = (unsigned char*)d_ws;
    if (hipMemsetAsync((char*)d_ws + WS_CTL, 0, 16384, stream) != hipSuccess) { fprintf(stderr, "memset of the barrier words failed\n"); return; }
    void* args[] = {&p};
    hipError_t e = hipLaunchCooperativeKernel((void*)fwd_mega, dim3(grid), dim3(NTHREADS), args, LDS_BYTES, stream);
    if (e != hipSuccess) fprintf(stderr, "cooperative launch failed: %s\n", hipGetErrorString(e));
}
```

```cpp
#include <hip/hip_runtime.h>
#include <hip/hip_cooperative_groups.h>
#include <cstdint>
#include <cstdio>

typedef unsigned short bf16_t;
__device__ __forceinline__ float bf2f(bf16_t v) { return __uint_as_float(((unsigned)v) << 16); }
typedef float f32x2_t __attribute__((ext_vector_type(2)));
typedef __bf16 bf16x2_t __attribute__((ext_vector_type(2)));
__device__ __forceinline__ unsigned cvtpk(float lo, float hi) { const f32x2_t v = {lo, hi}; const bf16x2_t b = __builtin_convertvector(v, bf16x2_t); return __builtin_bit_cast(unsigned, b); }
__device__ __forceinline__ bf16_t f2bf(float f) { return (bf16_t)cvtpk(f, 0.f); }

constexpr int D = 1024, NP = 2, T = 8192, MP = NP * T, NS = 128, R = MP + NS, NSEQ = NP + NS, L = 4;
constexpr int PROJ = 3080, PCOLS = 3072, DFF = 2816;
constexpr int OFF_B = 1024, OFF_Z = 1536, OFF_XBC = 2048;
constexpr float NORM_EPS = 1e-6f, GN_EPS = 64e-5f;
constexpr int NTHREADS = 512, NWAVES = 8;
typedef short bf16x8 __attribute__((ext_vector_type(8)));
typedef short bf16x4 __attribute__((ext_vector_type(4)));
typedef float f32x4 __attribute__((ext_vector_type(4)));
__device__ __forceinline__ bf16x4 pack4(f32x4 v) { typedef unsigned u32x2_t __attribute__((ext_vector_type(2))); const u32x2_t w = {cvtpk(v[0], v[1]), cvtpk(v[2], v[3])}; return __builtin_bit_cast(bf16x4, w); }
constexpr int LD = 72, MSZ = 64 * LD;
constexpr int LD2 = 136;

enum { I_XP = 0, I_XS, I_CP, I_CS, I_SHIFT, I_WKV, I_CK, I_CV, I_SCONV, I_SSM, I_FCONV, I_ADAW, I_ADAB, I_NMIXG, I_NFFNG, I_WIN, I_WOUT,
       I_MU, I_W0, I_W2, I_A0, I_A2, I_G2, I_KK, I_KA, I_RK, I_LNG, I_LNB, I_QNG, I_KNG, I_SINK, I_CONVW, I_CONVB, I_DTB, I_ALOG, I_SSMD, I_SSMNG,
       I_WUP, I_FCW, I_FCB, I_WDOWN, N_IN };

constexpr size_t O_YP = 0;
constexpr size_t O_YS = O_YP + (size_t)MP * D;
constexpr size_t O_PSHIFT = O_YS + (size_t)NS * D;
constexpr size_t O_PWKV = O_PSHIFT + (size_t)L * NP * 1024;
constexpr size_t O_PK = O_PWKV + (size_t)L * NP * 4 * 64 * 64;
constexpr size_t O_PV = O_PK + (size_t)L * NP * 128 * 128;
constexpr size_t O_PCONV = O_PV + (size_t)L * NP * 128 * 128;
constexpr size_t O_PSSM = O_PCONV + (size_t)L * NP * 3 * 1024;
constexpr size_t O_PFFN = O_PSSM + (size_t)L * NP * 8 * 64 * 128;
constexpr size_t O_SSHIFT = O_PFFN + (size_t)L * NP * 2 * DFF;
constexpr size_t O_SWKV = O_SSHIFT + (size_t)L * NS * 1024;
constexpr size_t O_SK = O_SWKV + (size_t)L * NS * 4 * 64 * 64;
constexpr size_t O_SV = O_SK + (size_t)L * NS * 128 * 128;
constexpr size_t O_SCONV = O_SV + (size_t)L * NS * 128 * 128;
constexpr size_t O_SSSM = O_SCONV + (size_t)L * NS * 3 * 1024;
constexpr size_t O_SFFN = O_SSSM + (size_t)L * NS * 8 * 64 * 128;
constexpr size_t O_END = O_SFFN + (size_t)L * NS * 2 * DFF;

constexpr size_t MiB = 1u << 20;
constexpr int MPAD = 16640;
constexpr size_t WS_XB = 0;
constexpr size_t WS_X = 0;
constexpr size_t WS_H = 65 * MiB;
constexpr size_t WS_YCAT = WS_H;
constexpr size_t WS_MOD = 98 * MiB;
constexpr size_t WS_P = 111 * MiB;
constexpr size_t WS_DT = 209 * MiB;
constexpr size_t WS_GV = 210 * MiB;
constexpr size_t WS_U = 389 * MiB;
constexpr size_t WS_WIN = 479 * MiB;
constexpr size_t WS_WOUT = 503 * MiB;
constexpr size_t WS_WUP = 511 * MiB;
constexpr size_t WS_WDN = 555 * MiB;
constexpr size_t WS_RWC_Y0 = 578 * MiB;
constexpr size_t WS_CTL = 595 * MiB;
constexpr size_t WS_LORA = 596 * MiB;
constexpr size_t WS_WDTT = WS_LORA + 512 * 1024;
constexpr size_t WS_DT2 = 597 * MiB;
constexpr size_t WS_END = 598 * MiB;
constexpr size_t WS_RWC_RP = WS_U + 65 * MiB;
constexpr size_t WS_RWC_MC = WS_RWC_RP + 8 * MiB;
constexpr size_t WS_RWC_NCT = WS_RWC_MC + 8 * MiB;
static_assert(WS_RWC_NCT + 8 * MiB <= WS_WIN, "rwkv chunk buffers fit the U region tail");
constexpr size_t WS_RW = WS_GV;
constexpr size_t WS_RWD = WS_RW + 49 * MiB;
constexpr size_t WS_HPREV = WS_RW + 70 * MiB;
constexpr size_t WS_QN = WS_RW + 113 * MiB;
constexpr size_t WS_KN = WS_QN + 17 * MiB;
constexpr size_t WS_YTMP = WS_KN + 9 * MiB;
static_assert(WS_YTMP + (size_t)R * 512 * 4 <= WS_U, "mixer temporaries fit the GV region");
constexpr size_t WS_XBCC = WS_U;
constexpr size_t WS_SST = WS_U + 33 * MiB;
static_assert(WS_XBCC + (size_t)R * 1024 * 2 <= WS_SST && WS_SST + 32 * MiB <= WS_RWC_RP, "xbc / ssd states fit the U region");
constexpr size_t WS_SCD = WS_RWC_Y0 + 16 * MiB;

struct Params {
    const float* in[N_IN];
    float* out;
    unsigned char* ws;
    int wave, pad;
};

__device__ __forceinline__ int seq_of_row(int row) { return row < MP ? (row >> 13) : (NP + row - MP); }
__device__ __forceinline__ float wave_sum(float v) {
#pragma unroll
    for (int o = 1; o < 64; o <<= 1) v += __shfl_xor(v, o);
    return v;
}
__device__ __forceinline__ float wave_max(float v) {
#pragma unroll
    for (int o = 1; o < 64; o <<= 1) v = fmaxf(v, __shfl_xor(v, o));
    return v;
}
__device__ __forceinline__ float silu_f(float x) { return x * __builtin_amdgcn_rcpf(1.f + __expf(-x)); }
__device__ __forceinline__ float sigmoid_f(float x) { return __builtin_amdgcn_rcpf(1.f + __expf(-x)); }
__device__ __forceinline__ float tanh_fast(float x) { return 1.f - 2.f * __builtin_amdgcn_rcpf(1.f + __expf(2.f * x)); }
__device__ __forceinline__ float softplus_fast(float x) { return fmaxf(x, 0.f) + __logf(1.f + __expf(-fabsf(x))); }
__device__ __forceinline__ float softplus_f(float x) { return fmaxf(x, 0.f) + log1pf(__expf(-fabsf(x))); }

namespace pg8 {
#define PG8_LAS __attribute__((address_space(3)))
typedef unsigned short bf16_t;
typedef short bf16x8 __attribute__((ext_vector_type(8)));
typedef float f32x4 __attribute__((ext_vector_type(4)));
typedef unsigned u32x4 __attribute__((ext_vector_type(4)));
constexpr int BM = 256, BK = 64, HALF = 128, HTB = HALF * BK * 2  , STAGE_BYTES = 8 * HTB, NXCD = 8, WGM = 8;

__host__ __device__ __forceinline__ int lds_byte(int r, int c) { const int st = (r >> 4) * 2 + (c >> 5), rr = r & 15, cc = c & 31, ob = rr * 64 + cc * 2; return st * 1024 + (ob ^ (((ob >> 9) & 1) << 5)); }
__host__ __device__ __forceinline__ void stage_rc(int b, int& R, int& C) { const int st = b / 1024, sb = b % 1024, swz = sb ^ (((sb >> 9) & 1) << 5); R = (st >> 1) * 16 + swz / 64; C = (st & 1) * 32 + (swz % 64) / 2; }
__host__ __device__ __forceinline__ int perm32(int rho) { const int n = rho >> 4, i = rho & 15; return 8 * (i >> 2) + 4 * n + (i & 3); }

struct Unit { int pm, pn; };
struct Gemm { const bf16_t* A; const bf16_t* Bt; int M, N, K; };

struct StaticOrder {
    int nM, nN, nwg, G, c;
    __host__ __device__ void init(int M, int N, int G_, int c_) { nM = M / BM; nN = N / BM; nwg = nM * nN; G = G_; c = c_; }
    __host__ __device__ bool next(int i, Unit& u) const {
        const long L = (long)i * G + c; if (L >= nwg) return false;
        int wgid = (int)L; { const int q = nwg / NXCD, r = nwg % NXCD, xcd = wgid % NXCD, off = wgid / NXCD; wgid = (xcd < r ? xcd * (q + 1) : r * (q + 1) + (xcd - r) * q) + off; }
        const int nig = WGM * nN, gid = wgid / nig, fm = gid * WGM, gsz = (nM - fm) < WGM ? (nM - fm) : WGM;
        u.pm = fm + ((wgid % nig) % gsz); u.pn = (wgid % nig) / gsz; return true;
    }
    __device__ __forceinline__ void a_ready(const Unit&) const {}
    __device__ __forceinline__ void done(const Unit&) const {}
};

__device__ __forceinline__ unsigned cvt_pk_bf16(float lo, float hi) { unsigned r; asm volatile("v_cvt_pk_bf16_f32 %0, %1, %2" : "=v"(r) : "v"(lo), "v"(hi)); return r; }
typedef float f32x2 __attribute__((ext_vector_type(2)));
__device__ __forceinline__ f32x2 gelu_pk(f32x2 v) {
    const f32x2 av = __builtin_elementwise_abs(v), d = av * 0.2316418882f + 1.0f;
    f32x2 t; t.x = __builtin_amdgcn_rcpf(d.x); t.y = __builtin_amdgcn_rcpf(d.y);
    f32x2 q = t * 0.5307027145f + (-0.7265760135f); q = q * t + 0.7107068705f; q = q * t + (-0.142248368f); q = q * t + 0.127414796f; q = q * t;
    const f32x2 s = (v * v) * (-0.72134752044f);
    f32x2 e; e.x = __builtin_amdgcn_exp2f(s.x); e.y = __builtin_amdgcn_exp2f(s.y);
    const f32x2 m = v * (q * e), r = v - m;
    f32x2 o; o.x = v.x < 0.f ? m.x : r.x; o.y = v.y < 0.f ? m.y : r.y; return o;
}

template <int ACT  > struct EpiBf16 {
    static constexpr bool PERM = true, AFTER_DRAIN = false; static_assert(ACT == 0 || ACT == 1, "EpiBf16: ACT is 0 (none) or 1 (gelu_pk)");
    bf16_t* O; int ldc; const float* bias; int split_cols; size_t split_stride; float scale0;
    __device__ __forceinline__ void operator()(const f32x4 (&acc)[2][2][4][2], const Unit& u, int wr, int wc, int fr, int fq) const {
        const int row0 = u.pm * BM + wr * 64 + fr; int colt = u.pn * BM; bf16_t* base = O;
        float sc = 1.f; if (split_cols) { const int t = colt / split_cols; base += (size_t)t * split_stride; colt -= t * split_cols; if (t == 0) sc = scale0; }
        const int col0 = colt + wc * 32 + 8 * fq, bcol0 = u.pn * BM + wc * 32 + 8 * fq;
        f32x4 bv[2][2];
#pragma unroll
        for (int bj = 0; bj < 2; ++bj)
#pragma unroll
            for (int n = 0; n < 2; ++n) bv[bj][n] = bias ? *(const f32x4*)(bias + bcol0 + bj * HALF + 4 * n) : (f32x4){0.f, 0.f, 0.f, 0.f};
#pragma unroll
        for (int ai = 0; ai < 2; ++ai)
#pragma unroll
            for (int m = 0; m < 4; ++m) { bf16_t* rowp = base + (size_t)(row0 + ai * HALF + m * 16) * ldc + col0;
#pragma unroll
                for (int bj = 0; bj < 2; ++bj) { f32x4 v0 = acc[ai][bj][m][0] + bv[bj][0], v1 = acc[ai][bj][m][1] + bv[bj][1];
                    if (ACT == 1) { f32x2 a = gelu_pk((f32x2){v0[0], v0[1]}), b = gelu_pk((f32x2){v0[2], v0[3]}), c = gelu_pk((f32x2){v1[0], v1[1]}), d = gelu_pk((f32x2){v1[2], v1[3]});
                        v0 = (f32x4){a.x, a.y, b.x, b.y}; v1 = (f32x4){c.x, c.y, d.x, d.y}; }
                    v0 = v0 * sc; v1 = v1 * sc; u32x4 w; w.x = cvt_pk_bf16(v0[0], v0[1]); w.y = cvt_pk_bf16(v0[2], v0[3]); w.z = cvt_pk_bf16(v1[0], v1[1]); w.w = cvt_pk_bf16(v1[2], v1[3]);
                    *(u32x4*)(rowp + bj * HALF) = w; } }
    }
};

__device__ __forceinline__ float dpp_shr(float cur, float prevblk, int n  ) {
    const int c = __builtin_bit_cast(int, cur), pb = __builtin_bit_cast(int, prevblk);
    int t;
    if (n == 1) { t = __builtin_amdgcn_update_dpp(0, pb, 0x121, 0xf, 0xf, false); t = __builtin_amdgcn_update_dpp(t, c, 0x111, 0xf, 0xf, false); }
    else        { t = __builtin_amdgcn_update_dpp(0, pb, 0x122, 0xf, 0xf, false); t = __builtin_amdgcn_update_dpp(t, c, 0x112, 0xf, 0xf, false); }
    return __builtin_bit_cast(float, t);
}
struct EpiGlu {
    static constexpr bool PERM = true, AFTER_DRAIN = false;
    bf16_t* GV; bf16_t* U; const float* cw; const float* cb;
    __device__ __forceinline__ void operator()(const f32x4 (&acc)[2][2][4][2], const Unit& u, int wr, int wc, int fr, int fq) const {
        const int row0 = u.pm * BM + wr * 64 + fr, x0 = wc * 32 + 8 * fq, ch0 = u.pn * HALF + x0;
        if (u.pm * BM >= MP) {
#pragma unroll
            for (int m = 0; m < 4; ++m) {
                bf16_t* gp = GV + (size_t)(row0 + m * 16) * 5632 + u.pn * BM + x0;
                u32x4 wg, wv;
                wg.x = cvt_pk_bf16(acc[0][0][m][0][0], acc[0][0][m][0][1]); wg.y = cvt_pk_bf16(acc[0][0][m][0][2], acc[0][0][m][0][3]); wg.z = cvt_pk_bf16(acc[0][0][m][1][0], acc[0][0][m][1][1]); wg.w = cvt_pk_bf16(acc[0][0][m][1][2], acc[0][0][m][1][3]);
                wv.x = cvt_pk_bf16(acc[0][1][m][0][0], acc[0][1][m][0][1]); wv.y = cvt_pk_bf16(acc[0][1][m][0][2], acc[0][1][m][0][3]); wv.z = cvt_pk_bf16(acc[0][1][m][1][0], acc[0][1][m][1][1]); wv.w = cvt_pk_bf16(acc[0][1][m][1][2], acc[0][1][m][1][3]);
                *(u32x4*)gp = wg; *(u32x4*)(gp + HALF) = wv;
            }
            return;
        }
        f32x4 w0[2], w1[2], w2[2], bb[2];
#pragma unroll
        for (int n = 0; n < 2; ++n) { w0[n] = *(const f32x4*)(cw + ch0 + 4 * n); w1[n] = *(const f32x4*)(cw + 2816 + ch0 + 4 * n); w2[n] = *(const f32x4*)(cw + 5632 + ch0 + 4 * n); bb[n] = *(const f32x4*)(cb + ch0 + 4 * n); }
#pragma unroll
        for (int ai = 0; ai < 2; ++ai)
#pragma unroll
            for (int m = 0; m < 4; ++m) {
                const int row = row0 + ai * HALF + m * 16;
                bf16_t* gp = GV + (size_t)row * 5632 + u.pn * BM + x0;
                u32x4 wu;
#pragma unroll
                for (int n = 0; n < 2; ++n) {
                    const f32x4 g = acc[ai][0][m][n], v = acc[ai][1][m][n], pv = acc[ai][0][m > 0 ? m - 1 : 0][n];
                    float o[4];
#pragma unroll
                    for (int e = 0; e < 4; ++e) {
                        const float g1 = dpp_shr(g[e], pv[e], 1), g2 = dpp_shr(g[e], pv[e], 2);
                        const float a = bb[n][e] + w0[n][e] * g2 + w1[n][e] * g1 + w2[n][e] * g[e];
                        o[e] = a * __builtin_amdgcn_rcpf(1.f + __expf(-a)) * v[e];
                    }
                    if (n == 0) { wu.x = cvt_pk_bf16(o[0], o[1]); wu.y = cvt_pk_bf16(o[2], o[3]); } else { wu.z = cvt_pk_bf16(o[0], o[1]); wu.w = cvt_pk_bf16(o[2], o[3]); }
                }
                if (m > 0 || fr >= 2) *(u32x4*)(U + (size_t)row * 2816 + ch0) = wu;
                u32x4 wg, wv;
                wg.x = cvt_pk_bf16(acc[ai][0][m][0][0], acc[ai][0][m][0][1]); wg.y = cvt_pk_bf16(acc[ai][0][m][0][2], acc[ai][0][m][0][3]); wg.z = cvt_pk_bf16(acc[ai][0][m][1][0], acc[ai][0][m][1][1]); wg.w = cvt_pk_bf16(acc[ai][0][m][1][2], acc[ai][0][m][1][3]);
                wv.x = cvt_pk_bf16(acc[ai][1][m][0][0], acc[ai][1][m][0][1]); wv.y = cvt_pk_bf16(acc[ai][1][m][0][2], acc[ai][1][m][0][3]); wv.z = cvt_pk_bf16(acc[ai][1][m][1][0], acc[ai][1][m][1][1]); wv.w = cvt_pk_bf16(acc[ai][1][m][1][2], acc[ai][1][m][1][3]);
                if ((m == 0 && fr < 2) || (m == 3 && fr >= 14)) { *(u32x4*)gp = wg; *(u32x4*)(gp + HALF) = wv; }
            }
    }
};

struct EpiResGate {
    static constexpr bool PERM = true, AFTER_DRAIN = false;
    float* Xf; const float* Xinf; bf16_t* Xb; const float* gate; int src_f32, dst_f32, seq_shift, gate_ld;
    __device__ __forceinline__ void operator()(const f32x4 (&acc)[2][2][4][2], const Unit& u, int wr, int wc, int fr, int fq) const {
        const int col0 = u.pn * BM + wc * 32 + 8 * fq;
#pragma unroll
        for (int ai = 0; ai < 2; ++ai)
#pragma unroll
            for (int m = 0; m < 4; ++m) {
                const int row = u.pm * BM + ai * HALF + wr * 64 + m * 16 + fr;
                const float* gp = gate + (size_t)(row >> seq_shift) * gate_ld + col0; const size_t off = (size_t)row * 1024 + col0;
#pragma unroll
                for (int bj = 0; bj < 2; ++bj) {
                    const f32x4 g0 = *(const f32x4*)(gp + bj * HALF), g1 = *(const f32x4*)(gp + bj * HALF + 4);
                    f32x4 x0, x1;
                    if (src_f32) { x0 = *(const f32x4*)(Xinf + off + bj * HALF); x1 = *(const f32x4*)(Xinf + off + bj * HALF + 4); }
                    else { const u32x4 w = *(const u32x4*)(Xb + off + bj * HALF);
                        x0 = (f32x4){__builtin_bit_cast(float, w.x << 16), __builtin_bit_cast(float, w.x & 0xffff0000u), __builtin_bit_cast(float, w.y << 16), __builtin_bit_cast(float, w.y & 0xffff0000u)};
                        x1 = (f32x4){__builtin_bit_cast(float, w.z << 16), __builtin_bit_cast(float, w.z & 0xffff0000u), __builtin_bit_cast(float, w.w << 16), __builtin_bit_cast(float, w.w & 0xffff0000u)}; }
                    x0 = x0 + g0 * acc[ai][bj][m][0]; x1 = x1 + g1 * acc[ai][bj][m][1];
                    if (dst_f32) { *(f32x4*)(Xf + off + bj * HALF) = x0; *(f32x4*)(Xf + off + bj * HALF + 4) = x1; }
                    else { u32x4 w; w.x = cvt_pk_bf16(x0[0], x0[1]); w.y = cvt_pk_bf16(x0[2], x0[3]); w.z = cvt_pk_bf16(x1[0], x1[1]); w.w = cvt_pk_bf16(x1[2], x1[3]); *(u32x4*)(Xb + off + bj * HALF) = w; }
                }
            }
    }
};
template <class Epi, class Sched, bool ALIGN_EPI = false, bool SP2 = false>
__device__ __forceinline__ void gemm_phase(PG8_LAS unsigned char* lds, const Gemm g, const Sched& S, const Epi& E, int tid_in) {
    int tid_ = tid_in; asm volatile("" : "+v"(tid_));
    const int tid = tid_, wid = __builtin_amdgcn_readfirstlane(tid >> 6), lane = tid & 63, wr = wid >> 2, wc = wid & 3, fr = lane & 15, fq = lane >> 4;
    const int K = g.K, nt = K / BK;
    unsigned voffA[2], voffB[2];
#pragma unroll
    for (int i = 0; i < 2; ++i) { int R, C; stage_rc(tid * 16 + i * 8192, R, C); const int Rb = Epi::PERM ? ((R & ~31) + perm32(R & 31)) : R;
        voffA[i] = (unsigned)(R * K + C) * 2u; voffB[i] = (unsigned)(Rb * K + C) * 2u; }
    const size_t kstep = (size_t)(BK * 2);
    const size_t hstep = (size_t)HALF * K * 2;
    const size_t tstep = 2 * hstep;
    const unsigned ldsw = (unsigned)wid * 1024u;
    const int aoff = lds_byte(wr * 64 + fr, fq * 8), boff = lds_byte(wc * 32 + fr, fq * 8);
#define PG8_SA(b, h) (((b) * 2 + (h)) * HTB)
#define PG8_SB(b, h) ((4 + (b) * 2 + (h)) * HTB)
#define PG8_STAGE(bufoff, gbase, voff) do { _Pragma("unroll") for (int _i = 0; _i < 2; ++_i) \
        __builtin_amdgcn_global_load_lds((const unsigned*)((const char*)(gbase) + (voff)[_i]), (PG8_LAS unsigned*)(lds + (bufoff) + ldsw + _i * 8192), 16, 0, 0); } while (0)
#define PG8_LDA(dst, b, h) do { _Pragma("unroll") for (int m = 0; m < 4; ++m) _Pragma("unroll") for (int k = 0; k < 2; ++k) dst[m][k] = *(const PG8_LAS bf16x8*)(lds + PG8_SA(b, h) + aoff + m * 2048 + k * 1024); } while (0)
#define PG8_LDB(dst, b, h) do { _Pragma("unroll") for (int n = 0; n < 2; ++n) _Pragma("unroll") for (int k = 0; k < 2; ++k) dst[n][k] = *(const PG8_LAS bf16x8*)(lds + PG8_SB(b, h) + boff + n * 2048 + k * 1024); } while (0)
#define PG8_MMA(ai, bj, At, Bt) do { __builtin_amdgcn_s_setprio(1); _Pragma("unroll") for (int m = 0; m < 4; ++m) _Pragma("unroll") for (int n = 0; n < 2; ++n) _Pragma("unroll") for (int k = 0; k < 2; ++k) \
        acc[ai][bj][m][n] = __builtin_amdgcn_mfma_f32_16x16x32_bf16(Bt[n][k], At[m][k], acc[ai][bj][m][n], 0, 0, 0); __builtin_amdgcn_s_setprio(0); } while (0)
#define PG8_WAIT_V(n) asm volatile("s_waitcnt vmcnt(" #n ")" ::: "memory")
#define PG8_WAIT_L(n) asm volatile("s_waitcnt lgkmcnt(" #n ")" ::: "memory")
#define PG8_BAR __builtin_amdgcn_s_barrier()
#define PG8_SCHED __builtin_amdgcn_sched_barrier(0)
    Unit cur, nxt; int ui = 0;
    if (!S.next(0, cur)) return;
    f32x4 acc[2][2][4][2];
#pragma unroll
    for (int a = 0; a < 2; ++a)
#pragma unroll
        for (int b = 0; b < 2; ++b)
#pragma unroll
            for (int m = 0; m < 4; ++m)
#pragma unroll
                for (int n = 0; n < 2; ++n) acc[a][b][m][n] = (f32x4){0.f, 0.f, 0.f, 0.f};
    bf16x8 At[4][2], B0[2][2], B1[2][2];
    const char* cA = (const char*)g.A + (size_t)cur.pm * tstep; const char* cB = (const char*)g.Bt + (size_t)cur.pn * tstep;
    S.a_ready(cur);
    if constexpr (SP2) {
        PG8_STAGE(PG8_SB(0, 0), cB, voffB); PG8_STAGE(PG8_SB(0, 1), cB + hstep, voffB); PG8_STAGE(PG8_SA(0, 0), cA, voffA); PG8_STAGE(PG8_SA(0, 1), cA + hstep, voffA);
        if (wr == 1) PG8_BAR;
        PG8_WAIT_V(2); PG8_BAR;
        PG8_STAGE(PG8_SB(1, 0), cB + kstep, voffB); PG8_STAGE(PG8_SA(1, 0), cA + kstep, voffA); PG8_STAGE(PG8_SB(1, 1), cB + hstep + kstep, voffB);
        PG8_WAIT_V(6); PG8_BAR;
    } else {
        PG8_STAGE(PG8_SB(0, 0), cB, voffB); PG8_STAGE(PG8_SA(0, 0), cA, voffA); PG8_STAGE(PG8_SB(0, 1), cB + hstep, voffB); PG8_STAGE(PG8_SA(0, 1), cA + hstep, voffA);
        if (wr == 1) PG8_BAR;
        PG8_WAIT_V(4); PG8_BAR;
        PG8_STAGE(PG8_SB(1, 0), cB + kstep, voffB); PG8_STAGE(PG8_SA(1, 0), cA + kstep, voffA); PG8_STAGE(PG8_SB(1, 1), cB + hstep + kstep, voffB);
        PG8_WAIT_V(6); PG8_BAR;
    }
    for (;;) {
        const bool has_next = S.next(ui + 1, nxt);
        const char* nA = has_next ? (const char*)g.A + (size_t)nxt.pm * tstep : cA; const char* nB = has_next ? (const char*)g.Bt + (size_t)nxt.pn * tstep : cB;
        for (int t = 0; t < nt; t += 2) {
            const bool last = (t == nt - 2);
            const char* a1 = cA + (size_t)(t + 1) * kstep;
            const char* a2 = last ? nA : cA + (size_t)(t + 2) * kstep; const char* b2 = last ? nB : cB + (size_t)(t + 2) * kstep;
            const char* a3 = a2 + kstep; const char* b3 = b2 + kstep;
            if (last && has_next) S.a_ready(nxt);
            if constexpr (SP2) {
            PG8_LDB(B0, 0, 0); PG8_LDB(B1, 0, 1); PG8_SCHED; PG8_LDA(At, 0, 0); PG8_STAGE(PG8_SA(1, 1), a1 + hstep, voffA);
            PG8_WAIT_V(8); PG8_WAIT_L(0); PG8_BAR; PG8_MMA(0, 0, At, B0); PG8_MMA(0, 1, At, B1); PG8_BAR; PG8_SCHED;
            PG8_LDA(At, 0, 1); PG8_STAGE(PG8_SB(0, 0), b2, voffB); PG8_STAGE(PG8_SB(0, 1), b2 + hstep, voffB); PG8_STAGE(PG8_SA(0, 0), a2, voffA);
            PG8_WAIT_V(8); PG8_WAIT_L(0); PG8_BAR; PG8_MMA(1, 0, At, B0); PG8_MMA(1, 1, At, B1); PG8_BAR; PG8_SCHED;
            PG8_LDB(B0, 1, 0); PG8_LDB(B1, 1, 1); PG8_SCHED; PG8_LDA(At, 1, 0); PG8_STAGE(PG8_SA(0, 1), a2 + hstep, voffA);
            PG8_WAIT_V(8); PG8_WAIT_L(0); PG8_BAR; PG8_MMA(0, 0, At, B0); PG8_MMA(0, 1, At, B1); PG8_BAR; PG8_SCHED;
            PG8_LDA(At, 1, 1); PG8_STAGE(PG8_SB(1, 0), b3, voffB); PG8_STAGE(PG8_SB(1, 1), b3 + hstep, voffB); PG8_STAGE(PG8_SA(1, 0), a3, voffA);
            PG8_WAIT_V(8); PG8_WAIT_L(0); PG8_BAR; PG8_MMA(1, 0, At, B0); PG8_MMA(1, 1, At, B1); PG8_BAR; PG8_SCHED;
            } else {
            PG8_LDB(B0, 0, 0); PG8_SCHED; PG8_LDA(At, 0, 0); PG8_STAGE(PG8_SA(1, 1), a1 + hstep, voffA);
            PG8_WAIT_L(8); PG8_BAR; PG8_WAIT_L(0); PG8_MMA(0, 0, At, B0); PG8_BAR; PG8_SCHED;
            PG8_LDB(B1, 0, 1); PG8_STAGE(PG8_SB(0, 0), b2, voffB);
            PG8_BAR; PG8_WAIT_L(0); PG8_MMA(0, 1, At, B1); PG8_BAR;
            PG8_LDA(At, 0, 1); PG8_STAGE(PG8_SA(0, 0), a2, voffA);
            PG8_BAR; PG8_WAIT_L(0); PG8_MMA(1, 0, At, B0); PG8_BAR; PG8_SCHED;
            PG8_STAGE(PG8_SB(0, 1), b2 + hstep, voffB);
            PG8_WAIT_V(6); PG8_BAR; PG8_MMA(1, 1, At, B1); PG8_BAR;
            PG8_LDB(B0, 1, 0); PG8_SCHED; PG8_LDA(At, 1, 0); PG8_STAGE(PG8_SA(0, 1), a2 + hstep, voffA);
            PG8_WAIT_L(8); PG8_BAR; PG8_WAIT_L(0); PG8_MMA(0, 0, At, B0); PG8_BAR; PG8_SCHED;
            PG8_LDB(B1, 1, 1); PG8_STAGE(PG8_SB(1, 0), b3, voffB);
            PG8_BAR; PG8_WAIT_L(0); PG8_MMA(0, 1, At, B1); PG8_BAR;
            PG8_LDA(At, 1, 1); PG8_STAGE(PG8_SA(1, 0), a3, voffA);
            PG8_BAR; PG8_WAIT_L(0); PG8_MMA(1, 0, At, B0); PG8_BAR; PG8_SCHED;
            PG8_STAGE(PG8_SB(1, 1), b3 + hstep, voffB);
            PG8_WAIT_V(6); PG8_BAR; PG8_MMA(1, 1, At, B1); PG8_BAR;
            }
        }
        if constexpr (ALIGN_EPI) { if (wr == 0) PG8_BAR; }
        if constexpr (!Epi::AFTER_DRAIN) { E(acc, cur, wr, wc, fr, fq); S.done(cur); }
        if (!has_next) break;
#pragma unroll
        for (int a = 0; a < 2; ++a)
#pragma unroll
            for (int b = 0; b < 2; ++b)
#pragma unroll
                for (int m = 0; m < 4; ++m)
#pragma unroll
                    for (int n = 0; n < 2; ++n) acc[a][b][m][n] = (f32x4){0.f, 0.f, 0.f, 0.f};
        cur = nxt; cA = nA; cB = nB; ++ui;
        if constexpr (ALIGN_EPI) { if (wr == 1) PG8_BAR; }
    }
    PG8_WAIT_V(0);
    if constexpr (!ALIGN_EPI) { if (wr == 0) PG8_BAR; }
    PG8_BAR;
    if constexpr (Epi::AFTER_DRAIN) { E.fused(acc, cur, wr, wc, fr, fq, lds, wid, lane); S.done(cur); }
#undef PG8_SA
#undef PG8_SB
#undef PG8_STAGE
#undef PG8_LDA
#undef PG8_LDB
#undef PG8_MMA
#undef PG8_WAIT_V
#undef PG8_WAIT_L
#undef PG8_BAR
#undef PG8_SCHED
}
}

struct Ctx { int tid, bid, nb; size_t z; };
__device__ __forceinline__ int lane_id() { return (int)__builtin_amdgcn_mbcnt_hi(~0u, __builtin_amdgcn_mbcnt_lo(~0u, 0u)); }
__device__ __forceinline__ Ctx mkctx(const Params& p, int first = 0, int count = 0) { Ctx c; c.tid = (p.wave << 6) | lane_id(); c.bid = blockIdx.x; c.nb = gridDim.x; c.z = 0; asm volatile("" : "+v"(c.tid), "+s"(c.bid), "+s"(c.nb), "+s"(c.z));
    if (first > 0 || count > 0) { const int hi = count > 0 ? first + count : c.nb; c.bid = (c.bid >= first && c.bid < hi) ? c.bid - first : (1 << 20); c.nb = hi - first; } return c; }
__device__ __forceinline__ int flip_bid(const Ctx& c) { return c.bid < c.nb ? c.nb - 1 - c.bid : (1 << 20); }
#define PIN(i) (p.in[i] + z)
__device__ __forceinline__ void stage_init(const Params& p) {
    const Ctx cx = mkctx(p); const size_t z = cx.z;
    const unsigned gt = (unsigned)cx.bid * NTHREADS + cx.tid, GT = (unsigned)cx.nb * NTHREADS;
    typedef float f4 __attribute__((ext_vector_type(4)));
    f4* X = (f4*)(p.out + z); const f4* xp = (const f4*)PIN(I_XP); const f4* xs = (const f4*)PIN(I_XS);
    (void)xp;
    for (unsigned i = gt; i < (unsigned)NS * (D / 4); i += GT) X[(unsigned)MP * (D / 4) + i] = xs[i];
}
__device__ __forceinline__ void stage_mod(const Params& p, unsigned char* lds, int l_lo, int l_hi, int first = 0) {
    const Ctx cx = mkctx(p, first); const size_t z = cx.z;
    float* MOD = (float*)(p.ws + z + WS_MOD);
    bf16_t* SCs = (bf16_t*)lds;
    bf16_t* WTs = (bf16_t*)(lds + 39168);
    const int lane = cx.tid & 63, wave = __builtin_amdgcn_readfirstlane(cx.tid >> 6), r = lane & 15, q = lane >> 4;
    const int lk = cx.tid >> 4, lj = (cx.tid & 15) * 8;
    for (int item = cx.bid; item < (l_hi - l_lo) * 48; item += cx.nb) {
        const int l = l_lo + item / 48, j0 = (item % 48) * 128;
        const float* w = PIN(I_ADAW) + (size_t)l * D * 6144 + j0 + lj;
        f32x4 acc[9];
#pragma unroll
        for (int i = 0; i < 9; ++i) acc[i] = (f32x4){0.f, 0.f, 0.f, 0.f};
        f32x4 n0 = *(const f32x4*)(w + (size_t)lk * 6144), n1 = *(const f32x4*)(w + (size_t)lk * 6144 + 4);
        __syncthreads();
#pragma unroll
        for (int e = 0; e < 4; ++e) { WTs[(lj + e) * 40 + lk] = f2bf(n0[e]); WTs[(lj + 4 + e) * 40 + lk] = f2bf(n1[e]); }
#pragma unroll 1
        for (int t = 0; t < 32; ++t) {
            if ((t & 3) == 0) {
                __syncthreads();
                for (int i = cx.tid; i < 144 * 16; i += NTHREADS) { const int sidx = i >> 4, k8 = (i & 15) * 8; bf16x8 o;
                    if (sidx < NSEQ) { const float* c = (sidx < NP ? PIN(I_CP) + (size_t)sidx * D : PIN(I_CS) + (size_t)(sidx - NP) * D) + (t >> 2) * 128 + k8;
                        const f32x4 c0 = *(const f32x4*)c, c1 = *(const f32x4*)(c + 4);
#pragma unroll
                        for (int e = 0; e < 4; ++e) { o[e] = (short)f2bf(silu_f(c0[e])); o[4 + e] = (short)f2bf(silu_f(c1[e])); } }
                    else o = (bf16x8){0, 0, 0, 0, 0, 0, 0, 0};
                    *(bf16x8*)(SCs + sidx * LD2 + k8) = o; }
            }
            const int tn = t + 1 < 32 ? t + 1 : 31;
            n0 = *(const f32x4*)(w + (size_t)(tn * 32 + lk) * 6144); n1 = *(const f32x4*)(w + (size_t)(tn * 32 + lk) * 6144 + 4);
            __syncthreads();
            {
                const bf16x8 a = *(const bf16x8*)(WTs + (t & 1) * 5120 + (16 * wave + r) * 40 + 8 * q);
#pragma unroll
                for (int st = 0; st < 9; ++st) {
                    const bf16x8 b = *(const bf16x8*)(SCs + (16 * st + r) * LD2 + 32 * (t & 3) + 8 * q);
                    acc[st] = __builtin_amdgcn_mfma_f32_16x16x32_bf16(a, b, acc[st], 0, 0, 0);
                }
            }
            bf16_t* wn = WTs + ((t + 1) & 1) * 5120;
#pragma unroll
            for (int e = 0; e < 4; ++e) { wn[(lj + e) * 40 + lk] = f2bf(n0[e]); wn[(lj + 4 + e) * 40 + lk] = f2bf(n1[e]); }
        }
        const int j = j0 + 16 * wave + 4 * q;
        const f32x4 b0 = *(const f32x4*)(PIN(I_ADAB) + (size_t)l * 6144 + j);
#pragma unroll
        for (int st = 0; st < 9; ++st) { const int sidx = 16 * st + r; if (sidx < NSEQ) *(f32x4*)(MOD + ((size_t)l * NSEQ + sidx) * 6144 + j) = acc[st] + b0; }
    }
}

__device__ __forceinline__ void stage_norm(const Params& p, int l, int which, float* wl, bool prompt_f32) {
    const Ctx cx = mkctx(p); const size_t z = cx.z;
    const int lane = cx.tid & 63, gw = cx.bid * NWAVES + (cx.tid >> 6), GW = cx.nb * NWAVES;
    const float* X = (l == 0 && which == 0) ? PIN(I_XP) : (const float*)(p.out + z);
    const float* XS = (const float*)(p.out + z);
    bf16_t* H = (bf16_t*)(p.ws + z + WS_H);
    const float* MOD = (const float*)(p.ws + z + WS_MOD);
    const float* g = PIN(which ? I_NFFNG : I_NMIXG) + (size_t)l * D;
    f32x4 gg[4];
#pragma unroll
    for (int j = 0; j < 4; ++j) gg[j] = *(const f32x4*)(g + 4 * lane + 256 * j);
    f32x4 v[2][4], nv[2][4];
    const int rbeg = (prompt_f32 ? 0 : MP) + 2 * gw;
    if (rbeg < R) {
#pragma unroll
        for (int k = 0; k < 2; ++k)
#pragma unroll
            for (int j = 0; j < 4; ++j) v[k][j] = *(const f32x4*)((rbeg + k < MP ? X : XS) + (size_t)(rbeg + k) * D + 4 * lane + 256 * j);
    }
    for (int row0 = rbeg; row0 < R; row0 += 2 * GW) {
        const int rnext = row0 + 2 * GW < R ? row0 + 2 * GW : row0;
#pragma unroll
        for (int k = 0; k < 2; ++k)
#pragma unroll
            for (int j = 0; j < 4; ++j) nv[k][j] = *(const f32x4*)((rnext + k < MP ? X : XS) + (size_t)(rnext + k) * D + 4 * lane + 256 * j);
#pragma unroll
        for (int k = 0; k < 2; ++k) {
            const int row = row0 + k;
            const float* md = MOD + ((size_t)l * NSEQ + seq_of_row(row)) * 6144 + which * 3072 + 4 * lane;
            f32x4 sh[4], sc[4];
#pragma unroll
            for (int j = 0; j < 4; ++j) { sh[j] = *(const f32x4*)(md + 256 * j); sc[j] = *(const f32x4*)(md + 1024 + 256 * j); }
            float ss = 0.f;
#pragma unroll
            for (int j = 0; j < 4; ++j) ss += (v[k][j][0] * v[k][j][0] + v[k][j][1] * v[k][j][1]) + (v[k][j][2] * v[k][j][2] + v[k][j][3] * v[k][j][3]);
            ss = wave_sum(ss);
            const float rstd = rsqrtf(ss * (1.f / D) + NORM_EPS);
#pragma unroll
            for (int j = 0; j < 4; ++j) { v[k][j] = v[k][j] * rstd * gg[j] * (1.f + sc[j]) + sh[j];
                *(bf16x4*)(H + (size_t)row * D + 4 * lane + 256 * j) = (bf16x4){(short)f2bf(v[k][j][0]), (short)f2bf(v[k][j][1]), (short)f2bf(v[k][j][2]), (short)f2bf(v[k][j][3])}; }
        }
#pragma unroll
        for (int k = 0; k < 2; ++k)
#pragma unroll
            for (int j = 0; j < 4; ++j) v[k][j] = nv[k][j];
    }
}

__device__ __forceinline__ void stage_norm_b(const Params& p, int l, int which) {
    const Ctx cx = mkctx(p); const size_t z = cx.z;
    const int lane = cx.tid & 63, gw = cx.bid * NWAVES + (cx.tid >> 6), GW = cx.nb * NWAVES;
    const bf16_t* XB = (const bf16_t*)(p.ws + z + WS_XB);
    bf16_t* H = (bf16_t*)(p.ws + z + WS_H);
    const float* MOD = (const float*)(p.ws + z + WS_MOD);
    const float* g = PIN(which ? I_NFFNG : I_NMIXG) + (size_t)l * D;
    f32x4 gg[2][2];
#pragma unroll
    for (int j = 0; j < 2; ++j) { gg[j][0] = *(const f32x4*)(g + 8 * lane + 512 * j); gg[j][1] = *(const f32x4*)(g + 8 * lane + 512 * j + 4); }
    typedef pg8::u32x4 u32x4;
    u32x4 v[4][2], nv[4][2];
    if (4 * gw < MP) {
#pragma unroll
        for (int k = 0; k < 4; ++k)
#pragma unroll
            for (int j = 0; j < 2; ++j) v[k][j] = *(const u32x4*)(XB + (size_t)(4 * gw + k) * D + 8 * lane + 512 * j);
    }
    for (int row0 = 4 * gw; row0 < MP; row0 += 4 * GW) {
        const int rnext = row0 + 4 * GW < MP ? row0 + 4 * GW : row0;
#pragma unroll
        for (int k = 0; k < 4; ++k)
#pragma unroll
            for (int j = 0; j < 2; ++j) nv[k][j] = *(const u32x4*)(XB + (size_t)(rnext + k) * D + 8 * lane + 512 * j);
        const float* md = MOD + ((size_t)l * NSEQ + (row0 >> 13)) * 6144 + which * 3072 + 8 * lane;
        f32x4 sh[2][2], sc[2][2];
#pragma unroll
        for (int j = 0; j < 2; ++j)
#pragma unroll
            for (int h = 0; h < 2; ++h) { sh[j][h] = *(const f32x4*)(md + 512 * j + 4 * h); sc[j][h] = *(const f32x4*)(md + 1024 + 512 * j + 4 * h) + 1.f; sc[j][h] = sc[j][h] * gg[j][h]; }
#pragma unroll
        for (int k = 0; k < 4; ++k) {
            const int row = row0 + k;
            f32x4 x[2][2]; float ss = 0.f;
#pragma unroll
            for (int j = 0; j < 2; ++j) { const u32x4 w = v[k][j];
                x[j][0] = (f32x4){__builtin_bit_cast(float, w.x << 16), __builtin_bit_cast(float, w.x & 0xffff0000u), __builtin_bit_cast(float, w.y << 16), __builtin_bit_cast(float, w.y & 0xffff0000u)};
                x[j][1] = (f32x4){__builtin_bit_cast(float, w.z << 16), __builtin_bit_cast(float, w.z & 0xffff0000u), __builtin_bit_cast(float, w.w << 16), __builtin_bit_cast(float, w.w & 0xffff0000u)};
#pragma unroll
                for (int h = 0; h < 2; ++h) ss += (x[j][h][0] * x[j][h][0] + x[j][h][1] * x[j][h][1]) + (x[j][h][2] * x[j][h][2] + x[j][h][3] * x[j][h][3]); }
            ss = wave_sum(ss);
            const float rstd = rsqrtf(ss * (1.f / D) + NORM_EPS);
#pragma unroll
            for (int j = 0; j < 2; ++j) { const f32x4 o0 = x[j][0] * rstd * sc[j][0] + sh[j][0], o1 = x[j][1] * rstd * sc[j][1] + sh[j][1];
                u32x4 w; w.x = cvtpk(o0[0], o0[1]); w.y = cvtpk(o0[2], o0[3]); w.z = cvtpk(o1[0], o1[1]); w.w = cvtpk(o1[2], o1[3]);
                *(u32x4*)(H + (size_t)row * D + 8 * lane + 512 * j) = w; }
        }
#pragma unroll
        for (int k = 0; k < 4; ++k)
#pragma unroll
            for (int j = 0; j < 2; ++j) v[k][j] = nv[k][j];
    }
}

__device__ __forceinline__ f32x4 ld4bf(const bf16_t* p) { const bf16x4 v = *(const bf16x4*)p; return (f32x4){bf2f((bf16_t)v[0]), bf2f((bf16_t)v[1]), bf2f((bf16_t)v[2]), bf2f((bf16_t)v[3])}; }
__device__ __forceinline__ void stage_rwprep(const Params& p, int l, float* lds) {
    const Ctx cx = mkctx(p); const size_t z = cx.z;
    const bf16_t* P = (const bf16_t*)(p.ws + z + WS_P);
    bf16_t* RWH = (bf16_t*)(p.ws + z + WS_RW); float* RWD = (float*)(p.ws + z + WS_RWD);
    float* xs = lds; float* kk = lds + 1024;
    const int tid = cx.tid;
    const float* mu = PIN(I_MU) + (size_t)l * 1024;
    for (int row = MP + cx.bid; row < R; row += cx.nb) {
        const bool samp = row >= MP; const int n = samp ? row - MP : row >> 13, t = samp ? 0 : (row & (T - 1));
        __syncthreads();
        for (int c = tid; c < 1024; c += NTHREADS) {
            const float pa = bf2f(P[(size_t)row * PCOLS + c]);
            float prev;
            if (t > 0) prev = bf2f(P[(size_t)(row - 1) * PCOLS + c]);
            else prev = samp ? PIN(I_SHIFT)[((size_t)l * NS + n) * 1024 + c] : 0.f;
            float v = pa + (prev - pa) * mu[c];
            if (c >= 768 && c < 832) v = tanh_fast(v);
            if (c >= 896) v = sigmoid_f(v);
            xs[c] = v;
            if (samp) (p.out + z)[O_SSHIFT + ((size_t)l * NS + n) * 1024 + c] = pa;
            else if (t == T - 1) (p.out + z)[O_PSHIFT + ((size_t)l * NP + n) * 1024 + c] = pa;
        }
        __syncthreads();
        float av = 0.f, gv = 0.f, dec = 0.f, kraw = 0.f;
        if (tid < 256) {
            const int j = tid;
            float wl = PIN(I_W0)[(size_t)l * 256 + j], al = PIN(I_A0)[(size_t)l * 256 + j]; gv = 0.f;
            const bf16_t* W2T = (const bf16_t*)(p.ws + z + WS_LORA) + (size_t)l * 65536;
            bf16x8 fw[8], fa[8], fg[16];
#pragma unroll
            for (int c8 = 0; c8 < 8; ++c8) { fw[c8] = *(const bf16x8*)(W2T + j * 64 + c8 * 8); fa[c8] = *(const bf16x8*)(W2T + 16384 + j * 64 + c8 * 8); }
#pragma unroll
            for (int c8 = 0; c8 < 16; ++c8) fg[c8] = *(const bf16x8*)(W2T + 32768 + j * 128 + c8 * 8);
#pragma unroll
            for (int c8 = 0; c8 < 8; ++c8)
#pragma unroll
                for (int e = 0; e < 8; ++e) { wl += xs[768 + c8 * 8 + e] * bf2f((bf16_t)fw[c8][e]); al += xs[832 + c8 * 8 + e] * bf2f((bf16_t)fa[c8][e]); }
#pragma unroll
            for (int c8 = 0; c8 < 16; ++c8)
#pragma unroll
                for (int e = 0; e < 8; ++e) gv += xs[896 + c8 * 8 + e] * bf2f((bf16_t)fg[c8][e]);
            const float w_log = -softplus_fast(-wl) - 0.5f;
            dec = -__expf(w_log);
            av = sigmoid_f(al);
            kraw = xs[256 + j];
            kk[j] = kraw * PIN(I_KK)[(size_t)l * 256 + j];
        }
        __syncthreads();
        if (tid < 256) {
            const int j = tid, h0 = j & ~63;
            float s = 0.f;
#pragma unroll 4
            for (int i = 0; i < 64; ++i) s += kk[h0 + i] * kk[h0 + i];
            const float kkn = kk[j] / fmaxf(sqrtf(s), 1e-12f);
            const float kmod = kraw * (1.f + (av - 1.f) * PIN(I_KA)[(size_t)l * 256 + j]);
            bf16_t* rw = RWH + (size_t)row * 1536 + j;
            rw[0] = f2bf(xs[j]); rw[256] = f2bf(kmod); rw[512] = f2bf(xs[512 + j]); rw[768] = f2bf(-kkn); rw[1024] = f2bf(kkn * av); rw[1280] = f2bf(gv); RWD[(size_t)row * 256 + j] = dec;
        }
    }
}

__device__ __forceinline__ void stage_rwprep2(const Params& p, int l, unsigned char* lds) {
    const Ctx cx = mkctx(p); const size_t z = cx.z;
    const int tid = cx.tid, lane = tid & 63, wave = __builtin_amdgcn_readfirstlane(tid >> 6), r = lane & 15, q = lane >> 4;
    bf16_t* ACW = (bf16_t*)lds;
    bf16_t* ACA = (bf16_t*)(lds + 9216);
    bf16_t* ACG = (bf16_t*)(lds + 18432);
    const bf16_t* P = (const bf16_t*)(p.ws + z + WS_P);
    bf16_t* RWH = (bf16_t*)(p.ws + z + WS_RW); float* RWD = (float*)(p.ws + z + WS_RWD);
    const bf16_t* W2T = (const bf16_t*)(p.ws + z + WS_LORA) + (size_t)l * 65536; const bf16_t* A2T = W2T + 16384; const bf16_t* G2T = W2T + 32768;
    const float* mu = PIN(I_MU) + (size_t)l * 1024;
    for (int tile = cx.bid; tile < MP / 64; tile += cx.nb) {
        const int row0 = tile * 64;
#pragma unroll
        for (int it = 0; it < 4; ++it) {
            const int task = it * NTHREADS + tid, tok = task >> 5, ch = task & 31, c = 768 + ch * 8, row = row0 + tok;
            const bf16x8 pa = *(const bf16x8*)(P + (size_t)row * PCOLS + c);
            bf16x8 pv = {0, 0, 0, 0, 0, 0, 0, 0};
            if ((row & (T - 1)) != 0) pv = *(const bf16x8*)(P + (size_t)(row - 1) * PCOLS + c);
            bf16x8 o;
#pragma unroll
            for (int e = 0; e < 8; ++e) { const float a = bf2f((bf16_t)pa[e]), b = bf2f((bf16_t)pv[e]); float x = a + (b - a) * mu[c + e];
                x = ch < 8 ? tanh_fast(x) : (ch >= 16 ? sigmoid_f(x) : x); o[e] = (short)f2bf(x); }
            if (ch < 8) *(bf16x8*)(ACW + tok * LD + ch * 8) = o;
            else if (ch < 16) *(bf16x8*)(ACA + tok * LD + (ch - 8) * 8) = o;
            else *(bf16x8*)(ACG + tok * LD2 + (ch - 16) * 8) = o;
        }
        if ((row0 & (T - 1)) == T - 64) {
            const int n = row0 >> 13;
            for (int c = tid; c < 1024; c += NTHREADS) (p.out + z)[O_PSHIFT + ((size_t)l * NP + n) * 1024 + c] = bf2f(P[(size_t)(row0 + 63) * PCOLS + c]);
        }
        __syncthreads();
        {
            const int h = wave >> 1, th = wave & 1;
#pragma unroll 1
            for (int nt = 0; nt < 2; ++nt) {
                const int tb = 32 * th + 16 * nt, row = row0 + tb + r; const bool first = (row & (T - 1)) == 0;
                float kkv[4][4], avv[4][4]; float ssq = 0.f;
                bf16x4 pc[4][3], pp_[4][3];
#pragma unroll
                for (int mt = 0; mt < 4; ++mt) { const int j = h * 64 + 16 * mt + 4 * q; const bf16x4 zero4 = {0, 0, 0, 0};
#pragma unroll
                    for (int f = 0; f < 3; ++f) { pc[mt][f] = *(const bf16x4*)(P + (size_t)row * PCOLS + 256 * f + j); pp_[mt][f] = first ? zero4 : *(const bf16x4*)(P + (size_t)(row - 1) * PCOLS + 256 * f + j); } }
#pragma unroll
                for (int mt = 0; mt < 4; ++mt) {
                    const int j0 = h * 64 + 16 * mt, j = j0 + 4 * q;
                    f32x4 aw = {0.f, 0.f, 0.f, 0.f}, aa = {0.f, 0.f, 0.f, 0.f}, ag = {0.f, 0.f, 0.f, 0.f};
#pragma unroll
                    for (int s2 = 0; s2 < 2; ++s2) {
                        const bf16x8 fw = *(const bf16x8*)(W2T + (j0 + r) * 64 + 32 * s2 + 8 * q), fa = *(const bf16x8*)(A2T + (j0 + r) * 64 + 32 * s2 + 8 * q);
                        const bf16x8 bw = *(const bf16x8*)(ACW + (tb + r) * LD + 32 * s2 + 8 * q), ba = *(const bf16x8*)(ACA + (tb + r) * LD + 32 * s2 + 8 * q);
                        aw = __builtin_amdgcn_mfma_f32_16x16x32_bf16(fw, bw, aw, 0, 0, 0);
                        aa = __builtin_amdgcn_mfma_f32_16x16x32_bf16(fa, ba, aa, 0, 0, 0);
                    }
#pragma unroll
                    for (int s2 = 0; s2 < 4; ++s2) {
                        const bf16x8 fg = *(const bf16x8*)(G2T + (j0 + r) * 128 + 32 * s2 + 8 * q), bg = *(const bf16x8*)(ACG + (tb + r) * LD2 + 32 * s2 + 8 * q);
                        ag = __builtin_amdgcn_mfma_f32_16x16x32_bf16(fg, bg, ag, 0, 0, 0);
                    }
                    const bf16x4 par = pc[mt][0], pak = pc[mt][1], pav = pc[mt][2], pvr = pp_[mt][0], pvk = pp_[mt][1], pvv = pp_[mt][2];
                    const f32x4 mur = *(const f32x4*)(mu + j), muk = *(const f32x4*)(mu + 256 + j), muv = *(const f32x4*)(mu + 512 + j);
                    const f32x4 w0 = *(const f32x4*)(PIN(I_W0) + (size_t)l * 256 + j), a0 = *(const f32x4*)(PIN(I_A0) + (size_t)l * 256 + j);
                    const f32x4 kkw = *(const f32x4*)(PIN(I_KK) + (size_t)l * 256 + j), kaw = *(const f32x4*)(PIN(I_KA) + (size_t)l * 256 + j);
                    f32x4 fr_, fk_, fv_, fd_;
#pragma unroll
                    for (int e = 0; e < 4; ++e) {
                        const float ar = bf2f((bf16_t)par[e]), ak = bf2f((bf16_t)pak[e]), av_ = bf2f((bf16_t)pav[e]);
                        const float xr = ar + (bf2f((bf16_t)pvr[e]) - ar) * mur[e], xk = ak + (bf2f((bf16_t)pvk[e]) - ak) * muk[e], xv = av_ + (bf2f((bf16_t)pvv[e]) - av_) * muv[e];
                        const float w_log = -softplus_fast(-(w0[e] + aw[e])) - 0.5f;
                        const float av = sigmoid_f(a0[e] + aa[e]);
                        fd_[e] = -__expf(w_log);
                        fr_[e] = xr; fv_[e] = xv;
                        fk_[e] = xk * (1.f + (av - 1.f) * kaw[e]);
                        const float kv = xk * kkw[e]; kkv[mt][e] = kv; avv[mt][e] = av; ssq += kv * kv;
                    }
                    bf16_t* rw = RWH + (size_t)row * 1536 + j;
                    *(bf16x4*)rw = pack4(fr_); *(bf16x4*)(rw + 256) = pack4(fk_); *(bf16x4*)(rw + 512) = pack4(fv_); *(bf16x4*)(rw + 1280) = pack4(ag); *(f32x4*)(RWD + (size_t)row * 256 + j) = fd_;
                }
                ssq += __shfl_xor(ssq, 16); ssq += __shfl_xor(ssq, 32);
                const float rn = 1.f / fmaxf(sqrtf(ssq), 1e-12f);
#pragma unroll
                for (int mt = 0; mt < 4; ++mt) {
                    bf16_t* rw = RWH + (size_t)row * 1536 + h * 64 + 16 * mt + 4 * q;
                    f32x4 fa_, fb_;
#pragma unroll
                    for (int e = 0; e < 4; ++e) { const float kn = kkv[mt][e] * rn; fa_[e] = -kn; fb_[e] = kn * avv[mt][e]; }
                    *(bf16x4*)(rw + 768) = pack4(fa_); *(bf16x4*)(rw + 1024) = pack4(fb_);
                }
            }
        }
        __syncthreads();
    }
}

#define WAVE_LDS_SYNC() do { asm volatile("s_waitcnt lgkmcnt(0)" ::: "memory"); __builtin_amdgcn_wave_barrier(); } while (0)
__device__ __forceinline__ void stage_rwscan(const Params& p, int l, float* lds, int first = 0) {
    const Ctx cx = mkctx(p, first); const size_t z = cx.z;
    const int lane = cx.tid & 63, wave = cx.tid >> 6;
    const bf16_t* RWH = (const bf16_t*)(p.ws + z + WS_RW); const float* RWD = (const float*)(p.ws + z + WS_RWD);
    bf16_t* Y = (bf16_t*)(p.ws + z + WS_YCAT);
    float* wl = lds + wave * 512;
    for (int u = NP * 4 + cx.bid + cx.nb * wave; u < NSEQ * 4; u += cx.nb * NWAVES) {
        const int s = u >> 2, h = u & 3; const bool samp = s >= NP; const int n = samp ? s - NP : s;
        const int row0 = samp ? MP + n : n * T, nt = samp ? 1 : T;
        float S[64];
        if (samp) { const float* st = PIN(I_WKV) + ((((size_t)l * NS + n) * 4 + h) * 64 + lane) * 64;
#pragma unroll
            for (int k = 0; k < 64; k += 4) { const f32x4 v4 = *(const f32x4*)(st + k); S[k] = v4[0]; S[k + 1] = v4[1]; S[k + 2] = v4[2]; S[k + 3] = v4[3]; } }
        else {
#pragma unroll
            for (int k = 0; k < 64; ++k) S[k] = 0.f; }
        const float lng = PIN(I_LNG)[(size_t)l * 256 + h * 64 + lane], lnb = PIN(I_LNB)[(size_t)l * 256 + h * 64 + lane];
        const float rkl = PIN(I_RK)[(size_t)l * 256 + h * 64 + lane];
        for (int t = 0; t < nt; ++t) {
            const bf16_t* rw = RWH + (size_t)(row0 + t) * 1536 + h * 64 + lane;
            const float rl = bf2f(rw[0]), kl = bf2f(rw[256]), vl = bf2f(rw[512]), gl = bf2f(rw[1280]);
            WAVE_LDS_SYNC();
            wl[lane] = rl; wl[64 + lane] = kl; wl[128 + lane] = __expf(RWD[(size_t)(row0 + t) * 256 + h * 64 + lane]); wl[192 + lane] = bf2f(rw[768]); wl[256 + lane] = bf2f(rw[1024]);
            WAVE_LDS_SYNC();
            const float bd = wave_sum(rl * kl * rkl);
            float sa = 0.f;
#pragma unroll
            for (int k = 0; k < 64; ++k) sa += S[k] * wl[192 + k];
            float y = 0.f;
#pragma unroll
            for (int k = 0; k < 64; ++k) {
                S[k] = S[k] * wl[128 + k] + sa * wl[256 + k] + vl * wl[64 + k];
                y += S[k] * wl[k];
            }
            const float mean = wave_sum(y) * (1.f / 64.f), dl = y - mean;
            const float var = wave_sum(dl * dl) * (1.f / 64.f);
            const float yn = dl * rsqrtf(var + GN_EPS) * lng + lnb;
            Y[(size_t)(row0 + t) * D + h * 64 + lane] = f2bf((yn + bd * vl) * gl);
        }
        float* so = (p.out + z) + (samp ? O_SWKV + ((((size_t)l * NS + n) * 4 + h) * 64 + lane) * 64 : O_PWKV + ((((size_t)l * NP + n) * 4 + h) * 64 + lane) * 64);
#pragma unroll
        for (int k = 0; k < 64; k += 4) *(f32x4*)(so + k) = (f32x4){S[k], S[k + 1], S[k + 2], S[k + 3]};
    }
}

constexpr int RWL = 64, NCH = T / RWL, RW_UNITS = NP * 4 * NCH;
__device__ __forceinline__ f32x4 mma16_k64(const bf16_t* A, const bf16_t* Bt, f32x4 acc, int r, int q) {
    const bf16x8 a0 = *(const bf16x8*)(A + r * LD + 8 * q), a1 = *(const bf16x8*)(A + r * LD + 32 + 8 * q);
    const bf16x8 b0 = *(const bf16x8*)(Bt + r * LD + 8 * q), b1 = *(const bf16x8*)(Bt + r * LD + 32 + 8 * q);
    acc = __builtin_amdgcn_mfma_f32_16x16x32_bf16(a0, b0, acc, 0, 0, 0);
    acc = __builtin_amdgcn_mfma_f32_16x16x32_bf16(a1, b1, acc, 0, 0, 0);
    return acc;
}

__device__ __forceinline__ void stage_rw1(const Params& p, int l, unsigned char* lds) {
    const Ctx cx = mkctx(p); const size_t z = cx.z;
    const int tid = cx.tid, lane0 = tid & 63, wave = __builtin_amdgcn_readfirstlane(tid >> 6);
#define RELANE() int lane_ = lane0; asm volatile("" : "+v"(lane_)); const int lane = lane_, r = lane & 15, q = lane >> 4; (void)r; (void)q;
    bf16_t* M = (bf16_t*)lds;
    float* AT = (float*)(lds + 12 * MSZ * 2);
    float* psum = AT + 64 * 68;
    float* PLs = psum + 512;
    bf16_t* TA10 = (bf16_t*)(PLs + 64);
    bf16_t* TT00 = TA10 + 32 * LD; bf16_t* TYT = TT00 + 32 * LD;
    unsigned char* const wsz = p.ws + z;
    for (int uu = cx.bid; uu < RW_UNITS; uu += cx.nb) {
        const int tile = uu & 255, h = uu >> 8, n = tile >> 7, c = tile & (NCH - 1), unit = (n * 4 + h) * NCH + c;
        const int row0 = n * T + c * RWL;
        {
            RELANE();
            const int k = lane, tg = wave;
            const bf16_t* rw = (const bf16_t*)(wsz + WS_RW) + (size_t)(row0 + tg * 8) * 1536 + h * 64 + k; const float* rwd = (const float*)(wsz + WS_RWD) + (size_t)(row0 + tg * 8) * 256 + h * 64 + k;
            float ld[8], f_r[8], f_k[8], f_v[8], f_a[8], f_b[8]; float cs = 0.f;
#pragma unroll
            for (int j = 0; j < 8; ++j) { ld[j] = rwd[j * 256]; f_r[j] = bf2f(rw[j * 1536]); f_k[j] = bf2f(rw[j * 1536 + 256]); f_v[j] = bf2f(rw[j * 1536 + 512]); f_a[j] = bf2f(rw[j * 1536 + 768]); f_b[j] = bf2f(rw[j * 1536 + 1024]); }
#pragma unroll
            for (int j = 0; j < 8; ++j) { cs += ld[j]; ld[j] = cs; }
            psum[tg * 64 + k] = cs;
            __syncthreads();
            float off = 0.f, tot = 0.f;
#pragma unroll
            for (int g = 0; g < 8; ++g) { const float v_ = psum[g * 64 + k]; tot += v_; off += g < tg ? v_ : 0.f; }
            if (tg == 0) PLs[k] = __expf(tot);
            bf16x8 atT, bcT, kcT, vT;
#pragma unroll
            for (int j = 0; j < 8; ++j) {
                const float lp = off + ld[j], lpm1 = j ? off + ld[j - 1] : off;
                const float Pt = __expf(lp), Pinv = __expf(-lp), Pm1 = __expf(lpm1), E = __expf(tot - lp);
                const float rr = f_r[j], km = f_k[j], vv = f_v[j], av = f_a[j], bv = f_b[j];
                const int t = tg * 8 + j;
                const bf16_t at = f2bf(av * Pm1);
                M[0 * MSZ + t * LD + k] = at; atT[j] = (short)at;
                M[3 * MSZ + t * LD + k] = f2bf(rr * Pt);
                M[1 * MSZ + t * LD + k] = f2bf(bv * Pinv);
                M[2 * MSZ + t * LD + k] = f2bf(km * Pinv);
                bcT[j] = (short)f2bf(bv * E); kcT[j] = (short)f2bf(km * E); vT[j] = (short)f2bf(vv);
            }
            *(bf16x8*)(M + 4 * MSZ + k * LD + tg * 8) = atT;
            *(bf16x8*)(M + 5 * MSZ + k * LD + tg * 8) = bcT;
            *(bf16x8*)(M + 6 * MSZ + k * LD + tg * 8) = kcT;
            *(bf16x8*)(M + 7 * MSZ + k * LD + tg * 8) = vT;
        }
        __syncthreads();
        {
            RELANE();
            const int mm = wave >> 1, hh = wave & 1;
            const bf16_t* Asrc = M + (mm < 2 ? 0 : 3) * MSZ; const bf16_t* Bsrc = M + ((mm & 1) ? 2 : 1) * MSZ;
#pragma unroll
            for (int m2 = 0; m2 < 2; ++m2) {
                const int mt = hh * 2 + m2;
#pragma unroll
                for (int nt = 0; nt < 4; ++nt) {
                    float zf = 0.f; asm volatile("" : "+v"(zf));
                    f32x4 acc = {zf, zf, zf, zf};
                    if (nt <= mt) acc = mma16_k64(Asrc + mt * 16 * LD, Bsrc + nt * 16 * LD, acc, r, q);
                    const int i = 16 * nt + r;
#pragma unroll
                    for (int e = 0; e < 4; ++e) { const int t = 16 * mt + 4 * q + e; const bool keep = mm < 2 ? (i < t) : (i <= t); acc[e] = keep ? acc[e] : 0.f; }
                    if (mm == 0) { *(f32x4*)(AT + i * 68 + 16 * mt + 4 * q) = acc;
                        if (mt >= 2 && nt < 2) {
#pragma unroll
                            for (int e = 0; e < 4; ++e) TA10[(16 * (mt - 2) + 4 * q + e) * LD + i] = f2bf(acc[e]); } }
                    else {
                        bf16_t* dst = M + (7 + mm) * MSZ;
#pragma unroll
                        for (int e = 0; e < 4; ++e) dst[(16 * mt + 4 * q + e) * LD + i] = f2bf(acc[e]);
                    }
                }
            }
        }
        __syncthreads();
        if (wave == 0) {
            RELANE();
            const int blk = lane >> 5, jl = lane & 31;
            const float* ATl = AT + blk * (32 * 68 + 32);
            float tc[32];
#pragma unroll
            for (int t = 0; t < 32; ++t) tc[t] = (t == jl) ? 1.f : 0.f;
            int aoff = 0;
            float cur[31], nxt[31];
#pragma unroll
            for (int t = 1; t < 32; ++t) cur[t - 1] = ATl[t];
#pragma unroll
            for (int i = 0; i < 31; ++i) {
                asm volatile("" : "+v"(aoff), "+v"(tc[i]));
                if (i + 1 < 31) {
#pragma unroll
                    for (int t = i + 2; t < 32; ++t) nxt[t - i - 2] = ATl[aoff + (i + 1) * 68 + t];
                }
                const float ti = tc[i];
#pragma unroll
                for (int t = i + 1; t < 32; ++t) tc[t] += cur[t - i - 1] * ti;
#pragma unroll
                for (int t = 0; t < 30; ++t) cur[t] = nxt[t];
            }
            bf16_t* T11 = M + 11 * MSZ;
#pragma unroll
            for (int t = 0; t < 32; ++t) { T11[(blk * 32 + t) * LD + lane] = f2bf(tc[t]); if (blk) T11[t * LD + lane] = 0; }
            if (blk == 0) {
#pragma unroll
                for (int c8 = 0; c8 < 4; ++c8) { bf16x8 o;
#pragma unroll
                    for (int e = 0; e < 8; ++e) o[e] = (short)f2bf(tc[c8 * 8 + e]);
                    *(bf16x8*)(TT00 + jl * LD + c8 * 8) = o; }
            }
        } else if (wave >= 4) {
            RELANE();
            const int mt = wave - 4;
#pragma unroll
            for (int nt = 0; nt < 4; ++nt) {
                f32x4 acc = {0.f, 0.f, 0.f, 0.f};
                acc = mma16_k64(M + 7 * MSZ + mt * 16 * LD, M + 8 * MSZ + nt * 16 * LD, acc, r, q);
#pragma unroll
                for (int e = 0; e < 4; ++e) M[1 * MSZ + (16 * mt + 4 * q + e) * LD + 16 * nt + r] = f2bf(acc[e]);
            }
        }
        __syncthreads();
        if (wave < 4) {
            RELANE();
            const int mt = wave >> 1, nt = wave & 1;
            const bf16x8 a = *(const bf16x8*)(TA10 + (16 * mt + r) * LD + 8 * q), b = *(const bf16x8*)(TT00 + (16 * nt + r) * LD + 8 * q);
            f32x4 acc = {0.f, 0.f, 0.f, 0.f};
            acc = __builtin_amdgcn_mfma_f32_16x16x32_bf16(a, b, acc, 0, 0, 0);
#pragma unroll
            for (int e = 0; e < 4; ++e) TYT[(16 * nt + r) * LD + 16 * mt + 4 * q + e] = f2bf(acc[e]);
        }
        __syncthreads();
        if (wave < 4) {
            RELANE();
            const int mt = wave >> 1, nt = wave & 1;
            const bf16x8 a = *(const bf16x8*)(M + 11 * MSZ + (32 + 16 * mt + r) * LD + 32 + 8 * q), b = *(const bf16x8*)(TYT + (16 * nt + r) * LD + 8 * q);
            f32x4 acc = {0.f, 0.f, 0.f, 0.f};
            acc = __builtin_amdgcn_mfma_f32_16x16x32_bf16(a, b, acc, 0, 0, 0);
#pragma unroll
            for (int e = 0; e < 4; ++e) M[11 * MSZ + (32 + 16 * mt + 4 * q + e) * LD + 16 * nt + r] = f2bf(acc[e]);
        }
        __syncthreads();
        {
            RELANE();
            const int mt = wave & 3; const bf16_t* Asrc = M + (wave < 4 ? 4 : 1) * MSZ; bf16_t* dst = M + (wave < 4 ? 0 : 2) * MSZ;
#pragma unroll
            for (int nt = 0; nt < 4; ++nt) {
                f32x4 acc = {0.f, 0.f, 0.f, 0.f};
                acc = mma16_k64(Asrc + mt * 16 * LD, M + 11 * MSZ + nt * 16 * LD, acc, r, q);
#pragma unroll
                for (int e = 0; e < 4; ++e) dst[(16 * mt + 4 * q + e) * LD + 16 * nt + r] = f2bf(acc[e]);
            }
        }
        __syncthreads();
        {
            RELANE();
            const int job = wave >> 1;
            bf16_t* RPg = (bf16_t*)(wsz + WS_RWC_RP); bf16_t* MCg = (bf16_t*)(wsz + WS_RWC_MC); bf16_t* NCTg = (bf16_t*)(wsz + WS_RWC_NCT); float* Y0g = (float*)(wsz + WS_RWC_Y0);
#pragma unroll
            for (int m2 = 0; m2 < 2; ++m2) {
                const int mt = (wave & 1) * 2 + m2;
#pragma unroll
                for (int nt = 0; nt < 4; ++nt) {
                    const size_t ub = (size_t)unit * 4096;
                    if (job == 0) {
                        const bf16x4 in = *(const bf16x4*)(M + 3 * MSZ + (16 * nt + r) * LD + 16 * mt + 4 * q);
                        f32x4 acc = {bf2f((bf16_t)in[0]), bf2f((bf16_t)in[1]), bf2f((bf16_t)in[2]), bf2f((bf16_t)in[3])};
                        acc = mma16_k64(M + 0 * MSZ + mt * 16 * LD, M + 9 * MSZ + nt * 16 * LD, acc, r, q);
                        *(bf16x4*)(RPg + ub + (16 * nt + r) * 64 + 16 * mt + 4 * q) = pack4(acc);
                    } else if (job == 1) {
                        f32x4 acc = {0.f, 0.f, 0.f, 0.f};
                        acc = mma16_k64(M + 0 * MSZ + mt * 16 * LD, M + 5 * MSZ + nt * 16 * LD, acc, r, q);
                        const int k1 = 16 * nt + r; const float pl = PLs[k1];
#pragma unroll
                        for (int e = 0; e < 4; ++e) acc[e] += (16 * mt + 4 * q + e == k1) ? pl : 0.f;
                        *(bf16x4*)(MCg + ub + k1 * 64 + 32 * (mt >> 1) + 8 * q + 4 * (mt & 1)) = pack4(acc);
                    } else if (job == 2) {
                        f32x4 acc = {0.f, 0.f, 0.f, 0.f};
                        acc = mma16_k64(M + 2 * MSZ + mt * 16 * LD, M + 9 * MSZ + nt * 16 * LD, acc, r, q);
                        acc = mma16_k64(M + 7 * MSZ + mt * 16 * LD, M + 10 * MSZ + nt * 16 * LD, acc, r, q);
                        *(f32x4*)(Y0g + ub + (16 * nt + r) * 64 + 16 * mt + 4 * q) = acc;
                    } else {
                        f32x4 acc = {0.f, 0.f, 0.f, 0.f};
                        acc = mma16_k64(M + 5 * MSZ + mt * 16 * LD, M + 2 * MSZ + nt * 16 * LD, acc, r, q);
                        acc = mma16_k64(M + 6 * MSZ + mt * 16 * LD, M + 7 * MSZ + nt * 16 * LD, acc, r, q);
                        *(bf16x4*)(NCTg + ub + (16 * nt + r) * 64 + 16 * mt + 4 * q) = pack4(acc);
                    }
                }
            }
        }
        __syncthreads();
    }
}
#undef RELANE

constexpr int RW2_WGS = NP * 4 * 2;
constexpr int RW2_D = 8, RW2_SLOT = 2 * MSZ;
struct RwRegs { bf16x8 m0, m1, n0, n1; };
__device__ __forceinline__ void rw2_fetch(RwRegs& R, const bf16_t* mc, const bf16_t* nct, int c, int lt) {
    const int cc = c & (NCH - 1);
    R.m0 = *(const bf16x8*)(mc + (size_t)cc * 4096 + lt * 8); R.m1 = *(const bf16x8*)(mc + (size_t)cc * 4096 + 2048 + lt * 8);
    R.n0 = *(const bf16x8*)(nct + (size_t)cc * 4096 + lt * 8); R.n1 = *(const bf16x8*)(nct + (size_t)cc * 4096 + 2048 + lt * 8);
}
__device__ __forceinline__ void rw2_put(const RwRegs& R, bf16_t* slot, int lt) {
    const int row = lt >> 3, pc = lt & 7;
    *(bf16x8*)(slot + row * LD + pc * 8) = R.m0; *(bf16x8*)(slot + (row + 32) * LD + pc * 8) = R.m1;
    *(bf16x8*)(slot + MSZ + row * LD + pc * 8) = R.n0; *(bf16x8*)(slot + MSZ + (row + 32) * LD + pc * 8) = R.n1;
}
__device__ __forceinline__ void rw2_consume(f32x4 (&acc)[4], const bf16_t* slot, bf16_t* s0, int c, int r, int q, int v) {
    bf16x4 pk[4];
#pragma unroll
    for (int mt = 0; mt < 4; ++mt) { pk[mt] = pack4(acc[mt]); *(bf16x4*)(s0 + (size_t)c * 4096 + v * 64 + 16 * mt + 4 * q) = pk[mt]; }
    const bf16x8 b0 = {pk[0][0], pk[0][1], pk[0][2], pk[0][3], pk[1][0], pk[1][1], pk[1][2], pk[1][3]};
    const bf16x8 b1 = {pk[2][0], pk[2][1], pk[2][2], pk[2][3], pk[3][0], pk[3][1], pk[3][2], pk[3][3]};
#pragma unroll
    for (int mt = 0; mt < 4; ++mt) {
        const bf16x8 a0 = *(const bf16x8*)(slot + (16 * mt + r) * LD + 8 * q), a1 = *(const bf16x8*)(slot + (16 * mt + r) * LD + 32 + 8 * q);
        const bf16x4 nc = *(const bf16x4*)(slot + MSZ + v * LD + 16 * mt + 4 * q);
        f32x4 ci = {bf2f((bf16_t)nc[0]), bf2f((bf16_t)nc[1]), bf2f((bf16_t)nc[2]), bf2f((bf16_t)nc[3])};
        ci = __builtin_amdgcn_mfma_f32_16x16x32_bf16(a0, b0, ci, 0, 0, 0);
        acc[mt] = __builtin_amdgcn_mfma_f32_16x16x32_bf16(a1, b1, ci, 0, 0, 0);
    }
}
__device__ __forceinline__ void stage_rw2(const Params& p, int l, unsigned char* lds) {
    const Ctx cx = mkctx(p); const size_t z = cx.z;
    const int tid = cx.tid, lane = tid & 63, wave = __builtin_amdgcn_readfirstlane(tid >> 6), r = lane & 15, q = lane >> 4;
    if (cx.bid < RW2_WGS) {
        const int nh = cx.bid & (NP * 4 - 1), vh = cx.bid >> 3, v = 32 * vh + 16 * (wave & 1) + r;
        const bf16_t* mc = (const bf16_t*)(p.ws + z + WS_RWC_MC) + (size_t)nh * NCH * 4096;
        bf16_t* nct = (bf16_t*)(p.ws + z + WS_RWC_NCT) + (size_t)nh * NCH * 4096;
        bf16_t* L0 = (bf16_t*)lds; bf16_t* L1 = L0 + RW2_SLOT;
        f32x4 acc[4];
#pragma unroll
        for (int mt = 0; mt < 4; ++mt) acc[mt] = (f32x4){0.f, 0.f, 0.f, 0.f};
        const int lt = tid - 128;
        const bool b_is_m = lt < 128;
        const int pb = b_is_m ? lt + 384 : lt - 128;
        const bf16_t* srcA = mc + lt * 8;
        const bf16_t* srcB = b_is_m ? mc + pb * 8 : nct + (32 * vh) * 64 + pb * 8;
        const int dstA = (lt >> 3) * LD + (lt & 7) * 8;
        const int dstB = b_is_m ? (pb >> 3) * LD + (pb & 7) * 8 : MSZ + (32 * vh + (pb >> 3)) * LD + (pb & 7) * 8;
        struct RwHalf { bf16x8 a, b; };
        RwHalf H0, H1, H2, H3, H4, H5, H6, H7, H8, H9, H10, H11, H12, H13, H14, H15;
#define RW2_FETCH(HH, c) do { HH.a = *(const bf16x8*)(srcA + (size_t)(c) * 4096); HH.b = *(const bf16x8*)(srcB + (size_t)(c) * 4096); } while (0)
#define RW2_PUT(HH, slot) do { *(bf16x8*)((slot) + dstA) = HH.a; *(bf16x8*)((slot) + dstB) = HH.b; } while (0)
        if (wave >= 2) {
            { RwHalf F; RW2_FETCH(F, 0); RW2_PUT(F, L0); }
            RW2_FETCH(H0, 1); RW2_FETCH(H1, 2); RW2_FETCH(H2, 3); RW2_FETCH(H3, 4); RW2_FETCH(H4, 5); RW2_FETCH(H5, 6); RW2_FETCH(H6, 7); RW2_FETCH(H7, 8);
            RW2_FETCH(H8, 9); RW2_FETCH(H9, 10); RW2_FETCH(H10, 11); RW2_FETCH(H11, 12); RW2_FETCH(H12, 13); RW2_FETCH(H13, 14); RW2_FETCH(H14, 15); RW2_FETCH(H15, 16);
        }
        __syncthreads();
        if (wave >= 2) {
#define RW2_LSTEP(HH, c) do { RW2_PUT(HH, ((c) & 1) ? L0 : L1); RW2_FETCH(HH, (c) + 17); __syncthreads(); } while (0)
#pragma unroll 1
            for (int c = 0; c < NCH; c += 16) {
                RW2_LSTEP(H0, c); RW2_LSTEP(H1, c + 1); RW2_LSTEP(H2, c + 2); RW2_LSTEP(H3, c + 3); RW2_LSTEP(H4, c + 4); RW2_LSTEP(H5, c + 5); RW2_LSTEP(H6, c + 6); RW2_LSTEP(H7, c + 7);
                RW2_LSTEP(H8, c + 8); RW2_LSTEP(H9, c + 9); RW2_LSTEP(H10, c + 10); RW2_LSTEP(H11, c + 11); RW2_LSTEP(H12, c + 12); RW2_LSTEP(H13, c + 13); RW2_LSTEP(H14, c + 14); RW2_LSTEP(H15, c + 15);
            }
#undef RW2_LSTEP
        } else {
#pragma unroll 1
            for (int c = 0; c < NCH; c += 2) {
                rw2_consume(acc, L0, nct, c, r, q, v); __syncthreads();
                rw2_consume(acc, L1, nct, c + 1, r, q, v); __syncthreads();
            }
        }
#undef RW2_FETCH
#undef RW2_PUT
        if (wave < 2) {
            float* so = (p.out + z) + O_PWKV + ((size_t)l * NP * 4 + nh) * 4096 + v * 64 + 4 * q;
#pragma unroll
            for (int mt = 0; mt < 4; ++mt) *(f32x4*)(so + 16 * mt) = acc[mt];
        }
    }
}

__device__ __forceinline__ void stage_rw3(const Params& p, int l, int first = 0) {
    const Ctx cx = mkctx(p, first); const size_t z = cx.z;
    const int tid = cx.tid, lane = tid & 63, wave = tid >> 6, r = lane & 15, q = lane >> 4;
    const bf16_t* RWH = (const bf16_t*)(p.ws + z + WS_RW);
    const bf16_t* RPg = (const bf16_t*)(p.ws + z + WS_RWC_RP); const bf16_t* S0g = (const bf16_t*)(p.ws + z + WS_RWC_NCT);
    const float* Y0g = (const float*)(p.ws + z + WS_RWC_Y0);
    bf16_t* Y = (bf16_t*)(p.ws + z + WS_YCAT);
    for (int it = cx.bid; it < RW_UNITS / 2; it += cx.nb) {
        const int c = (it & 63) * 2 + (wave >> 2), nh = it >> 6, n = nh >> 2, h = nh & 3, unit = nh * NCH + c, nt = wave & 3;
        const int t = 16 * nt + r, row = n * T + c * RWL + t;
        const size_t ub = (size_t)unit * 4096;
        const bf16x8 rp0 = *(const bf16x8*)(RPg + ub + t * 64 + 8 * q), rp1 = *(const bf16x8*)(RPg + ub + t * 64 + 32 + 8 * q);
        const bf16_t* rw = RWH + (size_t)row * 1536 + h * 64;
        f32x4 y[4]; float sum = 0.f, bd = 0.f;
#pragma unroll
        for (int mt = 0; mt < 4; ++mt) {
            const bf16x8 s0 = *(const bf16x8*)(S0g + ub + (16 * mt + r) * 64 + 8 * q), s1 = *(const bf16x8*)(S0g + ub + (16 * mt + r) * 64 + 32 + 8 * q);
            f32x4 acc = *(const f32x4*)(Y0g + ub + t * 64 + 16 * mt + 4 * q);
            acc = __builtin_amdgcn_mfma_f32_16x16x32_bf16(s0, rp0, acc, 0, 0, 0);
            acc = __builtin_amdgcn_mfma_f32_16x16x32_bf16(s1, rp1, acc, 0, 0, 0);
            y[mt] = acc; sum += (acc[0] + acc[1]) + (acc[2] + acc[3]);
            const f32x4 rr = ld4bf(rw + 16 * mt + 4 * q), km = ld4bf(rw + 256 + 16 * mt + 4 * q), rk = *(const f32x4*)(PIN(I_RK) + (size_t)l * 256 + h * 64 + 16 * mt + 4 * q);
            bd += (rr[0] * km[0] * rk[0] + rr[1] * km[1] * rk[1]) + (rr[2] * km[2] * rk[2] + rr[3] * km[3] * rk[3]);
        }
        sum += __shfl_xor(sum, 16); sum += __shfl_xor(sum, 32);
        bd += __shfl_xor(bd, 16); bd += __shfl_xor(bd, 32);
        const float mean = sum * (1.f / 64.f); float vs = 0.f;
#pragma unroll
        for (int mt = 0; mt < 4; ++mt)
#pragma unroll
            for (int e = 0; e < 4; ++e) { const float d_ = y[mt][e] - mean; vs += d_ * d_; }
        vs += __shfl_xor(vs, 16); vs += __shfl_xor(vs, 32);
        const float rstd = rsqrtf(vs * (1.f / 64.f) + GN_EPS);
#pragma unroll
        for (int mt = 0; mt < 4; ++mt) {
            const int vi = 16 * mt + 4 * q;
            const f32x4 vv = ld4bf(rw + 512 + vi), gg = ld4bf(rw + 1280 + vi);
            const f32x4 lg = *(const f32x4*)(PIN(I_LNG) + (size_t)l * 256 + h * 64 + vi), lb = *(const f32x4*)(PIN(I_LNB) + (size_t)l * 256 + h * 64 + vi);
            f32x4 o;
#pragma unroll
            for (int e = 0; e < 4; ++e) o[e] = ((y[mt][e] - mean) * rstd * lg[e] + lb[e] + bd * vv[e]) * gg[e];
            *(bf16x4*)(Y + (size_t)row * D + h * 64 + vi) = pack4(o);
        }
    }
}

__device__ __forceinline__ void stage_qkn(const Params& p, int l) {
    const Ctx cx = mkctx(p); const size_t z = cx.z;
    const int lane = cx.tid & 63, gw = cx.bid * NWAVES + (cx.tid >> 6), GW = cx.nb * NWAVES;
    const bf16_t* P = (const bf16_t*)(p.ws + z + WS_P);
    float* QN = (float*)(p.ws + z + WS_QN); float* KN = (float*)(p.ws + z + WS_KN);
    for (int it = MP * 6 + gw; it < R * 6; it += GW) {
        const int row = it / 6, unit = it % 6;
        const bool samp = row >= MP; const int n = samp ? row - MP : row >> 13, t = samp ? 0 : (row & (T - 1));
        const float x = bf2f(P[(size_t)row * PCOLS + OFF_B + unit * 64 + lane]);
        const float ss = wave_sum(x * x) * (1.f / 64.f);
        const float g = unit < 4 ? PIN(I_QNG)[(size_t)l * 64 + lane] : PIN(I_KNG)[(size_t)l * 64 + lane];
        const float y = x * rsqrtf(ss + NORM_EPS) * g;
        if (unit < 4) QN[(size_t)row * 256 + unit * 64 + lane] = y;
        else {
            const int kvh = unit - 4;
            KN[(size_t)row * 128 + kvh * 64 + lane] = y;
            const float v = bf2f(P[(size_t)row * PCOLS + OFF_B + 384 + kvh * 64 + lane]);
            if (samp) { const size_t o = (((size_t)l * NS + n) * 128 + 127) * 128 + kvh * 64 + lane; (p.out + z)[O_SK + o] = y; (p.out + z)[O_SV + o] = v; }
            else if (t >= T - 128) { const size_t o = (((size_t)l * NP + n) * 128 + (t - (T - 128))) * 128 + kvh * 64 + lane; (p.out + z)[O_PK + o] = y; (p.out + z)[O_PV + o] = v; }
        }
    }
}

__device__ __forceinline__ void stage_cachecopy(const Params& p, int l, int first = 0) {
    const Ctx cx = mkctx(p, first); const size_t z = cx.z;
    {
        typedef float f4 __attribute__((ext_vector_type(4)));
        const unsigned gt4 = (unsigned)cx.bid * NTHREADS + cx.tid, GT4 = (unsigned)cx.nb * NTHREADS;
        for (unsigned i = gt4; i < (unsigned)NS * 4064; i += GT4) {
            const unsigned n = i / 4064u, o4 = i - n * 4064u;
            const size_t src = (((size_t)l * NS + n) * 128 + 1) * 128 + (size_t)o4 * 4, dst = ((size_t)l * NS + n) * 128 * 128 + (size_t)o4 * 4;
            *(f4*)((p.out + z) + O_SK + dst) = *(const f4*)(PIN(I_CK) + src); *(f4*)((p.out + z) + O_SV + dst) = *(const f4*)(PIN(I_CV) + src);
        }
    }
}

__device__ __forceinline__ void stage_att(const Params& p, int l, int first = 0) {
    const Ctx cx = mkctx(p, first); const size_t z = cx.z;
    const int lane = cx.tid & 63, gw = flip_bid(cx) * NWAVES + (cx.tid >> 6), GW = cx.nb * NWAVES;
    const bf16_t* P = (const bf16_t*)(p.ws + z + WS_P);
    const float* QN = (const float*)(p.ws + z + WS_QN); const float* KN = (const float*)(p.ws + z + WS_KN);
    bf16_t* Y = (bf16_t*)(p.ws + z + WS_YCAT);
    for (int it = MP * 4 + gw; it < R * 4; it += GW) {
        const int row = it >> 2, hq = it & 3, kvh = hq >> 1;
        const bool samp = row >= MP; const int n = samp ? row - MP : row >> 13, t = samp ? 0 : (row & (T - 1));
        const int rowbase = row - t;
        const float* q = QN + (size_t)row * 256 + hq * 64;
        const float sink = PIN(I_SINK)[(size_t)l * 4 + hq];
        f32x4 qreg[16];
#pragma unroll
        for (int d4 = 0; d4 < 16; ++d4) qreg[d4] = *(const f32x4*)(q + 4 * d4);
        float sc[3]; float mx = -INFINITY;
#pragma unroll
        for (int j = 0; j < 3; ++j) {
            const int i = lane + 64 * j; sc[j] = -INFINITY;
            if (i <= 128) {
                const int pos = t - 128 + i;
                const float* kp = nullptr;
                if (pos >= 0) kp = KN + (size_t)(rowbase + pos) * 128 + kvh * 64;
                else if (samp) kp = PIN(I_CK) + (((size_t)l * NS + n) * 128 + i) * 128 + kvh * 64;
                if (kp) { float s = 0.f;
#pragma unroll
                    for (int hf = 0; hf < 2; ++hf) {
                        f32x4 kv[8];
#pragma unroll
                        for (int d4 = 0; d4 < 8; ++d4) kv[d4] = *(const f32x4*)(kp + 32 * hf + 4 * d4);
#pragma unroll
                        for (int d4 = 0; d4 < 8; ++d4) { const f32x4 qv = qreg[8 * hf + d4]; s += (qv[0] * kv[d4][0] + qv[1] * kv[d4][1]) + (qv[2] * kv[d4][2] + qv[3] * kv[d4][3]); }
                        __builtin_amdgcn_sched_barrier(0);
                    }
                    sc[j] = s * 0.125f; }
            }
            mx = fmaxf(mx, sc[j]);
            __builtin_amdgcn_sched_barrier(0);
        }
        mx = fmaxf(wave_max(mx), sink);
        float pr[3]; float sum = 0.f;
#pragma unroll
        for (int j = 0; j < 3; ++j) { pr[j] = sc[j] == -INFINITY ? 0.f : __expf(sc[j] - mx); sum += pr[j]; }
        sum = wave_sum(sum) + __expf(sink - mx);
        float o = 0.f;
        for (int i = 0; i <= 128; ++i) {
            const float prs = i < 64 ? pr[0] : (i < 128 ? pr[1] : pr[2]);
            const float pi = __shfl(prs, i & 63);
            const int pos = t - 128 + i;
            float v = 0.f;
            if (pos >= 0) v = bf2f(P[(size_t)(rowbase + pos) * PCOLS + OFF_B + 384 + kvh * 64 + lane]);
            else if (samp) v = PIN(I_CV)[(((size_t)l * NS + n) * 128 + i) * 128 + kvh * 64 + lane];
            o += pi * v;
        }
        Y[(size_t)row * D + 256 + hq * 64 + lane] = f2bf(o / sum);
    }
}

constexpr int LDV = 264;
__device__ __forceinline__ void stage_attn(const Params& p, int l, unsigned char* lds, int first = 0) {
    const Ctx cx = mkctx(p, first); const size_t z = cx.z;
    const int tid = cx.tid, lane = tid & 63, wave = __builtin_amdgcn_readfirstlane(tid >> 6), r = lane & 15, q = lane >> 4;
    bf16_t* Ks = (bf16_t*)lds;
    bf16_t* Qs = (bf16_t*)(lds + 36864);
    bf16_t* Vt = (bf16_t*)(lds + 73728);
    const bf16_t* P = (const bf16_t*)(p.ws + z + WS_P);
    bf16_t* Y = (bf16_t*)(p.ws + z + WS_YCAT);
    for (int unit = cx.bid; unit < NP * 2 * (T / 128); unit += cx.nb) {
        const int b = unit & 63, kvh = (unit >> 6) & 1, n = unit >> 7, t0 = b * 128;
        const size_t rowb = (size_t)n * T;
        float gk[8], gq[8];
#pragma unroll
        for (int j = 0; j < 8; ++j) { gk[j] = PIN(I_KNG)[(size_t)l * 64 + (tid & 7) * 8 + j]; gq[j] = PIN(I_QNG)[(size_t)l * 64 + (tid & 7) * 8 + j]; }
        bf16x8 kraw[4], qraw[4], vraw[4];
#pragma unroll
        for (int it = 0; it < 4; ++it) {
            const int task = it * NTHREADS + tid, c8 = task & 7, kk = task >> 3, kp = t0 - 128 + kk, g = kk >> 7, tl = kk & 127;
            const bf16x8 zz = {0, 0, 0, 0, 0, 0, 0, 0};
            kraw[it] = kp >= 0 ? *(const bf16x8*)(P + (rowb + kp) * PCOLS + OFF_B + 256 + kvh * 64 + c8 * 8) : zz;
            qraw[it] = *(const bf16x8*)(P + (rowb + t0 + tl) * PCOLS + OFF_B + (kvh * 2 + g) * 64 + c8 * 8);
            const int d = task & 63, m0 = (task >> 6) * 8;
#pragma unroll
            for (int j = 0; j < 8; ++j) { const int vp = t0 - 128 + m0 + j; vraw[it][j] = vp >= 0 ? (short)P[(rowb + vp) * PCOLS + OFF_B + 384 + kvh * 64 + d] : (short)0; }
        }
#pragma unroll
        for (int it = 0; it < 4; ++it) {
            const int task = it * NTHREADS + tid, c8 = task & 7;
            {
                const int kk = task >> 3;
                float x[8]; float ss = 0.f;
#pragma unroll
                for (int j = 0; j < 8; ++j) { x[j] = bf2f((bf16_t)kraw[it][j]); ss += x[j] * x[j]; }
                ss += __shfl_xor(ss, 1); ss += __shfl_xor(ss, 2); ss += __shfl_xor(ss, 4);
                const float rstd = rsqrtf(ss * (1.f / 64.f) + NORM_EPS);
                bf16x8 o;
#pragma unroll
                for (int j = 0; j < 8; ++j) { x[j] = x[j] * rstd * gk[j]; o[j] = (short)f2bf(x[j]); }
                *(bf16x8*)(Ks + kk * LD + c8 * 8) = o;
                if (b == 63 && kk >= 128) { float* ko = (p.out + z) + O_PK + (((size_t)l * NP + n) * 128 + (kk - 128)) * 128 + kvh * 64 + c8 * 8;
#pragma unroll
                    for (int j = 0; j < 8; ++j) ko[j] = x[j]; }
            }
            {
                const int qr = task >> 3;
                float x[8]; float ss = 0.f;
#pragma unroll
                for (int j = 0; j < 8; ++j) { x[j] = bf2f((bf16_t)qraw[it][j]); ss += x[j] * x[j]; }
                ss += __shfl_xor(ss, 1); ss += __shfl_xor(ss, 2); ss += __shfl_xor(ss, 4);
                const float rstd = rsqrtf(ss * (1.f / 64.f) + NORM_EPS) * 0.125f;
                bf16x8 o;
#pragma unroll
                for (int j = 0; j < 8; ++j) o[j] = (short)f2bf(x[j] * rstd * gq[j]);
                *(bf16x8*)(Qs + qr * LD + c8 * 8) = o;
            }
            {
                const int d = task & 63, m0 = (task >> 6) * 8;
                *(bf16x8*)(Vt + d * LDV + m0) = vraw[it];
                if (b == 63 && m0 >= 128) { float* vo = (p.out + z) + O_PV + (((size_t)l * NP + n) * 128 + (m0 - 128)) * 128 + kvh * 64 + d;
#pragma unroll
                    for (int j = 0; j < 8; ++j) vo[j * 128] = bf2f((bf16_t)vraw[it][j]); }
            }
        }
        __syncthreads();
        {
            const int g = wave >> 2, sb = wave & 3, hq = kvh * 2 + g;
            const float sink = PIN(I_SINK)[(size_t)l * 4 + hq];
#pragma unroll 1
            for (int mt = 0; mt < 2; ++mt) {
                const int ql = 32 * sb + 16 * mt + r;
                const bf16_t* Qb = Qs + (g * 128 + 32 * sb + 16 * mt) * LD;
                f32x4 sacc[10]; float mx = -INFINITY;
#pragma unroll
                for (int j = 0; j < 10; ++j) {
                    f32x4 a = {0.f, 0.f, 0.f, 0.f};
                    a = mma16_k64(Ks + (32 * sb + 16 * j) * LD, Qb, a, r, q);
#pragma unroll
                    for (int e = 0; e < 4; ++e) { const int kk = 32 * sb + 16 * j + 4 * q + e, rel = ql + 128 - kk;
                        const bool ok = rel >= 0 && rel <= 128 && (t0 - 128 + kk) >= 0;
                        a[e] = ok ? a[e] : -INFINITY; mx = fmaxf(mx, a[e]); }
                    sacc[j] = a;
                    __builtin_amdgcn_sched_barrier(0);
                }
                mx = fmaxf(mx, __shfl_xor(mx, 16)); mx = fmaxf(mx, __shfl_xor(mx, 32)); mx = fmaxf(mx, sink);
                float sum = 0.f;
#pragma unroll
                for (int j = 0; j < 10; ++j)
#pragma unroll
                    for (int e = 0; e < 4; ++e) { const float pv = __expf(sacc[j][e] - mx); sacc[j][e] = pv; sum += pv; }
                sum += __shfl_xor(sum, 16); sum += __shfl_xor(sum, 32); sum += __expf(sink - mx);
                const float inv = 1.f / sum;
                f32x4 o[4];
#pragma unroll
                for (int dt = 0; dt < 4; ++dt) o[dt] = (f32x4){0.f, 0.f, 0.f, 0.f};
#pragma unroll
                for (int s2 = 0; s2 < 5; ++s2) {
                    const bf16x4 p0 = pack4(sacc[2 * s2]), p1 = pack4(sacc[2 * s2 + 1]);
                    const bf16x8 pb = {p0[0], p0[1], p0[2], p0[3], p1[0], p1[1], p1[2], p1[3]};
#pragma unroll
                    for (int dt = 0; dt < 4; ++dt) {
                        const bf16_t* vp = Vt + (16 * dt + r) * LDV + 32 * sb + 32 * s2 + 4 * q;
                        const bf16x4 v0 = *(const bf16x4*)vp, v1 = *(const bf16x4*)(vp + 16);
                        const bf16x8 va = {v0[0], v0[1], v0[2], v0[3], v1[0], v1[1], v1[2], v1[3]};
                        o[dt] = __builtin_amdgcn_mfma_f32_16x16x32_bf16(va, pb, o[dt], 0, 0, 0);
                    }
                    __builtin_amdgcn_sched_barrier(0);
                }
                bf16_t* yo = Y + (rowb + t0 + ql) * D + 256 + hq * 64 + 4 * q;
#pragma unroll
                for (int dt = 0; dt < 4; ++dt) { f32x4 ov = o[dt] * inv; *(bf16x4*)(yo + 16 * dt) = pack4(ov); }
            }
        }
        __syncthreads();
    }
}

__device__ __forceinline__ void mconv_unit(const Params& p, size_t z, int l, int n, int c, int g, int tid) {
    const bf16_t* P = (const bf16_t*)(p.ws + z + WS_P);
    bf16_t* XB = (bf16_t*)(p.ws + z + WS_XBCC);
    const float* cw = PIN(I_CONVW) + (size_t)l * 4 * 1024; const float* cb = PIN(I_CONVB) + (size_t)l * 1024;
#pragma unroll 1
    for (int i = tid; i < 1024; i += NTHREADS) {
        const int ch = i & 63, c0 = ch < 32 ? g * 256 + ch * 8 : (ch < 48 ? 512 + g * 128 + (ch - 32) * 8 : 768 + g * 128 + (ch - 48) * 8);
        const int row = n * T + c * 128 + (i >> 6) * 8, t = row & (T - 1);
        bf16x8 u[11];
#pragma unroll
        for (int k = 0; k < 11; ++k) { const bf16x8 zz = {0, 0, 0, 0, 0, 0, 0, 0}; u[k] = (t - 3 + k >= 0) ? *(const bf16x8*)(P + (size_t)(row - 3 + k) * PCOLS + OFF_XBC + c0) : zz; }
        float w[4][8], b[8];
#pragma unroll
        for (int e = 0; e < 8; ++e) { b[e] = cb[c0 + e];
#pragma unroll
            for (int j = 0; j < 4; ++j) w[j][e] = cw[j * 1024 + c0 + e]; }
#pragma unroll
        for (int r = 0; r < 8; ++r) { bf16x8 o;
#pragma unroll
            for (int e = 0; e < 8; ++e) { float acc = b[e];
#pragma unroll
                for (int j = 0; j < 4; ++j) acc += w[j][e] * bf2f((bf16_t)u[r + j][e]);
                o[e] = (short)f2bf(silu_f(acc)); }
            *(bf16x8*)(XB + (size_t)(row + r) * 1024 + c0) = o;
            if (t + r >= T - 3) { float* op = (p.out + z) + O_PCONV + (((size_t)l * NP + n) * 3 + (t + r - (T - 3))) * 1024 + c0;
#pragma unroll
                for (int e = 0; e < 8; ++e) op[e] = bf2f((bf16_t)u[3 + r][e]); }
        }
    }
}

__device__ __forceinline__ void stage_mconv(const Params& p, int l) {
    const Ctx cx = mkctx(p); const size_t z = cx.z;
    const unsigned gt = (unsigned)cx.bid * NTHREADS + cx.tid, GT = (unsigned)cx.nb * NTHREADS;
    const bf16_t* P = (const bf16_t*)(p.ws + z + WS_P);
    bf16_t* XB = (bf16_t*)(p.ws + z + WS_XBCC); float* DT = (float*)(p.ws + z + WS_DT);
    const float* cw = PIN(I_CONVW) + (size_t)l * 4 * 1024; const float* cb = PIN(I_CONVB) + (size_t)l * 1024;
    for (unsigned i = (unsigned)MP * 1024 + gt; i < (unsigned)R * 1024; i += GT) {
        const int c = (int)(i & 1023), row = (int)(i >> 10), n = row - MP;
        const float* st = PIN(I_SCONV) + ((size_t)l * NS + n) * 3 * 1024 + c;
        const float raw = bf2f(P[(size_t)row * PCOLS + OFF_XBC + c]);
        const float acc = cb[c] + cw[c] * st[0] + cw[1024 + c] * st[1024] + cw[2048 + c] * st[2048] + cw[3072 + c] * raw;
        XB[i] = f2bf(silu_f(acc));
        float* o = (p.out + z) + O_SCONV + ((size_t)l * NS + n) * 3 * 1024 + c;
        o[0] = st[1024]; o[1024] = st[2048]; o[2048] = raw;
    }
    float* DT2 = (float*)(p.ws + z + WS_DT2);
    for (unsigned i = (unsigned)MP * 8 + gt; i < (unsigned)R * 8; i += GT) DT2[i] = softplus_f(DT[i] + PIN(I_DTB)[(size_t)l * 8 + (i & 7)]);
}

__device__ __forceinline__ void stage_mscan(const Params& p, int l, float* lds, int first = 0) {
    const Ctx cx = mkctx(p, first); const size_t z = cx.z;
    const int lane = cx.tid & 63, wave = cx.tid >> 6;
    const bf16_t* XB = (const bf16_t*)(p.ws + z + WS_XBCC); const float* DT = (const float*)(p.ws + z + WS_DT2);
    float* YT = (float*)(p.ws + z + WS_YTMP);
    float* wl = lds + wave * 512;
    const int dh = lane & 1, pl = lane >> 1;
    for (int u = NP * 16 + flip_bid(cx) + cx.nb * wave; u < NSEQ * 16; u += cx.nb * NWAVES) {
        const int s = u >> 4, h = (u >> 1) & 7, ph = u & 1, g = h >> 2; const bool samp = s >= NP; const int n = samp ? s - NP : s;
        const int row0 = samp ? MP + n : n * T, nt = samp ? 1 : T, pp = ph * 32 + pl;
        float hs[64];
        if (samp) { const float* st = PIN(I_SSM) + ((((size_t)l * NS + n) * 8 + h) * 64 + pp) * 128 + dh * 64;
#pragma unroll
            for (int d = 0; d < 64; d += 4) { const f32x4 v4 = *(const f32x4*)(st + d); hs[d] = v4[0]; hs[d + 1] = v4[1]; hs[d + 2] = v4[2]; hs[d + 3] = v4[3]; } }
        else {
#pragma unroll
            for (int d = 0; d < 64; ++d) hs[d] = 0.f; }
        const float A = -__expf(PIN(I_ALOG)[(size_t)l * 8 + h]), Dh = PIN(I_SSMD)[(size_t)l * 8 + h];
        for (int t = 0; t < nt; ++t) {
            const size_t row = (size_t)row0 + t;
            const float dtv = DT[row * 8 + h], dA = __expf(dtv * A);
            const float x = bf2f(XB[row * 1024 + h * 64 + pp]), xdt = x * dtv;
            const bf16_t* b = XB + row * 1024 + 512 + g * 128; const bf16_t* c = XB + row * 1024 + 768 + g * 128;
            WAVE_LDS_SYNC();
            wl[lane] = bf2f(b[lane]); wl[64 + lane] = bf2f(b[64 + lane]); wl[128 + lane] = bf2f(c[lane]); wl[192 + lane] = bf2f(c[64 + lane]);
            WAVE_LDS_SYNC();
            float y = 0.f;
#pragma unroll
            for (int d = 0; d < 64; ++d) { hs[d] = hs[d] * dA + xdt * wl[dh * 64 + d]; y += hs[d] * wl[128 + dh * 64 + d]; }
            y += __shfl_xor(y, 1);
            if (dh == 0) YT[row * 512 + h * 64 + pp] = y + Dh * x;
        }
        float* so = (p.out + z) + (samp ? O_SSSM + ((((size_t)l * NS + n) * 8 + h) * 64 + pp) * 128 : O_PSSM + ((((size_t)l * NP + n) * 8 + h) * 64 + pp) * 128) + dh * 64;
#pragma unroll
        for (int d = 0; d < 64; d += 4) *(f32x4*)(so + d) = (f32x4){hs[d], hs[d + 1], hs[d + 2], hs[d + 3]};
    }
}

__device__ __forceinline__ void mgate_rows(const Params& p, size_t z, int l, int row_lo, int row_hi, int gw, int GW, int lane) {
    const bf16_t* P = (const bf16_t*)(p.ws + z + WS_P); const float* YT = (const float*)(p.ws + z + WS_YTMP);
    bf16_t* Y = (bf16_t*)(p.ws + z + WS_YCAT);
    const f32x4 g0 = *(const f32x4*)(PIN(I_SSMNG) + (size_t)l * 512 + lane * 8), g1 = *(const f32x4*)(PIN(I_SSMNG) + (size_t)l * 512 + lane * 8 + 4);
    for (int row = row_lo + 2 * gw; row < row_hi; row += 2 * GW) {
        f32x4 ya[2][2]; bf16x8 zz[2];
#pragma unroll
        for (int k = 0; k < 2; ++k) { ya[k][0] = *(const f32x4*)(YT + (size_t)(row + k) * 512 + lane * 8); ya[k][1] = *(const f32x4*)(YT + (size_t)(row + k) * 512 + lane * 8 + 4);
            zz[k] = *(const bf16x8*)(P + (size_t)(row + k) * PCOLS + OFF_Z + lane * 8); }
#pragma unroll
        for (int k = 0; k < 2; ++k) {
            float v[8]; float ss = 0.f;
#pragma unroll
            for (int e = 0; e < 8; ++e) { v[e] = ya[k][e >> 2][e & 3] * silu_f(bf2f((bf16_t)zz[k][e])); ss += v[e] * v[e]; }
            const float rstd = rsqrtf(wave_sum(ss) * (1.f / 512.f) + NORM_EPS);
            bf16x8 o;
#pragma unroll
            for (int e = 0; e < 8; ++e) o[e] = (short)f2bf(v[e] * rstd * (e < 4 ? g0[e & 3] : g1[e & 3]));
            *(bf16x8*)(Y + (size_t)(row + k) * D + 512 + lane * 8) = o;
        }
    }
}
constexpr int SL = 128, SNC = T / SL;
__device__ __forceinline__ f32x4 mma16(const bf16_t* A, const bf16_t* Bt, int nsteps, f32x4 acc, int r, int q) {
#pragma unroll
    for (int s = 0; s < 4; ++s) if (s < nsteps) {
        const bf16x8 a = *(const bf16x8*)(A + r * LD2 + 32 * s + 8 * q), b = *(const bf16x8*)(Bt + r * LD2 + 32 * s + 8 * q);
        acc = __builtin_amdgcn_mfma_f32_16x16x32_bf16(a, b, acc, 0, 0, 0);
    }
    return acc;
}
constexpr int SSD_OFF_AUX = 104448;
template <bool FROM_RAW>
__device__ __forceinline__ void ssd_aux(const Params& p, size_t z, int l, int g, int row0, float* aux, int tid) {
    float* DT2 = (float*)(p.ws + z + WS_DT2);
    const int t = tid & 127, e = tid >> 7, h = g * 4 + e;
    float dtv;
    if (FROM_RAW) { dtv = softplus_f(((const float*)(p.ws + z + WS_DT))[(size_t)(row0 + t) * 8 + h] + PIN(I_DTB)[(size_t)l * 8 + h]); DT2[(size_t)(row0 + t) * 8 + h] = dtv; }
    else dtv = DT2[(size_t)(row0 + t) * 8 + h];
    const float A = -__expf(PIN(I_ALOG)[(size_t)l * 8 + h]);
    aux[e * 128 + t] = dtv; aux[512 + e * 128 + t] = dtv * A;
    __syncthreads();
    float acc = 0.f;
    for (int i = 0; i <= t; ++i) acc += aux[512 + e * 128 + i];
    aux[1024 + e * 128 + t] = acc;
    __syncthreads();
}
__device__ __forceinline__ void stage_ssd1(const Params& p, int l, unsigned char* lds) {
    const Ctx cx = mkctx(p); const size_t z = cx.z;
    const int tid = cx.tid, lane = tid & 63, wave = __builtin_amdgcn_readfirstlane(tid >> 6), r = lane & 15, q = lane >> 4;
    bf16_t* BT = (bf16_t*)lds;
    bf16_t* XW = (bf16_t*)(lds + 34816);
    float* aux = (float*)(lds + SSD_OFF_AUX);
    const bf16_t* XB = (const bf16_t*)(p.ws + z + WS_XBCC);
    float* ST = (float*)(p.ws + z + WS_SST); float* CD = (float*)(p.ws + z + WS_SCD);
    for (int unit = cx.bid; unit < NP * SNC * 2; unit += cx.nb) {
        const int g = unit & 1, c = (unit >> 1) & (SNC - 1), n = unit >> 7, row0 = n * T + c * SL;
        mconv_unit(p, z, l, n, c, g, tid);
        asm volatile("s_waitcnt vmcnt(0)" ::: "memory"); __syncthreads();
        const int d = tid & 127, mg = tid >> 7, pp = tid & 63, mgp = tid >> 6;
        bf16x8 bv[4], xv[4][2];
#pragma unroll
        for (int it = 0; it < 4; ++it) { const int m0 = mg * 32 + it * 8;
#pragma unroll
            for (int j = 0; j < 8; ++j) bv[it][j] = (short)XB[(size_t)(row0 + m0 + j) * 1024 + 512 + g * 128 + d]; }
#pragma unroll
        for (int e = 0; e < 4; ++e)
#pragma unroll
            for (int it = 0; it < 2; ++it) { const int m0 = mgp * 16 + it * 8;
#pragma unroll
                for (int j = 0; j < 8; ++j) xv[e][it][j] = (short)XB[(size_t)(row0 + m0 + j) * 1024 + (g * 4 + e) * 64 + pp]; }
        ssd_aux<true>(p, z, l, g, row0, aux, tid);
        {
#pragma unroll
            for (int it = 0; it < 4; ++it) *(bf16x8*)(BT + d * LD2 + mg * 32 + it * 8) = bv[it];
#pragma unroll
            for (int e = 0; e < 4; ++e) { const float alast = aux[1024 + e * 128 + 127];
#pragma unroll
                for (int it = 0; it < 2; ++it) { const int m0 = mgp * 16 + it * 8; bf16x8 v;
#pragma unroll
                    for (int j = 0; j < 8; ++j) { const int m = m0 + j; v[j] = (short)f2bf(bf2f((bf16_t)xv[e][it][j]) * aux[e * 128 + m] * __expf(alast - aux[1024 + e * 128 + m])); }
                    *(bf16x8*)(XW + e * 64 * LD2 + pp * LD2 + m0) = v; } }
        }
        __syncthreads();
#pragma unroll
        for (int e = 0; e < 4; ++e) {
            float* st = ST + ((size_t)(n * SNC + c) * 8 + g * 4 + e) * 8192;
#pragma unroll
            for (int nt = 0; nt < 4; ++nt) {
                f32x4 acc = {0.f, 0.f, 0.f, 0.f};
                acc = mma16(BT + 16 * wave * LD2, XW + e * 64 * LD2 + 16 * nt * LD2, 4, acc, r, q);
                *(f32x4*)(st + (16 * nt + r) * 128 + 16 * wave + 4 * q) = acc;
            }
        }
        if (tid < 4) CD[(size_t)(n * SNC + c) * 8 + g * 4 + tid] = __expf(aux[1024 + tid * 128 + 127]);
        __syncthreads();
    }
}
__device__ __forceinline__ void stage_ssd2(const Params& p, int l) {
    const Ctx cx = mkctx(p); const size_t z = cx.z;
    const int first = cx.nb > 32 ? RW2_WGS : 0;
    if (cx.bid >= first) {
        typedef float f32x2 __attribute__((ext_vector_type(2)));
        const float* ST = (const float*)(p.ws + z + WS_SST); const float* CD = (const float*)(p.ws + z + WS_SCD);
        unsigned* HPV = (unsigned*)(p.ws + z + WS_HPREV);
        for (int idx = (cx.bid - first) * NTHREADS + cx.tid; idx < NP * 8 * 4096; idx += (cx.nb - first) * NTHREADS) {
            const int n = idx >> 15, h = (idx >> 12) & 7, pd = (idx & 4095) * 2;
            const float* base = ST + ((size_t)(n * SNC) * 8 + h) * 8192 + pd; const float* cd = CD + (size_t)(n * SNC) * 8 + h;
            unsigned* hb = HPV + (((size_t)(n * SNC) * 8 + h) * 8192 + pd) / 2;
            f32x2 hc = {0.f, 0.f};
#pragma unroll 1
            for (int c0 = 0; c0 < SNC; c0 += 16) {
                f32x2 v[16]; float dcy[16];
#pragma unroll
                for (int k = 0; k < 16; ++k) { v[k] = *(const f32x2*)(base + (size_t)(c0 + k) * 65536); dcy[k] = cd[(c0 + k) * 8]; }
#pragma unroll
                for (int k = 0; k < 16; ++k) { hb[(size_t)(c0 + k) * 32768] = cvtpk(hc[0], hc[1]); hc = hc * dcy[k] + v[k]; }
            }
            *(f32x2*)((p.out + z) + O_PSSM + ((size_t)(l * NP + n) * 8 + h) * 8192 + pd) = hc;
        }
    }
}
__device__ __forceinline__ void stage_ssd3(const Params& p, int l, unsigned char* lds, int first = 0, int count = 0) {
    const Ctx cx = mkctx(p, first, count); const size_t z = cx.z;
    const int tid = cx.tid, lane = tid & 63, wave = __builtin_amdgcn_readfirstlane(tid >> 6), r = lane & 15, q = lane >> 4;
    bf16_t* CM = (bf16_t*)lds;
    bf16_t* BG = (bf16_t*)(lds + 34816);
    bf16_t* XT = (bf16_t*)(lds + 69632);
    bf16_t* HP = (bf16_t*)(lds + 87040);
    float* aux = (float*)(lds + SSD_OFF_AUX);
    const bf16_t* XB = (const bf16_t*)(p.ws + z + WS_XBCC);
    const bf16_t* HPV = (const bf16_t*)(p.ws + z + WS_HPREV);
    float* YT = (float*)(p.ws + z + WS_YTMP);
    for (int u2 = cx.bid; u2 < NP * SNC; u2 += cx.nb)
    for (int g = 0; g < 2; ++g) {
        const int c = u2 & (SNC - 1), n = u2 >> 6, row0 = n * T + c * SL;
        bf16x8 cc[4], bb[4];
        {
            const int d0 = (tid & 15) * 8;
#pragma unroll
            for (int it = 0; it < 4; ++it) { const int row = (tid >> 4) + 32 * it;
                cc[it] = *(const bf16x8*)(XB + (size_t)(row0 + row) * 1024 + 768 + g * 128 + d0); bb[it] = *(const bf16x8*)(XB + (size_t)(row0 + row) * 1024 + 512 + g * 128 + d0); }
        }
        ssd_aux<false>(p, z, l, g, row0, aux, tid);
        {
            const int d0 = (tid & 15) * 8;
#pragma unroll
            for (int it = 0; it < 4; ++it) { const int row = (tid >> 4) + 32 * it; *(bf16x8*)(CM + row * LD2 + d0) = cc[it]; *(bf16x8*)(BG + row * LD2 + d0) = bb[it]; }
        }
        __syncthreads();
        f32x4 cb[8];
#pragma unroll
        for (int nt = 0; nt < 8; ++nt) { cb[nt] = (f32x4){0.f, 0.f, 0.f, 0.f}; if (nt <= wave) cb[nt] = mma16(CM + 16 * wave * LD2, BG + 16 * nt * LD2, 4, cb[nt], r, q); }
        __syncthreads();
        const int xpp = tid & 63, xmg = tid >> 6, hpp = tid >> 3, hd0 = (tid & 7) * 16;
        bf16_t xr[16]; bf16x8 hv[2];
#define SSD3_FETCH(ee) do { const int hh_ = g * 4 + (ee); \
            _Pragma("unroll") for (int j_ = 0; j_ < 16; ++j_) xr[j_] = XB[(size_t)(row0 + xmg * 16 + j_) * 1024 + hh_ * 64 + xpp]; \
            const bf16_t* src_ = HPV + ((size_t)(n * SNC + c) * 8 + hh_) * 8192 + hpp * 128 + hd0; \
            hv[0] = *(const bf16x8*)src_; hv[1] = *(const bf16x8*)(src_ + 8); } while (0)
        SSD3_FETCH(0);
#pragma unroll 1
        for (int e = 0; e < 4; ++e) {
            const int h = g * 4 + e;
            {
#pragma unroll
                for (int nt = 0; nt < 8; ++nt) { const int m = 16 * nt + r; const float am = aux[1024 + e * 128 + m];
#pragma unroll
                    for (int e2 = 0; e2 < 4; ++e2) { const int li = 16 * wave + 4 * q + e2; const float v = (m <= li) ? cb[nt][e2] * __expf(aux[1024 + e * 128 + li] - am) : 0.f; BG[li * LD2 + m] = f2bf(v); } }
#pragma unroll
                for (int it = 0; it < 2; ++it) { const int m0 = xmg * 16 + it * 8; bf16x8 v;
#pragma unroll
                    for (int j = 0; j < 8; ++j) v[j] = (short)f2bf(bf2f(xr[it * 8 + j]) * aux[e * 128 + m0 + j]);
                    *(bf16x8*)(XT + xpp * LD2 + m0) = v; }
                *(bf16x8*)(HP + hpp * LD2 + hd0) = hv[0]; *(bf16x8*)(HP + hpp * LD2 + hd0 + 8) = hv[1];
                if (e + 1 < 4) SSD3_FETCH(e + 1);
            }
            __syncthreads();
            {
                const int li = 16 * wave + r; const size_t row = (size_t)row0 + li;
                const float sc = __expf(aux[1024 + e * 128 + li]), Dh = PIN(I_SSMD)[(size_t)l * 8 + h];
                bf16x4 xq[4];
#pragma unroll
                for (int mt = 0; mt < 4; ++mt) xq[mt] = *(const bf16x4*)(XB + row * 1024 + h * 64 + 16 * mt + 4 * q);
#pragma unroll
                for (int mt = 0; mt < 4; ++mt) {
                    f32x4 ad = {0.f, 0.f, 0.f, 0.f}, ao = {0.f, 0.f, 0.f, 0.f};
                    ad = mma16(XT + 16 * mt * LD2, BG + 16 * wave * LD2, (wave >> 1) + 1, ad, r, q);
                    ao = mma16(HP + 16 * mt * LD2, CM + 16 * wave * LD2, 4, ao, r, q);
                    const bf16x4 xv = xq[mt];
                    f32x4 y;
#pragma unroll
                    for (int e2 = 0; e2 < 4; ++e2) y[e2] = ad[e2] + sc * ao[e2] + Dh * bf2f((bf16_t)xv[e2]);
                    *(f32x4*)(YT + row * 512 + h * 64 + 16 * mt + 4 * q) = y;
                }
            }
            __syncthreads();
        }
        if (g == 1) { asm volatile("s_waitcnt vmcnt(0)" ::: "memory"); __syncthreads(); mgate_rows(p, z, l, row0, row0 + SL, wave, NWAVES, lane); }
#undef SSD3_FETCH
    }
}

__device__ __forceinline__ void stage_mgate_sample(const Params& p, int l, int first) {
    const Ctx cx = mkctx(p, first); const size_t z = cx.z;
    mgate_rows(p, z, l, MP, R, cx.bid * NWAVES + (cx.tid >> 6), cx.nb * NWAVES, cx.tid & 63);
}

__device__ __forceinline__ void stage_glu(const Params& p, int l) {
    const Ctx cx = mkctx(p); const size_t z = cx.z;
    const unsigned gt = (unsigned)cx.bid * NTHREADS + cx.tid, GT = (unsigned)cx.nb * NTHREADS;
    const bf16_t* GV = (const bf16_t*)(p.ws + z + WS_GV); bf16_t* U = (bf16_t*)(p.ws + z + WS_U);
    const float* cw = PIN(I_FCW) + (size_t)l * 3 * DFF; const float* cb = PIN(I_FCB) + (size_t)l * DFF;
    for (unsigned i = gt; i < (unsigned)(MP / 32) * (DFF / 8); i += GT) {
        const int hr = (int)(i / (unsigned)(DFF / 8)), c0 = (int)(i - (unsigned)hr * (DFF / 8)) * 8, row = (hr >> 1) * 64 + (hr & 1), t = row & (T - 1);
        const int cg = 256 * (c0 >> 7) + (c0 & 127);
        bf16x8 u[3];
#pragma unroll
        for (int k = 0; k < 3; ++k) { const bf16x8 zz = {0, 0, 0, 0, 0, 0, 0, 0}; u[k] = (t - 2 + k >= 0) ? *(const bf16x8*)(GV + (size_t)(row - 2 + k) * 5632 + cg) : zz; }
        const bf16x8 vv = *(const bf16x8*)(GV + (size_t)row * 5632 + cg + 128);
        bf16x8 o;
#pragma unroll
        for (int e = 0; e < 8; ++e) { const float acc = cb[c0 + e] + cw[c0 + e] * bf2f((bf16_t)u[0][e]) + cw[DFF + c0 + e] * bf2f((bf16_t)u[1][e]) + cw[2 * DFF + c0 + e] * bf2f((bf16_t)u[2][e]);
            o[e] = (short)f2bf(silu_f(acc) * bf2f((bf16_t)vv[e])); }
        *(bf16x8*)(U + (size_t)row * DFF + c0) = o;
    }
    for (unsigned i = gt; i < (unsigned)NP * 2 * DFF; i += GT) {
        const int c = (int)(i % (unsigned)DFF), j = (int)(i / (unsigned)DFF) & 1, n = (int)(i / (unsigned)(2 * DFF));
        (p.out + z)[O_PFFN + (((size_t)l * NP + n) * 2 + j) * DFF + c] = bf2f(GV[(size_t)(n * T + T - 2 + j) * 5632 + 256 * (c >> 7) + (c & 127)]);
    }
    for (unsigned i = (unsigned)MP * (DFF / 8) + gt; i < (unsigned)R * (DFF / 8); i += GT) {
        const int row = (int)(i / (unsigned)(DFF / 8)), c0 = (int)(i - (unsigned)row * (DFF / 8)) * 8;
        const int cg = 256 * (c0 >> 7) + (c0 & 127);
        const bool samp = row >= MP; const int n = samp ? row - MP : row >> 13, t = samp ? 0 : (row & (T - 1));
        float acc[8], raw[8];
#pragma unroll
        for (int e = 0; e < 8; ++e) acc[e] = cb[c0 + e];
#pragma unroll
        for (int j = 0; j < 3; ++j) {
            const int tau = t - 2 + j; float u[8];
            if (tau >= 0) { const bf16x8 v = *(const bf16x8*)(GV + (size_t)(row - 2 + j) * 5632 + cg);
#pragma unroll
                for (int e = 0; e < 8; ++e) u[e] = bf2f((bf16_t)v[e]); }
            else {
#pragma unroll
                for (int e = 0; e < 8; ++e) u[e] = samp ? PIN(I_FCONV)[(((size_t)l * NS + n) * 2 + (2 + tau)) * DFF + c0 + e] : 0.f; }
#pragma unroll
            for (int e = 0; e < 8; ++e) { acc[e] += cw[j * DFF + c0 + e] * u[e]; if (j == 2) raw[e] = u[e]; }
        }
        const bf16x8 vv = *(const bf16x8*)(GV + (size_t)row * 5632 + cg + 128);
        bf16x8 o;
#pragma unroll
        for (int e = 0; e < 8; ++e) o[e] = (short)f2bf(silu_f(acc[e]) * bf2f((bf16_t)vv[e]));
        *(bf16x8*)(U + (size_t)row * DFF + c0) = o;
        if (samp) { float* op = (p.out + z) + O_SFFN + ((size_t)l * NS + n) * 2 * DFF + c0;
#pragma unroll
            for (int e = 0; e < 8; ++e) { op[e] = PIN(I_FCONV)[(((size_t)l * NS + n) * 2 + 1) * DFF + c0 + e]; op[DFF + e] = raw[e]; } }
        else if (t >= T - 2) { float* op = (p.out + z) + O_PFFN + (((size_t)l * NP + n) * 2 + (t - (T - 2))) * DFF + c0;
#pragma unroll
            for (int e = 0; e < 8; ++e) op[e] = raw[e]; }
    }
}

__device__ __forceinline__ void stage_final(const Params& p) {
    const Ctx cx = mkctx(p); const size_t z = cx.z;
    const size_t gt = (size_t)cx.bid * NTHREADS + cx.tid, GT = (size_t)cx.nb * NTHREADS;
    const float* X = (const float*)(p.out + z);
    for (size_t i = gt; i < (size_t)R * D; i += GT) (p.out + z)[i] = X[i];
}

#define LAS __attribute__((address_space(3)))
typedef unsigned v4u __attribute__((ext_vector_type(4)));
__device__ __forceinline__ unsigned pk2(float lo, float hi) { return cvtpk(lo, hi); }
template <bool GV_PERM = false>
__device__ __forceinline__ void p0_transpose_item(const float* W, int ldw, int K, int nblk, bf16_t* WT, LAS float* scr, int item, int lane) {
    const int kb = item / nblk, nb = item % nblk, k0 = 64 * kb, n0 = 32 * nb;
    int nd = n0;
    if (GV_PERM) { const int bj = n0 >= DFF ? 1 : 0, rem = n0 - bj * DFF; nd = 256 * (rem >> 7) + 128 * bj + (rem & 127); }
    {
        f32x4 t[8];
#pragma unroll
        for (int i = 0; i < 8; ++i) t[i] = *(const f32x4*)(W + (size_t)(k0 + 8 * i + (lane >> 3)) * ldw + n0 + 4 * (lane & 7));
#pragma unroll
        for (int i = 0; i < 8; ++i) { LAS float* d = scr + (8 * i + (lane >> 3)) * 33 + 4 * (lane & 7); d[0] = t[i][0]; d[1] = t[i][1]; d[2] = t[i][2]; d[3] = t[i][3]; }
    }
    asm volatile("s_waitcnt lgkmcnt(0)" ::: "memory");
    const int c = lane & 7;
#pragma unroll
    for (int j = 0; j < 4; ++j) { const int n = (lane >> 3) + 8 * j; const LAS float* s = scr + (8 * c) * 33 + n;
        v4u o; o.x = pk2(s[0 * 33], s[1 * 33]); o.y = pk2(s[2 * 33], s[3 * 33]); o.z = pk2(s[4 * 33], s[5 * 33]); o.w = pk2(s[6 * 33], s[7 * 33]);
        *(v4u*)(WT + (size_t)(nd + n) * K + k0 + 8 * c) = o; }
    asm volatile("s_waitcnt lgkmcnt(0)" ::: "memory");
}
__device__ __forceinline__ void stage_wconv(const Params& p, unsigned char* lds, int l_lo, int l_hi, int first = 0) {
    const Ctx cx = mkctx(p, first); const size_t z = cx.z;
    if (l_lo == 0) {
        bf16_t* LT = (bf16_t*)(p.ws + z + WS_LORA);
        for (unsigned i = (unsigned)cx.bid * NTHREADS + cx.tid; i < (unsigned)L * 65536; i += (unsigned)cx.nb * NTHREADS) {
            const int l = i >> 16, e = i & 65535, j = e & 255, ii = e >> 8;
            float v; bf16_t* dst;
            if (ii < 64) { v = PIN(I_W2)[(size_t)l * 16384 + ii * 256 + j]; dst = LT + (size_t)l * 65536 + j * 64 + ii; }
            else if (ii < 128) { v = PIN(I_A2)[(size_t)l * 16384 + (ii - 64) * 256 + j]; dst = LT + (size_t)l * 65536 + 16384 + j * 64 + (ii - 64); }
            else { v = PIN(I_G2)[(size_t)l * 32768 + (ii - 128) * 256 + j]; dst = LT + (size_t)l * 65536 + 32768 + j * 128 + (ii - 128); }
            *dst = f2bf(v);
        }
        bf16_t* WD = (bf16_t*)(p.ws + z + WS_WDTT);
        for (unsigned i = (unsigned)cx.bid * NTHREADS + cx.tid; i < (unsigned)L * 16384; i += (unsigned)cx.nb * NTHREADS) {
            const int l = i >> 14, j = (i >> 10) & 15, k = i & 1023;
            WD[i] = j < 8 ? f2bf(PIN(I_WIN)[(size_t)l * D * PROJ + (size_t)k * PROJ + PCOLS + j]) : (bf16_t)0;
        }
    }
    const int lane = cx.tid & 63, wave = cx.tid >> 6;
    LAS float* scr = (LAS float*)(lds + wave * 16384);
    const int gw = flip_bid(cx) * NWAVES + wave, NGW = cx.nb * NWAVES;
    constexpr int I_IN = 16 * 96, I_OUT = 16 * 32, I_UP = 16 * 176, I_DN = 44 * 32, PER_L = I_IN + I_OUT + I_UP + I_DN;
    for (int it = gw; it < (l_hi - l_lo) * PER_L; it += NGW) {
        const int l = l_lo + it / PER_L; int r = it % PER_L;
        if (r < I_IN) { p0_transpose_item(PIN(I_WIN) + (size_t)l * D * PROJ, PROJ, D, 96, (bf16_t*)(p.ws + z + WS_WIN) + (size_t)l * PCOLS * D, scr, r, lane); continue; } r -= I_IN;
        if (r < I_OUT) { p0_transpose_item(PIN(I_WOUT) + (size_t)l * D * D, D, D, 32, (bf16_t*)(p.ws + z + WS_WOUT) + (size_t)l * D * D, scr, r, lane); continue; } r -= I_OUT;
        if (r < I_UP) { p0_transpose_item<true>(PIN(I_WUP) + (size_t)l * D * 5632, 5632, D, 176, (bf16_t*)(p.ws + z + WS_WUP) + (size_t)l * 5632 * D, scr, r, lane); continue; } r -= I_UP;
        p0_transpose_item(PIN(I_WDOWN) + (size_t)l * DFF * D, D, DFF, 32, (bf16_t*)(p.ws + z + WS_WDN) + (size_t)l * D * DFF, scr, r, lane);
    }
}

template <int NT, class F>
__device__ __forceinline__ void gemm_small(const Params& p, const bf16_t* A, int lda, const bf16_t* Bt, int N, int K, int ksplit, const F& epi) {
    const Ctx cx = mkctx(p); A += cx.z; Bt += cx.z;
    const int lane = cx.tid & 63, wave = __builtin_amdgcn_readfirstlane(cx.tid >> 6), r = lane & 15, q = lane >> 4;
    const int ntile = N / (16 * NT), kc = K / ksplit;
    for (int task = cx.nb - 1 - cx.bid; task < ntile * ksplit; task += cx.nb) {
        const int tn = task % ntile, ks = task / ntile, n0 = tn * 16 * NT, k0 = ks * kc;
        const bf16_t* ap = A + (size_t)(16 * wave + r) * lda + k0 + 8 * q;
        const bf16_t* bp = Bt + (size_t)(n0 + r) * K + k0 + 8 * q;
        f32x4 acc[NT];
#pragma unroll
        for (int nt = 0; nt < NT; ++nt) acc[nt] = (f32x4){0.f, 0.f, 0.f, 0.f};
#pragma unroll 8
        for (int s2 = 0; s2 < kc / 32; ++s2) {
            const bf16x8 fa = *(const bf16x8*)(ap + 32 * s2);
#pragma unroll
            for (int nt = 0; nt < NT; ++nt) { const bf16x8 fb = *(const bf16x8*)(bp + (size_t)nt * 16 * K + 32 * s2); acc[nt] = __builtin_amdgcn_mfma_f32_16x16x32_bf16(fb, fa, acc[nt], 0, 0, 0); }
        }
#pragma unroll
        for (int nt = 0; nt < NT; ++nt) epi(16 * wave + r, n0 + 16 * nt + 4 * q, acc[nt]);
    }
}
struct SmallBf { bf16_t* O; int ldc; __device__ __forceinline__ void operator()(int row, int col, f32x4 v) const { *(bf16x4*)(O + (size_t)(MP + row) * ldc + col) = pack4(v); } };
struct SmallRes { float* X; const float* gate;   __device__ __forceinline__ void operator()(int row, int col, f32x4 v) const {
    const f32x4 g = *(const f32x4*)(gate + (size_t)(NP + row) * 6144 + col); float* x = X + (size_t)(MP + row) * D + col;
#pragma unroll
    for (int e = 0; e < 4; ++e) unsafeAtomicAdd(x + e, g[e] * v[e]); } };

__device__ __forceinline__ void stage_dtgemm(const Params& p, int l) {
    const Ctx cx = mkctx(p); const size_t z = cx.z;
    const int lane = cx.tid & 63, wave = __builtin_amdgcn_readfirstlane(cx.tid >> 6), r = lane & 15, q = lane >> 4;
    const bf16_t* H = (const bf16_t*)(p.ws + z + WS_H); const bf16_t* WD = (const bf16_t*)(p.ws + z + WS_WDTT) + (size_t)l * 16384;
    float* DT = (float*)(p.ws + z + WS_DT);
    for (int task = cx.bid; task < R / 128; task += cx.nb) {
        const int row = task * 128 + 16 * wave + r;
        const bf16_t* hp = H + (size_t)row * D + 8 * q; const bf16_t* wp = WD + r * 1024 + 8 * q;
        f32x4 acc = {0.f, 0.f, 0.f, 0.f};
#pragma unroll 8
        for (int s2 = 0; s2 < 32; ++s2) { const bf16x8 fa = *(const bf16x8*)(hp + 32 * s2), fb = *(const bf16x8*)(wp + 32 * s2); acc = __builtin_amdgcn_mfma_f32_16x16x32_bf16(fb, fa, acc, 0, 0, 0); }
        if (q < 2) *(f32x4*)(DT + (size_t)row * 8 + 4 * q) = acc;
    }
}

#define RLX_AGENT __ATOMIC_RELAXED, __HIP_MEMORY_SCOPE_AGENT
#define XB_TMO      128
#define XB_XCNT(j)  (256  + 64 * (j))
#define XB_XSUB(j)  (1280 + 64 * (j))
#define XB_XGEN(j)  (2304 + 64 * (j))
#define XB_TOP      3328
#define XB_TOPGEN   3392
#define XCD_BAR_WORDS 3456
#define XB_SPIN_CAP (1u << 18)

__device__ __forceinline__ unsigned xb_ld(unsigned* p)              { return __hip_atomic_load(p, __ATOMIC_RELAXED, __HIP_MEMORY_SCOPE_AGENT); }
__device__ __forceinline__ unsigned xb_add(unsigned* p, unsigned v) { return __hip_atomic_fetch_add(p, v, __ATOMIC_RELAXED, __HIP_MEMORY_SCOPE_AGENT); }
__device__ __forceinline__ unsigned xb_xcc_id() { return (unsigned)__builtin_amdgcn_s_getreg((3 << 11) | 20) & 0xFu; }
#define XB_SPIN(cond, bar) do { unsigned _sp = 0; while (cond) { __builtin_amdgcn_s_sleep(1); \
    if ((++_sp & 255u) == 0u) { if (xb_ld(&(bar)[XB_TMO])) break; if (_sp > XB_SPIN_CAP) { atomicAdd(&(bar)[XB_TMO], 1u); break; } } } } while (0)

struct XcdBarrier {
    unsigned* bar; unsigned x; int wave;
    volatile LAS unsigned* st;
};

__device__ __forceinline__ XcdBarrier xcd_barrier_post(unsigned* bar, volatile LAS unsigned* st, int wave) {
    XcdBarrier b; b.bar = bar; b.x = xb_xcc_id(); b.st = st; b.wave = wave;
    if (wave == 0 && lane_id() == 0) (void)xb_add(&bar[XB_XCNT(b.x)], 1u);
    return b;
}
__device__ __forceinline__ void xcd_barrier_complete(unsigned* bar, unsigned x, unsigned& nloc, unsigned& nx) {
    const unsigned G = gridDim.x * gridDim.y * gridDim.z;
    unsigned sum, cnt, mine, sp = 0u;
    for (;;) {
        sum = 0u; cnt = 0u; mine = 0u;
#pragma unroll
        for (unsigned j = 0; j < 16; ++j) { const unsigned c = xb_ld(&bar[XB_XCNT(j)]); sum += c; cnt += (c > 0u) ? 1u : 0u; mine = (j == x) ? c : mine; }
        if (sum == G) break;
        __builtin_amdgcn_s_sleep(1);
        if ((++sp & 255u) == 0u) { if (xb_ld(&bar[XB_TMO])) break; if (sp > XB_SPIN_CAP) { atomicAdd(&bar[XB_TMO], 1u); break; } }
    }
    nloc = mine > 0u ? mine : 1u; nx = cnt > 0u ? cnt : 1u;
}

__device__ __forceinline__ void xcd_barrier(const XcdBarrier& b) {
    asm volatile("s_waitcnt vmcnt(0)" ::: "memory");
    __syncthreads();
    if (b.wave == 0 && lane_id() == 0) {
        unsigned* bar = b.bar;
        __builtin_amdgcn_s_waitcnt(0);
        unsigned nloc = b.st[0], nx = b.st[1];
        if (nloc == 0u) { xcd_barrier_complete(bar, b.x, nloc, nx); b.st[0] = nloc; b.st[1] = nx; }
        const unsigned old = xb_add(&bar[XB_XSUB(b.x)], 1u);
        const unsigned gen = old / nloc;
        if (old + 1u == (gen + 1u) * nloc) {
            __builtin_amdgcn_fence(__ATOMIC_RELEASE, "agent");
            asm volatile("s_waitcnt vmcnt(0)" ::: "memory");
            const unsigned og = xb_add(&bar[XB_TOP], 1u);
            const unsigned tg = og / nx;
            if (og + 1u == (tg + 1u) * nx) xb_add(&bar[XB_TOPGEN], 1u);
            else XB_SPIN(xb_ld(&bar[XB_TOPGEN]) == tg, bar);
            __builtin_amdgcn_fence(__ATOMIC_ACQUIRE, "agent");
            xb_add(&bar[XB_XGEN(b.x)], 1u);
            asm volatile("s_waitcnt vmcnt(0)" ::: "memory");
        } else {
            XB_SPIN(xb_ld(&bar[XB_XGEN(b.x)]) == gen, bar);
            __builtin_amdgcn_fence(__ATOMIC_ACQUIRE, "agent");
            asm volatile("s_waitcnt vmcnt(0)" ::: "memory");
        }
    }
    __syncthreads();
}

namespace cg = cooperative_groups;
constexpr int LDS_BYTES = 153600;
__global__ void __launch_bounds__(NTHREADS, 2) fwd_mega(Params p_in) {
    Params p = p_in; p.wave = __builtin_amdgcn_readfirstlane((int)(threadIdx.x >> 6));
    extern __shared__ __attribute__((aligned(16))) unsigned char lds[];
    cg::grid_group grid = cg::this_grid();
    float* ldsf = (float*)lds;
    volatile LAS unsigned* MISC = (volatile LAS unsigned*)((LAS unsigned char*)lds + LDS_BYTES - 64);
    if (p.wave == 0 && lane_id() < 16) MISC[lane_id()] = 0u;
    __syncthreads();
    const XcdBarrier bar = xcd_barrier_post((unsigned*)(p.ws + WS_CTL), MISC, p.wave);
#define GSYNC() xcd_barrier(bar)
    stage_init(p); stage_wconv(p, lds, 0, 1); __syncthreads(); stage_mod(p, lds, 0, L); grid.sync();
    for (int l = 0; l < L; ++l) {
        const float* MODl = (const float*)(p.ws + WS_MOD) + (size_t)l * NSEQ * 6144;
        if (l > 0) stage_norm_b(p, l, 0);
        stage_norm(p, l, 0, ldsf, l == 0); GSYNC();
        { pg8::Gemm g{(const bf16_t*)(p.ws + WS_H), (const bf16_t*)(p.ws + WS_WIN) + (size_t)l * PCOLS * D, MP, PCOLS, D}; pg8::StaticOrder S; S.init(MP, PCOLS, (int)gridDim.x, (int)blockIdx.x);
          pg8::EpiBf16<0> E{(bf16_t*)(p.ws + WS_P), PCOLS, nullptr, 0, 0, 1.f};
          pg8::gemm_phase<pg8::EpiBf16<0>, pg8::StaticOrder, true, true>((LAS unsigned char*)lds, g, S, E, (p.wave << 6) | lane_id()); }
        gemm_small<2>(p, (const bf16_t*)(p.ws + WS_H) + (size_t)MP * D, D, (const bf16_t*)(p.ws + WS_WIN) + (size_t)l * PCOLS * D, PCOLS, D, 1, SmallBf{(bf16_t*)(p.ws + WS_P), PCOLS});
        stage_dtgemm(p, l);
        GSYNC();
        stage_rwprep(p, l, ldsf); __syncthreads(); stage_rwprep2(p, l, lds); asm volatile("s_waitcnt vmcnt(0)" ::: "memory"); __syncthreads();
        stage_rw1(p, l, lds); stage_mconv(p, l); stage_qkn(p, l); stage_ssd1(p, l, lds); GSYNC();
        stage_rw2(p, l, lds); stage_ssd2(p, l); stage_att(p, l, RW2_WGS); stage_rwscan(p, l, ldsf, RW2_WGS); stage_mscan(p, l, ldsf, RW2_WGS);
        if (l + 1 < L) { __syncthreads(); stage_wconv(p, lds, l + 1, l + 2, RW2_WGS); }
        GSYNC();
        stage_ssd3(p, l, lds, 0, 128); stage_rw3(p, l, 128); stage_attn(p, l, lds, 128); stage_mgate_sample(p, l, 128); GSYNC();
        { pg8::Gemm g{(const bf16_t*)(p.ws + WS_YCAT), (const bf16_t*)(p.ws + WS_WOUT) + (size_t)l * D * D, MP, D, D}; pg8::StaticOrder S; S.init(MP, D, (int)gridDim.x, (int)blockIdx.x);
          pg8::EpiResGate E{p.out, p.in[I_XP], (bf16_t*)(p.ws + WS_XB), MODl + 2048, l == 0, 0, 13, 6144};
          pg8::gemm_phase<pg8::EpiResGate, pg8::StaticOrder, true, true>((LAS unsigned char*)lds, g, S, E, (p.wave << 6) | lane_id()); }
        gemm_small<1>(p, (const bf16_t*)(p.ws + WS_YCAT) + (size_t)MP * D, D, (const bf16_t*)(p.ws + WS_WOUT) + (size_t)l * D * D, D, D, 4, SmallRes{p.out, MODl + 2048});
        GSYNC();
        stage_norm_b(p, l, 1); stage_norm(p, l, 1, ldsf, false); GSYNC();
        { pg8::Gemm g{(const bf16_t*)(p.ws + WS_H), (const bf16_t*)(p.ws + WS_WUP) + (size_t)l * 5632 * D, MPAD, 5632, D}; pg8::StaticOrder S; S.init(MPAD, 5632, (int)gridDim.x, (int)blockIdx.x);
          pg8::EpiGlu E{(bf16_t*)(p.ws + WS_GV), (bf16_t*)(p.ws + WS_U), p.in[I_FCW] + (size_t)l * 3 * DFF, p.in[I_FCB] + (size_t)l * DFF};
          pg8::gemm_phase<pg8::EpiGlu, pg8::StaticOrder, true, true>((LAS unsigned char*)lds, g, S, E, (p.wave << 6) | lane_id()); }
        stage_cachecopy(p, l, 150);
        GSYNC();
        stage_glu(p, l); GSYNC();
        { pg8::Gemm g{(const bf16_t*)(p.ws + WS_U), (const bf16_t*)(p.ws + WS_WDN) + (size_t)l * D * DFF, MP, D, DFF}; pg8::StaticOrder S; S.init(MP, D, (int)gridDim.x, (int)blockIdx.x);
          pg8::EpiResGate E{p.out, p.in[I_XP], (bf16_t*)(p.ws + WS_XB), MODl + 5120, 0, l == L - 1, 13, 6144};
          pg8::gemm_phase<pg8::EpiResGate, pg8::StaticOrder, true, true>((LAS unsigned char*)lds, g, S, E, (p.wave << 6) | lane_id()); }
        gemm_small<1>(p, (const bf16_t*)(p.ws + WS_U) + (size_t)MP * DFF, DFF, (const bf16_t*)(p.ws + WS_WDN) + (size_t)l * D * DFF, D, DFF, 4, SmallRes{p.out, MODl + 5120});
        GSYNC();
    }
}

extern "C" void kernel_launch(void* const* d_in, const int* in_sizes, int n_in, void* d_out, int out_size, void* d_ws, size_t ws_size, hipStream_t stream) {
    static int grid = 0;
    if (grid == 0) {
        if (n_in != N_IN || (size_t)out_size != O_END || ws_size < WS_END) { fprintf(stderr, "kernel_launch: unexpected sizes n_in %d out %d ws %zu\n", n_in, out_size, ws_size); grid = -1; return; }
        int dev = 0, cus = 0, per_cu = 0;
        hipGetDevice(&dev); hipDeviceGetAttribute(&cus, hipDeviceAttributeMultiprocessorCount, dev);
        if (hipFuncSetAttribute((const void*)fwd_mega, hipFuncAttributeMaxDynamicSharedMemorySize, LDS_BYTES) != hipSuccess) { fprintf(stderr, "hipFuncSetAttribute failed\n"); grid = -1; return; }
        hipOccupancyMaxActiveBlocksPerMultiprocessor(&per_cu, (const void*)fwd_mega, NTHREADS, LDS_BYTES);
        if (per_cu < 1) { fprintf(stderr, "occupancy query says %d blocks per CU\n", per_cu); grid = -1; return; }
        grid = cus;
    }
    if (grid < 0) return;
    Params p{};
    for (int i = 0; i < N_IN; ++i) p.in[i] = (const float*)d_in[i];
    p.out = (float*)d_out; p.ws = (unsigned char*)d_ws;
    if (hipMemsetAsync((char*)d_ws + WS_CTL, 0, 16384, stream) != hipSuccess) { fprintf(stderr, "memset of the barrier words failed\n"); return; }
    void* args[] = {&p};
    hipError_t e = hipLaunchCooperativeKernel((void*)fwd_mega, dim3(grid), dim3(NTHREADS), args, LDS_BYTES, stream);
    if (e != hipSuccess) fprintf(stderr, "cooperative launch failed: %s\n", hipGetErrorString(e));
}
```
